# Optimizing an MI355X kernel written in HIP

```python
import jax, jax.numpy as jnp
from jax import lax
import numpy as np

D_MODEL = 2048
BATCH = 2
SEQ = 4096
DEPTH = 2
DEC_BATCH = 128
DEC_SEQ = 1
PAST_LEN = 8192
PAGE_SIZE = 128

GLA_HEADS = 4
GLA_DK = 256
GLA_DV = 512
GLA_KEY = GLA_HEADS * GLA_DK
GLA_VAL = GLA_HEADS * GLA_DV
GLA_RANK = 16
GLA_GATE_NORM = 16.0
GLA_CHUNK = 16
GM_WIDTH = 1024
GM_GROUPS = 4
GM_GW = GM_WIDTH // GM_GROUPS
GM_CHUNK = 128
SWA_HQ = 16
SWA_HKV = 4
SWA_G = SWA_HQ // SWA_HKV
SWA_HD = 64
WINDOW = 128
FFN_HIDDEN = ((8 * D_MODEL // 3 + 255) // 256) * 256
N_BRANCH = 3
IN_WIDTHS = (GLA_KEY, GLA_KEY, GLA_VAL, GLA_VAL, GLA_RANK,
             GM_WIDTH, GM_WIDTH,
             SWA_HQ * SWA_HD, SWA_HKV * SWA_HD, SWA_HKV * SWA_HD,
             N_BRANCH * D_MODEL)
IN_WIDTH = sum(IN_WIDTHS)
EPS = 1e-6
NEG_BIG = -1e30

kernel_name = "hybrid_gla_gmlp_swa_adaln_step"


def _split_points():
    return [int(v) for v in np.cumsum(np.array(IN_WIDTHS))[:-1]]


def _rmsnorm(x, w):
    xf = x.astype(jnp.float32)
    y = xf * lax.rsqrt(jnp.mean(xf * xf, axis=-1, keepdims=True) + EPS)
    return (y * w.astype(jnp.float32)).astype(x.dtype)


def _layernorm(x, w, b):
    xf = x.astype(jnp.float32)
    mu = jnp.mean(xf, axis=-1, keepdims=True)
    var = jnp.mean(jnp.square(xf - mu), axis=-1, keepdims=True)
    y = (xf - mu) * lax.rsqrt(var + EPS)
    return (y * w.astype(jnp.float32) + b.astype(jnp.float32)).astype(x.dtype)


def _alibi_slopes():
    return jnp.exp2(-8.0 * jnp.arange(1, SWA_HQ + 1, dtype=jnp.float32) / SWA_HQ)


def _gla_chunked(q, k, v, gk, s0):
    B, T, H, _ = q.shape
    C = min(GLA_CHUNK, T)
    N = T // C

    def blocks(a):
        return a.astype(jnp.float32).reshape(B, N, C, H, a.shape[-1]).transpose(1, 0, 3, 2, 4)

    causal = jnp.tril(jnp.ones((C, C), dtype=bool))

    def step(S, inp):
        qc, kc, vc, gc = inp
        b = jnp.cumsum(gc, axis=-2)
        bl = b[:, :, -1:, :]
        q_in = qc * jnp.exp(b)
        a = jnp.einsum('bhtd,bhsd->bhts', q_in, kc * jnp.exp(-b))
        a = jnp.where(causal, a, 0.0)
        o = jnp.einsum('bhts,bhsv->bhtv', a, vc) + jnp.einsum('bhtd,bhdv->bhtv', q_in, S)
        S = jnp.exp(bl[:, :, 0, :])[..., None] * S + jnp.einsum('bhsd,bhsv->bhdv', kc * jnp.exp(bl - b), vc)
        return S, o

    S, o = lax.scan(step, s0.astype(jnp.float32), (blocks(q), blocks(k), blocks(v), blocks(gk)))
    o = o.transpose(1, 0, 3, 2, 4).reshape(B, T, H, GLA_DV)
    return o.astype(v.dtype), S


def _gla_recurrent(q, k, v, gk, s0):
    def step(S, inp):
        qt, kt, vt, gt = inp
        S = jnp.exp(gt)[..., None] * S + kt[..., None] * vt[..., None, :]
        return S, jnp.einsum('bhd,bhdv->bhv', qt, S)

    xs = tuple(a.astype(jnp.float32).transpose(1, 0, 2, 3) for a in (q, k, v, gk))
    S, o = lax.scan(step, s0.astype(jnp.float32), xs)
    return o.transpose(1, 0, 2, 3).astype(v.dtype), S


def _spatial_gate(u, v, ws, bs, nw, nb):
    B, T, _ = u.shape
    C = min(GM_CHUNK, T)
    N = T // C
    u = jax.nn.gelu(u)
    v = _layernorm(jax.nn.gelu(v), nw, nb)
    vb = v.reshape(B, N, C, GM_GROUPS, GM_GW)
    w_m = jnp.where(jnp.tril(jnp.ones((C, C), dtype=bool)), ws[:, :C, :C], 0.0)
    mixed = jnp.einsum('gts,bnsgc->bntgc', w_m, vb) + bs[:, :C].T[None, None, :, :, None]
    return u * mixed.reshape(B, T, GM_WIDTH), v


def _sink_attention(q, k, v, dist, valid, sinks):
    slopes = _alibi_slopes().reshape(SWA_HKV, SWA_G)[None, None, :, :, None, None]
    s = jnp.einsum('bnqkgd,bnskd->bnkgqs', q, k).astype(jnp.float32) * (SWA_HD ** -0.5)
    s = s - slopes * dist.astype(jnp.float32)[None, :, None, None]
    s = jnp.where(valid[None, :, None, None], s, NEG_BIG)
    sink = sinks.astype(jnp.float32).reshape(SWA_HKV, SWA_G)[None, None, :, :, None, None]
    m = jnp.maximum(jnp.max(s, axis=-1, keepdims=True), sink)
    p = jnp.exp(s - m)
    probs = p / (jnp.sum(p, axis=-1, keepdims=True) + jnp.exp(sink - m))
    return jnp.einsum('bnkgqs,bnskd->bnqkgd', probs.astype(v.dtype), v)


def _swa_prompt(q, k, v, sinks):
    B, T = q.shape[:2]
    W = WINDOW
    N = T // W
    qb = q.reshape(B, N, W, SWA_HKV, SWA_G, SWA_HD)
    kb = k.reshape(B, N, W, SWA_HKV, SWA_HD)
    vb = v.reshape(B, N, W, SWA_HKV, SWA_HD)
    kcat = jnp.concatenate([jnp.concatenate([jnp.zeros_like(kb[:, :1]), kb[:, :-1]], axis=1), kb], axis=2)
    vcat = jnp.concatenate([jnp.concatenate([jnp.zeros_like(vb[:, :1]), vb[:, :-1]], axis=1), vb], axis=2)
    i = jnp.arange(W)[:, None]
    j = jnp.arange(2 * W)[None, :]
    dist = (W + i - j)[None]
    keypos = jnp.arange(N)[:, None, None] * W - W + j[None]
    valid = (dist >= 0) & (dist < WINDOW) & (keypos >= 0)
    o = _sink_attention(qb, kcat, vcat, dist, valid, sinks)
    return o.reshape(B, T, SWA_HQ * SWA_HD)


def _swa_sample(q, k, v, kbuf, vbuf, sinks):
    B, S = q.shape[:2]
    Wb = kbuf.shape[1]
    kcat = jnp.concatenate([kbuf.astype(k.dtype), k], axis=1)[:, None]
    vcat = jnp.concatenate([vbuf.astype(v.dtype), v], axis=1)[:, None]
    qb = q.reshape(B, 1, S, SWA_HKV, SWA_G, SWA_HD)
    dist = (jnp.arange(S)[:, None] + Wb - jnp.arange(Wb + S)[None, :])[None]
    valid = (dist >= 0) & (dist < WINDOW)
    o = _sink_attention(qb, kcat, vcat, dist, valid, sinks)
    return o.reshape(B, S, SWA_HQ * SWA_HD)


def _mixer_block(h, p, gla_s0, kbuf, vbuf):
    B, T, _ = h.shape
    z = h @ p['w_in']
    qa, ka, va, ga, lra, ub, vb, qc, kc, vc, gates = jnp.split(z, _split_points(), axis=-1)
    gk = jax.nn.log_sigmoid(lra @ p['w_gk2'] + p['b_gk']) / GLA_GATE_NORM
    qa = qa.reshape(B, T, GLA_HEADS, GLA_DK) * (GLA_DK ** -0.5)
    ka = ka.reshape(B, T, GLA_HEADS, GLA_DK)
    va = va.reshape(B, T, GLA_HEADS, GLA_DV)
    gk = gk.reshape(B, T, GLA_HEADS, GLA_DK)
    if gla_s0 is None:
        s0 = jnp.zeros((B, GLA_HEADS, GLA_DK, GLA_DV), jnp.float32)
        oa, s_new = _gla_chunked(qa, ka, va, gk, s0)
    else:
        oa, s_new = _gla_recurrent(qa, ka, va, gk, gla_s0)
    oa = _rmsnorm(oa, p['gla_norm_w']) * jax.nn.silu(ga.reshape(B, T, GLA_HEADS, GLA_DV))
    oa = oa.reshape(B, T, GLA_VAL)
    ob, v_gm = _spatial_gate(ub, vb, p['gm_ws'], p['gm_bs'], p['gm_norm_w'], p['gm_norm_b'])
    qc = qc.reshape(B, T, SWA_HQ, SWA_HD)
    kc = kc.reshape(B, T, SWA_HKV, SWA_HD)
    vc = vc.reshape(B, T, SWA_HKV, SWA_HD)
    if kbuf is None:
        oc = _swa_prompt(qc, kc, vc, p['swa_sinks'])
        keep = min(WINDOW, T)
        k_rows, v_rows = kc[:, T - keep:], vc[:, T - keep:]
    else:
        oc = _swa_sample(qc, kc, vc, kbuf, vbuf, p['swa_sinks'])
        k_rows, v_rows = kc, vc
    g_a, g_b, g_c = jnp.split(jax.nn.sigmoid(gates), N_BRANCH, axis=-1)
    merged = g_a * (oa @ p['w_pa']) + g_b * (ob @ p['w_pb']) + g_c * (oc @ p['w_pc'])
    return merged @ p['w_o'], s_new, k_rows, v_rows, v_gm


def _layer(x, c, p, gla_s0, kbuf, vbuf):
    mod = (jax.nn.silu(c) @ p['w_ada'] + p['b_ada'])[:, None, :]
    sh1, sc1, g1, sh2, sc2, g2 = jnp.split(mod, 6, axis=-1)
    h = _rmsnorm(x, p['norm1_w']) * (1.0 + sc1) + sh1
    mix, s_new, k_rows, v_rows, v_gm = _mixer_block(h, p, gla_s0, kbuf, vbuf)
    x = x + g1 * mix
    h2 = _rmsnorm(x, p['norm2_w']) * (1.0 + sc2) + sh2
    a, b = jnp.split(h2 @ p['w_ffn_in'], 2, axis=-1)
    x = x + g2 * ((jax.nn.silu(a) * b) @ p['w_ffn_out'])
    return x, s_new, k_rows, v_rows, v_gm


def setup_inputs(seed: int = 0) -> dict:
    key = jax.random.key(seed)
    ks = jax.random.split(key, 32)

    def nrm(k, shape, scale):
        return jax.random.normal(k, shape, jnp.float32) * scale

    D = D_MODEL
    wb = min(WINDOW, PAST_LEN)
    return {
        'x_prompt': nrm(ks[0], (BATCH, SEQ, D), 1.0),
        'x_sample': nrm(ks[1], (DEC_BATCH, DEC_SEQ, D), 1.0),
        'c_prompt': nrm(ks[2], (BATCH, D), 1.0),
        'c_sample': nrm(ks[3], (DEC_BATCH, D), 1.0),
        'state_gla': nrm(ks[4], (DEPTH, DEC_BATCH, GLA_HEADS, GLA_DK, GLA_DV), 0.5),
        'cache_swa_k': nrm(ks[5], (DEPTH, DEC_BATCH, wb, SWA_HKV, SWA_HD), 1.0),
        'cache_swa_v': nrm(ks[6], (DEPTH, DEC_BATCH, wb, SWA_HKV, SWA_HD), 1.0),
        'w_ada': nrm(ks[7], (DEPTH, D, 6 * D), 0.5 * D ** -0.5),
        'b_ada': nrm(ks[8], (DEPTH, 6 * D), 0.01),
        'norm1_w': 1.0 + nrm(ks[9], (DEPTH, D), 0.02),
        'norm2_w': 1.0 + nrm(ks[10], (DEPTH, D), 0.02),
        'w_in': nrm(ks[11], (DEPTH, D, IN_WIDTH), D ** -0.5),
        'w_gk2': nrm(ks[12], (DEPTH, GLA_RANK, GLA_KEY), GLA_RANK ** -0.5),
        'b_gk': nrm(ks[13], (DEPTH, GLA_KEY), 0.01),
        'gla_norm_w': 1.0 + nrm(ks[14], (DEPTH, GLA_DV), 0.02),
        'gm_norm_w': 1.0 + nrm(ks[15], (DEPTH, GM_WIDTH), 0.02),
        'gm_norm_b': nrm(ks[16], (DEPTH, GM_WIDTH), 0.01),
        'gm_ws': nrm(ks[17], (DEPTH, GM_GROUPS, GM_CHUNK, GM_CHUNK), 0.5 * GM_CHUNK ** -0.5),
        'gm_bs': 1.0 + nrm(ks[18], (DEPTH, GM_GROUPS, GM_CHUNK), 0.02),
        'swa_sinks': nrm(ks[19], (DEPTH, SWA_HQ), 1.0),
        'w_pa': nrm(ks[20], (DEPTH, GLA_VAL, D), GLA_VAL ** -0.5),
        'w_pb': nrm(ks[21], (DEPTH, GM_WIDTH, D), GM_WIDTH ** -0.5),
        'w_pc': nrm(ks[22], (DEPTH, SWA_HQ * SWA_HD, D), (SWA_HQ * SWA_HD) ** -0.5),
        'w_o': nrm(ks[23], (DEPTH, D, D), D ** -0.5),
        'w_ffn_in': nrm(ks[24], (DEPTH, D, 2 * FFN_HIDDEN), D ** -0.5),
        'w_ffn_out': nrm(ks[25], (DEPTH, FFN_HIDDEN, D), FFN_HIDDEN ** -0.5),
        'final_norm_w': 1.0 + nrm(ks[26], (D,), 0.02),
    }


def reference(x_prompt, x_sample, c_prompt, c_sample, state_gla, cache_swa_k, cache_swa_v,
              w_ada, b_ada, norm1_w, norm2_w, w_in, w_gk2, b_gk, gla_norm_w, gm_norm_w, gm_norm_b,
              gm_ws, gm_bs, swa_sinks, w_pa, w_pb, w_pc, w_o, w_ffn_in, w_ffn_out, final_norm_w):
    xp, xs = x_prompt, x_sample
    gla_p, gla_s, kp, vp, ksm, vsm, gmv_s = [], [], [], [], [], [], []
    for l in range(DEPTH):
        p = {'w_ada': w_ada[l], 'b_ada': b_ada[l], 'norm1_w': norm1_w[l], 'norm2_w': norm2_w[l],
             'w_in': w_in[l], 'w_gk2': w_gk2[l], 'b_gk': b_gk[l], 'gla_norm_w': gla_norm_w[l],
             'gm_norm_w': gm_norm_w[l], 'gm_norm_b': gm_norm_b[l], 'gm_ws': gm_ws[l], 'gm_bs': gm_bs[l],
             'swa_sinks': swa_sinks[l], 'w_pa': w_pa[l], 'w_pb': w_pb[l], 'w_pc': w_pc[l], 'w_o': w_o[l],
             'w_ffn_in': w_ffn_in[l], 'w_ffn_out': w_ffn_out[l]}
        xp, s_p, k_p, v_p, _ = _layer(xp, c_prompt, p, None, None, None)
        xs, s_s, k_s, v_s, gv_s = _layer(xs, c_sample, p, state_gla[l], cache_swa_k[l], cache_swa_v[l])
        gla_p.append(s_p)
        gla_s.append(s_s)
        kp.append(k_p)
        vp.append(v_p)
        ksm.append(k_s)
        vsm.append(v_s)
        gmv_s.append(gv_s)
    y_prompt = _rmsnorm(xp, final_norm_w)
    y_sample = _rmsnorm(xs, final_norm_w)
    state_gla_prompt = jnp.stack(gla_p, axis=0)
    state_gla_sample = jnp.stack(gla_s, axis=0)
    cache_swa_k_prompt = jnp.stack(kp, axis=0)
    cache_swa_v_prompt = jnp.stack(vp, axis=0)
    cache_swa_k_sample = jnp.stack(ksm, axis=0)
    cache_swa_v_sample = jnp.stack(vsm, axis=0)
    state_gmlp_v_sample = jnp.stack(gmv_s, axis=0)
    return (y_prompt, y_sample, state_gla_prompt, state_gla_sample, cache_swa_k_prompt, cache_swa_v_prompt,
            cache_swa_k_sample, cache_swa_v_sample, state_gmlp_v_sample)
```

```cpp
#include <hip/hip_runtime.h>
#include <cstdio>
#include <cstdint>
namespace pg8 {
#define PG8_LAS __attribute__((address_space(3)))
typedef unsigned short bf16_t;
typedef short bf16x8 __attribute__((ext_vector_type(8)));
typedef float f32x4 __attribute__((ext_vector_type(4)));
typedef unsigned u32x4 __attribute__((ext_vector_type(4)));
constexpr int BM = 256, BK = 64, HALF = 128, HTB = HALF * BK * 2  , STAGE_BYTES = 8 * HTB, NXCD = 8, WGM = 8;

__host__ __device__ __forceinline__ int lds_byte(int r, int c) { const int st = (r >> 4) * 2 + (c >> 5), rr = r & 15, cc = c & 31, ob = rr * 64 + cc * 2; return st * 1024 + (ob ^ (((ob >> 9) & 1) << 5)); }
__host__ __device__ __forceinline__ void stage_rc(int b, int& R, int& C) { const int st = b / 1024, sb = b % 1024, swz = sb ^ (((sb >> 9) & 1) << 5); R = (st >> 1) * 16 + swz / 64; C = (st & 1) * 32 + (swz % 64) / 2; }
__host__ __device__ __forceinline__ int perm32(int rho) { const int n = rho >> 4, i = rho & 15; return 8 * (i >> 2) + 4 * n + (i & 3); }

__device__ __forceinline__ f32x4 zero4() { float z; asm volatile("v_mov_b32 %0, 0" : "=v"(z)); return (f32x4){z, z, z, z}; }
struct Unit { int pm, pn, kt0, nt; };
struct Gemm { const bf16_t* A; const bf16_t* Bt; int M, N, K, ld; };

struct StaticOrder {
    int nM, nN, nwg, G, c, ntf;
    __host__ __device__ __forceinline__ void init(int M, int N, int G_, int c_, int K) { nM = M / BM; nN = N / BM; nwg = nM * nN; G = G_; c = c_; ntf = K / BK; }
    __host__ __device__ __forceinline__ bool next(int i, Unit& u) const {
        const long L = (long)i * G + c; if (L >= nwg) return false;
        int wgid = (int)L; { const int q = nwg / NXCD, r = nwg % NXCD, xcd = wgid % NXCD, off = wgid / NXCD; wgid = (xcd < r ? xcd * (q + 1) : r * (q + 1) + (xcd - r) * q) + off; }
        const int nig = WGM * nN, gid = wgid / nig, fm = gid * WGM, gsz = (nM - fm) < WGM ? (nM - fm) : WGM;
        u.pm = fm + ((wgid % nig) % gsz); u.pn = (wgid % nig) / gsz; u.kt0 = 0; u.nt = ntf; return true;
    }
    __device__ __forceinline__ void a_ready(const Unit&) const {}
    __device__ __forceinline__ void done(const Unit&) const {}
};
struct MiniOrder {
    StaticOrder main; int nmini, ntm;
    __host__ __device__ __forceinline__ void init(int G_, int c_, int K, int ntm_, int var = 0) { main.init(32 * BM, 2048, G_, c_, K); ntm = ntm_; nmini = (var & 4) ? 0 : 8 * ((K / BK) / ntm_); }
    __host__ __device__ __forceinline__ bool next(int i, Unit& u) const {
        const bool has_mini = main.c < nmini;
        if (has_mini && i == 0) { const int m = main.c; u.pm = 32; u.pn = m & 7; u.kt0 = ntm * (m >> 3); u.nt = ntm; return true; }
        return main.next(has_mini ? i - 1 : i, u);
    }
    __device__ __forceinline__ void a_ready(const Unit&) const {}
    __device__ __forceinline__ void done(const Unit&) const {}
};


__device__ __forceinline__ unsigned cvt_pk_bf16(float lo, float hi) { unsigned r; asm volatile("v_cvt_pk_bf16_f32 %0, %1, %2" : "=v"(r) : "v"(lo), "v"(hi)); return r; }
typedef float f32x2 __attribute__((ext_vector_type(2)));
__device__ __forceinline__ f32x2 gelu_pk(f32x2 v) {
    const f32x2 av = __builtin_elementwise_abs(v), d = av * 0.2316418882f + 1.0f;
    f32x2 t; t.x = __builtin_amdgcn_rcpf(d.x); t.y = __builtin_amdgcn_rcpf(d.y);
    f32x2 q = t * 0.5307027145f + (-0.7265760135f); q = q * t + 0.7107068705f; q = q * t + (-0.142248368f); q = q * t + 0.127414796f; q = q * t;
    const f32x2 s = (v * v) * (-0.72134752044f);
    f32x2 e; e.x = __builtin_amdgcn_exp2f(s.x); e.y = __builtin_amdgcn_exp2f(s.y);
    const f32x2 m = v * (q * e), r = v - m;
    f32x2 o; o.x = v.x < 0.f ? m.x : r.x; o.y = v.y < 0.f ? m.y : r.y; return o;
}

template <int ACT  > struct EpiBf16 {
    static constexpr bool PERM = true, AFTER_DRAIN = false, HAS_HOOK = false; static_assert(ACT == 0 || ACT == 1, "EpiBf16: ACT is 0 (none) or 1 (gelu_pk)");
    bf16_t* O; int ldc; const float* bias; int split_cols; size_t split_stride; float scale0;
    __device__ __forceinline__ void operator()(const f32x4 (&acc)[2][2][4][2], const Unit& u, int wr, int wc, int fr, int fq) const {
        const int row0 = u.pm * BM + wr * 64 + fr; int colt = u.pn * BM; bf16_t* base = O;
        float sc = 1.f; if (split_cols) { const int t = colt / split_cols; base += (size_t)t * split_stride; colt -= t * split_cols; if (t == 0) sc = scale0; }
        const int col0 = colt + wc * 32 + 8 * fq, bcol0 = u.pn * BM + wc * 32 + 8 * fq;
        f32x4 bv[2][2];
#pragma unroll
        for (int bj = 0; bj < 2; ++bj)
#pragma unroll
            for (int n = 0; n < 2; ++n) bv[bj][n] = bias ? *(const f32x4*)(bias + bcol0 + bj * HALF + 4 * n) : (f32x4){0.f, 0.f, 0.f, 0.f};
#pragma unroll
        for (int ai = 0; ai < 2; ++ai)
#pragma unroll
            for (int m = 0; m < 4; ++m) { bf16_t* rowp = base + (size_t)(row0 + ai * HALF + m * 16) * ldc + col0;
#pragma unroll
                for (int bj = 0; bj < 2; ++bj) { f32x4 v0 = acc[ai][bj][m][0] + bv[bj][0], v1 = acc[ai][bj][m][1] + bv[bj][1];
                    if (ACT == 1) { f32x2 a = gelu_pk((f32x2){v0[0], v0[1]}), b = gelu_pk((f32x2){v0[2], v0[3]}), c = gelu_pk((f32x2){v1[0], v1[1]}), d = gelu_pk((f32x2){v1[2], v1[3]});
                        v0 = (f32x4){a.x, a.y, b.x, b.y}; v1 = (f32x4){c.x, c.y, d.x, d.y}; }
                    v0 = v0 * sc; v1 = v1 * sc; u32x4 w; w.x = cvt_pk_bf16(v0[0], v0[1]); w.y = cvt_pk_bf16(v0[2], v0[3]); w.z = cvt_pk_bf16(v1[0], v1[1]); w.w = cvt_pk_bf16(v1[2], v1[3]);
                    *(u32x4*)(rowp + bj * HALF) = w; } }
    }
};
struct EpiF32 {
    static constexpr bool PERM = false, AFTER_DRAIN = false, HAS_HOOK = false;
    float* C; int ldc; const float* bias;
    __device__ __forceinline__ void operator()(const f32x4 (&acc)[2][2][4][2], const Unit& u, int wr, int wc, int fr, int fq) const {
        const int row0 = u.pm * BM + wr * 64 + fr, col0 = u.pn * BM + wc * 32 + 4 * fq;
        f32x4 bv[2][2];
#pragma unroll
        for (int bj = 0; bj < 2; ++bj)
#pragma unroll
            for (int n = 0; n < 2; ++n) bv[bj][n] = bias ? *(const f32x4*)(bias + col0 + bj * HALF + n * 16) : (f32x4){0.f, 0.f, 0.f, 0.f};
#pragma unroll
        for (int ai = 0; ai < 2; ++ai)
#pragma unroll
            for (int m = 0; m < 4; ++m) { float* rowp = C + (size_t)(row0 + ai * HALF + m * 16) * ldc + col0;
#pragma unroll
                for (int bj = 0; bj < 2; ++bj)
#pragma unroll
                    for (int n = 0; n < 2; ++n) *(f32x4*)(rowp + bj * HALF + n * 16) = acc[ai][bj][m][n] + bv[bj][n]; }
    }
};
__device__ __forceinline__ float bf_lo(unsigned w) { return __uint_as_float(w << 16); }
__device__ __forceinline__ float bf_hi(unsigned w) { return __uint_as_float(w & 0xffff0000u); }
__device__ __forceinline__ float fsigmoid(float x) { return __builtin_amdgcn_rcpf(1.0f + __expf(-x)); }
__device__ __forceinline__ float fsilu(float x) { return x * fsigmoid(x); }
__device__ __forceinline__ int batch_of_row(int row) { return row < 4096 ? 0 : (row < 8192 ? 1 : (row - 8192 < 128 ? row - 8190 : 129)); }
typedef unsigned u32x2 __attribute__((ext_vector_type(2)));

struct EpiZ {
    static constexpr bool PERM = true, AFTER_DRAIN = false, HAS_HOOK = false;
    bf16_t* O; int ldc; int gate_pn0; int var;
    __device__ __forceinline__ void operator()(const f32x4 (&acc)[2][2][4][2], const Unit& u, int wr, int wc, int fr, int fq) const {
        if (var & 1) return;
        const int row0 = u.pm * BM + wr * 64 + fr, col0 = u.pn * BM + wc * 32 + 8 * fq; const bool gt = (u.pn >= gate_pn0) && !(var & 2);
#pragma unroll
        for (int ai = 0; ai < 2; ++ai)
#pragma unroll
            for (int m = 0; m < 4; ++m) { bf16_t* rowp = O + (size_t)(row0 + ai * HALF + m * 16) * ldc + col0;
#pragma unroll
                for (int bj = 0; bj < 2; ++bj) { f32x4 v0 = acc[ai][bj][m][0], v1 = acc[ai][bj][m][1];
                    if (gt) {
#pragma unroll
                        for (int j = 0; j < 4; ++j) { v0[j] = 1.0f + __expf(-fminf(fmaxf(v0[j], -40.f), 40.f)); v1[j] = 1.0f + __expf(-fminf(fmaxf(v1[j], -40.f), 40.f)); } }
                    u32x4 w; w.x = cvt_pk_bf16(v0[0], v0[1]); w.y = cvt_pk_bf16(v0[2], v0[3]); w.z = cvt_pk_bf16(v1[0], v1[1]); w.w = cvt_pk_bf16(v1[2], v1[3]);
                    *(u32x4*)(rowp + bj * HALF) = w; } }
    }
};
struct EpiProjR {
    static constexpr bool PERM = false, AFTER_DRAIN = false, HAS_HOOK = true;
    const bf16_t* Z; int ldz; int gcol0; float* PART; bf16_t* MG; int mp0; int var;
    __device__ __forceinline__ bool hook_at(const Unit& u, int t) const { return u.nt == 64 && (t == 32 || t == 48) && !(var & 2); }
    __device__ __forceinline__ void hook(f32x4 (&acc)[2][2][4][2], const Unit& u, int t, int wr, int wc, int fr, int fq) const {
        int row0 = u.pm * BM + wr * 64 + fr, col0 = u.pn * BM + wc * 32 + 4 * fq; asm volatile("" : "+v"(row0), "+v"(col0));
        const int gp = gcol0 + (t == 32 ? 0 : 2048);
#pragma unroll
        for (int ai = 0; ai < 2; ++ai) {
            u32x2 gprev[4][4], gnext[4][4];
#pragma unroll
            for (int m = 0; m < 4; ++m) { const bf16_t* zp = Z + (size_t)(row0 + ai * HALF + m * 16) * ldz + gp + col0;
#pragma unroll
                for (int q = 0; q < 4; ++q) { gprev[m][q] = *(const u32x2*)(zp + (q >> 1) * HALF + (q & 1) * 16); gnext[m][q] = *(const u32x2*)(zp + 2048 + (q >> 1) * HALF + (q & 1) * 16); } }
#pragma unroll
            for (int m = 0; m < 4; ++m)
#pragma unroll
                for (int q = 0; q < 4; ++q) { const u32x2 gpv = gprev[m][q], gnx = gnext[m][q];
                    f32x4 r; r[0] = bf_lo(gnx.x) * __builtin_amdgcn_rcpf(bf_lo(gpv.x)); r[1] = bf_hi(gnx.x) * __builtin_amdgcn_rcpf(bf_hi(gpv.x));
                    r[2] = bf_lo(gnx.y) * __builtin_amdgcn_rcpf(bf_lo(gpv.y)); r[3] = bf_hi(gnx.y) * __builtin_amdgcn_rcpf(bf_hi(gpv.y));
                    acc[ai][q >> 1][m][q & 1] = acc[ai][q >> 1][m][q & 1] * r; }
            asm volatile("" ::: "memory"); }
        asm volatile("s_waitcnt vmcnt(0)" ::: "memory");
    }
    __device__ __forceinline__ void operator()(const f32x4 (&acc)[2][2][4][2], const Unit& u, int wr, int wc, int fr, int fq) const {
        if (var & 1) return;
        int row0 = u.pm * BM + wr * 64 + fr, col0 = u.pn * BM + wc * 32 + 4 * fq; asm volatile("" : "+v"(row0), "+v"(col0));
        const bool mini = u.nt != 64; const int br = mini ? (u.kt0 < 32 ? 0 : (u.kt0 < 48 ? 1 : 2)) : 2;
#pragma unroll
        for (int ai = 0; ai < 2; ++ai) {
            u32x2 gw[4][4];
#pragma unroll
            for (int m = 0; m < 4; ++m) { const bf16_t* zp = Z + (size_t)(row0 + ai * HALF + m * 16) * ldz + gcol0 + br * 2048 + col0;
#pragma unroll
                for (int q = 0; q < 4; ++q) gw[m][q] = *(const u32x2*)(zp + (q >> 1) * HALF + (q & 1) * 16); }
#pragma unroll
            for (int m = 0; m < 4; ++m) { const int row = row0 + ai * HALF + m * 16;
#pragma unroll
                for (int q = 0; q < 4; ++q) { const int col = col0 + (q >> 1) * HALF + (q & 1) * 16; const u32x2 gq = gw[m][q];
                    f32x4 g; g[0] = __builtin_amdgcn_rcpf(bf_lo(gq.x)); g[1] = __builtin_amdgcn_rcpf(bf_hi(gq.x)); g[2] = __builtin_amdgcn_rcpf(bf_lo(gq.y)); g[3] = __builtin_amdgcn_rcpf(bf_hi(gq.y));
                    const f32x4 v = acc[ai][q >> 1][m][q & 1] * g;
                    if (!mini) { u32x2 w; w.x = cvt_pk_bf16(v[0], v[1]); w.y = cvt_pk_bf16(v[2], v[3]); *(u32x2*)(MG + (size_t)row * 2048 + col) = w; }
                    else if (ai == 0) *(f32x4*)(PART + ((size_t)(u.kt0 / u.nt) * 128 + (row - mp0)) * 2048 + col) = v; } }
            asm volatile("" ::: "memory"); }
    }
};
struct EpiResid {
    static constexpr bool PERM = false, AFTER_DRAIN = false, HAS_HOOK = false;
    float* X; const float* gate; int ldg; float* PART; int mp0; int var;
    __device__ __forceinline__ void operator()(const f32x4 (&acc)[2][2][4][2], const Unit& u, int wr, int wc, int fr, int fq) const {
        if (var & 1) return;
        int row0 = u.pm * BM + wr * 64 + fr, col0 = u.pn * BM + wc * 32 + 4 * fq; asm volatile("" : "+v"(row0), "+v"(col0)); const bool mini = u.pm >= 32;
#pragma unroll
        for (int ai = 0; ai < 2; ++ai)
#pragma unroll
            for (int mp = 0; mp < 2; ++mp) {
                f32x4 gg[2][4], xx[2][4];
#pragma unroll
                for (int mm = 0; mm < 2; ++mm) { const int row = row0 + ai * HALF + (2 * mp + mm) * 16; const float* gp = gate + (size_t)batch_of_row(row) * ldg + col0; const float* xp = X + (size_t)row * 2048 + col0;
#pragma unroll
                    for (int q = 0; q < 4; ++q) { gg[mm][q] = *(const f32x4*)(gp + (q >> 1) * HALF + (q & 1) * 16); if (!mini) xx[mm][q] = *(const f32x4*)(xp + (q >> 1) * HALF + (q & 1) * 16); } }
#pragma unroll
                for (int mm = 0; mm < 2; ++mm) { const int m = 2 * mp + mm, row = row0 + ai * HALF + m * 16; float* xp = X + (size_t)row * 2048 + col0;
#pragma unroll
                    for (int q = 0; q < 4; ++q) { float* xq = xp + (q >> 1) * HALF + (q & 1) * 16; const f32x4 v = gg[mm][q] * acc[ai][q >> 1][m][q & 1];
                        if (!mini) *(f32x4*)xq = xx[mm][q] + v;
                        else if (ai == 0) *(f32x4*)(PART + ((size_t)(u.kt0 / u.nt) * 128 + (row - mp0)) * 2048 + col0 + (q >> 1) * HALF + (q & 1) * 16) = v; } }
                asm volatile("" ::: "memory"); }
    }
};
struct EpiSwiGLU {
    static constexpr bool PERM = true, AFTER_DRAIN = false, HAS_HOOK = false;
    bf16_t* ACT; int ldc;
    __device__ __forceinline__ void operator()(const f32x4 (&acc)[2][2][4][2], const Unit& u, int wr, int wc, int fr, int fq) const {
        const int row0 = u.pm * BM + wr * 64 + fr, col0 = u.pn * HALF + wc * 32 + 8 * fq;
#pragma unroll
        for (int ai = 0; ai < 2; ++ai)
#pragma unroll
            for (int m = 0; m < 4; ++m) { bf16_t* rowp = ACT + (size_t)(row0 + ai * HALF + m * 16) * ldc + col0;
                const f32x4 a0 = acc[ai][0][m][0], a1 = acc[ai][0][m][1], b0 = acc[ai][1][m][0], b1 = acc[ai][1][m][1];
                u32x4 w; w.x = cvt_pk_bf16(fsilu(a0[0]) * b0[0], fsilu(a0[1]) * b0[1]); w.y = cvt_pk_bf16(fsilu(a0[2]) * b0[2], fsilu(a0[3]) * b0[3]);
                w.z = cvt_pk_bf16(fsilu(a1[0]) * b1[0], fsilu(a1[1]) * b1[1]); w.w = cvt_pk_bf16(fsilu(a1[2]) * b1[2], fsilu(a1[3]) * b1[3]);
                *(u32x4*)rowp = w; }
    }
};
template <class Epi, class Sched, bool ALIGN_EPI = false, bool SP2 = false>
__device__ __forceinline__ void gemm_phase(PG8_LAS unsigned char* lds, const Gemm g, const Sched& S, const Epi& E) {
    int tid_ = threadIdx.x; asm volatile("" : "+v"(tid_));
    const int tid = tid_, wid = __builtin_amdgcn_readfirstlane(tid >> 6), lane = tid & 63, wr = wid >> 2, wc = wid & 3, fr = lane & 15, fq = lane >> 4;
    const int LD = g.ld;
    unsigned voffA[2], voffB[2];
#pragma unroll
    for (int i = 0; i < 2; ++i) { int R, C; stage_rc(tid * 16 + i * 8192, R, C); const int Rb = Epi::PERM ? ((R & ~31) + perm32(R & 31)) : R;
        voffA[i] = (unsigned)(R * LD + C) * 2u; voffB[i] = (unsigned)(Rb * LD + C) * 2u; }
    const size_t kstep = (size_t)(BK * 2);
    const size_t hstep = (size_t)HALF * LD * 2;
    const size_t tstep = 2 * hstep;
    const unsigned ldsw = (unsigned)wid * 1024u;
    const int aoff = lds_byte(wr * 64 + fr, fq * 8), boff = lds_byte(wc * 32 + fr, fq * 8);
#define PG8_SA(b, h) (((b) * 2 + (h)) * HTB)
#define PG8_SB(b, h) ((4 + (b) * 2 + (h)) * HTB)
#define PG8_STAGE(bufoff, gbase, voff) do { _Pragma("unroll") for (int _i = 0; _i < 2; ++_i) \
        __builtin_amdgcn_global_load_lds((const unsigned*)((const char*)(gbase) + (voff)[_i]), (PG8_LAS unsigned*)(lds + (bufoff) + ldsw + _i * 8192), 16, 0, 0); } while (0)
#define PG8_LDA(dst, b, h) do { _Pragma("unroll") for (int m = 0; m < 4; ++m) _Pragma("unroll") for (int k = 0; k < 2; ++k) dst[m][k] = *(const PG8_LAS bf16x8*)(lds + PG8_SA(b, h) + aoff + m * 2048 + k * 1024); } while (0)
#define PG8_LDB(dst, b, h) do { _Pragma("unroll") for (int n = 0; n < 2; ++n) _Pragma("unroll") for (int k = 0; k < 2; ++k) dst[n][k] = *(const PG8_LAS bf16x8*)(lds + PG8_SB(b, h) + boff + n * 2048 + k * 1024); } while (0)
#define PG8_MMA(ai, bj, At, Bt) do { __builtin_amdgcn_s_setprio(1); _Pragma("unroll") for (int m = 0; m < 4; ++m) _Pragma("unroll") for (int n = 0; n < 2; ++n) _Pragma("unroll") for (int k = 0; k < 2; ++k) \
        acc[ai][bj][m][n] = __builtin_amdgcn_mfma_f32_16x16x32_bf16(Bt[n][k], At[m][k], acc[ai][bj][m][n], 0, 0, 0); __builtin_amdgcn_s_setprio(0); } while (0)
#define PG8_WAIT_V(n) asm volatile("s_waitcnt vmcnt(" #n ")" ::: "memory")
#define PG8_WAIT_L(n) asm volatile("s_waitcnt lgkmcnt(" #n ")" ::: "memory")
#define PG8_BAR __builtin_amdgcn_s_barrier()
#define PG8_SCHED __builtin_amdgcn_sched_barrier(0)
    Unit cur, nxt; int ui = 0;
    if (!S.next(0, cur)) return;
    f32x4 acc[2][2][4][2];
#pragma unroll
    for (int a = 0; a < 2; ++a)
#pragma unroll
        for (int b = 0; b < 2; ++b)
#pragma unroll
            for (int m = 0; m < 4; ++m)
#pragma unroll
                for (int n = 0; n < 2; ++n) acc[a][b][m][n] = (f32x4){0.f, 0.f, 0.f, 0.f};
    bf16x8 At[4][2], B0[2][2], B1[2][2];
    const char* cA = (const char*)g.A + (size_t)cur.pm * tstep + (size_t)cur.kt0 * kstep; const char* cB = (const char*)g.Bt + (size_t)cur.pn * tstep + (size_t)cur.kt0 * kstep;
    S.a_ready(cur);
    if constexpr (SP2) {
        PG8_STAGE(PG8_SB(0, 0), cB, voffB); PG8_STAGE(PG8_SB(0, 1), cB + hstep, voffB); PG8_STAGE(PG8_SA(0, 0), cA, voffA); PG8_STAGE(PG8_SA(0, 1), cA + hstep, voffA);
        if (wr == 1) PG8_BAR;
        PG8_WAIT_V(2); PG8_BAR;
        PG8_STAGE(PG8_SB(1, 0), cB + kstep, voffB); PG8_STAGE(PG8_SA(1, 0), cA + kstep, voffA); PG8_STAGE(PG8_SB(1, 1), cB + hstep + kstep, voffB);
        PG8_WAIT_V(6); PG8_BAR;
    } else {
        PG8_STAGE(PG8_SB(0, 0), cB, voffB); PG8_STAGE(PG8_SA(0, 0), cA, voffA); PG8_STAGE(PG8_SB(0, 1), cB + hstep, voffB); PG8_STAGE(PG8_SA(0, 1), cA + hstep, voffA);
        if (wr == 1) PG8_BAR;
        PG8_WAIT_V(4); PG8_BAR;
        PG8_STAGE(PG8_SB(1, 0), cB + kstep, voffB); PG8_STAGE(PG8_SA(1, 0), cA + kstep, voffA); PG8_STAGE(PG8_SB(1, 1), cB + hstep + kstep, voffB);
        PG8_WAIT_V(6); PG8_BAR;
    }
    for (;;) {
        const bool has_next = S.next(ui + 1, nxt);
        const char* nA = has_next ? (const char*)g.A + (size_t)nxt.pm * tstep + (size_t)nxt.kt0 * kstep : cA; const char* nB = has_next ? (const char*)g.Bt + (size_t)nxt.pn * tstep + (size_t)nxt.kt0 * kstep : cB;
        const int nt = cur.nt;
        for (int t = 0; t < nt; t += 2) {
            const bool last = (t == nt - 2);
            if constexpr (Epi::HAS_HOOK) { if (E.hook_at(cur, t)) E.hook(acc, cur, t, wr, wc, fr, fq); }
            const char* a1 = cA + (size_t)(t + 1) * kstep;
            const char* a2 = last ? nA : cA + (size_t)(t + 2) * kstep; const char* b2 = last ? nB : cB + (size_t)(t + 2) * kstep;
            const char* a3 = a2 + kstep; const char* b3 = b2 + kstep;
            if (last && has_next) S.a_ready(nxt);
            if constexpr (SP2) {
            PG8_LDB(B0, 0, 0); PG8_LDB(B1, 0, 1); PG8_SCHED; PG8_LDA(At, 0, 0); PG8_STAGE(PG8_SA(1, 1), a1 + hstep, voffA);
            PG8_WAIT_V(8); PG8_WAIT_L(0); PG8_BAR; PG8_MMA(0, 0, At, B0); PG8_MMA(0, 1, At, B1); PG8_BAR; PG8_SCHED;
            PG8_LDA(At, 0, 1); PG8_STAGE(PG8_SB(0, 0), b2, voffB); PG8_STAGE(PG8_SB(0, 1), b2 + hstep, voffB); PG8_STAGE(PG8_SA(0, 0), a2, voffA);
            PG8_WAIT_V(8); PG8_WAIT_L(0); PG8_BAR; PG8_MMA(1, 0, At, B0); PG8_MMA(1, 1, At, B1); PG8_BAR; PG8_SCHED;
            PG8_LDB(B0, 1, 0); PG8_LDB(B1, 1, 1); PG8_SCHED; PG8_LDA(At, 1, 0); PG8_STAGE(PG8_SA(0, 1), a2 + hstep, voffA);
            PG8_WAIT_V(8); PG8_WAIT_L(0); PG8_BAR; PG8_MMA(0, 0, At, B0); PG8_MMA(0, 1, At, B1); PG8_BAR; PG8_SCHED;
            PG8_LDA(At, 1, 1); PG8_STAGE(PG8_SB(1, 0), b3, voffB); PG8_STAGE(PG8_SB(1, 1), b3 + hstep, voffB); PG8_STAGE(PG8_SA(1, 0), a3, voffA);
            PG8_WAIT_V(8); PG8_WAIT_L(0); PG8_BAR; PG8_MMA(1, 0, At, B0); PG8_MMA(1, 1, At, B1); PG8_BAR; PG8_SCHED;
            } else {
            PG8_LDB(B0, 0, 0); PG8_SCHED; PG8_LDA(At, 0, 0); PG8_STAGE(PG8_SA(1, 1), a1 + hstep, voffA);
            PG8_WAIT_L(8); PG8_BAR; PG8_WAIT_L(0); PG8_MMA(0, 0, At, B0); PG8_BAR; PG8_SCHED;
            PG8_LDB(B1, 0, 1); PG8_STAGE(PG8_SB(0, 0), b2, voffB);
            PG8_BAR; PG8_WAIT_L(0); PG8_MMA(0, 1, At, B1); PG8_BAR;
            PG8_LDA(At, 0, 1); PG8_STAGE(PG8_SA(0, 0), a2, voffA);
            PG8_BAR; PG8_WAIT_L(0); PG8_MMA(1, 0, At, B0); PG8_BAR; PG8_SCHED;
            PG8_STAGE(PG8_SB(0, 1), b2 + hstep, voffB);
            PG8_WAIT_V(6); PG8_BAR; PG8_MMA(1, 1, At, B1); PG8_BAR;
            PG8_LDB(B0, 1, 0); PG8_SCHED; PG8_LDA(At, 1, 0); PG8_STAGE(PG8_SA(0, 1), a2 + hstep, voffA);
            PG8_WAIT_L(8); PG8_BAR; PG8_WAIT_L(0); PG8_MMA(0, 0, At, B0); PG8_BAR; PG8_SCHED;
            PG8_LDB(B1, 1, 1); PG8_STAGE(PG8_SB(1, 0), b3, voffB);
            PG8_BAR; PG8_WAIT_L(0); PG8_MMA(0, 1, At, B1); PG8_BAR;
            PG8_LDA(At, 1, 1); PG8_STAGE(PG8_SA(1, 0), a3, voffA);
            PG8_BAR; PG8_WAIT_L(0); PG8_MMA(1, 0, At, B0); PG8_BAR; PG8_SCHED;
            PG8_STAGE(PG8_SB(1, 1), b3 + hstep, voffB);
            PG8_WAIT_V(6); PG8_BAR; PG8_MMA(1, 1, At, B1); PG8_BAR;
            }
        }
        if constexpr (ALIGN_EPI) { if (wr == 0) PG8_BAR; }
        if constexpr (!Epi::AFTER_DRAIN) { E(acc, cur, wr, wc, fr, fq); S.done(cur); }
        if (!has_next) break;
#pragma unroll
        for (int a = 0; a < 2; ++a)
#pragma unroll
            for (int b = 0; b < 2; ++b)
#pragma unroll
                for (int m = 0; m < 4; ++m)
#pragma unroll
                    for (int n = 0; n < 2; ++n) acc[a][b][m][n] = (f32x4){0.f, 0.f, 0.f, 0.f};
        cur = nxt; cA = nA; cB = nB; ++ui;
        if constexpr (ALIGN_EPI) { if (wr == 1) PG8_BAR; }
    }
    PG8_WAIT_V(0);
    if constexpr (!ALIGN_EPI) { if (wr == 0) PG8_BAR; }
    PG8_BAR;
    if constexpr (Epi::AFTER_DRAIN) { E.fused(acc, cur, wr, wc, fr, fq, lds, wid, lane); S.done(cur); }
#undef PG8_SA
#undef PG8_SB
#undef PG8_STAGE
#undef PG8_LDA
#undef PG8_LDB
#undef PG8_MMA
#undef PG8_WAIT_V
#undef PG8_WAIT_L
#undef PG8_BAR
#undef PG8_SCHED
}
}
constexpr int NWAVES = 8, NT = NWAVES * 64;
constexpr int D = 2048, MP = 8192, MS = 128, MR = MP + MS, MT = 8448;
constexpr int SEQ = 4096;
constexpr int NZ = 15872;
constexpr int NZW = 16128;
constexpr int ZQA = 0, ZKA = 1024, ZVA = 2048, ZGA = 4096, ZUB = 6144, ZVB = 7168, ZQC = 8192, ZKC = 9216, ZVC = 9472, ZGT = 9728, ZLR = 15872;
constexpr int NIN = 15888, FF = 5632, NADA = 12288;
constexpr int MOD_SH1 = 0, MOD_SC1 = 2048, MOD_G1 = 4096, MOD_SH2 = 6144, MOD_SC2 = 8192, MOD_G2 = 10240;
constexpr float EPS = 1e-6f;
constexpr size_t O_YP = 0, O_YS = 16777216, O_SGP = 17039360, O_SGS = 19136512, O_CKP = 153354240, O_CVP = 153485312, O_CKS = 153616384, O_CVS = 153681920, O_GMV = 153747456, O_END = 154009600;
enum { I_XP = 0, I_XS, I_CP, I_CS, I_SGLA, I_CK, I_CV, I_WADA, I_BADA, I_N1W, I_N2W, I_WIN, I_WGK2, I_BGK, I_GLANW, I_GMNW, I_GMNB, I_GMWS, I_GMBS, I_SINK, I_WPA, I_WPB, I_WPC, I_WO, I_WFI, I_WFO, I_FNW, N_IN };

constexpr size_t MiB = 1u << 20;
constexpr size_t WS_CTL = 0, CTL_ZERO_BYTES = 1 * MiB;
constexpr size_t WS_WADA = 2 * MiB;
constexpr size_t WS_CA   = WS_WADA + 2 * 48 * MiB;
constexpr size_t WS_MOD  = WS_CA + 1 * MiB;
constexpr size_t WS_WIN  = WS_MOD + 24 * MiB;
constexpr size_t WS_WPRJ = WS_WIN + 2 * 63 * MiB;
constexpr size_t WS_WO   = WS_WPRJ + 32 * MiB;
constexpr size_t WS_WFI  = WS_WO + 16 * MiB;
constexpr size_t WS_WFO  = WS_WFI + 88 * MiB;
constexpr size_t WS_X    = WS_WFO + 44 * MiB;
constexpr size_t WS_H    = WS_X + 66 * MiB;
constexpr size_t WS_Z    = WS_H + 33 * MiB;
constexpr size_t WS_OABC = WS_Z + 260 * MiB;
constexpr size_t WS_M32  = WS_OABC + 66 * MiB;
constexpr size_t WS_MG   = WS_M32 + 66 * MiB;
constexpr size_t WS_ACT  = WS_MG + 33 * MiB;
constexpr size_t WS_GK   = WS_ACT + 91 * MiB;
constexpr size_t WS_OB   = WS_GK + 33 * MiB;
constexpr size_t WS_VN   = WS_OB + 65 * MiB;
constexpr size_t WS_QT   = WS_VN + 33 * MiB;
constexpr size_t WS_KH   = WS_QT + 16 * MiB;
constexpr size_t WS_AI   = WS_KH + 16 * MiB;
constexpr size_t WS_GAM  = WS_AI + 4 * MiB;
constexpr size_t WS_GST  = WS_GAM + 1 * MiB;
constexpr size_t WS_GAMS = WS_GST + 32 * MiB;
constexpr size_t WS_VNB  = WS_GAMS + 1 * MiB;
constexpr size_t WS_PART = WS_VNB + 16 * MiB;
constexpr size_t WS_END  = WS_PART + 32 * MiB;
static_assert((size_t)MT * NZ * 2 <= 260 * MiB && (size_t)MT * FF * 2 <= 91 * MiB && (size_t)NZW * D * 2 <= 63 * MiB, "ws map");
constexpr int CW_BAR = 4096;

constexpr int RING_BYTES = 131072;
constexpr int MISC_OFF = 150 * 1024;
constexpr int LDS_BYTES = 152 * 1024;

#define GAS __attribute__((address_space(1)))
#define LAS __attribute__((address_space(3)))
typedef unsigned short bf16;
typedef unsigned v4u __attribute__((ext_vector_type(4)));
typedef unsigned v2u __attribute__((ext_vector_type(2)));
typedef float f32x4 __attribute__((ext_vector_type(4)));
#define LDS_WAIT() asm volatile("s_waitcnt lgkmcnt(0)" ::: "memory")
#define VM_WAIT() asm volatile("s_waitcnt vmcnt(0)" ::: "memory")
__device__ __forceinline__ unsigned f2bf(float f) { unsigned u = __builtin_bit_cast(unsigned, f); return (u + 0x7fffu + ((u >> 16) & 1u)) >> 16; }
__device__ __forceinline__ unsigned pk2(float lo, float hi) { return f2bf(lo) | (f2bf(hi) << 16); }
__device__ __forceinline__ float bf2f(bf16 b) { return __uint_as_float(((unsigned)b) << 16); }
__device__ __forceinline__ float wave_sum(float v) {
#pragma unroll
    for (int o = 1; o < 64; o <<= 1) v += __shfl_xor(v, o);
    return v;
}
__device__ __forceinline__ f32x4 zero4() { float z; asm volatile("v_mov_b32 %0, 0" : "=v"(z)); return (f32x4){z, z, z, z}; }
__device__ __forceinline__ float sigmoidf_(float x) { return 1.0f / (1.0f + __expf(-x)); }
__device__ __forceinline__ float siluf_(float x) { return x * sigmoidf_(x); }
__device__ __forceinline__ float geluf_(float x) { return x * sigmoidf_(1.5957691216057308f * (x + 0.044715f * x * x * x)); }
__device__ __forceinline__ float logsigmoidf_(float x) { return fminf(x, 0.f) - log1pf(expf(-fabsf(x))); }
#define XB_TMO      128
#define XB_XCNT(j)  (256  + 64 * (j))
#define XB_XSUB(j)  (1280 + 64 * (j))
#define XB_XGEN(j)  (2304 + 64 * (j))
#define XB_TOP      3328
#define XB_TOPGEN   3392
#define XCD_BAR_WORDS 3456
#define XB_SPIN_CAP (1u << 18)

__device__ __forceinline__ unsigned xb_ld(unsigned* p)              { return __hip_atomic_load(p, __ATOMIC_RELAXED, __HIP_MEMORY_SCOPE_AGENT); }
__device__ __forceinline__ unsigned xb_add(unsigned* p, unsigned v) { return __hip_atomic_fetch_add(p, v, __ATOMIC_RELAXED, __HIP_MEMORY_SCOPE_AGENT); }
__device__ __forceinline__ unsigned xb_xcc_id() { return (unsigned)__builtin_amdgcn_s_getreg((3 << 11) | 20) & 0xFu; }
#define XB_SPIN(cond, bar) do { unsigned _sp = 0; while (cond) { __builtin_amdgcn_s_sleep(1); \
    if ((++_sp & 255u) == 0u) { if (xb_ld(&(bar)[XB_TMO])) break; if (_sp > XB_SPIN_CAP) { atomicAdd(&(bar)[XB_TMO], 1u); break; } } } } while (0)

struct XcdBarrier {
    unsigned* bar; unsigned x;
    volatile LAS unsigned* st;
};

__device__ __forceinline__ XcdBarrier xcd_barrier_post(unsigned* bar, volatile LAS unsigned* st) {
    XcdBarrier b; b.bar = bar; b.x = xb_xcc_id(); b.st = st;
    if (threadIdx.x == 0) (void)xb_add(&bar[XB_XCNT(b.x)], 1u);
    return b;
}
__device__ __forceinline__ void xcd_barrier_complete(unsigned* bar, unsigned x, unsigned& nloc, unsigned& nx) {
    const unsigned G = gridDim.x * gridDim.y * gridDim.z;
    unsigned sum, cnt, mine, sp = 0u;
    for (;;) {
        sum = 0u; cnt = 0u; mine = 0u;
#pragma unroll
        for (unsigned j = 0; j < 16; ++j) { const unsigned c = xb_ld(&bar[XB_XCNT(j)]); sum += c; cnt += (c > 0u) ? 1u : 0u; mine = (j == x) ? c : mine; }
        if (sum == G) break;
        __builtin_amdgcn_s_sleep(1);
        if ((++sp & 255u) == 0u) { if (xb_ld(&bar[XB_TMO])) break; if (sp > XB_SPIN_CAP) { atomicAdd(&bar[XB_TMO], 1u); break; } }
    }
    nloc = mine > 0u ? mine : 1u; nx = cnt > 0u ? cnt : 1u;
}

__device__ __forceinline__ void xcd_barrier(const XcdBarrier& b) {
    asm volatile("s_waitcnt vmcnt(0)" ::: "memory");
    __syncthreads();
    if (threadIdx.x == 0) {
        unsigned* bar = b.bar;
        __builtin_amdgcn_s_waitcnt(0);
        unsigned nloc = b.st[0], nx = b.st[1];
        if (nloc == 0u) { xcd_barrier_complete(bar, b.x, nloc, nx); b.st[0] = nloc; b.st[1] = nx; }
        const unsigned old = xb_add(&bar[XB_XSUB(b.x)], 1u);
        const unsigned gen = old / nloc;
        if (old + 1u == (gen + 1u) * nloc) {
            __builtin_amdgcn_fence(__ATOMIC_RELEASE, "agent");
            asm volatile("s_waitcnt vmcnt(0)" ::: "memory");
            const unsigned og = xb_add(&bar[XB_TOP], 1u);
            const unsigned tg = og / nx;
            if (og + 1u == (tg + 1u) * nx) xb_add(&bar[XB_TOPGEN], 1u);
            else XB_SPIN(xb_ld(&bar[XB_TOPGEN]) == tg, bar);
            __builtin_amdgcn_fence(__ATOMIC_ACQUIRE, "agent");
            xb_add(&bar[XB_XGEN(b.x)], 1u);
            asm volatile("s_waitcnt vmcnt(0)" ::: "memory");
        } else {
            XB_SPIN(xb_ld(&bar[XB_XGEN(b.x)]) == gen, bar);
            __builtin_amdgcn_fence(__ATOMIC_ACQUIRE, "agent");
            asm volatile("s_waitcnt vmcnt(0)" ::: "memory");
        }
    }
    __syncthreads();
}
struct Prm { const float* in[N_IN]; float* out; unsigned char* ws; int ph_lo, ph_hi, var, pad; };
static_assert(sizeof(Prm) == N_IN * 8 + 32, "Prm has no padding bytes");
struct Frame {
    LAS unsigned char* lds;
    int vcu, G;
};
struct Tix { int tid, lane, wave; };
__device__ __forceinline__ Tix tix() { int t = threadIdx.x; asm volatile("" : "+v"(t)); Tix r; r.tid = t; r.lane = t & 63; r.wave = __builtin_amdgcn_readfirstlane(t >> 6); return r; }

__device__ __forceinline__ int map_col(int mode, int n) {
    if (mode == 1) return n < 6144 ? n : (n < 6160 ? ZLR + (n - 6144) : n - 16);
    if (mode == 2) return n < FF ? ((n >> 7) * 256 + (n & 127)) : ((((n - FF) >> 7) * 256) + 128 + ((n - FF) & 127));
    return n;
}
__device__ __forceinline__ void conv_item(const float* W, int K, int N, bf16* WT, int ld, int koff, int mode, LAS float* scr, int item, int lane, int var = 0) {
    const int nkb = K / 64, nb = item / nkb, kb = item % nkb, k0 = 64 * kb, n0 = 64 * nb;
    const int q = lane & 15, kr = lane >> 4; const bool okc = (n0 + 4 * q) < N;
    f32x4 v[16];
#pragma unroll
    for (int i = 0; i < 16; ++i) v[i] = okc ? *(const f32x4*)(W + (size_t)(k0 + 4 * i + kr) * N + n0 + 4 * q) : zero4();
    if (var & 512) {
#pragma unroll
        for (int j = 0; j < 8; ++j) { const int n = (lane >> 3) + 8 * j; v4u o; o.x = pk2(v[2 * j].x, v[2 * j].y); o.y = pk2(v[2 * j].z, v[2 * j].w); o.z = pk2(v[2 * j + 1].x, v[2 * j + 1].y); o.w = pk2(v[2 * j + 1].z, v[2 * j + 1].w);
            if (n0 + n < N) *(GAS v4u*)(WT + (size_t)map_col(mode, n0 + n) * ld + koff + k0 + 8 * (lane & 7)) = o; }
        return; }
#pragma unroll
    for (int i = 0; i < 16; ++i) { LAS float* s = scr + (4 * i + kr) * 65 + 4 * q; s[0] = v[i].x; s[1] = v[i].y; s[2] = v[i].z; s[3] = v[i].w; }
    LDS_WAIT(); asm volatile("" ::: "memory");
    const int c = lane & 7;
#pragma unroll
    for (int j = 0; j < 8; ++j) { const int n = (lane >> 3) + 8 * j; const LAS float* s = scr + (8 * c) * 65 + n;
        v4u o; o.x = pk2(s[0 * 65], s[1 * 65]); o.y = pk2(s[2 * 65], s[3 * 65]); o.z = pk2(s[4 * 65], s[5 * 65]); o.w = pk2(s[6 * 65], s[7 * 65]);
        if (n0 + n < N) *(GAS v4u*)(WT + (size_t)map_col(mode, n0 + n) * ld + koff + k0 + 8 * c) = o; }
    LDS_WAIT(); asm volatile("" ::: "memory");
}
struct ConvDesc { const float* W; bf16* WT; int K, N, ld, koff, mode, items; };

__device__ __forceinline__ void phase_convert(Frame& F) {
    const Tix T = tix();
    const __attribute__((address_space(4))) Prm* Pk = (const __attribute__((address_space(4))) Prm*)__builtin_amdgcn_kernarg_segment_ptr(); asm volatile("" : "+s"(Pk));
    LAS float* scr = (LAS float*)(F.lds + T.wave * 16640);
    const int gw = F.vcu * NWAVES + T.wave, NGW = F.G * NWAVES;
    unsigned char* ws = Pk->ws;
    for (int l = 0; l < 2; ++l) {
        for (int mi = 1; mi < 8; ++mi) {
            ConvDesc d;
            if (mi == 0)      { d.W = Pk->in[I_WADA] + (size_t)l * D * NADA; d.WT = (bf16*)(ws + WS_WADA) + (size_t)l * NADA * D; d.K = D; d.N = NADA; d.ld = D; d.koff = 0; d.mode = 0; }
            else if (mi == 1) { d.W = Pk->in[I_WIN] + (size_t)l * D * NIN;   d.WT = (bf16*)(ws + WS_WIN) + (size_t)l * NZW * D;    d.K = D; d.N = NIN;  d.ld = D; d.koff = 0; d.mode = 1; }
            else if (mi == 2) { d.W = Pk->in[I_WPA] + (size_t)l * 2048 * D;  d.WT = (bf16*)(ws + WS_WPRJ) + (size_t)l * D * 4096; d.K = 2048; d.N = D; d.ld = 4096; d.koff = 0; d.mode = 0; }
            else if (mi == 3) { d.W = Pk->in[I_WPB] + (size_t)l * 1024 * D;  d.WT = (bf16*)(ws + WS_WPRJ) + (size_t)l * D * 4096; d.K = 1024; d.N = D; d.ld = 4096; d.koff = 2048; d.mode = 0; }
            else if (mi == 4) { d.W = Pk->in[I_WPC] + (size_t)l * 1024 * D;  d.WT = (bf16*)(ws + WS_WPRJ) + (size_t)l * D * 4096; d.K = 1024; d.N = D; d.ld = 4096; d.koff = 3072; d.mode = 0; }
            else if (mi == 5) { d.W = Pk->in[I_WO] + (size_t)l * D * D;      d.WT = (bf16*)(ws + WS_WO) + (size_t)l * D * D;      d.K = D; d.N = D; d.ld = D; d.koff = 0; d.mode = 0; }
            else if (mi == 6) { d.W = Pk->in[I_WFI] + (size_t)l * D * 2 * FF; d.WT = (bf16*)(ws + WS_WFI) + (size_t)l * 2 * FF * D; d.K = D; d.N = 2 * FF; d.ld = D; d.koff = 0; d.mode = 2; }
            else              { d.W = Pk->in[I_WFO] + (size_t)l * FF * D;    d.WT = (bf16*)(ws + WS_WFO) + (size_t)l * D * FF;    d.K = FF; d.N = D; d.ld = FF; d.koff = 0; d.mode = 0; }
            d.items = (d.K / 64) * ((d.N + 63) / 64);
            for (int it = gw; it < d.items; it += NGW) conv_item(d.W, d.K, d.N, d.WT, d.ld, d.koff, d.mode, scr, it, T.lane, Pk->var);
        }
    }
    { bf16* CA = (bf16*)(ws + WS_CA);
      for (int i = blockIdx.x * NT + T.tid; i < 256 * D; i += F.G * NT) { const int r = i >> 11, c = i & 2047; float v = 0.f;
          if (r < 2) v = Pk->in[I_CP][r * D + c]; else if (r < 130) v = Pk->in[I_CS][(r - 2) * D + c];
          CA[i] = (bf16)f2bf(r < 130 ? siluf_(v) : 0.f); } }
    { f32x4* X4 = (f32x4*)(ws + WS_X); const f32x4* xp = (const f32x4*)Pk->in[I_XP]; const f32x4* xs = (const f32x4*)Pk->in[I_XS];
      for (int i = blockIdx.x * NT + T.tid; i < MT * D / 4; i += F.G * NT) { const int r = i >> 9;
          X4[i] = r < MP ? xp[i] : (r < MR ? xs[i - MP * D / 4] : zero4()); } }
}

template <bool FINAL>
__device__ __forceinline__ void phase_norm_t(Frame& F, float* X, const float* nw, const float* mod, int sh_off, int sc_off, bf16* H, float* out, const float* part, int nsl) {
    const Tix T = tix();
    const int gw = F.vcu * NWAVES + T.wave, NGW = F.G * NWAVES;
    const int nit = FINAL ? MP : MP + (MT - MR);
    f32x4 vn[8];
    if (gw < nit) { const int row = gw < MP ? gw : gw + MS; const f32x4* xr = (const f32x4*)(X + (size_t)row * D) + T.lane;
#pragma unroll
        for (int j = 0; j < 8; ++j) vn[j] = xr[64 * j]; }
    for (int it = gw; it < nit; it += NGW) {
        const int row = it < MP ? it : it + MS;
        f32x4 v[8]; float s = 0.f;
#pragma unroll
        for (int j = 0; j < 8; ++j) v[j] = vn[j];
        if (it + NGW < nit) { const int it2 = it + NGW, row2 = it2 < MP ? it2 : it2 + MS; const f32x4* xr = (const f32x4*)(X + (size_t)row2 * D) + T.lane;
#pragma unroll
            for (int j = 0; j < 8; ++j) vn[j] = xr[64 * j]; }
#pragma unroll
        for (int j = 0; j < 8; ++j) s += (v[j].x * v[j].x + v[j].y * v[j].y) + (v[j].z * v[j].z + v[j].w * v[j].w);
        const float rstd = 1.0f / sqrtf(wave_sum(s) * (1.0f / D) + EPS);
        if (FINAL) { f32x4* o = (f32x4*)(out + (size_t)row * D) + T.lane;
#pragma unroll
            for (int j = 0; j < 8; ++j) { const f32x4 w = *(const f32x4*)(nw + 4 * (T.lane + 64 * j)); o[64 * j] = (v[j] * rstd) * w; } }
        else { const float* md = mod + (size_t)pg8::batch_of_row(row) * NADA; v2u* o = (v2u*)(H + (size_t)row * D) + T.lane;
#pragma unroll
            for (int j = 0; j < 8; ++j) { const int c = 4 * (T.lane + 64 * j);
                const f32x4 w = *(const f32x4*)(nw + c), sc = *(const f32x4*)(md + sc_off + c), sh = *(const f32x4*)(md + sh_off + c);
                const f32x4 y = (v[j] * rstd) * w * (sc + 1.0f) + sh;
                v2u q; q.x = pk2(y.x, y.y); q.y = pk2(y.z, y.w); o[64 * j] = q; } }
    }
    LAS float* red = (LAS float*)F.lds;
    for (int sr = (int)blockIdx.x; sr < MS; sr += F.G) {
        const int row = MP + sr, c = 4 * T.tid;
        f32x4 x = *(const f32x4*)(X + (size_t)row * D + c);
        { f32x4 pp[11];
#pragma unroll
          for (int s = 0; s < 11; ++s) pp[s] = s < nsl ? *(const f32x4*)(part + ((size_t)s * 128 + sr) * D + c) : zero4();
#pragma unroll
          for (int s = 0; s < 11; ++s) x += pp[s]; }
        if (nsl > 0) *(f32x4*)(X + (size_t)row * D + c) = x;
        const float ss = wave_sum((x.x * x.x + x.y * x.y) + (x.z * x.z + x.w * x.w));
        __syncthreads();
        if (T.lane == 0) red[T.wave] = ss;
        __syncthreads();
        const float tot = ((red[0] + red[1]) + (red[2] + red[3])) + ((red[4] + red[5]) + (red[6] + red[7]));
        const float rstd = 1.0f / sqrtf(tot * (1.0f / D) + EPS);
        const f32x4 w = *(const f32x4*)(nw + c);
        if (FINAL) *(f32x4*)(out + (size_t)row * D + c) = (x * rstd) * w;
        else { const float* md = mod + (size_t)pg8::batch_of_row(row) * NADA; const f32x4 sc = *(const f32x4*)(md + sc_off + c), sh = *(const f32x4*)(md + sh_off + c);
            const f32x4 y = (x * rstd) * w * (sc + 1.0f) + sh; v2u q; q.x = pk2(y.x, y.y); q.y = pk2(y.z, y.w); *(v2u*)(H + (size_t)row * D + c) = q; }
    }
    __syncthreads();
}

__device__ __forceinline__ void gla_sample_unit(Frame& F, int unit, const bf16* Z, const bf16* H, const bf16* WlraT, const float* wgk2, const float* bgk, const float* Sin  , float* Sout, const float* gnw, bf16* OABC) {
    const Tix T = tix();
    const int b = unit >> 2, h = unit & 3; const size_t row = MP + b;
    LAS float* sq = (LAS float*)F.lds; LAS float* sk = sq + 256; LAS float* se = sk + 256; LAS float* red = se + 256;
    LAS float* lrs = red + 2048;
    __syncthreads();
    { const int rr = T.tid & 15, ksg = T.tid >> 4; float a = 0.f;
      const bf16* hp = H + row * D + 64 * ksg; const bf16* wp = WlraT + (size_t)rr * D + 64 * ksg;
#pragma unroll
      for (int i = 0; i < 8; ++i) { const v4u hv = *(const v4u*)(hp + 8 * i), wv = *(const v4u*)(wp + 8 * i);
          a += (__uint_as_float(hv.x << 16) * __uint_as_float(wv.x << 16) + __uint_as_float(hv.x & 0xffff0000u) * __uint_as_float(wv.x & 0xffff0000u)) + (__uint_as_float(hv.y << 16) * __uint_as_float(wv.y << 16) + __uint_as_float(hv.y & 0xffff0000u) * __uint_as_float(wv.y & 0xffff0000u))
             + (__uint_as_float(hv.z << 16) * __uint_as_float(wv.z << 16) + __uint_as_float(hv.z & 0xffff0000u) * __uint_as_float(wv.z & 0xffff0000u)) + (__uint_as_float(hv.w << 16) * __uint_as_float(wv.w << 16) + __uint_as_float(hv.w & 0xffff0000u) * __uint_as_float(wv.w & 0xffff0000u)); }
      lrs[ksg * 16 + rr] = a; }
    __syncthreads();
    if (T.tid < 16) { float a = 0.f;
#pragma unroll
        for (int s = 0; s < 32; ++s) a += lrs[s * 16 + T.tid];
        lrs[512 + T.tid] = a; }
    __syncthreads();
    if (T.tid < 256) { const int d = T.tid; sq[d] = bf2f(Z[row * NZ + ZQA + h * 256 + d]) * 0.0625f; sk[d] = bf2f(Z[row * NZ + ZKA + h * 256 + d]);
        float x = bgk[h * 256 + d];
#pragma unroll
        for (int rr = 0; rr < 16; ++rr) x += lrs[512 + rr] * wgk2[rr * 1024 + h * 256 + d];
        se[d] = __expf((fminf(x, 0.f) - __logf(1.0f + __expf(-fabsf(x)))) * (1.0f / 16.0f)); }
    __syncthreads();
    const int c4 = T.tid & 127, rg = T.tid >> 7;
    f32x4 v; { const bf16* vp = Z + row * NZ + ZVA + h * 512 + 4 * c4; v.x = bf2f(vp[0]); v.y = bf2f(vp[1]); v.z = bf2f(vp[2]); v.w = bf2f(vp[3]); }
    const size_t base = ((size_t)b * 4 + h) * 256 * 512;
    f32x4 o = zero4();
    for (int it0 = 0; it0 < 64; it0 += 16) {
        f32x4 sv[16];
#pragma unroll
        for (int u = 0; u < 16; ++u) sv[u] = __builtin_nontemporal_load((const f32x4*)(Sin + base + (size_t)(rg + 4 * (it0 + u)) * 512 + 4 * c4));
#pragma unroll
        for (int u = 0; u < 16; ++u) { const int dk = rg + 4 * (it0 + u);
            const f32x4 sn = sv[u] * se[dk] + v * sk[dk];
            __builtin_nontemporal_store(sn, (f32x4*)(Sout + base + (size_t)dk * 512 + 4 * c4));
            o += sn * sq[dk]; } }
    *(LAS f32x4*)(red + rg * 512 + 4 * c4) = o;
    __syncthreads();
    { const int c = T.tid; const float t = (red[c] + red[512 + c]) + (red[1024 + c] + red[1536 + c]);
      const float ss = wave_sum(t * t);
      if (T.lane == 0) lrs[600 + T.wave] = ss;
      __syncthreads();
      const float tot = ((lrs[600] + lrs[601]) + (lrs[602] + lrs[603])) + ((lrs[604] + lrs[605]) + (lrs[606] + lrs[607]));
      const float rstd = 1.0f / sqrtf(tot * (1.0f / 512.0f) + EPS);
      OABC[row * 4096 + h * 512 + c] = (bf16)f2bf(t * rstd * gnw[c] * siluf_(bf2f(Z[row * NZ + ZGA + h * 512 + c]))); }
}

__device__ __forceinline__ void gm_ln_row(const Tix& T, int row, const v2u (&vw)[4], const bf16* Z, const float* nw, const float* nb, bf16* VNB, float* gmv_out  , const float* ws_, const float* bs, bf16* OABC) {
    float x[16]; float s = 0.f;
#pragma unroll
    for (int j = 0; j < 4; ++j) { const v2u w = vw[j];
        x[4 * j + 0] = geluf_(__uint_as_float(w.x << 16)); x[4 * j + 1] = geluf_(__uint_as_float(w.x & 0xffff0000u)); x[4 * j + 2] = geluf_(__uint_as_float(w.y << 16)); x[4 * j + 3] = geluf_(__uint_as_float(w.y & 0xffff0000u));
        s += (x[4 * j] + x[4 * j + 1]) + (x[4 * j + 2] + x[4 * j + 3]); }
    const float mu = wave_sum(s) * (1.0f / 1024.0f); float q = 0.f;
#pragma unroll
    for (int i = 0; i < 16; ++i) { x[i] -= mu; q += x[i] * x[i]; }
    const float rstd = 1.0f / sqrtf(wave_sum(q) * (1.0f / 1024.0f) + EPS);
#pragma unroll
    for (int j = 0; j < 4; ++j) { const int c = 4 * (T.lane + 64 * j); const f32x4 w = *(const f32x4*)(nw + c), bb = *(const f32x4*)(nb + c);
        f32x4 y; y.x = x[4 * j] * rstd * w.x + bb.x; y.y = x[4 * j + 1] * rstd * w.y + bb.y; y.z = x[4 * j + 2] * rstd * w.z + bb.z; y.w = x[4 * j + 3] * rstd * w.w + bb.w;
        if (row < MP) { v2u o; o.x = pk2(y.x, y.y); o.y = pk2(y.z, y.w); *(v2u*)(VNB + (size_t)row * 1024 + c) = o; }
        else { *(f32x4*)(gmv_out + (size_t)(row - MP) * 1024 + c) = y;
            const int g = c >> 8; const float w00 = ws_[(size_t)g * 128 * 128], b0 = bs[g * 128];
            const v2u uq = *(const v2u*)(Z + (size_t)row * NZ + ZUB + c);
            v2u o; o.x = pk2(geluf_(__uint_as_float(uq.x << 16)) * (w00 * y.x + b0), geluf_(__uint_as_float(uq.x & 0xffff0000u)) * (w00 * y.y + b0));
            o.y = pk2(geluf_(__uint_as_float(uq.y << 16)) * (w00 * y.z + b0), geluf_(__uint_as_float(uq.y & 0xffff0000u)) * (w00 * y.w + b0));
            *(v2u*)(OABC + (size_t)row * 4096 + 2048 + c) = o; } }
}
__device__ __forceinline__ void gm_ln_rows(Frame& F, int ow, int OW, const bf16* Z, const float* nw, const float* nb, bf16* VNB, float* gmv_out, const float* ws_, const float* bs, bf16* OABC) {
    const Tix T = tix();
    const int w0 = ow * NWAVES + T.wave, stride = OW * NWAVES;
    v2u nx[4];
    if (w0 < MR) {
#pragma unroll
        for (int j = 0; j < 4; ++j) nx[j] = *(const v2u*)(Z + (size_t)w0 * NZ + ZVB + 4 * (T.lane + 64 * j)); }
    for (int row = w0; row < MR; row += stride) {
        v2u cur[4];
#pragma unroll
        for (int j = 0; j < 4; ++j) cur[j] = nx[j];
        if (row + stride < MR) {
#pragma unroll
            for (int j = 0; j < 4; ++j) nx[j] = *(const v2u*)(Z + (size_t)(row + stride) * NZ + ZVB + 4 * (T.lane + 64 * j)); }
        gm_ln_row(T, row, cur, Z, nw, nb, VNB, gmv_out, ws_, bs, OABC);
    }
}

__device__ __forceinline__ void cache_outs(Frame& F, int wg, int nwg, int l, const bf16* Z, float* out) {
    const Tix T = tix();
    for (int idx = wg * NT + T.tid; idx < 2 * 128 * 512; idx += nwg * NT) {
        const int c = idx & 511, r = (idx >> 9) & 127, b = idx >> 16; const size_t row = (size_t)b * SEQ + (SEQ - 128) + r;
        const float v = bf2f(Z[row * NZ + ZKC + c]);
        if (c < 256) out[O_CKP + ((size_t)(l * 2 + b) * 128 + r) * 256 + c] = v; else out[O_CVP + ((size_t)(l * 2 + b) * 128 + r) * 256 + (c - 256)] = v;
    }
    for (int idx = wg * NT + T.tid; idx < 128 * 512; idx += nwg * NT) {
        const int c = idx & 511, b = idx >> 9; const float v = bf2f(Z[(size_t)(MP + b) * NZ + ZKC + c]);
        if (c < 256) out[O_CKS + (size_t)(l * 128 + b) * 256 + c] = v; else out[O_CVS + (size_t)(l * 128 + b) * 256 + (c - 256)] = v;
    }
}

__device__ __forceinline__ void gla_fin(Frame& F, const float* OB, const bf16* Z, const float* gnw, bf16* OABC) {
    const Tix T = tix();
    const int gw = F.vcu * NWAVES + T.wave, NGW = F.G * NWAVES;
    f32x4 on[8]; v2u gn[8];
#define FIN_LOAD(rw) do { const f32x4* op_ = (const f32x4*)(OB + (size_t)(rw) * 2048) + T.lane; const bf16* gp_ = Z + (size_t)(rw) * NZ + ZGA + 4 * T.lane; \
        _Pragma("unroll") for (int j = 0; j < 8; ++j) { on[j] = op_[64 * j]; gn[j] = *(const v2u*)(gp_ + 256 * j); } } while (0)
    if (gw < MP) FIN_LOAD(gw);
    for (int row = gw; row < MP; row += NGW) {
        f32x4 o[8]; v2u gq[8];
#pragma unroll
        for (int j = 0; j < 8; ++j) { o[j] = on[j]; gq[j] = gn[j]; }
        if (row + NGW < MP) FIN_LOAD(row + NGW);
#pragma unroll
        for (int h = 0; h < 4; ++h) { const f32x4 a = o[2 * h], b = o[2 * h + 1];
            const float s = (a.x * a.x + a.y * a.y) + (a.z * a.z + a.w * a.w) + (b.x * b.x + b.y * b.y) + (b.z * b.z + b.w * b.w);
            const float rstd = 1.0f / sqrtf(wave_sum(s) * (1.0f / 512.0f) + EPS);
#pragma unroll
            for (int jj = 0; jj < 2; ++jj) { const int j = 2 * h + jj, c = 4 * (T.lane + 64 * jj); const f32x4 ov = o[j]; const f32x4 w = *(const f32x4*)(gnw + c);
                const float g0 = siluf_(__uint_as_float(gq[j].x << 16)), g1 = siluf_(__uint_as_float(gq[j].x & 0xffff0000u)), g2 = siluf_(__uint_as_float(gq[j].y << 16)), g3 = siluf_(__uint_as_float(gq[j].y & 0xffff0000u));
                v2u r; r.x = pk2(ov.x * rstd * w.x * g0, ov.y * rstd * w.y * g1); r.y = pk2(ov.z * rstd * w.z * g2, ov.w * rstd * w.w * g3);
                *(v2u*)(OABC + (size_t)row * 4096 + h * 512 + c) = r; } }
    }
#undef FIN_LOAD
}
typedef short bf16x8 __attribute__((ext_vector_type(8)));
typedef unsigned short u16x4 __attribute__((ext_vector_type(4)));
__device__ __forceinline__ unsigned offb(unsigned row, unsigned ch) { return 256u * row + 16u * (ch ^ (((row & 3u) << 2) | ((row >> 2) & 3u))); }
__device__ __forceinline__ unsigned tr_addr16(unsigned lane, unsigned c, unsigned ks, unsigned t) {
    const unsigned g = lane >> 4, q = (lane & 15u) >> 2, p = lane & 3u; return offb(32u * ks + 8u * g + 4u * t + q, 2u * c + (p >> 1)) + 8u * (p & 1u); }
struct TrLane { unsigned L0, L1, X0, X1; };
__device__ __forceinline__ TrLane tr_lane(unsigned lane) {
    const unsigned g = lane >> 4, q = (lane & 15u) >> 2, p = lane & 3u; TrLane t;
    const unsigned m0 = (q << 2) | ((2u * g) & 3u), m1 = (q << 2) | ((2u * g + 1u) & 3u);
    t.L0 = 2048u * g + 256u * q + 8u * (p & 1u) + 16u * ((p >> 1) ^ (m0 & 1u)); t.L1 = 2048u * g + 1024u + 256u * q + 8u * (p & 1u) + 16u * ((p >> 1) ^ (m1 & 1u));
    t.X0 = (m0 >> 1) << 5; t.X1 = (m1 >> 1) << 5; return t;
}
__device__ __forceinline__ void tr_frag2(unsigned base, const TrLane& tl, unsigned c, bf16x8& f0, bf16x8& f1) {
    const unsigned a0 = base + tl.L0 + ((c << 5) ^ tl.X0), a1 = base + tl.L1 + ((c << 5) ^ tl.X1);
    u16x4 r0, r1, r2, r3;
    asm volatile("ds_read_b64_tr_b16 %0, %4\n\tds_read_b64_tr_b16 %1, %5\n\tds_read_b64_tr_b16 %2, %4 offset:8192\n\tds_read_b64_tr_b16 %3, %5 offset:8192\n\ts_waitcnt lgkmcnt(0)"
                 : "=&v"(r0), "=&v"(r1), "=&v"(r2), "=&v"(r3) : "v"(a0), "v"(a1) : "memory");
    f0 = (bf16x8){(short)r0[0], (short)r0[1], (short)r0[2], (short)r0[3], (short)r1[0], (short)r1[1], (short)r1[2], (short)r1[3]};
    f1 = (bf16x8){(short)r2[0], (short)r2[1], (short)r2[2], (short)r2[3], (short)r3[0], (short)r3[1], (short)r3[2], (short)r3[3]};
}
__device__ __forceinline__ void tr_frag4(unsigned base, const TrLane& tl, unsigned c, bf16x8& f0, bf16x8& f1, bf16x8& f2, bf16x8& f3) {
    const unsigned a0 = base + tl.L0 + ((c << 5) ^ tl.X0), a1 = base + tl.L1 + ((c << 5) ^ tl.X1), a2 = base + tl.L0 + (((c + 1u) << 5) ^ tl.X0), a3 = base + tl.L1 + (((c + 1u) << 5) ^ tl.X1);
    u16x4 r0, r1, r2, r3, r4, r5, r6, r7;
    asm volatile("ds_read_b64_tr_b16 %0, %8\n\tds_read_b64_tr_b16 %1, %9\n\tds_read_b64_tr_b16 %2, %8 offset:8192\n\tds_read_b64_tr_b16 %3, %9 offset:8192\n\t"
                 "ds_read_b64_tr_b16 %4, %10\n\tds_read_b64_tr_b16 %5, %11\n\tds_read_b64_tr_b16 %6, %10 offset:8192\n\tds_read_b64_tr_b16 %7, %11 offset:8192\n\ts_waitcnt lgkmcnt(0)"
                 : "=&v"(r0), "=&v"(r1), "=&v"(r2), "=&v"(r3), "=&v"(r4), "=&v"(r5), "=&v"(r6), "=&v"(r7) : "v"(a0), "v"(a1), "v"(a2), "v"(a3) : "memory");
    f0 = (bf16x8){(short)r0[0], (short)r0[1], (short)r0[2], (short)r0[3], (short)r1[0], (short)r1[1], (short)r1[2], (short)r1[3]};
    f1 = (bf16x8){(short)r2[0], (short)r2[1], (short)r2[2], (short)r2[3], (short)r3[0], (short)r3[1], (short)r3[2], (short)r3[3]};
    f2 = (bf16x8){(short)r4[0], (short)r4[1], (short)r4[2], (short)r4[3], (short)r5[0], (short)r5[1], (short)r5[2], (short)r5[3]};
    f3 = (bf16x8){(short)r6[0], (short)r6[1], (short)r6[2], (short)r6[3], (short)r7[0], (short)r7[1], (short)r7[2], (short)r7[3]};
}
__device__ __forceinline__ unsigned cvtpk(float lo, float hi) { unsigned r; asm volatile("v_cvt_pk_bf16_f32 %0, %1, %2" : "=v"(r) : "v"(lo), "v"(hi)); return r; }

constexpr int GLA_PREP_STRIDE = 264;

__device__ __forceinline__ void gla_prep_unit(Frame& F, int unit, const bf16* Z, const bf16* H, const bf16* WlraT, const float* wgk2, const float* bgk, bf16* QT, bf16* KH, bf16* AI, float* GAM) {
    const Tix T = tix();
    const int b = unit >> 8, h = (unit >> 6) & 3, c = unit & 63;
    const int d4 = 4 * T.lane, seg = T.wave;
    const int r = T.lane & 15, g = T.lane >> 4;
    LAS bf16* QA = (LAS bf16*)F.lds; LAS bf16* KA = QA + 64 * GLA_PREP_STRIDE; LAS float* tots = (LAS float*)(KA + 64 * GLA_PREP_STRIDE);
    LAS float* lrp = tots + 2048;
    const size_t rowc = (size_t)b * SEQ + c * 64;
    __syncthreads();
    {
      const int tl = T.wave & 3, kh = T.wave >> 2; f32x4 acc = zero4();
      const bf16* hp = H + (rowc + 16 * tl + r) * D + kh * 1024 + 8 * g; const bf16* wp = WlraT + (size_t)r * D + kh * 1024 + 8 * g;
#pragma unroll 16
      for (int s = 0; s < 32; ++s) acc = __builtin_amdgcn_mfma_f32_16x16x32_bf16(*(const bf16x8*)(hp + 32 * s), *(const bf16x8*)(wp + 32 * s), acc, 0, 0, 0);
#pragma unroll
      for (int e = 0; e < 4; ++e) lrp[(kh * 64 + 16 * tl + 4 * g + e) * 16 + r] = acc[e]; }
    const size_t row0 = rowc + seg * 8;
    v2u qv[8], kv[8];
#pragma unroll
    for (int t = 0; t < 8; ++t) { qv[t] = *(const v2u*)(Z + (row0 + t) * NZ + ZQA + h * 256 + d4); kv[t] = *(const v2u*)(Z + (row0 + t) * NZ + ZKA + h * 256 + d4); }
    __syncthreads();
    f32x4 cum[8]; f32x4 run = zero4();
    { f32x4 w[16];
#pragma unroll
      for (int rr = 0; rr < 16; ++rr) w[rr] = *(const f32x4*)(wgk2 + rr * 1024 + h * 256 + d4);
      const f32x4 bb = *(const f32x4*)(bgk + h * 256 + d4);
#pragma unroll
      for (int t = 0; t < 8; ++t) { const int tk = seg * 8 + t; f32x4 x = bb;
#pragma unroll
          for (int r4 = 0; r4 < 4; ++r4) { const f32x4 l0 = *(const LAS f32x4*)(lrp + tk * 16 + 4 * r4), l1 = *(const LAS f32x4*)(lrp + (64 + tk) * 16 + 4 * r4);
              x += (l0.x + l1.x) * w[4 * r4] + (l0.y + l1.y) * w[4 * r4 + 1] + (l0.z + l1.z) * w[4 * r4 + 2] + (l0.w + l1.w) * w[4 * r4 + 3]; }
#pragma unroll
          for (int j = 0; j < 4; ++j) run[j] += (fminf(x[j], 0.f) - __logf(1.0f + __expf(-fabsf(x[j])))) * (1.0f / 16.0f);
          cum[t] = run; } }
    *(LAS f32x4*)(tots + seg * 256 + d4) = run;
    __syncthreads();
    f32x4 add = zero4(), bmid = add, bl = add;
#pragma unroll
    for (int s = 0; s < 8; ++s) { const f32x4 ts = *(const LAS f32x4*)(tots + s * 256 + d4); if (s < seg) add += ts; if (s < 4) bmid += ts; bl += ts; }
#pragma unroll
    for (int t = 0; t < 8; ++t) { const f32x4 bt = cum[t] + add; const size_t row = row0 + t; const int tk = seg * 8 + t;
        f32x4 q, k; q[0] = __uint_as_float(qv[t].x << 16); q[1] = __uint_as_float(qv[t].x & 0xffff0000u); q[2] = __uint_as_float(qv[t].y << 16); q[3] = __uint_as_float(qv[t].y & 0xffff0000u);
        k[0] = __uint_as_float(kv[t].x << 16); k[1] = __uint_as_float(kv[t].x & 0xffff0000u); k[2] = __uint_as_float(kv[t].y << 16); k[3] = __uint_as_float(kv[t].y & 0xffff0000u);
        q = q * 0.0625f;
        f32x4 o0, o1, o2, o3;
#pragma unroll
        for (int j = 0; j < 4; ++j) { o0[j] = q[j] * __expf(bt[j]); o1[j] = k[j] * __expf(bl[j] - bt[j]); o2[j] = q[j] * __expf(bt[j] - bmid[j]); o3[j] = k[j] * __expf(bmid[j] - bt[j]); }
        v2u w0, w1, w2, w3; w0.x = pk2(o0[0], o0[1]); w0.y = pk2(o0[2], o0[3]); w1.x = pk2(o1[0], o1[1]); w1.y = pk2(o1[2], o1[3]); w2.x = pk2(o2[0], o2[1]); w2.y = pk2(o2[2], o2[3]); w3.x = pk2(o3[0], o3[1]); w3.y = pk2(o3[2], o3[3]);
        *(v2u*)(QT + row * 1024 + h * 256 + d4) = w0; *(v2u*)(KH + row * 1024 + h * 256 + d4) = w1;
        *(LAS v2u*)(QA + tk * GLA_PREP_STRIDE + d4) = w2; *(LAS v2u*)(KA + tk * GLA_PREP_STRIDE + d4) = w3; }
    if (seg == 0) { f32x4 eg; eg[0] = __expf(bl[0]); eg[1] = __expf(bl[1]); eg[2] = __expf(bl[2]); eg[3] = __expf(bl[3]); *(f32x4*)(GAM + (size_t)unit * 256 + d4) = eg; }
    __syncthreads();
#pragma unroll
    for (int x = 0; x < 2; ++x) { const int tt = 2 * T.wave + x, j = tt >> 2, sb = tt & 3;
        f32x4 acc = zero4();
        if (sb <= j) {
#pragma unroll
            for (int ks = 0; ks < 8; ++ks) { const bf16x8 a = *(const LAS bf16x8*)(QA + (16 * j + r) * GLA_PREP_STRIDE + 32 * ks + 8 * g), bb = *(const LAS bf16x8*)(KA + (16 * sb + r) * GLA_PREP_STRIDE + 32 * ks + 8 * g);
                acc = __builtin_amdgcn_mfma_f32_16x16x32_bf16(a, bb, acc, 0, 0, 0); } }
        bf16* ap = AI + (size_t)unit * 4096;
#pragma unroll
        for (int e = 0; e < 4; ++e) { const int t = 16 * j + 4 * g + e, s = 16 * sb + r; ap[t * 64 + s] = (bf16)f2bf(s <= t ? acc[e] : 0.f); } }
}

constexpr int GL_KH = 0, GL_QT = 32768, GL_V = 65536, GL_A = 81920, GL_GAM = 90112, GL_END = 91136;
template <bool OUT>
__device__ __forceinline__ void gla_pass(Frame& F, int worker, const bf16* Z, const bf16* QT, const bf16* KH, const bf16* AI, const float* GAM, float* GST, float* GAMS, float* OB, float* state_out, int var = 0) {
    const Tix T = tix();
    const int lane = T.lane, wave = T.wave, r = lane & 15, g = lane >> 4;
    const int grp = worker >> 2, qs = worker & 3, b = grp >> 5, h = (grp >> 3) & 3, sc = grp & 7;
    const unsigned lbase = (unsigned)(size_t)F.lds; const TrLane tl = tr_lane((unsigned)lane);
    f32x4 S[16];
#pragma unroll
    for (int i = 0; i < 16; ++i) S[i] = zero4();
    if (OUT && !(var & 2048)) {
        const f32x4* gp = (const f32x4*)(GST + ((((size_t)grp * 4 + qs) * 8 + wave) * 16) * 256) + lane;
#pragma unroll
        for (int i = 0; i < 16; ++i) S[i] = gp[64 * i];
    }
    const int srow = T.tid >> 4, sch = T.tid & 15;
    v4u pk[2][2], pq[2][2], pv[2], pa; f32x4 pg;
    const size_t seq0 = (size_t)b * SEQ + sc * 512;
    const unsigned tko = (unsigned)(srow * 1024 + 8 * sch) * 2u, tvo = (unsigned)(srow * NZ + 8 * sch) * 2u;
#define GLA_LOAD(cc) do { const size_t rw = seq0 + (cc) * 64; const size_t un = (size_t)((b * 4 + h) * 64 + sc * 8 + (cc)); \
        const char* kb = (const char*)(KH + rw * 1024 + h * 256); const char* qb = (const char*)(QT + rw * 1024 + h * 256); const char* vb = (const char*)(Z + rw * NZ + ZVA + h * 512 + qs * 128); \
        _Pragma("unroll") for (int hh = 0; hh < 2; ++hh) _Pragma("unroll") for (int u = 0; u < 2; ++u) { \
            pk[hh][u] = *(const v4u*)(kb + (hh * 256 + u * 65536) + tko); \
            if (OUT) pq[hh][u] = *(const v4u*)(qb + (hh * 256 + u * 65536) + tko); } \
        _Pragma("unroll") for (int u = 0; u < 2; ++u) pv[u] = *(const v4u*)(vb + (size_t)u * (32 * NZ * 2) + tvo); \
        if (OUT) pa = *(const v4u*)((const char*)(AI + un * 4096) + (unsigned)T.tid * 16u); \
        if (T.tid < 64) pg = *(const f32x4*)((const char*)(GAM + un * 256) + (unsigned)T.tid * 16u); } while (0)
    GLA_LOAD(0);
    for (int c = 0; c < 8; ++c) {
        __syncthreads();
#pragma unroll
        for (int hh = 0; hh < 2; ++hh)
#pragma unroll
            for (int u = 0; u < 2; ++u) { *(LAS v4u*)(F.lds + GL_KH + hh * 16384 + offb(srow + 32 * u, sch)) = pk[hh][u]; if (OUT) *(LAS v4u*)(F.lds + GL_QT + hh * 16384 + offb(srow + 32 * u, sch)) = pq[hh][u]; }
#pragma unroll
        for (int u = 0; u < 2; ++u) *(LAS v4u*)(F.lds + GL_V + offb(srow + 32 * u, sch)) = pv[u];
        if (OUT) { const int ar = T.tid >> 3, ach = T.tid & 7; *(LAS v4u*)(F.lds + GL_A + 128 * ar + 16 * (ach ^ (ar & 7))) = pa; }
        if (T.tid < 64) *(LAS f32x4*)(F.lds + GL_GAM + 16 * T.tid) = pg;
        __syncthreads();
        if (c + 1 < 8) GLA_LOAD(c + 1);
        bf16x8 V0, V1; tr_frag2(lbase + GL_V, tl, (unsigned)wave, V0, V1);
        if (OUT && !(var & 1024)) {
            const size_t orow0 = seq0 + c * 64;
            const unsigned mr = ((unsigned)(r & 3) << 2) | ((unsigned)(r >> 2) & 3u);
            const unsigned ql0 = 256u * r + 8u * (g & 1) + 16u * (((unsigned)(g >> 1)) ^ (mr & 3u)), ql1 = 256u * r + 8u * (g & 1) + 16u * ((((unsigned)(g >> 1)) | 2u) ^ (mr & 3u)), qx = (mr >> 2) << 6;
            const unsigned al0 = 128u * r + 16u * (((unsigned)g) ^ (unsigned)(r & 7)), al1 = 128u * r + 16u * ((4u + (unsigned)g) ^ (unsigned)(r & 7));
#pragma unroll 1
            for (int j = 0; j < 4; ++j) {
                f32x4 acc = zero4();
                { const bf16x8 a0 = *(const LAS bf16x8*)(F.lds + GL_A + 2048 * j + al0), a1 = *(const LAS bf16x8*)(F.lds + GL_A + 2048 * j + al1);
                  acc = __builtin_amdgcn_mfma_f32_16x16x32_bf16(V0, a0, acc, 0, 0, 0); acc = __builtin_amdgcn_mfma_f32_16x16x32_bf16(V1, a1, acc, 0, 0, 0); }
#pragma unroll
                for (int s = 0; s < 8; ++s) {
                    const unsigned qo = GL_QT + (unsigned)(s >> 2) * 16384u + 4096u * j + ((64u * (s & 3)) ^ qx);
                    const v2u lo = *(const LAS v2u*)(F.lds + qo + ql0), hi = *(const LAS v2u*)(F.lds + qo + ql1);
                    const v4u w = (v4u){lo.x, lo.y, hi.x, hi.y};
                    const v4u sw = (v4u){cvtpk(S[2 * s][0], S[2 * s][1]), cvtpk(S[2 * s][2], S[2 * s][3]), cvtpk(S[2 * s + 1][0], S[2 * s + 1][1]), cvtpk(S[2 * s + 1][2], S[2 * s + 1][3])};
                    acc = __builtin_amdgcn_mfma_f32_16x16x32_bf16(__builtin_bit_cast(bf16x8, sw), __builtin_bit_cast(bf16x8, w), acc, 0, 0, 0); }
                *(f32x4*)(OB + (orow0 + 16 * j + r) * 2048 + h * 512 + qs * 128 + 16 * wave + 4 * g) = acc;
            }
        }
#pragma unroll
        for (int i = 0; i < 16; i += 2) {
            const f32x4 gm0 = *(const LAS f32x4*)(F.lds + GL_GAM + 4 * (16 * i + 4 * g)), gm1 = *(const LAS f32x4*)(F.lds + GL_GAM + 4 * (16 * (i + 1) + 4 * g));
            bf16x8 k0, k1, k2, k3; tr_frag4(lbase + GL_KH + (i >> 3) * 16384, tl, (unsigned)(i & 7), k0, k1, k2, k3);
            f32x4 s0 = S[i] * gm0, s1 = S[i + 1] * gm1;
            s0 = __builtin_amdgcn_mfma_f32_16x16x32_bf16(k0, V0, s0, 0, 0, 0); s1 = __builtin_amdgcn_mfma_f32_16x16x32_bf16(k2, V0, s1, 0, 0, 0);
            S[i] = __builtin_amdgcn_mfma_f32_16x16x32_bf16(k1, V1, s0, 0, 0, 0); S[i + 1] = __builtin_amdgcn_mfma_f32_16x16x32_bf16(k3, V1, s1, 0, 0, 0);
        }
    }
#undef GLA_LOAD
    if (!OUT) {
        f32x4* gp = (f32x4*)(GST + ((((size_t)grp * 4 + qs) * 8 + wave) * 16) * 256) + lane;
#pragma unroll
        for (int i = 0; i < 16; ++i) gp[64 * i] = S[i];
        if (qs == 0 && wave == 0) {
            f32x4 gt = (f32x4){1.f, 1.f, 1.f, 1.f};
            for (int c = 0; c < 8; ++c) gt = gt * *(const f32x4*)(GAM + ((size_t)((b * 4 + h) * 64 + sc * 8 + c)) * 256 + 4 * lane);
            *(f32x4*)(GAMS + (size_t)grp * 256 + 4 * lane) = gt; }
    } else if (sc == 7) {
#pragma unroll
        for (int i = 0; i < 16; ++i)
#pragma unroll
            for (int e = 0; e < 4; ++e) state_out[(((size_t)b * 4 + h) * 256 + 16 * i + 4 * g + e) * 512 + qs * 128 + 16 * wave + r] = S[i][e];
    }
    __syncthreads();
}

constexpr int GM_W = 0, GM_V = 32768, GM_END = 98304;
__device__ __forceinline__ void gm_mix_unit(Frame& F, int unit, const bf16* Z, const bf16* VNB, const float* ws_, const float* bs, bf16* OABC) {
    const Tix T = tix();
    const int lane = T.lane, wave = T.wave, r = lane & 15, g4 = lane >> 4;
    const int n = unit >> 2, grp = unit & 3; const size_t row0 = (size_t)n * 128;
    __syncthreads();
#pragma unroll
    for (int i = 0; i < 4; ++i) { const int ci = T.tid + 512 * i, row = ci >> 4, ch = ci & 15; const float* wp = ws_ + ((size_t)grp * 128 + row) * 128 + 8 * ch;
        const f32x4 a = *(const f32x4*)wp, b = *(const f32x4*)(wp + 4); const int s0 = 8 * ch;
        v4u o; o.x = pk2(s0 + 0 <= row ? a.x : 0.f, s0 + 1 <= row ? a.y : 0.f); o.y = pk2(s0 + 2 <= row ? a.z : 0.f, s0 + 3 <= row ? a.w : 0.f);
        o.z = pk2(s0 + 4 <= row ? b.x : 0.f, s0 + 5 <= row ? b.y : 0.f); o.w = pk2(s0 + 6 <= row ? b.z : 0.f, s0 + 7 <= row ? b.w : 0.f);
        *(LAS v4u*)(F.lds + GM_W + offb((unsigned)row, (unsigned)ch)) = o; }
#pragma unroll
    for (int i = 0; i < 8; ++i) { const int ci = T.tid + 512 * i, row = ci >> 5, c32 = ci & 31;
        const v4u v = *(const v4u*)(VNB + (row0 + row) * 1024 + grp * 256 + 8 * c32);
        *(LAS v4u*)(F.lds + GM_V + (c32 >> 4) * 32768 + offb((unsigned)row, (unsigned)(c32 & 15))) = v; }
    __syncthreads();
    const unsigned lbase = (unsigned)(size_t)F.lds; const TrLane tl = tr_lane((unsigned)lane);
    bf16x8 Bf[2][4];
#pragma unroll
    for (int x = 0; x < 2; ++x) { const unsigned ct = 2u * wave + x;
        const unsigned vb = lbase + GM_V + (ct >> 3) * 32768u;
        tr_frag2(vb, tl, ct & 7u, Bf[x][0], Bf[x][1]); tr_frag2(vb + 16384u, tl, ct & 7u, Bf[x][2], Bf[x][3]); }
    const unsigned mr = ((unsigned)(r & 3) << 2) | ((unsigned)(r >> 2) & 3u);
#pragma unroll
    for (int j = 0; j < 8; ++j) {
        f32x4 acc0 = zero4(), acc1 = acc0;
#pragma unroll
        for (int ks = 0; ks <= (j >> 1); ++ks) {
            const bf16x8 a = *(const LAS bf16x8*)(F.lds + GM_W + 256u * (16 * j + r) + 16u * (((unsigned)(4 * ks + g4)) ^ mr));
            acc0 = __builtin_amdgcn_mfma_f32_16x16x32_bf16(Bf[0][ks], a, acc0, 0, 0, 0); acc1 = __builtin_amdgcn_mfma_f32_16x16x32_bf16(Bf[1][ks], a, acc1, 0, 0, 0); }
        const int t = 16 * j + r; const size_t row = row0 + t; const float bb = bs[grp * 128 + t];
#pragma unroll
        for (int x = 0; x < 2; ++x) { const int c = grp * 256 + 32 * wave + 16 * x + 4 * g4; const f32x4 av = x ? acc1 : acc0;
            const v2u uq = *(const v2u*)(Z + row * NZ + ZUB + c);
            v2u o; o.x = pk2(geluf_(__uint_as_float(uq.x << 16)) * (av[0] + bb), geluf_(__uint_as_float(uq.x & 0xffff0000u)) * (av[1] + bb));
            o.y = pk2(geluf_(__uint_as_float(uq.y << 16)) * (av[2] + bb), geluf_(__uint_as_float(uq.y & 0xffff0000u)) * (av[3] + bb));
            *(v2u*)(OABC + row * 4096 + 2048 + c) = o; }
    }
}

constexpr int SW_K = 0, SW_V = 32768, SW_END = 65536;
__device__ __forceinline__ void swa_unit(Frame& F, int unit, const bf16* Z, const float* sinks, bf16* OABC) {
    const Tix T = tix();
    const int lane = T.lane, wave = T.wave, r = lane & 15, g = lane >> 4;
    const int kv = unit & 3, n = (unit >> 2) & 31, b = unit >> 7;
    const size_t rowq0 = (size_t)b * SEQ + n * 128;
    __syncthreads();
#pragma unroll
    for (int i = 0; i < 4; ++i) { const int ci = T.tid + 512 * i, key = ci >> 3, ch = ci & 7;
        v4u kk = (v4u){0u, 0u, 0u, 0u}, vv = kk;
        if (n > 0 || key >= 128) { const bf16* zp = Z + (rowq0 - 128 + key) * NZ + kv * 64 + 8 * ch; kk = *(const v4u*)(zp + ZKC); vv = *(const v4u*)(zp + ZVC); }
        const unsigned o = 128u * key + 16u * ((unsigned)ch ^ (unsigned)(key & 7));
        *(LAS v4u*)(F.lds + SW_K + o) = kk; *(LAS v4u*)(F.lds + SW_V + o) = vv; }
    __syncthreads();
    const int head = kv * 4 + (wave >> 1), qh = wave & 1;
    const float slope = exp2f(-0.5f * (float)(head + 1)), sink = sinks[head];
    const unsigned lbase = (unsigned)(size_t)F.lds;
    bf16x8 qfa[4][2];
#pragma unroll
    for (int qt = 0; qt < 4; ++qt)
#pragma unroll
        for (int ks = 0; ks < 2; ++ks) qfa[qt][ks] = *(const bf16x8*)(Z + (rowq0 + 64 * qh + 16 * qt + r) * NZ + ZQC + head * 64 + 32 * ks + 8 * g);
#pragma unroll
    for (int qt = 0; qt < 4; ++qt) {
        const int i0 = 64 * qh + 16 * qt, a = i0 >> 4;
        const size_t qrow = rowq0 + i0 + r;
        bf16x8 qf[2]; qf[0] = qfa[qt][0]; qf[1] = qfa[qt][1];
        f32x4 st[10];
#pragma unroll
        for (int t = 0; t < 9; ++t) { const int krow = 16 * (a + t) + r; f32x4 acc = zero4();
#pragma unroll
            for (int ks = 0; ks < 2; ++ks) { const bf16x8 kf = *(const LAS bf16x8*)(F.lds + SW_K + 128u * krow + 16u * (((unsigned)(4 * ks + g)) ^ (unsigned)(krow & 7)));
                acc = __builtin_amdgcn_mfma_f32_16x16x32_bf16(kf, qf[ks], acc, 0, 0, 0); }
            st[t] = acc; }
        st[9] = zero4();
        const int iq = i0 + r; float mx = sink;
#pragma unroll
        for (int t = 0; t < 9; ++t)
#pragma unroll
            for (int e = 0; e < 4; ++e) { const int j = 16 * (a + t) + 4 * g + e, dist = 128 + iq - j; const bool ok = dist >= 0 && dist < 128 && (n > 0 || j >= 128);
                const float s = ok ? st[t][e] * 0.125f - slope * (float)dist : -1e30f; st[t][e] = s; mx = fmaxf(mx, s); }
        mx = fmaxf(mx, __shfl_xor(mx, 16)); mx = fmaxf(mx, __shfl_xor(mx, 32));
        float sum = 0.f;
#pragma unroll
        for (int t = 0; t < 9; ++t)
#pragma unroll
            for (int e = 0; e < 4; ++e) { const float p = __expf(st[t][e] - mx); st[t][e] = p; sum += p; }
        sum += __shfl_xor(sum, 16); sum += __shfl_xor(sum, 32);
        const float inv = 1.0f / (sum + __expf(sink - mx));
        f32x4 o[4];
#pragma unroll
        for (int dt = 0; dt < 4; ++dt) o[dt] = zero4();
#pragma unroll
        for (int pr = 0; pr < 5; ++pr) {
            const v4u pw = (v4u){cvtpk(st[2 * pr][0], st[2 * pr][1]), cvtpk(st[2 * pr][2], st[2 * pr][3]), cvtpk(st[2 * pr + 1][0], st[2 * pr + 1][1]), cvtpk(st[2 * pr + 1][2], st[2 * pr + 1][3])};
            const bf16x8 pf = __builtin_bit_cast(bf16x8, pw);
            const int q4 = r >> 2, p4 = r & 3;
            const int k0 = 16 * (a + 2 * pr) + 4 * g + q4; int k1 = k0 + 16; if (k1 > 255) k1 = 255;
            const unsigned b0 = lbase + SW_V + 128u * k0 + 8u * (p4 & 1), b1 = lbase + SW_V + 128u * k1 + 8u * (p4 & 1);
            const unsigned x0 = (unsigned)(k0 & 7), x1 = (unsigned)(k1 & 7), ph = (unsigned)(p4 >> 1);
            u16x4 r0, r1, r2, r3, r4, r5, r6, r7;
            asm volatile("ds_read_b64_tr_b16 %0, %8\n\tds_read_b64_tr_b16 %1, %9\n\tds_read_b64_tr_b16 %2, %10\n\tds_read_b64_tr_b16 %3, %11\n\t"
                         "ds_read_b64_tr_b16 %4, %12\n\tds_read_b64_tr_b16 %5, %13\n\tds_read_b64_tr_b16 %6, %14\n\tds_read_b64_tr_b16 %7, %15\n\ts_waitcnt lgkmcnt(0)"
                         : "=&v"(r0), "=&v"(r1), "=&v"(r2), "=&v"(r3), "=&v"(r4), "=&v"(r5), "=&v"(r6), "=&v"(r7)
                         : "v"(b0 + 16u * ((0u + ph) ^ x0)), "v"(b1 + 16u * ((0u + ph) ^ x1)), "v"(b0 + 16u * ((2u + ph) ^ x0)), "v"(b1 + 16u * ((2u + ph) ^ x1)),
                           "v"(b0 + 16u * ((4u + ph) ^ x0)), "v"(b1 + 16u * ((4u + ph) ^ x1)), "v"(b0 + 16u * ((6u + ph) ^ x0)), "v"(b1 + 16u * ((6u + ph) ^ x1)) : "memory");
            const bf16x8 v0 = (bf16x8){(short)r0[0], (short)r0[1], (short)r0[2], (short)r0[3], (short)r1[0], (short)r1[1], (short)r1[2], (short)r1[3]};
            const bf16x8 v1 = (bf16x8){(short)r2[0], (short)r2[1], (short)r2[2], (short)r2[3], (short)r3[0], (short)r3[1], (short)r3[2], (short)r3[3]};
            const bf16x8 v2 = (bf16x8){(short)r4[0], (short)r4[1], (short)r4[2], (short)r4[3], (short)r5[0], (short)r5[1], (short)r5[2], (short)r5[3]};
            const bf16x8 v3 = (bf16x8){(short)r6[0], (short)r6[1], (short)r6[2], (short)r6[3], (short)r7[0], (short)r7[1], (short)r7[2], (short)r7[3]};
            o[0] = __builtin_amdgcn_mfma_f32_16x16x32_bf16(v0, pf, o[0], 0, 0, 0); o[1] = __builtin_amdgcn_mfma_f32_16x16x32_bf16(v1, pf, o[1], 0, 0, 0);
            o[2] = __builtin_amdgcn_mfma_f32_16x16x32_bf16(v2, pf, o[2], 0, 0, 0); o[3] = __builtin_amdgcn_mfma_f32_16x16x32_bf16(v3, pf, o[3], 0, 0, 0);
        }
        bf16* op = OABC + qrow * 4096 + 3072 + head * 64 + 4 * g;
#pragma unroll
        for (int dt = 0; dt < 4; ++dt) { v2u w; w.x = pk2(o[dt][0] * inv, o[dt][1] * inv); w.y = pk2(o[dt][2] * inv, o[dt][3] * inv); *(v2u*)(op + 16 * dt) = w; }
    }
}

__device__ __forceinline__ void swa_sample_wave(Frame& F, int item, const bf16* Z, const float* sinks, const float* ck, const float* cv, bf16* OABC) {
    const Tix T = tix();
    const int lane = T.lane, b = item >> 4, head = item & 15, kv = head >> 2; const size_t row = MP + b;
    LAS float* sq = (LAS float*)(F.lds + T.wave * 1024); LAS float* sp = sq + 64;
    const float slope = exp2f(-0.5f * (float)(head + 1)), sink = sinks[head];
    sq[lane] = bf2f(Z[row * NZ + ZQC + head * 64 + lane]);
    LDS_WAIT();
    float s2[2];
#pragma unroll
    for (int u = 0; u < 2; ++u) { const int j = 1 + lane + 64 * u;
        float s = 0.f;
        if (j < 128) { const float* kp = ck + ((size_t)(b * 128 + j) * 4 + kv) * 64;
#pragma unroll
            for (int d4 = 0; d4 < 16; ++d4) { const f32x4 kk = *(const f32x4*)(kp + 4 * d4); const f32x4 qq = *(const LAS f32x4*)(sq + 4 * d4); s += (qq.x * kk.x + qq.y * kk.y) + (qq.z * kk.z + qq.w * kk.w); } }
        else { const bf16* kp = Z + row * NZ + ZKC + kv * 64;
#pragma unroll
            for (int d = 0; d < 64; ++d) s += sq[d] * bf2f(kp[d]); }
        s2[u] = s * 0.125f - slope * (float)(128 - j); }
    float mx = fmaxf(fmaxf(s2[0], s2[1]), sink);
#pragma unroll
    for (int o = 1; o < 64; o <<= 1) mx = fmaxf(mx, __shfl_xor(mx, o));
    const float p0 = __expf(s2[0] - mx), p1 = __expf(s2[1] - mx);
    const float inv = 1.0f / (wave_sum(p0 + p1) + __expf(sink - mx));
    sp[lane] = p0; sp[64 + lane] = p1;
    LDS_WAIT();
    { const int jq = lane >> 4, d4 = 4 * (lane & 15); f32x4 acc = zero4();
      f32x4 vv[32];
#pragma unroll
      for (int i = 0; i < 32; ++i) { const int jj = 4 * i + jq;
          if (jj < 127) vv[i] = *(const f32x4*)(cv + ((size_t)(b * 128 + jj + 1) * 4 + kv) * 64 + d4);
          else { const v2u w = *(const v2u*)(Z + row * NZ + ZVC + kv * 64 + d4); vv[i] = (f32x4){__uint_as_float(w.x << 16), __uint_as_float(w.x & 0xffff0000u), __uint_as_float(w.y << 16), __uint_as_float(w.y & 0xffff0000u)}; } }
#pragma unroll
      for (int i = 0; i < 32; ++i) acc += vv[i] * sp[4 * i + jq];
#pragma unroll
      for (int j = 0; j < 4; ++j) { acc[j] += __shfl_xor(acc[j], 16); acc[j] += __shfl_xor(acc[j], 32); }
      if (jq == 0) { v2u w; w.x = pk2(acc[0] * inv, acc[1] * inv); w.y = pk2(acc[2] * inv, acc[3] * inv); *(v2u*)(OABC + row * 4096 + 3072 + head * 64 + d4) = w; } }
    LDS_WAIT();
}

constexpr int MD_PITCH = 208;
__device__ __forceinline__ void mod_direct(Frame& F, const bf16* CA  , const float* wada  , const float* bada  , float* MOD  ) {
    const Tix T = tix();
    const int lane = T.lane, wave = T.wave, r = lane & 15, g = lane >> 4;
    for (int sl = (int)blockIdx.x; sl < 256; sl += F.G) {
        const int l = sl >> 7, n0 = (sl & 127) * 96;
        const float* W = wada + (size_t)l * D * NADA + n0;
        f32x4 acc[7];
#pragma unroll
        for (int i = 0; i < 7; ++i) acc[i] = zero4();
        f32x4 pw[6];
        const unsigned sk0 = (unsigned)(T.tid / 24), sq0 = (unsigned)(T.tid % 24);
#define MD_LOAD(kb) do { unsigned kk = sk0, q = sq0; _Pragma("unroll") for (int i = 0; i < 6; ++i) { pw[i] = *(const f32x4*)(W + (size_t)((kb) * 128 + kk) * NADA + 4 * q); q += 8; kk += 21; if (q >= 24) { q -= 24; kk += 1; } } } while (0)
        MD_LOAD(0);
        const unsigned lbase = (unsigned)(size_t)F.lds;
        for (int kb = 0; kb < 16; ++kb) {
            __syncthreads();
            { unsigned kk = sk0, q = sq0;
#pragma unroll
              for (int i = 0; i < 6; ++i) { v2u w; w.x = pk2(pw[i].x, pw[i].y); w.y = pk2(pw[i].z, pw[i].w); *(LAS v2u*)(F.lds + kk * MD_PITCH + 8 * q) = w; q += 8; kk += 21; if (q >= 24) { q -= 24; kk += 1; } } }
            __syncthreads();
            if (kb + 1 < 16) MD_LOAD(kb + 1);
            bf16x8 af[4], ag[4];
#pragma unroll
            for (int k4 = 0; k4 < 4; ++k4) { af[k4] = *(const bf16x8*)(CA + (size_t)(16 * wave + r) * D + kb * 128 + 32 * k4 + 8 * g); ag[k4] = *(const bf16x8*)(CA + (size_t)(128 + r) * D + kb * 128 + 32 * k4 + 8 * g); }
#pragma unroll
            for (int ks = 0; ks < 4; ++ks) {
                const bf16x8 a0 = af[ks], a8 = ag[ks];
                const unsigned q4 = (unsigned)(r >> 2), p4 = (unsigned)(r & 3);
                const unsigned a_lo = lbase + (32u * ks + 8u * g + q4) * MD_PITCH + 8u * p4, a_hi = a_lo + 4u * MD_PITCH;
                u16x4 t0, t1, t2, t3, t4, t5, t6, t7, t8, t9, ta, tb;
                asm volatile("ds_read_b64_tr_b16 %0, %12\n\tds_read_b64_tr_b16 %1, %13\n\tds_read_b64_tr_b16 %2, %12 offset:32\n\tds_read_b64_tr_b16 %3, %13 offset:32\n\t"
                             "ds_read_b64_tr_b16 %4, %12 offset:64\n\tds_read_b64_tr_b16 %5, %13 offset:64\n\tds_read_b64_tr_b16 %6, %12 offset:96\n\tds_read_b64_tr_b16 %7, %13 offset:96\n\t"
                             "ds_read_b64_tr_b16 %8, %12 offset:128\n\tds_read_b64_tr_b16 %9, %13 offset:128\n\tds_read_b64_tr_b16 %10, %12 offset:160\n\tds_read_b64_tr_b16 %11, %13 offset:160\n\ts_waitcnt lgkmcnt(0)"
                             : "=&v"(t0), "=&v"(t1), "=&v"(t2), "=&v"(t3), "=&v"(t4), "=&v"(t5), "=&v"(t6), "=&v"(t7), "=&v"(t8), "=&v"(t9), "=&v"(ta), "=&v"(tb) : "v"(a_lo), "v"(a_hi) : "memory");
#define MD_FR(lo, hi) (bf16x8){(short)lo[0], (short)lo[1], (short)lo[2], (short)lo[3], (short)hi[0], (short)hi[1], (short)hi[2], (short)hi[3]}
                const bf16x8 bfr[6] = {MD_FR(t0, t1), MD_FR(t2, t3), MD_FR(t4, t5), MD_FR(t6, t7), MD_FR(t8, t9), MD_FR(ta, tb)};
#undef MD_FR
#pragma unroll
                for (int nt = 0; nt < 6; ++nt) {
                    acc[nt] = __builtin_amdgcn_mfma_f32_16x16x32_bf16(a0, bfr[nt], acc[nt], 0, 0, 0);
                    if (nt == wave) acc[6] = __builtin_amdgcn_mfma_f32_16x16x32_bf16(a8, bfr[nt], acc[6], 0, 0, 0);
                }
            }
        }
#undef MD_LOAD
        float* mo = MOD + (size_t)l * 256 * NADA; const float* bb = bada + (size_t)l * NADA;
#pragma unroll
        for (int nt = 0; nt < 6; ++nt) { const int col = n0 + 16 * nt + r; const float bv = bb[col];
#pragma unroll
            for (int e = 0; e < 4; ++e) mo[(size_t)(16 * wave + 4 * g + e) * NADA + col] = acc[nt][e] + bv; }
        if (wave < 6) { const int col = n0 + 16 * wave + r; const float bv = bb[col];
#pragma unroll
            for (int e = 0; e < 4; ++e) mo[(size_t)(128 + 4 * g + e) * NADA + col] = acc[6][e] + bv; }
        __syncthreads();
    }
}

__device__ __forceinline__ void gla_scan(Frame& F, float* GST, const float* GAMS) {
    const Tix T = tix();
    const int gw = F.vcu * NWAVES + T.wave, NGW = F.G * NWAVES, g = T.lane >> 4;
    for (int item = gw; item < 8 * 4 * 8 * 16; item += NGW) {
        const int i = item & 15, w = (item >> 4) & 7, qs = (item >> 7) & 3, bh = item >> 9;
        f32x4 G[8], Gm[8];
#pragma unroll
        for (int sc = 0; sc < 8; ++sc) { const int grp = bh * 8 + sc;
            G[sc] = *((const f32x4*)(GST + ((((size_t)grp * 4 + qs) * 8 + w) * 16 + i) * 256) + T.lane);
            Gm[sc] = *(const f32x4*)(GAMS + (size_t)grp * 256 + 16 * i + 4 * g); }
        f32x4 S = zero4();
#pragma unroll
        for (int sc = 0; sc < 8; ++sc) { const int grp = bh * 8 + sc;
            *((f32x4*)(GST + ((((size_t)grp * 4 + qs) * 8 + w) * 16 + i) * 256) + T.lane) = S;
            S = Gm[sc] * S + G[sc]; }
    }
}
constexpr int NPH = 27;
#ifndef EN_CONV
#define EN_CONV 1
#endif
#ifndef EN_MOD
#define EN_MOD 1
#endif
#ifndef EN_NORM
#define EN_NORM 1
#endif
#ifndef EN_WIN
#define EN_WIN 1
#endif
#ifndef EN_GK
#define EN_GK 1
#endif
#ifndef EN_GLAN
#define EN_GLAN 1
#endif
#ifndef EN_MIXA
#define EN_MIXA 1
#endif
#ifndef EN_MIXB
#define EN_MIXB 1
#endif
#ifndef EN_PROJ
#define EN_PROJ 1
#endif
#ifndef EN_WO
#define EN_WO 1
#endif
#ifndef EN_FFI
#define EN_FFI 1
#endif
#ifndef EN_FFO
#define EN_FFO 1
#endif
#ifndef EN_FINAL
#define EN_FINAL 1
#endif
#ifndef MK_PROBE
#define MK_PROBE 1
#endif
#ifndef MK_REP_K
#define MK_REP_K 24
#endif
#ifndef MK_REP_N
#define MK_REP_N 4
#endif
#ifndef MK_REP_VAR
#define MK_REP_VAR 0
#endif
#ifndef MK_ONE_LAUNCH
#define MK_ONE_LAUNCH 1
#endif
typedef const __attribute__((address_space(4))) Prm* KPrm;
__device__ __forceinline__ KPrm kargs() { KPrm p = (KPrm)__builtin_amdgcn_kernarg_segment_ptr(); asm volatile("" : "+s"(p)); return p; }
#define PH_BEGIN KPrm K = kargs(); unsigned char* ws = K->ws; (void)ws;
__global__ void __launch_bounds__(NT, 2) mega_fwd(Prm P_unused) {
    extern __shared__ __attribute__((aligned(16))) unsigned char lds_raw[];
    Frame F;
    F.lds = (LAS unsigned char*)lds_raw;
    F.G = gridDim.x; { const int bx = blockIdx.x; F.vcu = (F.G % 8 == 0) ? (bx % 8) * (F.G / 8) + bx / 8 : bx; }
    volatile LAS unsigned* MISC = (volatile LAS unsigned*)(F.lds + MISC_OFF);
    if (threadIdx.x < 64) MISC[threadIdx.x] = 0u;
    __syncthreads();
    int lo, hi;
    XcdBarrier bar;
    { KPrm K = kargs(); lo = K->ph_lo; hi = K->ph_hi; unsigned* ctl = (unsigned*)(K->ws + WS_CTL);
      bar.bar = ctl + CW_BAR; bar.x = 0; bar.st = nullptr;
      if (hi - lo > 1) bar = xcd_barrier_post(ctl + CW_BAR, MISC + 8); }
#define IN(k) (lo <= (k) && (k) < hi)
#define SEAM(k) do { if (IN(k) && IN((k) + 1)) xcd_barrier(bar); } while (0)
#define WSP(T, off) ((T*)(ws + (off)))

    if (EN_CONV && IN(0)) { phase_convert(F); }
    SEAM(0);
    if (EN_MOD && IN(1)) { PH_BEGIN mod_direct(F, WSP(const bf16, WS_CA), K->in[I_WADA], K->in[I_BADA], WSP(float, WS_MOD)); }
    SEAM(1);
#if 0
    SEAM(0);
    if (EN_MOD && IN(1)) {
        PH_BEGIN
        const int c = (int)blockIdx.x, l = c / 48;
        if (l < 2) {
            pg8::Gemm g{WSP(const bf16, WS_CA), WSP(const bf16, WS_WADA) + (size_t)l * NADA * D, 256, NADA, D, D};
            pg8::StaticOrder S; S.init(256, NADA, 1 << 20, c - 48 * l, D);
            pg8::EpiF32 E{WSP(float, WS_MOD) + (size_t)l * 256 * NADA, NADA, K->in[I_BADA] + (size_t)l * NADA};
            pg8::gemm_phase<pg8::EpiF32, pg8::StaticOrder, true, true>(F.lds, g, S, E);
        }
    }
    SEAM(1);
#endif

    for (int l = 0; l < 2; ++l) {
        const int pb = 2 + 12 * l;
        if (EN_NORM && IN(pb + 0)) { PH_BEGIN phase_norm_t<false>(F, WSP(float, WS_X), K->in[I_N1W] + (size_t)l * D, WSP(const float, WS_MOD) + (size_t)l * 256 * NADA, MOD_SH1, MOD_SC1, WSP(bf16, WS_H), nullptr, WSP(const float, WS_PART + 16 * MiB), l == 0 ? 0 : 11); }
        SEAM(pb + 0);
        if (EN_WIN && IN(pb + 1)) {
            PH_BEGIN
            pg8::Gemm g{WSP(const bf16, WS_H), WSP(const bf16, WS_WIN) + (size_t)l * NZW * D, MT, NZ, D, D};
            pg8::StaticOrder S; S.init(MT, NZ, F.G, (int)blockIdx.x, D);
            pg8::EpiZ E{WSP(bf16, WS_Z), NZ, ZGT / 256, K->var};
            pg8::gemm_phase<pg8::EpiZ, pg8::StaticOrder, true, true>(F.lds, g, S, E);
        }
        SEAM(pb + 1);
        if (IN(pb + 2)) {
            PH_BEGIN
            const bf16* Zb = WSP(const bf16, WS_Z); const bf16* Hb = WSP(const bf16, WS_H); const bf16* Wl = WSP(const bf16, WS_WIN) + (size_t)l * NZW * D + (size_t)ZLR * D;
            const float* wgk2 = K->in[I_WGK2] + (size_t)l * 16 * 1024; const float* bgk = K->in[I_BGK] + (size_t)l * 1024;
            const int ow = (int)blockIdx.x, OW = F.G;
            for (int half = 0; half < 2; ++half) {
                if ((half == 0) == ((ow & 1) == 1)) {
                    if (EN_MIXA && !(K->var & 8)) for (int u = ow; u < 512; u += OW) gla_sample_unit(F, u, Zb, Hb, Wl, wgk2, bgk, K->in[I_SGLA] + (size_t)l * 128 * 4 * 256 * 512, K->out + O_SGS + (size_t)l * 128 * 4 * 256 * 512, K->in[I_GLANW] + (size_t)l * 512, WSP(bf16, WS_OABC));
                } else {
                    if (EN_GLAN && !(K->var & 16)) for (int u = ow; u < 512; u += OW) gla_prep_unit(F, u, Zb, Hb, Wl, wgk2, bgk, WSP(bf16, WS_QT), WSP(bf16, WS_KH), WSP(bf16, WS_AI), WSP(float, WS_GAM));
                    if (EN_MIXA && !(K->var & 32)) {
                        __syncthreads();
                        if (!(K->var & 64)) gm_ln_rows(F, ow, OW, Zb, K->in[I_GMNW] + (size_t)l * 1024, K->in[I_GMNB] + (size_t)l * 1024, WSP(bf16, WS_VNB), K->out + O_GMV + (size_t)l * 128 * 1024, K->in[I_GMWS] + (size_t)l * 4 * 128 * 128, K->in[I_GMBS] + (size_t)l * 4 * 128, WSP(bf16, WS_OABC));
                        if (!(K->var & 128)) for (int u = ow; u < 256; u += OW) swa_unit(F, u, Zb, K->in[I_SINK] + (size_t)l * 16, WSP(bf16, WS_OABC));
                        __syncthreads();
                        if (!(K->var & 256)) for (int it = ow * NWAVES + tix().wave; it < MS * 16; it += OW * NWAVES) swa_sample_wave(F, it, Zb, K->in[I_SINK] + (size_t)l * 16, K->in[I_CK] + (size_t)l * 128 * 128 * 256, K->in[I_CV] + (size_t)l * 128 * 128 * 256, WSP(bf16, WS_OABC));
                        __syncthreads();
                        cache_outs(F, ow, OW, l, Zb, K->out);
                    }
                }
            }
        }
        SEAM(pb + 2);
        if (IN(pb + 3)) {
            PH_BEGIN
            if (EN_GLAN) for (int w = (int)blockIdx.x; w < 256; w += F.G) gla_pass<false>(F, w, WSP(const bf16, WS_Z), WSP(const bf16, WS_QT), WSP(const bf16, WS_KH), WSP(const bf16, WS_AI), WSP(const float, WS_GAM), WSP(float, WS_GST), WSP(float, WS_GAMS), nullptr, nullptr);
            if (EN_MIXB) for (int u = (int)blockIdx.x; u < 256; u += F.G) gm_mix_unit(F, u, WSP(const bf16, WS_Z), WSP(const bf16, WS_VNB), K->in[I_GMWS] + (size_t)l * 4 * 128 * 128, K->in[I_GMBS] + (size_t)l * 4 * 128, WSP(bf16, WS_OABC));
        }
        SEAM(pb + 3);
        if (EN_GLAN && IN(pb + 4)) { PH_BEGIN gla_scan(F, WSP(float, WS_GST), WSP(const float, WS_GAMS)); }
        SEAM(pb + 4);
        if (IN(pb + 5)) {
            PH_BEGIN
            if (EN_GLAN) for (int w = (int)blockIdx.x; w < 256; w += F.G) gla_pass<true>(F, w, WSP(const bf16, WS_Z), WSP(const bf16, WS_QT), WSP(const bf16, WS_KH), WSP(const bf16, WS_AI), WSP(const float, WS_GAM), WSP(float, WS_GST), WSP(float, WS_GAMS), WSP(float, WS_OB), K->out + O_SGP + (size_t)l * 2 * 4 * 256 * 512, K->var);
        }
        SEAM(pb + 5);
        if (EN_MIXB && IN(pb + 6)) { PH_BEGIN gla_fin(F, WSP(const float, WS_OB), WSP(const bf16, WS_Z), K->in[I_GLANW] + (size_t)l * 512, WSP(bf16, WS_OABC)); }
        SEAM(pb + 6);
        if (EN_PROJ && IN(pb + 7)) {
            PH_BEGIN
            pg8::Gemm g{WSP(const bf16, WS_OABC), WSP(const bf16, WS_WPRJ) + (size_t)l * D * 4096, MT, D, 4096, 4096};
            pg8::MiniOrder S; S.init(F.G, (int)blockIdx.x, 4096, 8, K->var);
            pg8::EpiProjR E{WSP(const bf16, WS_Z), NZ, ZGT, WSP(float, WS_PART), WSP(bf16, WS_MG), MP, K->var};
            pg8::gemm_phase<pg8::EpiProjR, pg8::MiniOrder, true, true>(F.lds, g, S, E);
        }
        SEAM(pb + 7);
        if (EN_WO && IN(pb + 8)) {
            PH_BEGIN
            pg8::Gemm g{WSP(const bf16, WS_MG), WSP(const bf16, WS_WO) + (size_t)l * D * D, MT, D, D, D};
            pg8::MiniOrder S; S.init(F.G, (int)blockIdx.x, D, 4, K->var);
            {
              const Tix T = tix(); pg8::Unit u;
              for (int i = 0; S.next(i, u); ++i) if (u.pm >= 32) { const int k0 = 64 * u.kt0, kw = 16 * u.nt;
                  for (int idx0 = T.tid; idx0 < 128 * kw; idx0 += 4 * NT) {
                      f32x4 pv[4][8];
#pragma unroll
                      for (int q = 0; q < 4; ++q) { const int idx = idx0 + q * NT, r = idx / kw, c = k0 + 4 * (idx % kw);
#pragma unroll
                          for (int s = 0; s < 8; ++s) pv[q][s] = *(const f32x4*)(WSP(const float, WS_PART) + ((size_t)s * 128 + r) * D + c); }
#pragma unroll
                      for (int q = 0; q < 4; ++q) { const int idx = idx0 + q * NT, r = idx / kw, c = k0 + 4 * (idx % kw);
                          const f32x4 v = ((pv[q][0] + pv[q][1]) + (pv[q][2] + pv[q][3])) + ((pv[q][4] + pv[q][5]) + (pv[q][6] + pv[q][7]));
                          v2u w; w.x = pk2(v.x, v.y); w.y = pk2(v.z, v.w); *(v2u*)(WSP(bf16, WS_MG) + (size_t)(MP + r) * D + c) = w; } }
                  for (int idx = T.tid; idx < 128 * kw; idx += NT) { const int r = 128 + idx / kw, c = k0 + 4 * (idx % kw); *(v2u*)(WSP(bf16, WS_MG) + (size_t)(MP + r) * D + c) = (v2u){0u, 0u}; } }
              VM_WAIT(); __syncthreads(); }
            pg8::EpiResid E{WSP(float, WS_X), WSP(const float, WS_MOD) + (size_t)l * 256 * NADA + MOD_G1, NADA, WSP(float, WS_PART + 8 * MiB), MP, K->var};
            pg8::gemm_phase<pg8::EpiResid, pg8::MiniOrder, true, true>(F.lds, g, S, E);
        }
        SEAM(pb + 8);
        if (EN_NORM && IN(pb + 9)) { PH_BEGIN phase_norm_t<false>(F, WSP(float, WS_X), K->in[I_N2W] + (size_t)l * D, WSP(const float, WS_MOD) + (size_t)l * 256 * NADA, MOD_SH2, MOD_SC2, WSP(bf16, WS_H), nullptr, WSP(const float, WS_PART + 8 * MiB), 8); }
        SEAM(pb + 9);
        if (EN_FFI && IN(pb + 10)) {
            PH_BEGIN
            pg8::Gemm g{WSP(const bf16, WS_H), WSP(const bf16, WS_WFI) + (size_t)l * 2 * FF * D, MT, 2 * FF, D, D};
            pg8::StaticOrder S; S.init(MT, 2 * FF, F.G, (int)blockIdx.x, D);
            pg8::EpiSwiGLU E{WSP(bf16, WS_ACT), FF};
            pg8::gemm_phase<pg8::EpiSwiGLU, pg8::StaticOrder, true, true>(F.lds, g, S, E);
        }
        SEAM(pb + 10);
        if (EN_FFO && IN(pb + 11)) {
            PH_BEGIN
            pg8::Gemm g{WSP(const bf16, WS_ACT), WSP(const bf16, WS_WFO) + (size_t)l * D * FF, MT, D, FF, FF};
            pg8::MiniOrder S; S.init(F.G, (int)blockIdx.x, FF, 8, K->var);
            pg8::EpiResid E{WSP(float, WS_X), WSP(const float, WS_MOD) + (size_t)l * 256 * NADA + MOD_G2, NADA, WSP(float, WS_PART + 16 * MiB), MP, K->var};
            pg8::gemm_phase<pg8::EpiResid, pg8::MiniOrder, true, true>(F.lds, g, S, E);
        }
        SEAM(pb + 11);
    }
    if (EN_FINAL && IN(26)) { PH_BEGIN phase_norm_t<true>(F, WSP(float, WS_X), K->in[I_FNW], nullptr, 0, 0, nullptr, K->out, WSP(const float, WS_PART + 16 * MiB), 11); }
#undef IN
#undef SEAM
}

extern "C" void kernel_launch(void* const* d_in, const int* in_sizes, int n_in, void* d_out, int out_size, void* d_ws, size_t ws_size, hipStream_t stream) {
    static int grid = 0;
    if (grid == 0) {
        if (n_in != N_IN || (size_t)out_size != O_END || ws_size < WS_END) { fprintf(stderr, "kernel_launch: unexpected problem (n_in %d, out %d, ws %zu); nothing launched\n", n_in, out_size, ws_size); grid = -1; return; }
        int dev = 0, cus = 0, per_cu = 0;
        if (hipGetDevice(&dev) != hipSuccess || hipDeviceGetAttribute(&cus, hipDeviceAttributeMultiprocessorCount, dev) != hipSuccess) { grid = -1; return; }
        if (hipFuncSetAttribute((const void*)mega_fwd, hipFuncAttributeMaxDynamicSharedMemorySize, LDS_BYTES) != hipSuccess) { fprintf(stderr, "kernel_launch: hipFuncSetAttribute failed\n"); grid = -1; return; }
        if (hipOccupancyMaxActiveBlocksPerMultiprocessor(&per_cu, (const void*)mega_fwd, NT, LDS_BYTES) != hipSuccess || per_cu < 1) { fprintf(stderr, "kernel_launch: occupancy query says %d\n", per_cu); }
        (void)hipGetLastError();
        grid = cus;
        if (grid < 128) { fprintf(stderr, "kernel_launch: this build needs >= 128 CUs (mini-unit deal)\n"); grid = -1; return; }
    }
    if (grid < 0) return;
    (void)hipMemsetAsync((char*)d_ws + WS_CTL, 0, CTL_ZERO_BYTES, stream);
    Prm p{};
    for (int i = 0; i < N_IN; ++i) p.in[i] = (const float*)d_in[i];
    p.out = (float*)d_out; p.ws = (unsigned char*)d_ws;
#if MK_ONE_LAUNCH
    p.ph_lo = 0; p.ph_hi = NPH;
    hipLaunchKernelGGL(mega_fwd, dim3(grid), dim3(NT), LDS_BYTES, stream, p);
#if MK_PROBE
    for (int i = 0; i < MK_REP_N; ++i) { p.ph_lo = MK_REP_K; p.ph_hi = MK_REP_K + 1; p.var = MK_REP_VAR; hipLaunchKernelGGL(mega_fwd, dim3(grid), dim3(NT), LDS_BYTES, stream, p); }
#endif
#else
    for (int k = 0; k < NPH; ++k) { p.ph_lo = k; p.ph_hi = k + 1; hipLaunchKernelGGL(mega_fwd, dim3(grid), dim3(NT), LDS_BYTES, stream, p); }
#endif
}
```

```cpp
#include <hip/hip_runtime.h>
#include <cstdio>
#include <cstdint>
namespace pg8 {
#define PG8_LAS __attribute__((address_space(3)))
typedef unsigned short bf16_t;
typedef short bf16x8 __attribute__((ext_vector_type(8)));
typedef float f32x4 __attribute__((ext_vector_type(4)));
typedef unsigned u32x4 __attribute__((ext_vector_type(4)));
constexpr int BM = 256, BK = 64, HALF = 128, HTB = HALF * BK * 2  , STAGE_BYTES = 8 * HTB, NXCD = 8, WGM = 8;

__host__ __device__ __forceinline__ int lds_byte(int r, int c) { const int st = (r >> 4) * 2 + (c >> 5), rr = r & 15, cc = c & 31, ob = rr * 64 + cc * 2; return st * 1024 + (ob ^ (((ob >> 9) & 1) << 5)); }
__host__ __device__ __forceinline__ void stage_rc(int b, int& R, int& C) { const int st = b / 1024, sb = b % 1024, swz = sb ^ (((sb >> 9) & 1) << 5); R = (st >> 1) * 16 + swz / 64; C = (st & 1) * 32 + (swz % 64) / 2; }
__host__ __device__ __forceinline__ int perm32(int rho) { const int n = rho >> 4, i = rho & 15; return 8 * (i >> 2) + 4 * n + (i & 3); }

struct Unit { int pm, pn, kt0, nt; };
struct Gemm { const bf16_t* A; const bf16_t* Bt; int M, N, K, ld; };

struct StaticOrder {
    int nM, nN, nwg, G, c, ntf;
    __host__ __device__ __forceinline__ void init(int M, int N, int G_, int c_, int K) { nM = M / BM; nN = N / BM; nwg = nM * nN; G = G_; c = c_; ntf = K / BK; }
    __host__ __device__ __forceinline__ bool next(int i, Unit& u) const {
        const long L = (long)i * G + c; if (L >= nwg) return false;
        int wgid = (int)L; { const int q = nwg / NXCD, r = nwg % NXCD, xcd = wgid % NXCD, off = wgid / NXCD; wgid = (xcd < r ? xcd * (q + 1) : r * (q + 1) + (xcd - r) * q) + off; }
        const int nig = WGM * nN, gid = wgid / nig, fm = gid * WGM, gsz = (nM - fm) < WGM ? (nM - fm) : WGM;
        u.pm = fm + ((wgid % nig) % gsz); u.pn = (wgid % nig) / gsz; u.kt0 = 0; u.nt = ntf; return true;
    }
    __device__ __forceinline__ void a_ready(const Unit&) const {}
    __device__ __forceinline__ void done(const Unit&) const {}
};
struct MiniOrder {
    StaticOrder main; int nmini, ntm;
    __host__ __device__ __forceinline__ void init(int G_, int c_, int K, int ntm_, int var = 0) { main.init(32 * BM, 2048, G_, c_, K); ntm = ntm_; nmini = (var & 4) ? 0 : 8 * ((K / BK) / ntm_); }
    __host__ __device__ __forceinline__ bool next(int i, Unit& u) const {
        const bool has_mini = main.c < nmini;
        if (has_mini && i == 0) { const int m = main.c; u.pm = 32; u.pn = m & 7; u.kt0 = ntm * (m >> 3); u.nt = ntm; return true; }
        return main.next(has_mini ? i - 1 : i, u);
    }
    __device__ __forceinline__ void a_ready(const Unit&) const {}
    __device__ __forceinline__ void done(const Unit&) const {}
};


__device__ __forceinline__ unsigned cvt_pk_bf16(float lo, float hi) { unsigned r; asm volatile("v_cvt_pk_bf16_f32 %0, %1, %2" : "=v"(r) : "v"(lo), "v"(hi)); return r; }
typedef float f32x2 __attribute__((ext_vector_type(2)));
__device__ __forceinline__ f32x2 gelu_pk(f32x2 v) {
    const f32x2 av = __builtin_elementwise_abs(v), d = av * 0.2316418882f + 1.0f;
    f32x2 t; t.x = __builtin_amdgcn_rcpf(d.x); t.y = __builtin_amdgcn_rcpf(d.y);
    f32x2 q = t * 0.5307027145f + (-0.7265760135f); q = q * t + 0.7107068705f; q = q * t + (-0.142248368f); q = q * t + 0.127414796f; q = q * t;
    const f32x2 s = (v * v) * (-0.72134752044f);
    f32x2 e; e.x = __builtin_amdgcn_exp2f(s.x); e.y = __builtin_amdgcn_exp2f(s.y);
    const f32x2 m = v * (q * e), r = v - m;
    f32x2 o; o.x = v.x < 0.f ? m.x : r.x; o.y = v.y < 0.f ? m.y : r.y; return o;
}

template <int ACT  > struct EpiBf16 {
    static constexpr bool PERM = true, AFTER_DRAIN = false, HAS_HOOK = false; static_assert(ACT == 0 || ACT == 1, "EpiBf16: ACT is 0 (none) or 1 (gelu_pk)");
    bf16_t* O; int ldc; const float* bias; int split_cols; size_t split_stride; float scale0;
    __device__ __forceinline__ void operator()(const f32x4 (&acc)[2][2][4][2], const Unit& u, int wr, int wc, int fr, int fq) const {
        const int row0 = u.pm * BM + wr * 64 + fr; int colt = u.pn * BM; bf16_t* base = O;
        float sc = 1.f; if (split_cols) { const int t = colt / split_cols; base += (size_t)t * split_stride; colt -= t * split_cols; if (t == 0) sc = scale0; }
        const int col0 = colt + wc * 32 + 8 * fq, bcol0 = u.pn * BM + wc * 32 + 8 * fq;
        f32x4 bv[2][2];
#pragma unroll
        for (int bj = 0; bj < 2; ++bj)
#pragma unroll
            for (int n = 0; n < 2; ++n) bv[bj][n] = bias ? *(const f32x4*)(bias + bcol0 + bj * HALF + 4 * n) : (f32x4){0.f, 0.f, 0.f, 0.f};
#pragma unroll
        for (int ai = 0; ai < 2; ++ai)
#pragma unroll
            for (int m = 0; m < 4; ++m) { bf16_t* rowp = base + (size_t)(row0 + ai * HALF + m * 16) * ldc + col0;
#pragma unroll
                for (int bj = 0; bj < 2; ++bj) { f32x4 v0 = acc[ai][bj][m][0] + bv[bj][0], v1 = acc[ai][bj][m][1] + bv[bj][1];
                    if (ACT == 1) { f32x2 a = gelu_pk((f32x2){v0[0], v0[1]}), b = gelu_pk((f32x2){v0[2], v0[3]}), c = gelu_pk((f32x2){v1[0], v1[1]}), d = gelu_pk((f32x2){v1[2], v1[3]});
                        v0 = (f32x4){a.x, a.y, b.x, b.y}; v1 = (f32x4){c.x, c.y, d.x, d.y}; }
                    v0 = v0 * sc; v1 = v1 * sc; u32x4 w; w.x = cvt_pk_bf16(v0[0], v0[1]); w.y = cvt_pk_bf16(v0[2], v0[3]); w.z = cvt_pk_bf16(v1[0], v1[1]); w.w = cvt_pk_bf16(v1[2], v1[3]);
                    *(u32x4*)(rowp + bj * HALF) = w; } }
    }
};
struct EpiF32 {
    static constexpr bool PERM = false, AFTER_DRAIN = false, HAS_HOOK = false;
    float* C; int ldc; const float* bias;
    __device__ __forceinline__ void operator()(const f32x4 (&acc)[2][2][4][2], const Unit& u, int wr, int wc, int fr, int fq) const {
        const int row0 = u.pm * BM + wr * 64 + fr, col0 = u.pn * BM + wc * 32 + 4 * fq;
        f32x4 bv[2][2];
#pragma unroll
        for (int bj = 0; bj < 2; ++bj)
#pragma unroll
            for (int n = 0; n < 2; ++n) bv[bj][n] = bias ? *(const f32x4*)(bias + col0 + bj * HALF + n * 16) : (f32x4){0.f, 0.f, 0.f, 0.f};
#pragma unroll
        for (int ai = 0; ai < 2; ++ai)
#pragma unroll
            for (int m = 0; m < 4; ++m) { float* rowp = C + (size_t)(row0 + ai * HALF + m * 16) * ldc + col0;
#pragma unroll
                for (int bj = 0; bj < 2; ++bj)
#pragma unroll
                    for (int n = 0; n < 2; ++n) *(f32x4*)(rowp + bj * HALF + n * 16) = acc[ai][bj][m][n] + bv[bj][n]; }
    }
};
__device__ __forceinline__ float bf_lo(unsigned w) { return __uint_as_float(w << 16); }
__device__ __forceinline__ float bf_hi(unsigned w) { return __uint_as_float(w & 0xffff0000u); }
__device__ __forceinline__ float fsigmoid(float x) { return __builtin_amdgcn_rcpf(1.0f + __expf(-x)); }
__device__ __forceinline__ float fsilu(float x) { return x * fsigmoid(x); }
__device__ __forceinline__ int batch_of_row(int row) { return row < 4096 ? 0 : (row < 8192 ? 1 : (row - 8192 < 128 ? row - 8190 : 129)); }
typedef unsigned u32x2 __attribute__((ext_vector_type(2)));

struct EpiZ {
    static constexpr bool PERM = true, AFTER_DRAIN = false, HAS_HOOK = false;
    bf16_t* O; int ldc; int gate_pn0; int var;
    __device__ __forceinline__ void operator()(const f32x4 (&acc)[2][2][4][2], const Unit& u, int wr, int wc, int fr, int fq) const {
        if (var & 1) return;
        const int row0 = u.pm * BM + wr * 64 + fr, col0 = u.pn * BM + wc * 32 + 8 * fq; const bool gt = (u.pn >= gate_pn0) && !(var & 2);
#pragma unroll
        for (int ai = 0; ai < 2; ++ai)
#pragma unroll
            for (int m = 0; m < 4; ++m) { bf16_t* rowp = O + (size_t)(row0 + ai * HALF + m * 16) * ldc + col0;
#pragma unroll
                for (int bj = 0; bj < 2; ++bj) { f32x4 v0 = acc[ai][bj][m][0], v1 = acc[ai][bj][m][1];
                    if (gt) {
#pragma unroll
                        for (int j = 0; j < 4; ++j) { v0[j] = 1.0f + __expf(-fminf(fmaxf(v0[j], -40.f), 40.f)); v1[j] = 1.0f + __expf(-fminf(fmaxf(v1[j], -40.f), 40.f)); } }
                    u32x4 w; w.x = cvt_pk_bf16(v0[0], v0[1]); w.y = cvt_pk_bf16(v0[2], v0[3]); w.z = cvt_pk_bf16(v1[0], v1[1]); w.w = cvt_pk_bf16(v1[2], v1[3]);
                    *(u32x4*)(rowp + bj * HALF) = w; } }
    }
};
struct EpiProjR {
    static constexpr bool PERM = false, AFTER_DRAIN = false, HAS_HOOK = true;
    const bf16_t* Z; int ldz; int gcol0; float* PART; bf16_t* MG; int mp0; int var;
    __device__ __forceinline__ bool hook_at(const Unit& u, int t) const { return u.nt == 64 && (t == 32 || t == 48) && !(var & 2); }
    __device__ __forceinline__ void hook(f32x4 (&acc)[2][2][4][2], const Unit& u, int t, int wr, int wc, int fr, int fq) const {
        int row0 = u.pm * BM + wr * 64 + fr, col0 = u.pn * BM + wc * 32 + 4 * fq; asm volatile("" : "+v"(row0), "+v"(col0));
        const int gp = gcol0 + (t == 32 ? 0 : 2048);
#pragma unroll
        for (int ai = 0; ai < 2; ++ai) {
            u32x2 gprev[4][4], gnext[4][4];
#pragma unroll
            for (int m = 0; m < 4; ++m) { const bf16_t* zp = Z + (size_t)(row0 + ai * HALF + m * 16) * ldz + gp + col0;
#pragma unroll
                for (int q = 0; q < 4; ++q) { gprev[m][q] = *(const u32x2*)(zp + (q >> 1) * HALF + (q & 1) * 16); gnext[m][q] = *(const u32x2*)(zp + 2048 + (q >> 1) * HALF + (q & 1) * 16); } }
#pragma unroll
            for (int m = 0; m < 4; ++m)
#pragma unroll
                for (int q = 0; q < 4; ++q) { const u32x2 gpv = gprev[m][q], gnx = gnext[m][q];
                    f32x4 r; r[0] = bf_lo(gnx.x) * __builtin_amdgcn_rcpf(bf_lo(gpv.x)); r[1] = bf_hi(gnx.x) * __builtin_amdgcn_rcpf(bf_hi(gpv.x));
                    r[2] = bf_lo(gnx.y) * __builtin_amdgcn_rcpf(bf_lo(gpv.y)); r[3] = bf_hi(gnx.y) * __builtin_amdgcn_rcpf(bf_hi(gpv.y));
                    acc[ai][q >> 1][m][q & 1] = acc[ai][q >> 1][m][q & 1] * r; }
            asm volatile("" ::: "memory"); }
        asm volatile("s_waitcnt vmcnt(0)" ::: "memory");
    }
    __device__ __forceinline__ void operator()(const f32x4 (&acc)[2][2][4][2], const Unit& u, int wr, int wc, int fr, int fq) const {
        if (var & 1) return;
        int row0 = u.pm * BM + wr * 64 + fr, col0 = u.pn * BM + wc * 32 + 4 * fq; asm volatile("" : "+v"(row0), "+v"(col0));
        const bool mini = u.nt != 64; const int br = mini ? (u.kt0 < 32 ? 0 : (u.kt0 < 48 ? 1 : 2)) : 2;
#pragma unroll
        for (int ai = 0; ai < 2; ++ai) {
            u32x2 gw[4][4];
#pragma unroll
            for (int m = 0; m < 4; ++m) { const bf16_t* zp = Z + (size_t)(row0 + ai * HALF + m * 16) * ldz + gcol0 + br * 2048 + col0;
#pragma unroll
                for (int q = 0; q < 4; ++q) gw[m][q] = *(const u32x2*)(zp + (q >> 1) * HALF + (q & 1) * 16); }
#pragma unroll
            for (int m = 0; m < 4; ++m) { const int row = row0 + ai * HALF + m * 16;
#pragma unroll
                for (int q = 0; q < 4; ++q) { const int col = col0 + (q >> 1) * HALF + (q & 1) * 16; const u32x2 gq = gw[m][q];
                    f32x4 g; g[0] = __builtin_amdgcn_rcpf(bf_lo(gq.x)); g[1] = __builtin_amdgcn_rcpf(bf_hi(gq.x)); g[2] = __builtin_amdgcn_rcpf(bf_lo(gq.y)); g[3] = __builtin_amdgcn_rcpf(bf_hi(gq.y));
                    const f32x4 v = acc[ai][q >> 1][m][q & 1] * g;
                    if (!mini) { u32x2 w; w.x = cvt_pk_bf16(v[0], v[1]); w.y = cvt_pk_bf16(v[2], v[3]); *(u32x2*)(MG + (size_t)row * 2048 + col) = w; }
                    else if (ai == 0) *(f32x4*)(PART + ((size_t)(u.kt0 / u.nt) * 128 + (row - mp0)) * 2048 + col) = v; } }
            asm volatile("" ::: "memory"); }
    }
};
struct EpiResid {
    static constexpr bool PERM = false, AFTER_DRAIN = false, HAS_HOOK = false;
    float* X; const float* gate; int ldg; float* PART; int mp0; int var;
    __device__ __forceinline__ void operator()(const f32x4 (&acc)[2][2][4][2], const Unit& u, int wr, int wc, int fr, int fq) const {
        if (var & 1) return;
        int row0 = u.pm * BM + wr * 64 + fr, col0 = u.pn * BM + wc * 32 + 4 * fq; asm volatile("" : "+v"(row0), "+v"(col0)); const bool mini = u.pm >= 32;
#pragma unroll
        for (int ai = 0; ai < 2; ++ai)
#pragma unroll
            for (int mp = 0; mp < 2; ++mp) {
                f32x4 gg[2][4], xx[2][4];
#pragma unroll
                for (int mm = 0; mm < 2; ++mm) { const int row = row0 + ai * HALF + (2 * mp + mm) * 16; const float* gp = gate + (size_t)batch_of_row(row) * ldg + col0; const float* xp = X + (size_t)row * 2048 + col0;
#pragma unroll
                    for (int q = 0; q < 4; ++q) { gg[mm][q] = *(const f32x4*)(gp + (q >> 1) * HALF + (q & 1) * 16); if (!mini) xx[mm][q] = *(const f32x4*)(xp + (q >> 1) * HALF + (q & 1) * 16); } }
#pragma unroll
                for (int mm = 0; mm < 2; ++mm) { const int m = 2 * mp + mm, row = row0 + ai * HALF + m * 16; float* xp = X + (size_t)row * 2048 + col0;
#pragma unroll
                    for (int q = 0; q < 4; ++q) { float* xq = xp + (q >> 1) * HALF + (q & 1) * 16; const f32x4 v = gg[mm][q] * acc[ai][q >> 1][m][q & 1];
                        if (!mini) *(f32x4*)xq = xx[mm][q] + v;
                        else if (ai == 0) *(f32x4*)(PART + ((size_t)(u.kt0 / u.nt) * 128 + (row - mp0)) * 2048 + col0 + (q >> 1) * HALF + (q & 1) * 16) = v; } }
                asm volatile("" ::: "memory"); }
    }
};
struct EpiSwiGLU {
    static constexpr bool PERM = true, AFTER_DRAIN = false, HAS_HOOK = false;
    bf16_t* ACT; int ldc;
    __device__ __forceinline__ void operator()(const f32x4 (&acc)[2][2][4][2], const Unit& u, int wr, int wc, int fr, int fq) const {
        const int row0 = u.pm * BM + wr * 64 + fr, col0 = u.pn * HALF + wc * 32 + 8 * fq;
#pragma unroll
        for (int ai = 0; ai < 2; ++ai)
#pragma unroll
            for (int m = 0; m < 4; ++m) { bf16_t* rowp = ACT + (size_t)(row0 + ai * HALF + m * 16) * ldc + col0;
                const f32x4 a0 = acc[ai][0][m][0], a1 = acc[ai][0][m][1], b0 = acc[ai][1][m][0], b1 = acc[ai][1][m][1];
                u32x4 w; w.x = cvt_pk_bf16(fsilu(a0[0]) * b0[0], fsilu(a0[1]) * b0[1]); w.y = cvt_pk_bf16(fsilu(a0[2]) * b0[2], fsilu(a0[3]) * b0[3]);
                w.z = cvt_pk_bf16(fsilu(a1[0]) * b1[0], fsilu(a1[1]) * b1[1]); w.w = cvt_pk_bf16(fsilu(a1[2]) * b1[2], fsilu(a1[3]) * b1[3]);
                *(u32x4*)rowp = w; }
    }
};
template <class Epi, class Sched, bool ALIGN_EPI = false, bool SP2 = false>
__device__ __forceinline__ void gemm_phase(PG8_LAS unsigned char* lds, const Gemm g, const Sched& S, const Epi& E) {
    int tid_ = threadIdx.x; asm volatile("" : "+v"(tid_));
    const int tid = tid_, wid = __builtin_amdgcn_readfirstlane(tid >> 6), lane = tid & 63, wr = wid >> 2, wc = wid & 3, fr = lane & 15, fq = lane >> 4;
    const int LD = g.ld;
    unsigned voffA[2], voffB[2];
#pragma unroll
    for (int i = 0; i < 2; ++i) { int R, C; stage_rc(tid * 16 + i * 8192, R, C); const int Rb = Epi::PERM ? ((R & ~31) + perm32(R & 31)) : R;
        voffA[i] = (unsigned)(R * LD + C) * 2u; voffB[i] = (unsigned)(Rb * LD + C) * 2u; }
    const size_t kstep = (size_t)(BK * 2);
    const size_t hstep = (size_t)HALF * LD * 2;
    const size_t tstep = 2 * hstep;
    const unsigned ldsw = (unsigned)wid * 1024u;
    const int aoff = lds_byte(wr * 64 + fr, fq * 8), boff = lds_byte(wc * 32 + fr, fq * 8);
#define PG8_SA(b, h) (((b) * 2 + (h)) * HTB)
#define PG8_SB(b, h) ((4 + (b) * 2 + (h)) * HTB)
#define PG8_STAGE(bufoff, gbase, voff) do { _Pragma("unroll") for (int _i = 0; _i < 2; ++_i) \
        __builtin_amdgcn_global_load_lds((const unsigned*)((const char*)(gbase) + (voff)[_i]), (PG8_LAS unsigned*)(lds + (bufoff) + ldsw + _i * 8192), 16, 0, 0); } while (0)
#define PG8_LDA(dst, b, h) do { _Pragma("unroll") for (int m = 0; m < 4; ++m) _Pragma("unroll") for (int k = 0; k < 2; ++k) dst[m][k] = *(const PG8_LAS bf16x8*)(lds + PG8_SA(b, h) + aoff + m * 2048 + k * 1024); } while (0)
#define PG8_LDB(dst, b, h) do { _Pragma("unroll") for (int n = 0; n < 2; ++n) _Pragma("unroll") for (int k = 0; k < 2; ++k) dst[n][k] = *(const PG8_LAS bf16x8*)(lds + PG8_SB(b, h) + boff + n * 2048 + k * 1024); } while (0)
#define PG8_MMA(ai, bj, At, Bt) do { __builtin_amdgcn_s_setprio(1); _Pragma("unroll") for (int m = 0; m < 4; ++m) _Pragma("unroll") for (int n = 0; n < 2; ++n) _Pragma("unroll") for (int k = 0; k < 2; ++k) \
        acc[ai][bj][m][n] = __builtin_amdgcn_mfma_f32_16x16x32_bf16(Bt[n][k], At[m][k], acc[ai][bj][m][n], 0, 0, 0); __builtin_amdgcn_s_setprio(0); } while (0)
#define PG8_WAIT_V(n) asm volatile("s_waitcnt vmcnt(" #n ")" ::: "memory")
#define PG8_WAIT_L(n) asm volatile("s_waitcnt lgkmcnt(" #n ")" ::: "memory")
#define PG8_BAR __builtin_amdgcn_s_barrier()
#define PG8_SCHED __builtin_amdgcn_sched_barrier(0)
    Unit cur, nxt; int ui = 0;
    if (!S.next(0, cur)) return;
    f32x4 acc[2][2][4][2];
#pragma unroll
    for (int a = 0; a < 2; ++a)
#pragma unroll
        for (int b = 0; b < 2; ++b)
#pragma unroll
            for (int m = 0; m < 4; ++m)
#pragma unroll
                for (int n = 0; n < 2; ++n) acc[a][b][m][n] = (f32x4){0.f, 0.f, 0.f, 0.f};
    bf16x8 At[4][2], B0[2][2], B1[2][2];
    const char* cA = (const char*)g.A + (size_t)cur.pm * tstep + (size_t)cur.kt0 * kstep; const char* cB = (const char*)g.Bt + (size_t)cur.pn * tstep + (size_t)cur.kt0 * kstep;
    S.a_ready(cur);
    if constexpr (SP2) {
        PG8_STAGE(PG8_SB(0, 0), cB, voffB); PG8_STAGE(PG8_SB(0, 1), cB + hstep, voffB); PG8_STAGE(PG8_SA(0, 0), cA, voffA); PG8_STAGE(PG8_SA(0, 1), cA + hstep, voffA);
        if (wr == 1) PG8_BAR;
        PG8_WAIT_V(2); PG8_BAR;
        PG8_STAGE(PG8_SB(1, 0), cB + kstep, voffB); PG8_STAGE(PG8_SA(1, 0), cA + kstep, voffA); PG8_STAGE(PG8_SB(1, 1), cB + hstep + kstep, voffB);
        PG8_WAIT_V(6); PG8_BAR;
    } else {
        PG8_STAGE(PG8_SB(0, 0), cB, voffB); PG8_STAGE(PG8_SA(0, 0), cA, voffA); PG8_STAGE(PG8_SB(0, 1), cB + hstep, voffB); PG8_STAGE(PG8_SA(0, 1), cA + hstep, voffA);
        if (wr == 1) PG8_BAR;
        PG8_WAIT_V(4); PG8_BAR;
        PG8_STAGE(PG8_SB(1, 0), cB + kstep, voffB); PG8_STAGE(PG8_SA(1, 0), cA + kstep, voffA); PG8_STAGE(PG8_SB(1, 1), cB + hstep + kstep, voffB);
        PG8_WAIT_V(6); PG8_BAR;
    }
    for (;;) {
        const bool has_next = S.next(ui + 1, nxt);
        const char* nA = has_next ? (const char*)g.A + (size_t)nxt.pm * tstep + (size_t)nxt.kt0 * kstep : cA; const char* nB = has_next ? (const char*)g.Bt + (size_t)nxt.pn * tstep + (size_t)nxt.kt0 * kstep : cB;
        const int nt = cur.nt;
        for (int t = 0; t < nt; t += 2) {
            const bool last = (t == nt - 2);
            if constexpr (Epi::HAS_HOOK) { if (E.hook_at(cur, t)) E.hook(acc, cur, t, wr, wc, fr, fq); }
            const char* a1 = cA + (size_t)(t + 1) * kstep;
            const char* a2 = last ? nA : cA + (size_t)(t + 2) * kstep; const char* b2 = last ? nB : cB + (size_t)(t + 2) * kstep;
            const char* a3 = a2 + kstep; const char* b3 = b2 + kstep;
            if (last && has_next) S.a_ready(nxt);
            if constexpr (SP2) {
            PG8_LDB(B0, 0, 0); PG8_LDB(B1, 0, 1); PG8_SCHED; PG8_LDA(At, 0, 0); PG8_STAGE(PG8_SA(1, 1), a1 + hstep, voffA);
            PG8_WAIT_V(8); PG8_WAIT_L(0); PG8_BAR; PG8_MMA(0, 0, At, B0); PG8_MMA(0, 1, At, B1); PG8_BAR; PG8_SCHED;
            PG8_LDA(At, 0, 1); PG8_STAGE(PG8_SB(0, 0), b2, voffB); PG8_STAGE(PG8_SB(0, 1), b2 + hstep, voffB); PG8_STAGE(PG8_SA(0, 0), a2, voffA);
            PG8_WAIT_V(8); PG8_WAIT_L(0); PG8_BAR; PG8_MMA(1, 0, At, B0); PG8_MMA(1, 1, At, B1); PG8_BAR; PG8_SCHED;
            PG8_LDB(B0, 1, 0); PG8_LDB(B1, 1, 1); PG8_SCHED; PG8_LDA(At, 1, 0); PG8_STAGE(PG8_SA(0, 1), a2 + hstep, voffA);
            PG8_WAIT_V(8); PG8_WAIT_L(0); PG8_BAR; PG8_MMA(0, 0, At, B0); PG8_MMA(0, 1, At, B1); PG8_BAR; PG8_SCHED;
            PG8_LDA(At, 1, 1); PG8_STAGE(PG8_SB(1, 0), b3, voffB); PG8_STAGE(PG8_SB(1, 1), b3 + hstep, voffB); PG8_STAGE(PG8_SA(1, 0), a3, voffA);
            PG8_WAIT_V(8); PG8_WAIT_L(0); PG8_BAR; PG8_MMA(1, 0, At, B0); PG8_MMA(1, 1, At, B1); PG8_BAR; PG8_SCHED;
            } else {
            PG8_LDB(B0, 0, 0); PG8_SCHED; PG8_LDA(At, 0, 0); PG8_STAGE(PG8_SA(1, 1), a1 + hstep, voffA);
            PG8_WAIT_L(8); PG8_BAR; PG8_WAIT_L(0); PG8_MMA(0, 0, At, B0); PG8_BAR; PG8_SCHED;
            PG8_LDB(B1, 0, 1); PG8_STAGE(PG8_SB(0, 0), b2, voffB);
            PG8_BAR; PG8_WAIT_L(0); PG8_MMA(0, 1, At, B1); PG8_BAR;
            PG8_LDA(At, 0, 1); PG8_STAGE(PG8_SA(0, 0), a2, voffA);
            PG8_BAR; PG8_WAIT_L(0); PG8_MMA(1, 0, At, B0); PG8_BAR; PG8_SCHED;
            PG8_STAGE(PG8_SB(0, 1), b2 + hstep, voffB);
            PG8_WAIT_V(6); PG8_BAR; PG8_MMA(1, 1, At, B1); PG8_BAR;
            PG8_LDB(B0, 1, 0); PG8_SCHED; PG8_LDA(At, 1, 0); PG8_STAGE(PG8_SA(0, 1), a2 + hstep, voffA);
            PG8_WAIT_L(8); PG8_BAR; PG8_WAIT_L(0); PG8_MMA(0, 0, At, B0); PG8_BAR; PG8_SCHED;
            PG8_LDB(B1, 1, 1); PG8_STAGE(PG8_SB(1, 0), b3, voffB);
            PG8_BAR; PG8_WAIT_L(0); PG8_MMA(0, 1, At, B1); PG8_BAR;
            PG8_LDA(At, 1, 1); PG8_STAGE(PG8_SA(1, 0), a3, voffA);
            PG8_BAR; PG8_WAIT_L(0); PG8_MMA(1, 0, At, B0); PG8_BAR; PG8_SCHED;
            PG8_STAGE(PG8_SB(1, 1), b3 + hstep, voffB);
            PG8_WAIT_V(6); PG8_BAR; PG8_MMA(1, 1, At, B1); PG8_BAR;
            }
        }
        if constexpr (ALIGN_EPI) { if (wr == 0) PG8_BAR; }
        if constexpr (!Epi::AFTER_DRAIN) { E(acc, cur, wr, wc, fr, fq); S.done(cur); }
        if (!has_next) break;
#pragma unroll
        for (int a = 0; a < 2; ++a)
#pragma unroll
            for (int b = 0; b < 2; ++b)
#pragma unroll
                for (int m = 0; m < 4; ++m)
#pragma unroll
                    for (int n = 0; n < 2; ++n) acc[a][b][m][n] = (f32x4){0.f, 0.f, 0.f, 0.f};
        cur = nxt; cA = nA; cB = nB; ++ui;
        if constexpr (ALIGN_EPI) { if (wr == 1) PG8_BAR; }
    }
    PG8_WAIT_V(0);
    if constexpr (!ALIGN_EPI) { if (wr == 0) PG8_BAR; }
    PG8_BAR;
    if constexpr (Epi::AFTER_DRAIN) { E.fused(acc, cur, wr, wc, fr, fq, lds, wid, lane); S.done(cur); }
#undef PG8_SA
#undef PG8_SB
#undef PG8_STAGE
#undef PG8_LDA
#undef PG8_LDB
#undef PG8_MMA
#undef PG8_WAIT_V
#undef PG8_WAIT_L
#undef PG8_BAR
#undef PG8_SCHED
}
}
constexpr int NWAVES = 8, NT = NWAVES * 64;
constexpr int D = 2048, MP = 8192, MS = 128, MR = MP + MS, MT = 8448;
constexpr int SEQ = 4096;
constexpr int NZ = 15872;
constexpr int NZW = 16128;
constexpr int ZQA = 0, ZKA = 1024, ZVA = 2048, ZGA = 4096, ZUB = 6144, ZVB = 7168, ZQC = 8192, ZKC = 9216, ZVC = 9472, ZGT = 9728, ZLR = 15872;
constexpr int NIN = 15888, FF = 5632, NADA = 12288;
constexpr int MOD_SH1 = 0, MOD_SC1 = 2048, MOD_G1 = 4096, MOD_SH2 = 6144, MOD_SC2 = 8192, MOD_G2 = 10240;
constexpr float EPS = 1e-6f;
constexpr size_t O_YP = 0, O_YS = 16777216, O_SGP = 17039360, O_SGS = 19136512, O_CKP = 153354240, O_CVP = 153485312, O_CKS = 153616384, O_CVS = 153681920, O_GMV = 153747456, O_END = 154009600;
enum { I_XP = 0, I_XS, I_CP, I_CS, I_SGLA, I_CK, I_CV, I_WADA, I_BADA, I_N1W, I_N2W, I_WIN, I_WGK2, I_BGK, I_GLANW, I_GMNW, I_GMNB, I_GMWS, I_GMBS, I_SINK, I_WPA, I_WPB, I_WPC, I_WO, I_WFI, I_WFO, I_FNW, N_IN };

constexpr size_t MiB = 1u << 20;
constexpr size_t WS_CTL = 0, CTL_ZERO_BYTES = 1 * MiB;
constexpr size_t WS_WADA = 2 * MiB;
constexpr size_t WS_CA   = WS_WADA + 2 * 48 * MiB;
constexpr size_t WS_MOD  = WS_CA + 1 * MiB;
constexpr size_t WS_WIN  = WS_MOD + 24 * MiB;
constexpr size_t WS_WPRJ = WS_WIN + 2 * 63 * MiB;
constexpr size_t WS_WO   = WS_WPRJ + 32 * MiB;
constexpr size_t WS_WFI  = WS_WO + 16 * MiB;
constexpr size_t WS_WFO  = WS_WFI + 88 * MiB;
constexpr size_t WS_X    = WS_WFO + 44 * MiB;
constexpr size_t WS_H    = WS_X + 66 * MiB;
constexpr size_t WS_Z    = WS_H + 33 * MiB;
constexpr size_t WS_OABC = WS_Z + 260 * MiB;
constexpr size_t WS_M32  = WS_OABC + 66 * MiB;
constexpr size_t WS_MG   = WS_M32 + 66 * MiB;
constexpr size_t WS_ACT  = WS_MG + 33 * MiB;
constexpr size_t WS_GK   = WS_ACT + 91 * MiB;
constexpr size_t WS_OB   = WS_GK + 33 * MiB;
constexpr size_t WS_VN   = WS_OB + 65 * MiB;
constexpr size_t WS_QT   = WS_VN + 33 * MiB;
constexpr size_t WS_KH   = WS_QT + 16 * MiB;
constexpr size_t WS_AI   = WS_KH + 16 * MiB;
constexpr size_t WS_GAM  = WS_AI + 4 * MiB;
constexpr size_t WS_GST  = WS_GAM + 1 * MiB;
constexpr size_t WS_GAMS = WS_GST + 32 * MiB;
constexpr size_t WS_VNB  = WS_GAMS + 1 * MiB;
constexpr size_t WS_PART = WS_VNB + 16 * MiB;
constexpr size_t WS_END  = WS_PART + 32 * MiB;
static_assert((size_t)MT * NZ * 2 <= 260 * MiB && (size_t)MT * FF * 2 <= 91 * MiB && (size_t)NZW * D * 2 <= 63 * MiB, "ws map");
constexpr int CW_BAR = 4096;

constexpr int RING_BYTES = 131072;
constexpr int MISC_OFF = 150 * 1024;
constexpr int LDS_BYTES = 152 * 1024;

#define GAS __attribute__((address_space(1)))
#define LAS __attribute__((address_space(3)))
typedef unsigned short bf16;
typedef unsigned v4u __attribute__((ext_vector_type(4)));
typedef unsigned v2u __attribute__((ext_vector_type(2)));
typedef float f32x4 __attribute__((ext_vector_type(4)));
#define LDS_WAIT() asm volatile("s_waitcnt lgkmcnt(0)" ::: "memory")
#define VM_WAIT() asm volatile("s_waitcnt vmcnt(0)" ::: "memory")
__device__ __forceinline__ unsigned f2bf(float f) { unsigned u = __builtin_bit_cast(unsigned, f); return (u + 0x7fffu + ((u >> 16) & 1u)) >> 16; }
__device__ __forceinline__ unsigned pk2(float lo, float hi) { return f2bf(lo) | (f2bf(hi) << 16); }
__device__ __forceinline__ float bf2f(bf16 b) { return __uint_as_float(((unsigned)b) << 16); }
__device__ __forceinline__ float wave_sum(float v) {
#pragma unroll
    for (int o = 1; o < 64; o <<= 1) v += __shfl_xor(v, o);
    return v;
}
__device__ __forceinline__ float sigmoidf_(float x) { return 1.0f / (1.0f + __expf(-x)); }
__device__ __forceinline__ float siluf_(float x) { return x * sigmoidf_(x); }
__device__ __forceinline__ float geluf_(float x) { return x * sigmoidf_(1.5957691216057308f * (x + 0.044715f * x * x * x)); }
__device__ __forceinline__ float logsigmoidf_(float x) { return fminf(x, 0.f) - log1pf(expf(-fabsf(x))); }
#define XB_TMO      128
#define XB_XCNT(j)  (256  + 64 * (j))
#define XB_XSUB(j)  (1280 + 64 * (j))
#define XB_XGEN(j)  (2304 + 64 * (j))
#define XB_TOP      3328
#define XB_TOPGEN   3392
#define XCD_BAR_WORDS 3456
#define XB_SPIN_CAP (1u << 18)

__device__ __forceinline__ unsigned xb_ld(unsigned* p)              { return __hip_atomic_load(p, __ATOMIC_RELAXED, __HIP_MEMORY_SCOPE_AGENT); }
__device__ __forceinline__ unsigned xb_add(unsigned* p, unsigned v) { return __hip_atomic_fetch_add(p, v, __ATOMIC_RELAXED, __HIP_MEMORY_SCOPE_AGENT); }
__device__ __forceinline__ unsigned xb_xcc_id() { return (unsigned)__builtin_amdgcn_s_getreg((3 << 11) | 20) & 0xFu; }
#define XB_SPIN(cond, bar) do { unsigned _sp = 0; while (cond) { __builtin_amdgcn_s_sleep(1); \
    if ((++_sp & 255u) == 0u) { if (xb_ld(&(bar)[XB_TMO])) break; if (_sp > XB_SPIN_CAP) { atomicAdd(&(bar)[XB_TMO], 1u); break; } } } } while (0)

struct XcdBarrier {
    unsigned* bar; unsigned x;
    volatile LAS unsigned* st;
};

__device__ __forceinline__ XcdBarrier xcd_barrier_post(unsigned* bar, volatile LAS unsigned* st) {
    XcdBarrier b; b.bar = bar; b.x = xb_xcc_id(); b.st = st;
    if (threadIdx.x == 0) (void)xb_add(&bar[XB_XCNT(b.x)], 1u);
    return b;
}
__device__ __forceinline__ void xcd_barrier_complete(unsigned* bar, unsigned x, unsigned& nloc, unsigned& nx) {
    const unsigned G = gridDim.x * gridDim.y * gridDim.z;
    unsigned sum, cnt, mine, sp = 0u;
    for (;;) {
        sum = 0u; cnt = 0u; mine = 0u;
#pragma unroll
        for (unsigned j = 0; j < 16; ++j) { const unsigned c = xb_ld(&bar[XB_XCNT(j)]); sum += c; cnt += (c > 0u) ? 1u : 0u; mine = (j == x) ? c : mine; }
        if (sum == G) break;
        __builtin_amdgcn_s_sleep(1);
        if ((++sp & 255u) == 0u) { if (xb_ld(&bar[XB_TMO])) break; if (sp > XB_SPIN_CAP) { atomicAdd(&bar[XB_TMO], 1u); break; } }
    }
    nloc = mine > 0u ? mine : 1u; nx = cnt > 0u ? cnt : 1u;
}

__device__ __forceinline__ void xcd_barrier(const XcdBarrier& b) {
    asm volatile("s_waitcnt vmcnt(0)" ::: "memory");
    __syncthreads();
    if (threadIdx.x == 0) {
        unsigned* bar = b.bar;
        __builtin_amdgcn_s_waitcnt(0);
        unsigned nloc = b.st[0], nx = b.st[1];
        if (nloc == 0u) { xcd_barrier_complete(bar, b.x, nloc, nx); b.st[0] = nloc; b.st[1] = nx; }
        const unsigned old = xb_add(&bar[XB_XSUB(b.x)], 1u);
        const unsigned gen = old / nloc;
        if (old + 1u == (gen + 1u) * nloc) {
            __builtin_amdgcn_fence(__ATOMIC_RELEASE, "agent");
            asm volatile("s_waitcnt vmcnt(0)" ::: "memory");
            const unsigned og = xb_add(&bar[XB_TOP], 1u);
            const unsigned tg = og / nx;
            if (og + 1u == (tg + 1u) * nx) xb_add(&bar[XB_TOPGEN], 1u);
            else XB_SPIN(xb_ld(&bar[XB_TOPGEN]) == tg, bar);
            __builtin_amdgcn_fence(__ATOMIC_ACQUIRE, "agent");
            xb_add(&bar[XB_XGEN(b.x)], 1u);
            asm volatile("s_waitcnt vmcnt(0)" ::: "memory");
        } else {
            XB_SPIN(xb_ld(&bar[XB_XGEN(b.x)]) == gen, bar);
            __builtin_amdgcn_fence(__ATOMIC_ACQUIRE, "agent");
            asm volatile("s_waitcnt vmcnt(0)" ::: "memory");
        }
    }
    __syncthreads();
}
struct Prm { const float* in[N_IN]; float* out; unsigned char* ws; int ph_lo, ph_hi, var, pad; };
static_assert(sizeof(Prm) == N_IN * 8 + 32, "Prm has no padding bytes");
struct Frame {
    LAS unsigned char* lds;
    int vcu, G;
};
struct Tix { int tid, lane, wave; };
__device__ __forceinline__ Tix tix() { int t = threadIdx.x; asm volatile("" : "+v"(t)); Tix r; r.tid = t; r.lane = t & 63; r.wave = __builtin_amdgcn_readfirstlane(t >> 6); return r; }

__device__ __forceinline__ int map_col(int mode, int n) {
    if (mode == 1) return n < 6144 ? n : (n < 6160 ? ZLR + (n - 6144) : n - 16);
    if (mode == 2) return n < FF ? ((n >> 7) * 256 + (n & 127)) : ((((n - FF) >> 7) * 256) + 128 + ((n - FF) & 127));
    return n;
}
__device__ __forceinline__ void conv_item(const float* W, int K, int N, bf16* WT, int ld, int koff, int mode, LAS float* scr, int item, int lane) {
    const int nkb = K / 64, nb = item / nkb, kb = item % nkb, k0 = 64 * kb, n0 = 64 * nb;
    const int q = lane & 15, kr = lane >> 4; const bool okc = (n0 + 4 * q) < N;
    f32x4 v[16];
#pragma unroll
    for (int i = 0; i < 16; ++i) v[i] = okc ? *(const f32x4*)(W + (size_t)(k0 + 4 * i + kr) * N + n0 + 4 * q) : (f32x4){0.f, 0.f, 0.f, 0.f};
#pragma unroll
    for (int i = 0; i < 16; ++i) { LAS float* s = scr + (4 * i + kr) * 65 + 4 * q; s[0] = v[i].x; s[1] = v[i].y; s[2] = v[i].z; s[3] = v[i].w; }
    LDS_WAIT(); asm volatile("" ::: "memory");
    const int c = lane & 7;
#pragma unroll
    for (int j = 0; j < 8; ++j) { const int n = (lane >> 3) + 8 * j; const LAS float* s = scr + (8 * c) * 65 + n;
        v4u o; o.x = pk2(s[0 * 65], s[1 * 65]); o.y = pk2(s[2 * 65], s[3 * 65]); o.z = pk2(s[4 * 65], s[5 * 65]); o.w = pk2(s[6 * 65], s[7 * 65]);
        if (n0 + n < N) *(GAS v4u*)(WT + (size_t)map_col(mode, n0 + n) * ld + koff + k0 + 8 * c) = o; }
    LDS_WAIT(); asm volatile("" ::: "memory");
}
struct ConvDesc { const float* W; bf16* WT; int K, N, ld, koff, mode, items; };

__device__ __forceinline__ void phase_convert(Frame& F) {
    const Tix T = tix();
    const __attribute__((address_space(4))) Prm* Pk = (const __attribute__((address_space(4))) Prm*)__builtin_amdgcn_kernarg_segment_ptr(); asm volatile("" : "+s"(Pk));
    LAS float* scr = (LAS float*)(F.lds + T.wave * 16640);
    const int gw = F.vcu * NWAVES + T.wave, NGW = F.G * NWAVES;
    unsigned char* ws = Pk->ws;
    for (int l = 0; l < 2; ++l) {
        for (int mi = 1; mi < 8; ++mi) {
            ConvDesc d;
            if (mi == 0)      { d.W = Pk->in[I_WADA] + (size_t)l * D * NADA; d.WT = (bf16*)(ws + WS_WADA) + (size_t)l * NADA * D; d.K = D; d.N = NADA; d.ld = D; d.koff = 0; d.mode = 0; }
            else if (mi == 1) { d.W = Pk->in[I_WIN] + (size_t)l * D * NIN;   d.WT = (bf16*)(ws + WS_WIN) + (size_t)l * NZW * D;    d.K = D; d.N = NIN;  d.ld = D; d.koff = 0; d.mode = 1; }
            else if (mi == 2) { d.W = Pk->in[I_WPA] + (size_t)l * 2048 * D;  d.WT = (bf16*)(ws + WS_WPRJ) + (size_t)l * D * 4096; d.K = 2048; d.N = D; d.ld = 4096; d.koff = 0; d.mode = 0; }
            else if (mi == 3) { d.W = Pk->in[I_WPB] + (size_t)l * 1024 * D;  d.WT = (bf16*)(ws + WS_WPRJ) + (size_t)l * D * 4096; d.K = 1024; d.N = D; d.ld = 4096; d.koff = 2048; d.mode = 0; }
            else if (mi == 4) { d.W = Pk->in[I_WPC] + (size_t)l * 1024 * D;  d.WT = (bf16*)(ws + WS_WPRJ) + (size_t)l * D * 4096; d.K = 1024; d.N = D; d.ld = 4096; d.koff = 3072; d.mode = 0; }
            else if (mi == 5) { d.W = Pk->in[I_WO] + (size_t)l * D * D;      d.WT = (bf16*)(ws + WS_WO) + (size_t)l * D * D;      d.K = D; d.N = D; d.ld = D; d.koff = 0; d.mode = 0; }
            else if (mi == 6) { d.W = Pk->in[I_WFI] + (size_t)l * D * 2 * FF; d.WT = (bf16*)(ws + WS_WFI) + (size_t)l * 2 * FF * D; d.K = D; d.N = 2 * FF; d.ld = D; d.koff = 0; d.mode = 2; }
            else              { d.W = Pk->in[I_WFO] + (size_t)l * FF * D;    d.WT = (bf16*)(ws + WS_WFO) + (size_t)l * D * FF;    d.K = FF; d.N = D; d.ld = FF; d.koff = 0; d.mode = 0; }
            d.items = (d.K / 64) * ((d.N + 63) / 64);
            for (int it = gw; it < d.items; it += NGW) conv_item(d.W, d.K, d.N, d.WT, d.ld, d.koff, d.mode, scr, it, T.lane);
        }
    }
    { bf16* CA = (bf16*)(ws + WS_CA);
      for (int i = blockIdx.x * NT + T.tid; i < 256 * D; i += F.G * NT) { const int r = i >> 11, c = i & 2047; float v = 0.f;
          if (r < 2) v = Pk->in[I_CP][r * D + c]; else if (r < 130) v = Pk->in[I_CS][(r - 2) * D + c];
          CA[i] = (bf16)f2bf(r < 130 ? siluf_(v) : 0.f); } }
    { f32x4* X4 = (f32x4*)(ws + WS_X); const f32x4* xp = (const f32x4*)Pk->in[I_XP]; const f32x4* xs = (const f32x4*)Pk->in[I_XS];
      for (int i = blockIdx.x * NT + T.tid; i < MT * D / 4; i += F.G * NT) { const int r = i >> 9;
          X4[i] = r < MP ? xp[i] : (r < MR ? xs[i - MP * D / 4] : (f32x4){0.f, 0.f, 0.f, 0.f}); } }
}

template <bool FINAL>
__device__ __forceinline__ void phase_norm_t(Frame& F, float* X, const float* nw, const float* mod, int sh_off, int sc_off, bf16* H, float* out, const float* part, int nsl) {
    const Tix T = tix();
    const int gw = F.vcu * NWAVES + T.wave, NGW = F.G * NWAVES;
    const int nit = FINAL ? MP : MP + (MT - MR);
    f32x4 vn[8];
    if (gw < nit) { const int row = gw < MP ? gw : gw + MS; const f32x4* xr = (const f32x4*)(X + (size_t)row * D) + T.lane;
#pragma unroll
        for (int j = 0; j < 8; ++j) vn[j] = xr[64 * j]; }
    for (int it = gw; it < nit; it += NGW) {
        const int row = it < MP ? it : it + MS;
        f32x4 v[8]; float s = 0.f;
#pragma unroll
        for (int j = 0; j < 8; ++j) v[j] = vn[j];
        if (it + NGW < nit) { const int it2 = it + NGW, row2 = it2 < MP ? it2 : it2 + MS; const f32x4* xr = (const f32x4*)(X + (size_t)row2 * D) + T.lane;
#pragma unroll
            for (int j = 0; j < 8; ++j) vn[j] = xr[64 * j]; }
#pragma unroll
        for (int j = 0; j < 8; ++j) s += (v[j].x * v[j].x + v[j].y * v[j].y) + (v[j].z * v[j].z + v[j].w * v[j].w);
        const float rstd = 1.0f / sqrtf(wave_sum(s) * (1.0f / D) + EPS);
        if (FINAL) { f32x4* o = (f32x4*)(out + (size_t)row * D) + T.lane;
#pragma unroll
            for (int j = 0; j < 8; ++j) { const f32x4 w = *(const f32x4*)(nw + 4 * (T.lane + 64 * j)); o[64 * j] = (v[j] * rstd) * w; } }
        else { const float* md = mod + (size_t)pg8::batch_of_row(row) * NADA; v2u* o = (v2u*)(H + (size_t)row * D) + T.lane;
#pragma unroll
            for (int j = 0; j < 8; ++j) { const int c = 4 * (T.lane + 64 * j);
                const f32x4 w = *(const f32x4*)(nw + c), sc = *(const f32x4*)(md + sc_off + c), sh = *(const f32x4*)(md + sh_off + c);
                const f32x4 y = (v[j] * rstd) * w * (sc + 1.0f) + sh;
                v2u q; q.x = pk2(y.x, y.y); q.y = pk2(y.z, y.w); o[64 * j] = q; } }
    }
    LAS float* red = (LAS float*)F.lds;
    for (int sr = (int)blockIdx.x; sr < MS; sr += F.G) {
        const int row = MP + sr, c = 4 * T.tid;
        f32x4 x = *(const f32x4*)(X + (size_t)row * D + c);
        { f32x4 pp[11];
#pragma unroll
          for (int s = 0; s < 11; ++s) pp[s] = s < nsl ? *(const f32x4*)(part + ((size_t)s * 128 + sr) * D + c) : (f32x4){0.f, 0.f, 0.f, 0.f};
#pragma unroll
          for (int s = 0; s < 11; ++s) x += pp[s]; }
        if (nsl > 0) *(f32x4*)(X + (size_t)row * D + c) = x;
        const float ss = wave_sum((x.x * x.x + x.y * x.y) + (x.z * x.z + x.w * x.w));
        __syncthreads();
        if (T.lane == 0) red[T.wave] = ss;
        __syncthreads();
        const float tot = ((red[0] + red[1]) + (red[2] + red[3])) + ((red[4] + red[5]) + (red[6] + red[7]));
        const float rstd = 1.0f / sqrtf(tot * (1.0f / D) + EPS);
        const f32x4 w = *(const f32x4*)(nw + c);
        if (FINAL) *(f32x4*)(out + (size_t)row * D + c) = (x * rstd) * w;
        else { const float* md = mod + (size_t)pg8::batch_of_row(row) * NADA; const f32x4 sc = *(const f32x4*)(md + sc_off + c), sh = *(const f32x4*)(md + sh_off + c);
            const f32x4 y = (x * rstd) * w * (sc + 1.0f) + sh; v2u q; q.x = pk2(y.x, y.y); q.y = pk2(y.z, y.w); *(v2u*)(H + (size_t)row * D + c) = q; }
    }
    __syncthreads();
}

__device__ __forceinline__ void gla_sample_unit(Frame& F, int unit, const bf16* Z, const bf16* H, const bf16* WlraT, const float* wgk2, const float* bgk, const float* Sin  , float* Sout, const float* gnw, bf16* OABC) {
    const Tix T = tix();
    const int b = unit >> 2, h = unit & 3; const size_t row = MP + b;
    LAS float* sq = (LAS float*)F.lds; LAS float* sk = sq + 256; LAS float* se = sk + 256; LAS float* red = se + 256;
    LAS float* lrs = red + 2048;
    __syncthreads();
    { const int rr = T.tid & 15, ksg = T.tid >> 4; float a = 0.f;
      const bf16* hp = H + row * D + 64 * ksg; const bf16* wp = WlraT + (size_t)rr * D + 64 * ksg;
#pragma unroll
      for (int i = 0; i < 8; ++i) { const v4u hv = *(const v4u*)(hp + 8 * i), wv = *(const v4u*)(wp + 8 * i);
          a += (__uint_as_float(hv.x << 16) * __uint_as_float(wv.x << 16) + __uint_as_float(hv.x & 0xffff0000u) * __uint_as_float(wv.x & 0xffff0000u)) + (__uint_as_float(hv.y << 16) * __uint_as_float(wv.y << 16) + __uint_as_float(hv.y & 0xffff0000u) * __uint_as_float(wv.y & 0xffff0000u))
             + (__uint_as_float(hv.z << 16) * __uint_as_float(wv.z << 16) + __uint_as_float(hv.z & 0xffff0000u) * __uint_as_float(wv.z & 0xffff0000u)) + (__uint_as_float(hv.w << 16) * __uint_as_float(wv.w << 16) + __uint_as_float(hv.w & 0xffff0000u) * __uint_as_float(wv.w & 0xffff0000u)); }
      lrs[ksg * 16 + rr] = a; }
    __syncthreads();
    if (T.tid < 16) { float a = 0.f;
#pragma unroll
        for (int s = 0; s < 32; ++s) a += lrs[s * 16 + T.tid];
        lrs[512 + T.tid] = a; }
    __syncthreads();
    if (T.tid < 256) { const int d = T.tid; sq[d] = bf2f(Z[row * NZ + ZQA + h * 256 + d]) * 0.0625f; sk[d] = bf2f(Z[row * NZ + ZKA + h * 256 + d]);
        float x = bgk[h * 256 + d];
#pragma unroll
        for (int rr = 0; rr < 16; ++rr) x += lrs[512 + rr] * wgk2[rr * 1024 + h * 256 + d];
        se[d] = __expf((fminf(x, 0.f) - __logf(1.0f + __expf(-fabsf(x)))) * (1.0f / 16.0f)); }
    __syncthreads();
    const int c4 = T.tid & 127, rg = T.tid >> 7;
    f32x4 v; { const bf16* vp = Z + row * NZ + ZVA + h * 512 + 4 * c4; v.x = bf2f(vp[0]); v.y = bf2f(vp[1]); v.z = bf2f(vp[2]); v.w = bf2f(vp[3]); }
    const size_t base = ((size_t)b * 4 + h) * 256 * 512;
    f32x4 o = (f32x4){0.f, 0.f, 0.f, 0.f};
    for (int it0 = 0; it0 < 64; it0 += 16) {
        f32x4 sv[16];
#pragma unroll
        for (int u = 0; u < 16; ++u) sv[u] = __builtin_nontemporal_load((const f32x4*)(Sin + base + (size_t)(rg + 4 * (it0 + u)) * 512 + 4 * c4));
#pragma unroll
        for (int u = 0; u < 16; ++u) { const int dk = rg + 4 * (it0 + u);
            const f32x4 sn = sv[u] * se[dk] + v * sk[dk];
            __builtin_nontemporal_store(sn, (f32x4*)(Sout + base + (size_t)dk * 512 + 4 * c4));
            o += sn * sq[dk]; } }
    *(LAS f32x4*)(red + rg * 512 + 4 * c4) = o;
    __syncthreads();
    { const int c = T.tid; const float t = (red[c] + red[512 + c]) + (red[1024 + c] + red[1536 + c]);
      const float ss = wave_sum(t * t);
      if (T.lane == 0) lrs[600 + T.wave] = ss;
      __syncthreads();
      const float tot = ((lrs[600] + lrs[601]) + (lrs[602] + lrs[603])) + ((lrs[604] + lrs[605]) + (lrs[606] + lrs[607]));
      const float rstd = 1.0f / sqrtf(tot * (1.0f / 512.0f) + EPS);
      OABC[row * 4096 + h * 512 + c] = (bf16)f2bf(t * rstd * gnw[c] * siluf_(bf2f(Z[row * NZ + ZGA + h * 512 + c]))); }
}

__device__ __forceinline__ void gm_ln_row(const Tix& T, int row, const v2u (&vw)[4], const bf16* Z, const float* nw, const float* nb, bf16* VNB, float* gmv_out  , const float* ws_, const float* bs, bf16* OABC) {
    float x[16]; float s = 0.f;
#pragma unroll
    for (int j = 0; j < 4; ++j) { const v2u w = vw[j];
        x[4 * j + 0] = geluf_(__uint_as_float(w.x << 16)); x[4 * j + 1] = geluf_(__uint_as_float(w.x & 0xffff0000u)); x[4 * j + 2] = geluf_(__uint_as_float(w.y << 16)); x[4 * j + 3] = geluf_(__uint_as_float(w.y & 0xffff0000u));
        s += (x[4 * j] + x[4 * j + 1]) + (x[4 * j + 2] + x[4 * j + 3]); }
    const float mu = wave_sum(s) * (1.0f / 1024.0f); float q = 0.f;
#pragma unroll
    for (int i = 0; i < 16; ++i) { x[i] -= mu; q += x[i] * x[i]; }
    const float rstd = 1.0f / sqrtf(wave_sum(q) * (1.0f / 1024.0f) + EPS);
#pragma unroll
    for (int j = 0; j < 4; ++j) { const int c = 4 * (T.lane + 64 * j); const f32x4 w = *(const f32x4*)(nw + c), bb = *(const f32x4*)(nb + c);
        f32x4 y; y.x = x[4 * j] * rstd * w.x + bb.x; y.y = x[4 * j + 1] * rstd * w.y + bb.y; y.z = x[4 * j + 2] * rstd * w.z + bb.z; y.w = x[4 * j + 3] * rstd * w.w + bb.w;
        if (row < MP) { v2u o; o.x = pk2(y.x, y.y); o.y = pk2(y.z, y.w); *(v2u*)(VNB + (size_t)row * 1024 + c) = o; }
        else { *(f32x4*)(gmv_out + (size_t)(row - MP) * 1024 + c) = y;
            const int g = c >> 8; const float w00 = ws_[(size_t)g * 128 * 128], b0 = bs[g * 128];
            const v2u uq = *(const v2u*)(Z + (size_t)row * NZ + ZUB + c);
            v2u o; o.x = pk2(geluf_(__uint_as_float(uq.x << 16)) * (w00 * y.x + b0), geluf_(__uint_as_float(uq.x & 0xffff0000u)) * (w00 * y.y + b0));
            o.y = pk2(geluf_(__uint_as_float(uq.y << 16)) * (w00 * y.z + b0), geluf_(__uint_as_float(uq.y & 0xffff0000u)) * (w00 * y.w + b0));
            *(v2u*)(OABC + (size_t)row * 4096 + 2048 + c) = o; } }
}
__device__ __forceinline__ void gm_ln_rows(Frame& F, int ow, int OW, const bf16* Z, const float* nw, const float* nb, bf16* VNB, float* gmv_out, const float* ws_, const float* bs, bf16* OABC) {
    const Tix T = tix();
    const int w0 = ow * NWAVES + T.wave, stride = OW * NWAVES;
    v2u nx[4];
    if (w0 < MR) {
#pragma unroll
        for (int j = 0; j < 4; ++j) nx[j] = *(const v2u*)(Z + (size_t)w0 * NZ + ZVB + 4 * (T.lane + 64 * j)); }
    for (int row = w0; row < MR; row += stride) {
        v2u cur[4];
#pragma unroll
        for (int j = 0; j < 4; ++j) cur[j] = nx[j];
        if (row + stride < MR) {
#pragma unroll
            for (int j = 0; j < 4; ++j) nx[j] = *(const v2u*)(Z + (size_t)(row + stride) * NZ + ZVB + 4 * (T.lane + 64 * j)); }
        gm_ln_row(T, row, cur, Z, nw, nb, VNB, gmv_out, ws_, bs, OABC);
    }
}

__device__ __forceinline__ void cache_outs(Frame& F, int wg, int nwg, int l, const bf16* Z, float* out) {
    const Tix T = tix();
    for (int idx = wg * NT + T.tid; idx < 2 * 128 * 512; idx += nwg * NT) {
        const int c = idx & 511, r = (idx >> 9) & 127, b = idx >> 16; const size_t row = (size_t)b * SEQ + (SEQ - 128) + r;
        const float v = bf2f(Z[row * NZ + ZKC + c]);
        if (c < 256) out[O_CKP + ((size_t)(l * 2 + b) * 128 + r) * 256 + c] = v; else out[O_CVP + ((size_t)(l * 2 + b) * 128 + r) * 256 + (c - 256)] = v;
    }
    for (int idx = wg * NT + T.tid; idx < 128 * 512; idx += nwg * NT) {
        const int c = idx & 511, b = idx >> 9; const float v = bf2f(Z[(size_t)(MP + b) * NZ + ZKC + c]);
        if (c < 256) out[O_CKS + (size_t)(l * 128 + b) * 256 + c] = v; else out[O_CVS + (size_t)(l * 128 + b) * 256 + (c - 256)] = v;
    }
}

__device__ __forceinline__ void gla_fin(Frame& F, const float* OB, const bf16* Z, const float* gnw, bf16* OABC) {
    const Tix T = tix();
    const int gw = F.vcu * NWAVES + T.wave, NGW = F.G * NWAVES;
    f32x4 on[8]; v2u gn[8];
#define FIN_LOAD(rw) do { const f32x4* op_ = (const f32x4*)(OB + (size_t)(rw) * 2048) + T.lane; const bf16* gp_ = Z + (size_t)(rw) * NZ + ZGA + 4 * T.lane; \
        _Pragma("unroll") for (int j = 0; j < 8; ++j) { on[j] = op_[64 * j]; gn[j] = *(const v2u*)(gp_ + 256 * j); } } while (0)
    if (gw < MP) FIN_LOAD(gw);
    for (int row = gw; row < MP; row += NGW) {
        f32x4 o[8]; v2u gq[8];
#pragma unroll
        for (int j = 0; j < 8; ++j) { o[j] = on[j]; gq[j] = gn[j]; }
        if (row + NGW < MP) FIN_LOAD(row + NGW);
#pragma unroll
        for (int h = 0; h < 4; ++h) { const f32x4 a = o[2 * h], b = o[2 * h + 1];
            const float s = (a.x * a.x + a.y * a.y) + (a.z * a.z + a.w * a.w) + (b.x * b.x + b.y * b.y) + (b.z * b.z + b.w * b.w);
            const float rstd = 1.0f / sqrtf(wave_sum(s) * (1.0f / 512.0f) + EPS);
#pragma unroll
            for (int jj = 0; jj < 2; ++jj) { const int j = 2 * h + jj, c = 4 * (T.lane + 64 * jj); const f32x4 ov = o[j]; const f32x4 w = *(const f32x4*)(gnw + c);
                const float g0 = siluf_(__uint_as_float(gq[j].x << 16)), g1 = siluf_(__uint_as_float(gq[j].x & 0xffff0000u)), g2 = siluf_(__uint_as_float(gq[j].y << 16)), g3 = siluf_(__uint_as_float(gq[j].y & 0xffff0000u));
                v2u r; r.x = pk2(ov.x * rstd * w.x * g0, ov.y * rstd * w.y * g1); r.y = pk2(ov.z * rstd * w.z * g2, ov.w * rstd * w.w * g3);
                *(v2u*)(OABC + (size_t)row * 4096 + h * 512 + c) = r; } }
    }
#undef FIN_LOAD
}
typedef short bf16x8 __attribute__((ext_vector_type(8)));
typedef unsigned short u16x4 __attribute__((ext_vector_type(4)));
__device__ __forceinline__ unsigned offb(unsigned row, unsigned ch) { return 256u * row + 16u * (ch ^ (((row & 3u) << 2) | ((row >> 2) & 3u))); }
__device__ __forceinline__ unsigned tr_addr16(unsigned lane, unsigned c, unsigned ks, unsigned t) {
    const unsigned g = lane >> 4, q = (lane & 15u) >> 2, p = lane & 3u; return offb(32u * ks + 8u * g + 4u * t + q, 2u * c + (p >> 1)) + 8u * (p & 1u); }
struct TrLane { unsigned L0, L1, X0, X1; };
__device__ __forceinline__ TrLane tr_lane(unsigned lane) {
    const unsigned g = lane >> 4, q = (lane & 15u) >> 2, p = lane & 3u; TrLane t;
    const unsigned m0 = (q << 2) | ((2u * g) & 3u), m1 = (q << 2) | ((2u * g + 1u) & 3u);
    t.L0 = 2048u * g + 256u * q + 8u * (p & 1u) + 16u * ((p >> 1) ^ (m0 & 1u)); t.L1 = 2048u * g + 1024u + 256u * q + 8u * (p & 1u) + 16u * ((p >> 1) ^ (m1 & 1u));
    t.X0 = (m0 >> 1) << 5; t.X1 = (m1 >> 1) << 5; return t;
}
__device__ __forceinline__ void tr_frag2(unsigned base, const TrLane& tl, unsigned c, bf16x8& f0, bf16x8& f1) {
    const unsigned a0 = base + tl.L0 + ((c << 5) ^ tl.X0), a1 = base + tl.L1 + ((c << 5) ^ tl.X1);
    u16x4 r0, r1, r2, r3;
    asm volatile("ds_read_b64_tr_b16 %0, %4\n\tds_read_b64_tr_b16 %1, %5\n\tds_read_b64_tr_b16 %2, %4 offset:8192\n\tds_read_b64_tr_b16 %3, %5 offset:8192\n\ts_waitcnt lgkmcnt(0)"
                 : "=&v"(r0), "=&v"(r1), "=&v"(r2), "=&v"(r3) : "v"(a0), "v"(a1) : "memory");
    f0 = (bf16x8){(short)r0[0], (short)r0[1], (short)r0[2], (short)r0[3], (short)r1[0], (short)r1[1], (short)r1[2], (short)r1[3]};
    f1 = (bf16x8){(short)r2[0], (short)r2[1], (short)r2[2], (short)r2[3], (short)r3[0], (short)r3[1], (short)r3[2], (short)r3[3]};
}
__device__ __forceinline__ void tr_frag4(unsigned base, const TrLane& tl, unsigned c, bf16x8& f0, bf16x8& f1, bf16x8& f2, bf16x8& f3) {
    const unsigned a0 = base + tl.L0 + ((c << 5) ^ tl.X0), a1 = base + tl.L1 + ((c << 5) ^ tl.X1), a2 = base + tl.L0 + (((c + 1u) << 5) ^ tl.X0), a3 = base + tl.L1 + (((c + 1u) << 5) ^ tl.X1);
    u16x4 r0, r1, r2, r3, r4, r5, r6, r7;
    asm volatile("ds_read_b64_tr_b16 %0, %8\n\tds_read_b64_tr_b16 %1, %9\n\tds_read_b64_tr_b16 %2, %8 offset:8192\n\tds_read_b64_tr_b16 %3, %9 offset:8192\n\t"
                 "ds_read_b64_tr_b16 %4, %10\n\tds_read_b64_tr_b16 %5, %11\n\tds_read_b64_tr_b16 %6, %10 offset:8192\n\tds_read_b64_tr_b16 %7, %11 offset:8192\n\ts_waitcnt lgkmcnt(0)"
                 : "=&v"(r0), "=&v"(r1), "=&v"(r2), "=&v"(r3), "=&v"(r4), "=&v"(r5), "=&v"(r6), "=&v"(r7) : "v"(a0), "v"(a1), "v"(a2), "v"(a3) : "memory");
    f0 = (bf16x8){(short)r0[0], (short)r0[1], (short)r0[2], (short)r0[3], (short)r1[0], (short)r1[1], (short)r1[2], (short)r1[3]};
    f1 = (bf16x8){(short)r2[0], (short)r2[1], (short)r2[2], (short)r2[3], (short)r3[0], (short)r3[1], (short)r3[2], (short)r3[3]};
    f2 = (bf16x8){(short)r4[0], (short)r4[1], (short)r4[2], (short)r4[3], (short)r5[0], (short)r5[1], (short)r5[2], (short)r5[3]};
    f3 = (bf16x8){(short)r6[0], (short)r6[1], (short)r6[2], (short)r6[3], (short)r7[0], (short)r7[1], (short)r7[2], (short)r7[3]};
}
__device__ __forceinline__ unsigned cvtpk(float lo, float hi) { unsigned r; asm volatile("v_cvt_pk_bf16_f32 %0, %1, %2" : "=v"(r) : "v"(lo), "v"(hi)); return r; }

constexpr int GLA_PREP_STRIDE = 264;

__device__ __forceinline__ void gla_prep_unit(Frame& F, int unit, const bf16* Z, const bf16* H, const bf16* WlraT, const float* wgk2, const float* bgk, bf16* QT, bf16* KH, bf16* AI, float* GAM) {
    const Tix T = tix();
    const int b = unit >> 8, h = (unit >> 6) & 3, c = unit & 63;
    const int d4 = 4 * T.lane, seg = T.wave;
    const int r = T.lane & 15, g = T.lane >> 4;
    LAS bf16* QA = (LAS bf16*)F.lds; LAS bf16* KA = QA + 64 * GLA_PREP_STRIDE; LAS float* tots = (LAS float*)(KA + 64 * GLA_PREP_STRIDE);
    LAS float* lrp = tots + 2048;
    const size_t rowc = (size_t)b * SEQ + c * 64;
    __syncthreads();
    {
      const int tl = T.wave & 3, kh = T.wave >> 2; f32x4 acc = (f32x4){0.f, 0.f, 0.f, 0.f};
      const bf16* hp = H + (rowc + 16 * tl + r) * D + kh * 1024 + 8 * g; const bf16* wp = WlraT + (size_t)r * D + kh * 1024 + 8 * g;
#pragma unroll 16
      for (int s = 0; s < 32; ++s) acc = __builtin_amdgcn_mfma_f32_16x16x32_bf16(*(const bf16x8*)(hp + 32 * s), *(const bf16x8*)(wp + 32 * s), acc, 0, 0, 0);
#pragma unroll
      for (int e = 0; e < 4; ++e) lrp[(kh * 64 + 16 * tl + 4 * g + e) * 16 + r] = acc[e]; }
    const size_t row0 = rowc + seg * 8;
    v2u qv[8], kv[8];
#pragma unroll
    for (int t = 0; t < 8; ++t) { qv[t] = *(const v2u*)(Z + (row0 + t) * NZ + ZQA + h * 256 + d4); kv[t] = *(const v2u*)(Z + (row0 + t) * NZ + ZKA + h * 256 + d4); }
    __syncthreads();
    f32x4 cum[8]; f32x4 run = (f32x4){0.f, 0.f, 0.f, 0.f};
    { f32x4 w[16];
#pragma unroll
      for (int rr = 0; rr < 16; ++rr) w[rr] = *(const f32x4*)(wgk2 + rr * 1024 + h * 256 + d4);
      const f32x4 bb = *(const f32x4*)(bgk + h * 256 + d4);
#pragma unroll
      for (int t = 0; t < 8; ++t) { const int tk = seg * 8 + t; f32x4 x = bb;
#pragma unroll
          for (int r4 = 0; r4 < 4; ++r4) { const f32x4 l0 = *(const LAS f32x4*)(lrp + tk * 16 + 4 * r4), l1 = *(const LAS f32x4*)(lrp + (64 + tk) * 16 + 4 * r4);
              x += (l0.x + l1.x) * w[4 * r4] + (l0.y + l1.y) * w[4 * r4 + 1] + (l0.z + l1.z) * w[4 * r4 + 2] + (l0.w + l1.w) * w[4 * r4 + 3]; }
#pragma unroll
          for (int j = 0; j < 4; ++j) run[j] += (fminf(x[j], 0.f) - __logf(1.0f + __expf(-fabsf(x[j])))) * (1.0f / 16.0f);
          cum[t] = run; } }
    *(LAS f32x4*)(tots + seg * 256 + d4) = run;
    __syncthreads();
    f32x4 add = (f32x4){0.f, 0.f, 0.f, 0.f}, bmid = add, bl = add;
#pragma unroll
    for (int s = 0; s < 8; ++s) { const f32x4 ts = *(const LAS f32x4*)(tots + s * 256 + d4); if (s < seg) add += ts; if (s < 4) bmid += ts; bl += ts; }
#pragma unroll
    for (int t = 0; t < 8; ++t) { const f32x4 bt = cum[t] + add; const size_t row = row0 + t; const int tk = seg * 8 + t;
        f32x4 q, k; q[0] = __uint_as_float(qv[t].x << 16); q[1] = __uint_as_float(qv[t].x & 0xffff0000u); q[2] = __uint_as_float(qv[t].y << 16); q[3] = __uint_as_float(qv[t].y & 0xffff0000u);
        k[0] = __uint_as_float(kv[t].x << 16); k[1] = __uint_as_float(kv[t].x & 0xffff0000u); k[2] = __uint_as_float(kv[t].y << 16); k[3] = __uint_as_float(kv[t].y & 0xffff0000u);
        q = q * 0.0625f;
        f32x4 o0, o1, o2, o3;
#pragma unroll
        for (int j = 0; j < 4; ++j) { o0[j] = q[j] * __expf(bt[j]); o1[j] = k[j] * __expf(bl[j] - bt[j]); o2[j] = q[j] * __expf(bt[j] - bmid[j]); o3[j] = k[j] * __expf(bmid[j] - bt[j]); }
        v2u w0, w1, w2, w3; w0.x = pk2(o0[0], o0[1]); w0.y = pk2(o0[2], o0[3]); w1.x = pk2(o1[0], o1[1]); w1.y = pk2(o1[2], o1[3]); w2.x = pk2(o2[0], o2[1]); w2.y = pk2(o2[2], o2[3]); w3.x = pk2(o3[0], o3[1]); w3.y = pk2(o3[2], o3[3]);
        *(v2u*)(QT + row * 1024 + h * 256 + d4) = w0; *(v2u*)(KH + row * 1024 + h * 256 + d4) = w1;
        *(LAS v2u*)(QA + tk * GLA_PREP_STRIDE + d4) = w2; *(LAS v2u*)(KA + tk * GLA_PREP_STRIDE + d4) = w3; }
    if (seg == 0) { f32x4 eg; eg[0] = __expf(bl[0]); eg[1] = __expf(bl[1]); eg[2] = __expf(bl[2]); eg[3] = __expf(bl[3]); *(f32x4*)(GAM + (size_t)unit * 256 + d4) = eg; }
    __syncthreads();
#pragma unroll
    for (int x = 0; x < 2; ++x) { const int tt = 2 * T.wave + x, j = tt >> 2, sb = tt & 3;
        f32x4 acc = (f32x4){0.f, 0.f, 0.f, 0.f};
        if (sb <= j) {
#pragma unroll
            for (int ks = 0; ks < 8; ++ks) { const bf16x8 a = *(const LAS bf16x8*)(QA + (16 * j + r) * GLA_PREP_STRIDE + 32 * ks + 8 * g), bb = *(const LAS bf16x8*)(KA + (16 * sb + r) * GLA_PREP_STRIDE + 32 * ks + 8 * g);
                acc = __builtin_amdgcn_mfma_f32_16x16x32_bf16(a, bb, acc, 0, 0, 0); } }
        bf16* ap = AI + (size_t)unit * 4096;
#pragma unroll
        for (int e = 0; e < 4; ++e) { const int t = 16 * j + 4 * g + e, s = 16 * sb + r; ap[t * 64 + s] = (bf16)f2bf(s <= t ? acc[e] : 0.f); } }
}

constexpr int GL_KH = 0, GL_QT = 32768, GL_V = 65536, GL_A = 81920, GL_GAM = 90112, GL_END = 91136;
template <bool OUT>
__device__ __forceinline__ void gla_pass(Frame& F, int worker, const bf16* Z, const bf16* QT, const bf16* KH, const bf16* AI, const float* GAM, float* GST, float* GAMS, float* OB, float* state_out) {
    const Tix T = tix();
    const int lane = T.lane, wave = T.wave, r = lane & 15, g = lane >> 4;
    const int grp = worker >> 2, qs = worker & 3, b = grp >> 5, h = (grp >> 3) & 3, sc = grp & 7;
    const unsigned lbase = (unsigned)(size_t)F.lds; const TrLane tl = tr_lane((unsigned)lane);
    f32x4 S[16];
#pragma unroll
    for (int i = 0; i < 16; ++i) S[i] = (f32x4){0.f, 0.f, 0.f, 0.f};
    if (OUT) {
        const f32x4* gp = (const f32x4*)(GST + ((((size_t)grp * 4 + qs) * 8 + wave) * 16) * 256) + lane;
#pragma unroll
        for (int i = 0; i < 16; ++i) S[i] = gp[64 * i];
    }
    const int srow = T.tid >> 4, sch = T.tid & 15;
    v4u pk[2][2], pq[2][2], pv[2], pa; f32x4 pg;
    const size_t seq0 = (size_t)b * SEQ + sc * 512;
    const unsigned tko = (unsigned)(srow * 1024 + 8 * sch) * 2u, tvo = (unsigned)(srow * NZ + 8 * sch) * 2u;
#define GLA_LOAD(cc) do { const size_t rw = seq0 + (cc) * 64; const size_t un = (size_t)((b * 4 + h) * 64 + sc * 8 + (cc)); \
        const char* kb = (const char*)(KH + rw * 1024 + h * 256); const char* qb = (const char*)(QT + rw * 1024 + h * 256); const char* vb = (const char*)(Z + rw * NZ + ZVA + h * 512 + qs * 128); \
        _Pragma("unroll") for (int hh = 0; hh < 2; ++hh) _Pragma("unroll") for (int u = 0; u < 2; ++u) { \
            pk[hh][u] = *(const v4u*)(kb + (hh * 256 + u * 65536) + tko); \
            if (OUT) pq[hh][u] = *(const v4u*)(qb + (hh * 256 + u * 65536) + tko); } \
        _Pragma("unroll") for (int u = 0; u < 2; ++u) pv[u] = *(const v4u*)(vb + (size_t)u * (32 * NZ * 2) + tvo); \
        if (OUT) pa = *(const v4u*)((const char*)(AI + un * 4096) + (unsigned)T.tid * 16u); \
        if (T.tid < 64) pg = *(const f32x4*)((const char*)(GAM + un * 256) + (unsigned)T.tid * 16u); } while (0)
    GLA_LOAD(0);
    for (int c = 0; c < 8; ++c) {
        __syncthreads();
#pragma unroll
        for (int hh = 0; hh < 2; ++hh)
#pragma unroll
            for (int u = 0; u < 2; ++u) { *(LAS v4u*)(F.lds + GL_KH + hh * 16384 + offb(srow + 32 * u, sch)) = pk[hh][u]; if (OUT) *(LAS v4u*)(F.lds + GL_QT + hh * 16384 + offb(srow + 32 * u, sch)) = pq[hh][u]; }
#pragma unroll
        for (int u = 0; u < 2; ++u) *(LAS v4u*)(F.lds + GL_V + offb(srow + 32 * u, sch)) = pv[u];
        if (OUT) { const int ar = T.tid >> 3, ach = T.tid & 7; *(LAS v4u*)(F.lds + GL_A + 128 * ar + 16 * (ach ^ (ar & 7))) = pa; }
        if (T.tid < 64) *(LAS f32x4*)(F.lds + GL_GAM + 16 * T.tid) = pg;
        __syncthreads();
        if (c + 1 < 8) GLA_LOAD(c + 1);
        bf16x8 V0, V1; tr_frag2(lbase + GL_V, tl, (unsigned)wave, V0, V1);
        if (OUT) {
            const size_t orow0 = seq0 + c * 64;
            const unsigned mr = ((unsigned)(r & 3) << 2) | ((unsigned)(r >> 2) & 3u);
            const unsigned ql0 = 256u * r + 8u * (g & 1) + 16u * (((unsigned)(g >> 1)) ^ (mr & 3u)), ql1 = 256u * r + 8u * (g & 1) + 16u * ((((unsigned)(g >> 1)) | 2u) ^ (mr & 3u)), qx = (mr >> 2) << 6;
            const unsigned al0 = 128u * r + 16u * (((unsigned)g) ^ (unsigned)(r & 7)), al1 = 128u * r + 16u * ((4u + (unsigned)g) ^ (unsigned)(r & 7));
#pragma unroll 1
            for (int j = 0; j < 4; ++j) {
                f32x4 acc = (f32x4){0.f, 0.f, 0.f, 0.f};
                { const bf16x8 a0 = *(const LAS bf16x8*)(F.lds + GL_A + 2048 * j + al0), a1 = *(const LAS bf16x8*)(F.lds + GL_A + 2048 * j + al1);
                  acc = __builtin_amdgcn_mfma_f32_16x16x32_bf16(V0, a0, acc, 0, 0, 0); acc = __builtin_amdgcn_mfma_f32_16x16x32_bf16(V1, a1, acc, 0, 0, 0); }
#pragma unroll
                for (int s = 0; s < 8; ++s) {
                    const unsigned qo = GL_QT + (unsigned)(s >> 2) * 16384u + 4096u * j + ((64u * (s & 3)) ^ qx);
                    const v2u lo = *(const LAS v2u*)(F.lds + qo + ql0), hi = *(const LAS v2u*)(F.lds + qo + ql1);
                    const v4u w = (v4u){lo.x, lo.y, hi.x, hi.y};
                    const v4u sw = (v4u){cvtpk(S[2 * s][0], S[2 * s][1]), cvtpk(S[2 * s][2], S[2 * s][3]), cvtpk(S[2 * s + 1][0], S[2 * s + 1][1]), cvtpk(S[2 * s + 1][2], S[2 * s + 1][3])};
                    acc = __builtin_amdgcn_mfma_f32_16x16x32_bf16(__builtin_bit_cast(bf16x8, sw), __builtin_bit_cast(bf16x8, w), acc, 0, 0, 0); }
                *(f32x4*)(OB + (orow0 + 16 * j + r) * 2048 + h * 512 + qs * 128 + 16 * wave + 4 * g) = acc;
            }
        }
#pragma unroll
        for (int i = 0; i < 16; i += 2) {
            const f32x4 gm0 = *(const LAS f32x4*)(F.lds + GL_GAM + 4 * (16 * i + 4 * g)), gm1 = *(const LAS f32x4*)(F.lds + GL_GAM + 4 * (16 * (i + 1) + 4 * g));
            bf16x8 k0, k1, k2, k3; tr_frag4(lbase + GL_KH + (i >> 3) * 16384, tl, (unsigned)(i & 7), k0, k1, k2, k3);
            f32x4 s0 = S[i] * gm0, s1 = S[i + 1] * gm1;
            s0 = __builtin_amdgcn_mfma_f32_16x16x32_bf16(k0, V0, s0, 0, 0, 0); s1 = __builtin_amdgcn_mfma_f32_16x16x32_bf16(k2, V0, s1, 0, 0, 0);
            S[i] = __builtin_amdgcn_mfma_f32_16x16x32_bf16(k1, V1, s0, 0, 0, 0); S[i + 1] = __builtin_amdgcn_mfma_f32_16x16x32_bf16(k3, V1, s1, 0, 0, 0);
        }
    }
#undef GLA_LOAD
    if (!OUT) {
        f32x4* gp = (f32x4*)(GST + ((((size_t)grp * 4 + qs) * 8 + wave) * 16) * 256) + lane;
#pragma unroll
        for (int i = 0; i < 16; ++i) gp[64 * i] = S[i];
        if (qs == 0 && wave == 0) {
            f32x4 gt = (f32x4){1.f, 1.f, 1.f, 1.f};
            for (int c = 0; c < 8; ++c) gt = gt * *(const f32x4*)(GAM + ((size_t)((b * 4 + h) * 64 + sc * 8 + c)) * 256 + 4 * lane);
            *(f32x4*)(GAMS + (size_t)grp * 256 + 4 * lane) = gt; }
    } else if (sc == 7) {
#pragma unroll
        for (int i = 0; i < 16; ++i)
#pragma unroll
            for (int e = 0; e < 4; ++e) state_out[(((size_t)b * 4 + h) * 256 + 16 * i + 4 * g + e) * 512 + qs * 128 + 16 * wave + r] = S[i][e];
    }
    __syncthreads();
}

constexpr int GM_W = 0, GM_V = 32768, GM_END = 98304;
__device__ __forceinline__ void gm_mix_unit(Frame& F, int unit, const bf16* Z, const bf16* VNB, const float* ws_, const float* bs, bf16* OABC) {
    const Tix T = tix();
    const int lane = T.lane, wave = T.wave, r = lane & 15, g4 = lane >> 4;
    const int n = unit >> 2, grp = unit & 3; const size_t row0 = (size_t)n * 128;
    __syncthreads();
#pragma unroll
    for (int i = 0; i < 4; ++i) { const int ci = T.tid + 512 * i, row = ci >> 4, ch = ci & 15; const float* wp = ws_ + ((size_t)grp * 128 + row) * 128 + 8 * ch;
        const f32x4 a = *(const f32x4*)wp, b = *(const f32x4*)(wp + 4); const int s0 = 8 * ch;
        v4u o; o.x = pk2(s0 + 0 <= row ? a.x : 0.f, s0 + 1 <= row ? a.y : 0.f); o.y = pk2(s0 + 2 <= row ? a.z : 0.f, s0 + 3 <= row ? a.w : 0.f);
        o.z = pk2(s0 + 4 <= row ? b.x : 0.f, s0 + 5 <= row ? b.y : 0.f); o.w = pk2(s0 + 6 <= row ? b.z : 0.f, s0 + 7 <= row ? b.w : 0.f);
        *(LAS v4u*)(F.lds + GM_W + offb((unsigned)row, (unsigned)ch)) = o; }
#pragma unroll
    for (int i = 0; i < 8; ++i) { const int ci = T.tid + 512 * i, row = ci >> 5, c32 = ci & 31;
        const v4u v = *(const v4u*)(VNB + (row0 + row) * 1024 + grp * 256 + 8 * c32);
        *(LAS v4u*)(F.lds + GM_V + (c32 >> 4) * 32768 + offb((unsigned)row, (unsigned)(c32 & 15))) = v; }
    __syncthreads();
    const unsigned lbase = (unsigned)(size_t)F.lds; const TrLane tl = tr_lane((unsigned)lane);
    bf16x8 Bf[2][4];
#pragma unroll
    for (int x = 0; x < 2; ++x) { const unsigned ct = 2u * wave + x;
        const unsigned vb = lbase + GM_V + (ct >> 3) * 32768u;
        tr_frag2(vb, tl, ct & 7u, Bf[x][0], Bf[x][1]); tr_frag2(vb + 16384u, tl, ct & 7u, Bf[x][2], Bf[x][3]); }
    const unsigned mr = ((unsigned)(r & 3) << 2) | ((unsigned)(r >> 2) & 3u);
#pragma unroll
    for (int j = 0; j < 8; ++j) {
        f32x4 acc0 = (f32x4){0.f, 0.f, 0.f, 0.f}, acc1 = acc0;
#pragma unroll
        for (int ks = 0; ks <= (j >> 1); ++ks) {
            const bf16x8 a = *(const LAS bf16x8*)(F.lds + GM_W + 256u * (16 * j + r) + 16u * (((unsigned)(4 * ks + g4)) ^ mr));
            acc0 = __builtin_amdgcn_mfma_f32_16x16x32_bf16(Bf[0][ks], a, acc0, 0, 0, 0); acc1 = __builtin_amdgcn_mfma_f32_16x16x32_bf16(Bf[1][ks], a, acc1, 0, 0, 0); }
        const int t = 16 * j + r; const size_t row = row0 + t; const float bb = bs[grp * 128 + t];
#pragma unroll
        for (int x = 0; x < 2; ++x) { const int c = grp * 256 + 32 * wave + 16 * x + 4 * g4; const f32x4 av = x ? acc1 : acc0;
            const v2u uq = *(const v2u*)(Z + row * NZ + ZUB + c);
            v2u o; o.x = pk2(geluf_(__uint_as_float(uq.x << 16)) * (av[0] + bb), geluf_(__uint_as_float(uq.x & 0xffff0000u)) * (av[1] + bb));
            o.y = pk2(geluf_(__uint_as_float(uq.y << 16)) * (av[2] + bb), geluf_(__uint_as_float(uq.y & 0xffff0000u)) * (av[3] + bb));
            *(v2u*)(OABC + row * 4096 + 2048 + c) = o; }
    }
}

constexpr int SW_K = 0, SW_V = 32768, SW_END = 65536;
__device__ __forceinline__ void swa_unit(Frame& F, int unit, const bf16* Z, const float* sinks, bf16* OABC) {
    const Tix T = tix();
    const int lane = T.lane, wave = T.wave, r = lane & 15, g = lane >> 4;
    const int kv = unit & 3, n = (unit >> 2) & 31, b = unit >> 7;
    const size_t rowq0 = (size_t)b * SEQ + n * 128;
    __syncthreads();
#pragma unroll
    for (int i = 0; i < 4; ++i) { const int ci = T.tid + 512 * i, key = ci >> 3, ch = ci & 7;
        v4u kk = (v4u){0u, 0u, 0u, 0u}, vv = kk;
        if (n > 0 || key >= 128) { const bf16* zp = Z + (rowq0 - 128 + key) * NZ + kv * 64 + 8 * ch; kk = *(const v4u*)(zp + ZKC); vv = *(const v4u*)(zp + ZVC); }
        const unsigned o = 128u * key + 16u * ((unsigned)ch ^ (unsigned)(key & 7));
        *(LAS v4u*)(F.lds + SW_K + o) = kk; *(LAS v4u*)(F.lds + SW_V + o) = vv; }
    __syncthreads();
    const int head = kv * 4 + (wave >> 1), qh = wave & 1;
    const float slope = exp2f(-0.5f * (float)(head + 1)), sink = sinks[head];
    const unsigned lbase = (unsigned)(size_t)F.lds;
    bf16x8 qfa[4][2];
#pragma unroll
    for (int qt = 0; qt < 4; ++qt)
#pragma unroll
        for (int ks = 0; ks < 2; ++ks) qfa[qt][ks] = *(const bf16x8*)(Z + (rowq0 + 64 * qh + 16 * qt + r) * NZ + ZQC + head * 64 + 32 * ks + 8 * g);
#pragma unroll
    for (int qt = 0; qt < 4; ++qt) {
        const int i0 = 64 * qh + 16 * qt, a = i0 >> 4;
        const size_t qrow = rowq0 + i0 + r;
        bf16x8 qf[2]; qf[0] = qfa[qt][0]; qf[1] = qfa[qt][1];
        f32x4 st[10];
#pragma unroll
        for (int t = 0; t < 9; ++t) { const int krow = 16 * (a + t) + r; f32x4 acc = (f32x4){0.f, 0.f, 0.f, 0.f};
#pragma unroll
            for (int ks = 0; ks < 2; ++ks) { const bf16x8 kf = *(const LAS bf16x8*)(F.lds + SW_K + 128u * krow + 16u * (((unsigned)(4 * ks + g)) ^ (unsigned)(krow & 7)));
                acc = __builtin_amdgcn_mfma_f32_16x16x32_bf16(kf, qf[ks], acc, 0, 0, 0); }
            st[t] = acc; }
        st[9] = (f32x4){0.f, 0.f, 0.f, 0.f};
        const int iq = i0 + r; float mx = sink;
#pragma unroll
        for (int t = 0; t < 9; ++t)
#pragma unroll
            for (int e = 0; e < 4; ++e) { const int j = 16 * (a + t) + 4 * g + e, dist = 128 + iq - j; const bool ok = dist >= 0 && dist < 128 && (n > 0 || j >= 128);
                const float s = ok ? st[t][e] * 0.125f - slope * (float)dist : -1e30f; st[t][e] = s; mx = fmaxf(mx, s); }
        mx = fmaxf(mx, __shfl_xor(mx, 16)); mx = fmaxf(mx, __shfl_xor(mx, 32));
        float sum = 0.f;
#pragma unroll
        for (int t = 0; t < 9; ++t)
#pragma unroll
            for (int e = 0; e < 4; ++e) { const float p = __expf(st[t][e] - mx); st[t][e] = p; sum += p; }
        sum += __shfl_xor(sum, 16); sum += __shfl_xor(sum, 32);
        const float inv = 1.0f / (sum + __expf(sink - mx));
        f32x4 o[4];
#pragma unroll
        for (int dt = 0; dt < 4; ++dt) o[dt] = (f32x4){0.f, 0.f, 0.f, 0.f};
#pragma unroll
        for (int pr = 0; pr < 5; ++pr) {
            const v4u pw = (v4u){cvtpk(st[2 * pr][0], st[2 * pr][1]), cvtpk(st[2 * pr][2], st[2 * pr][3]), cvtpk(st[2 * pr + 1][0], st[2 * pr + 1][1]), cvtpk(st[2 * pr + 1][2], st[2 * pr + 1][3])};
            const bf16x8 pf = __builtin_bit_cast(bf16x8, pw);
            const int q4 = r >> 2, p4 = r & 3;
            const int k0 = 16 * (a + 2 * pr) + 4 * g + q4; int k1 = k0 + 16; if (k1 > 255) k1 = 255;
            const unsigned b0 = lbase + SW_V + 128u * k0 + 8u * (p4 & 1), b1 = lbase + SW_V + 128u * k1 + 8u * (p4 & 1);
            const unsigned x0 = (unsigned)(k0 & 7), x1 = (unsigned)(k1 & 7), ph = (unsigned)(p4 >> 1);
            u16x4 r0, r1, r2, r3, r4, r5, r6, r7;
            asm volatile("ds_read_b64_tr_b16 %0, %8\n\tds_read_b64_tr_b16 %1, %9\n\tds_read_b64_tr_b16 %2, %10\n\tds_read_b64_tr_b16 %3, %11\n\t"
                         "ds_read_b64_tr_b16 %4, %12\n\tds_read_b64_tr_b16 %5, %13\n\tds_read_b64_tr_b16 %6, %14\n\tds_read_b64_tr_b16 %7, %15\n\ts_waitcnt lgkmcnt(0)"
                         : "=&v"(r0), "=&v"(r1), "=&v"(r2), "=&v"(r3), "=&v"(r4), "=&v"(r5), "=&v"(r6), "=&v"(r7)
                         : "v"(b0 + 16u * ((0u + ph) ^ x0)), "v"(b1 + 16u * ((0u + ph) ^ x1)), "v"(b0 + 16u * ((2u + ph) ^ x0)), "v"(b1 + 16u * ((2u + ph) ^ x1)),
                           "v"(b0 + 16u * ((4u + ph) ^ x0)), "v"(b1 + 16u * ((4u + ph) ^ x1)), "v"(b0 + 16u * ((6u + ph) ^ x0)), "v"(b1 + 16u * ((6u + ph) ^ x1)) : "memory");
            const bf16x8 v0 = (bf16x8){(short)r0[0], (short)r0[1], (short)r0[2], (short)r0[3], (short)r1[0], (short)r1[1], (short)r1[2], (short)r1[3]};
            const bf16x8 v1 = (bf16x8){(short)r2[0], (short)r2[1], (short)r2[2], (short)r2[3], (short)r3[0], (short)r3[1], (short)r3[2], (short)r3[3]};
            const bf16x8 v2 = (bf16x8){(short)r4[0], (short)r4[1], (short)r4[2], (short)r4[3], (short)r5[0], (short)r5[1], (short)r5[2], (short)r5[3]};
            const bf16x8 v3 = (bf16x8){(short)r6[0], (short)r6[1], (short)r6[2], (short)r6[3], (short)r7[0], (short)r7[1], (short)r7[2], (short)r7[3]};
            o[0] = __builtin_amdgcn_mfma_f32_16x16x32_bf16(v0, pf, o[0], 0, 0, 0); o[1] = __builtin_amdgcn_mfma_f32_16x16x32_bf16(v1, pf, o[1], 0, 0, 0);
            o[2] = __builtin_amdgcn_mfma_f32_16x16x32_bf16(v2, pf, o[2], 0, 0, 0); o[3] = __builtin_amdgcn_mfma_f32_16x16x32_bf16(v3, pf, o[3], 0, 0, 0);
        }
        bf16* op = OABC + qrow * 4096 + 3072 + head * 64 + 4 * g;
#pragma unroll
        for (int dt = 0; dt < 4; ++dt) { v2u w; w.x = pk2(o[dt][0] * inv, o[dt][1] * inv); w.y = pk2(o[dt][2] * inv, o[dt][3] * inv); *(v2u*)(op + 16 * dt) = w; }
    }
}

__device__ __forceinline__ void swa_sample_wave(Frame& F, int item, const bf16* Z, const float* sinks, const float* ck, const float* cv, bf16* OABC) {
    const Tix T = tix();
    const int lane = T.lane, b = item >> 4, head = item & 15, kv = head >> 2; const size_t row = MP + b;
    LAS float* sq = (LAS float*)(F.lds + T.wave * 1024); LAS float* sp = sq + 64;
    const float slope = exp2f(-0.5f * (float)(head + 1)), sink = sinks[head];
    sq[lane] = bf2f(Z[row * NZ + ZQC + head * 64 + lane]);
    LDS_WAIT();
    float s2[2];
#pragma unroll
    for (int u = 0; u < 2; ++u) { const int j = 1 + lane + 64 * u;
        float s = 0.f;
        if (j < 128) { const float* kp = ck + ((size_t)(b * 128 + j) * 4 + kv) * 64;
#pragma unroll
            for (int d4 = 0; d4 < 16; ++d4) { const f32x4 kk = *(const f32x4*)(kp + 4 * d4); const f32x4 qq = *(const LAS f32x4*)(sq + 4 * d4); s += (qq.x * kk.x + qq.y * kk.y) + (qq.z * kk.z + qq.w * kk.w); } }
        else { const bf16* kp = Z + row * NZ + ZKC + kv * 64;
#pragma unroll
            for (int d = 0; d < 64; ++d) s += sq[d] * bf2f(kp[d]); }
        s2[u] = s * 0.125f - slope * (float)(128 - j); }
    float mx = fmaxf(fmaxf(s2[0], s2[1]), sink);
#pragma unroll
    for (int o = 1; o < 64; o <<= 1) mx = fmaxf(mx, __shfl_xor(mx, o));
    const float p0 = __expf(s2[0] - mx), p1 = __expf(s2[1] - mx);
    const float inv = 1.0f / (wave_sum(p0 + p1) + __expf(sink - mx));
    sp[lane] = p0; sp[64 + lane] = p1;
    LDS_WAIT();
    { const int jq = lane >> 4, d4 = 4 * (lane & 15); f32x4 acc = (f32x4){0.f, 0.f, 0.f, 0.f};
      f32x4 vv[32];
#pragma unroll
      for (int i = 0; i < 32; ++i) { const int jj = 4 * i + jq;
          if (jj < 127) vv[i] = *(const f32x4*)(cv + ((size_t)(b * 128 + jj + 1) * 4 + kv) * 64 + d4);
          else { const v2u w = *(const v2u*)(Z + row * NZ + ZVC + kv * 64 + d4); vv[i] = (f32x4){__uint_as_float(w.x << 16), __uint_as_float(w.x & 0xffff0000u), __uint_as_float(w.y << 16), __uint_as_float(w.y & 0xffff0000u)}; } }
#pragma unroll
      for (int i = 0; i < 32; ++i) acc += vv[i] * sp[4 * i + jq];
#pragma unroll
      for (int j = 0; j < 4; ++j) { acc[j] += __shfl_xor(acc[j], 16); acc[j] += __shfl_xor(acc[j], 32); }
      if (jq == 0) { v2u w; w.x = pk2(acc[0] * inv, acc[1] * inv); w.y = pk2(acc[2] * inv, acc[3] * inv); *(v2u*)(OABC + row * 4096 + 3072 + head * 64 + d4) = w; } }
    LDS_WAIT();
}

constexpr int MD_PITCH = 208;
__device__ __forceinline__ void mod_direct(Frame& F, const bf16* CA  , const float* wada  , const float* bada  , float* MOD  ) {
    const Tix T = tix();
    const int lane = T.lane, wave = T.wave, r = lane & 15, g = lane >> 4;
    for (int sl = (int)blockIdx.x; sl < 256; sl += F.G) {
        const int l = sl >> 7, n0 = (sl & 127) * 96;
        const float* W = wada + (size_t)l * D * NADA + n0;
        f32x4 acc[7];
#pragma unroll
        for (int i = 0; i < 7; ++i) acc[i] = (f32x4){0.f, 0.f, 0.f, 0.f};
        f32x4 pw[6];
        const unsigned sk0 = (unsigned)(T.tid / 24), sq0 = (unsigned)(T.tid % 24);
#define MD_LOAD(kb) do { unsigned kk = sk0, q = sq0; _Pragma("unroll") for (int i = 0; i < 6; ++i) { pw[i] = *(const f32x4*)(W + (size_t)((kb) * 128 + kk) * NADA + 4 * q); q += 8; kk += 21; if (q >= 24) { q -= 24; kk += 1; } } } while (0)
        MD_LOAD(0);
        const unsigned lbase = (unsigned)(size_t)F.lds;
        for (int kb = 0; kb < 16; ++kb) {
            __syncthreads();
            { unsigned kk = sk0, q = sq0;
#pragma unroll
              for (int i = 0; i < 6; ++i) { v2u w; w.x = pk2(pw[i].x, pw[i].y); w.y = pk2(pw[i].z, pw[i].w); *(LAS v2u*)(F.lds + kk * MD_PITCH + 8 * q) = w; q += 8; kk += 21; if (q >= 24) { q -= 24; kk += 1; } } }
            __syncthreads();
            if (kb + 1 < 16) MD_LOAD(kb + 1);
            bf16x8 af[4], ag[4];
#pragma unroll
            for (int k4 = 0; k4 < 4; ++k4) { af[k4] = *(const bf16x8*)(CA + (size_t)(16 * wave + r) * D + kb * 128 + 32 * k4 + 8 * g); ag[k4] = *(const bf16x8*)(CA + (size_t)(128 + r) * D + kb * 128 + 32 * k4 + 8 * g); }
#pragma unroll
            for (int ks = 0; ks < 4; ++ks) {
                const bf16x8 a0 = af[ks], a8 = ag[ks];
                const unsigned q4 = (unsigned)(r >> 2), p4 = (unsigned)(r & 3);
                const unsigned a_lo = lbase + (32u * ks + 8u * g + q4) * MD_PITCH + 8u * p4, a_hi = a_lo + 4u * MD_PITCH;
                u16x4 t0, t1, t2, t3, t4, t5, t6, t7, t8, t9, ta, tb;
                asm volatile("ds_read_b64_tr_b16 %0, %12\n\tds_read_b64_tr_b16 %1, %13\n\tds_read_b64_tr_b16 %2, %12 offset:32\n\tds_read_b64_tr_b16 %3, %13 offset:32\n\t"
                             "ds_read_b64_tr_b16 %4, %12 offset:64\n\tds_read_b64_tr_b16 %5, %13 offset:64\n\tds_read_b64_tr_b16 %6, %12 offset:96\n\tds_read_b64_tr_b16 %7, %13 offset:96\n\t"
                             "ds_read_b64_tr_b16 %8, %12 offset:128\n\tds_read_b64_tr_b16 %9, %13 offset:128\n\tds_read_b64_tr_b16 %10, %12 offset:160\n\tds_read_b64_tr_b16 %11, %13 offset:160\n\ts_waitcnt lgkmcnt(0)"
                             : "=&v"(t0), "=&v"(t1), "=&v"(t2), "=&v"(t3), "=&v"(t4), "=&v"(t5), "=&v"(t6), "=&v"(t7), "=&v"(t8), "=&v"(t9), "=&v"(ta), "=&v"(tb) : "v"(a_lo), "v"(a_hi) : "memory");
#define MD_FR(lo, hi) (bf16x8){(short)lo[0], (short)lo[1], (short)lo[2], (short)lo[3], (short)hi[0], (short)hi[1], (short)hi[2], (short)hi[3]}
                const bf16x8 bfr[6] = {MD_FR(t0, t1), MD_FR(t2, t3), MD_FR(t4, t5), MD_FR(t6, t7), MD_FR(t8, t9), MD_FR(ta, tb)};
#undef MD_FR
#pragma unroll
                for (int nt = 0; nt < 6; ++nt) {
                    acc[nt] = __builtin_amdgcn_mfma_f32_16x16x32_bf16(a0, bfr[nt], acc[nt], 0, 0, 0);
                    if (nt == wave) acc[6] = __builtin_amdgcn_mfma_f32_16x16x32_bf16(a8, bfr[nt], acc[6], 0, 0, 0);
                }
            }
        }
#undef MD_LOAD
        float* mo = MOD + (size_t)l * 256 * NADA; const float* bb = bada + (size_t)l * NADA;
#pragma unroll
        for (int nt = 0; nt < 6; ++nt) { const int col = n0 + 16 * nt + r; const float bv = bb[col];
#pragma unroll
            for (int e = 0; e < 4; ++e) mo[(size_t)(16 * wave + 4 * g + e) * NADA + col] = acc[nt][e] + bv; }
        if (wave < 6) { const int col = n0 + 16 * wave + r; const float bv = bb[col];
#pragma unroll
            for (int e = 0; e < 4; ++e) mo[(size_t)(128 + 4 * g + e) * NADA + col] = acc[6][e] + bv; }
        __syncthreads();
    }
}

__device__ __forceinline__ void gla_scan(Frame& F, float* GST, const float* GAMS) {
    const Tix T = tix();
    const int gw = F.vcu * NWAVES + T.wave, NGW = F.G * NWAVES, g = T.lane >> 4;
    for (int item = gw; item < 8 * 4 * 8 * 16; item += NGW) {
        const int i = item & 15, w = (item >> 4) & 7, qs = (item >> 7) & 3, bh = item >> 9;
        f32x4 G[8], Gm[8];
#pragma unroll
        for (int sc = 0; sc < 8; ++sc) { const int grp = bh * 8 + sc;
            G[sc] = *((const f32x4*)(GST + ((((size_t)grp * 4 + qs) * 8 + w) * 16 + i) * 256) + T.lane);
            Gm[sc] = *(const f32x4*)(GAMS + (size_t)grp * 256 + 16 * i + 4 * g); }
        f32x4 S = G[0] * 0.0f;
#pragma unroll
        for (int sc = 0; sc < 8; ++sc) { const int grp = bh * 8 + sc;
            *((f32x4*)(GST + ((((size_t)grp * 4 + qs) * 8 + w) * 16 + i) * 256) + T.lane) = S;
            S = Gm[sc] * S + G[sc]; }
    }
}
constexpr int NPH = 27;
#ifndef EN_CONV
#define EN_CONV 1
#endif
#ifndef EN_MOD
#define EN_MOD 1
#endif
#ifndef EN_NORM
#define EN_NORM 1
#endif
#ifndef EN_WIN
#define EN_WIN 1
#endif
#ifndef EN_GK
#define EN_GK 1
#endif
#ifndef EN_GLAN
#define EN_GLAN 1
#endif
#ifndef EN_MIXA
#define EN_MIXA 1
#endif
#ifndef EN_MIXB
#define EN_MIXB 1
#endif
#ifndef EN_PROJ
#define EN_PROJ 1
#endif
#ifndef EN_WO
#define EN_WO 1
#endif
#ifndef EN_FFI
#define EN_FFI 1
#endif
#ifndef EN_FFO
#define EN_FFO 1
#endif
#ifndef EN_FINAL
#define EN_FINAL 1
#endif
#ifndef MK_PROBE
#define MK_PROBE 0
#endif
#ifndef MK_REP_K
#define MK_REP_K 0
#endif
#ifndef MK_REP_N
#define MK_REP_N 0
#endif
#ifndef MK_REP_VAR
#define MK_REP_VAR 0
#endif
#ifndef MK_ONE_LAUNCH
#define MK_ONE_LAUNCH 1
#endif
typedef const __attribute__((address_space(4))) Prm* KPrm;
__device__ __forceinline__ KPrm kargs() { KPrm p = (KPrm)__builtin_amdgcn_kernarg_segment_ptr(); asm volatile("" : "+s"(p)); return p; }
#define PH_BEGIN KPrm K = kargs(); unsigned char* ws = K->ws; (void)ws;
__global__ void __launch_bounds__(NT, 2) mega_fwd(Prm P_unused) {
    extern __shared__ __attribute__((aligned(16))) unsigned char lds_raw[];
    Frame F;
    F.lds = (LAS unsigned char*)lds_raw;
    F.G = gridDim.x; { const int bx = blockIdx.x; F.vcu = (F.G % 8 == 0) ? (bx % 8) * (F.G / 8) + bx / 8 : bx; }
    volatile LAS unsigned* MISC = (volatile LAS unsigned*)(F.lds + MISC_OFF);
    if (threadIdx.x < 64) MISC[threadIdx.x] = 0u;
    __syncthreads();
    int lo, hi;
    XcdBarrier bar;
    { KPrm K = kargs(); lo = K->ph_lo; hi = K->ph_hi; unsigned* ctl = (unsigned*)(K->ws + WS_CTL);
      bar.bar = ctl + CW_BAR; bar.x = 0; bar.st = nullptr;
      if (hi - lo > 1) bar = xcd_barrier_post(ctl + CW_BAR, MISC + 8); }
#define IN(k) (lo <= (k) && (k) < hi)
#define SEAM(k) do { if (IN(k) && IN((k) + 1)) xcd_barrier(bar); } while (0)
#define WSP(T, off) ((T*)(ws + (off)))

    if (EN_CONV && IN(0)) { phase_convert(F); }
    SEAM(0);
    if (EN_MOD && IN(1)) { PH_BEGIN mod_direct(F, WSP(const bf16, WS_CA), K->in[I_WADA], K->in[I_BADA], WSP(float, WS_MOD)); }
    SEAM(1);
#if 0
    SEAM(0);
    if (EN_MOD && IN(1)) {
        PH_BEGIN
        const int c = (int)blockIdx.x, l = c / 48;
        if (l < 2) {
            pg8::Gemm g{WSP(const bf16, WS_CA), WSP(const bf16, WS_WADA) + (size_t)l * NADA * D, 256, NADA, D, D};
            pg8::StaticOrder S; S.init(256, NADA, 1 << 20, c - 48 * l, D);
            pg8::EpiF32 E{WSP(float, WS_MOD) + (size_t)l * 256 * NADA, NADA, K->in[I_BADA] + (size_t)l * NADA};
            pg8::gemm_phase<pg8::EpiF32, pg8::StaticOrder, true, true>(F.lds, g, S, E);
        }
    }
    SEAM(1);
#endif

    for (int l = 0; l < 2; ++l) {
        const int pb = 2 + 12 * l;
        if (EN_NORM && IN(pb + 0)) { PH_BEGIN phase_norm_t<false>(F, WSP(float, WS_X), K->in[I_N1W] + (size_t)l * D, WSP(const float, WS_MOD) + (size_t)l * 256 * NADA, MOD_SH1, MOD_SC1, WSP(bf16, WS_H), nullptr, WSP(const float, WS_PART + 16 * MiB), l == 0 ? 0 : 11); }
        SEAM(pb + 0);
        if (EN_WIN && IN(pb + 1)) {
            PH_BEGIN
            pg8::Gemm g{WSP(const bf16, WS_H), WSP(const bf16, WS_WIN) + (size_t)l * NZW * D, MT, NZ, D, D};
            pg8::StaticOrder S; S.init(MT, NZ, F.G, (int)blockIdx.x, D);
            pg8::EpiZ E{WSP(bf16, WS_Z), NZ, ZGT / 256, K->var};
            pg8::gemm_phase<pg8::EpiZ, pg8::StaticOrder, true, true>(F.lds, g, S, E);
        }
        SEAM(pb + 1);
        if (IN(pb + 2)) {
            PH_BEGIN
            const bf16* Zb = WSP(const bf16, WS_Z); const bf16* Hb = WSP(const bf16, WS_H); const bf16* Wl = WSP(const bf16, WS_WIN) + (size_t)l * NZW * D + (size_t)ZLR * D;
            const float* wgk2 = K->in[I_WGK2] + (size_t)l * 16 * 1024; const float* bgk = K->in[I_BGK] + (size_t)l * 1024;
            const int ow = (int)blockIdx.x, OW = F.G;
            for (int half = 0; half < 2; ++half) {
                if ((half == 0) == ((ow & 1) == 1)) {
                    if (EN_MIXA && !(K->var & 8)) for (int u = ow; u < 512; u += OW) gla_sample_unit(F, u, Zb, Hb, Wl, wgk2, bgk, K->in[I_SGLA] + (size_t)l * 128 * 4 * 256 * 512, K->out + O_SGS + (size_t)l * 128 * 4 * 256 * 512, K->in[I_GLANW] + (size_t)l * 512, WSP(bf16, WS_OABC));
                } else {
                    if (EN_GLAN && !(K->var & 16)) for (int u = ow; u < 512; u += OW) gla_prep_unit(F, u, Zb, Hb, Wl, wgk2, bgk, WSP(bf16, WS_QT), WSP(bf16, WS_KH), WSP(bf16, WS_AI), WSP(float, WS_GAM));
                    if (EN_MIXA && !(K->var & 32)) {
                        __syncthreads();
                        if (!(K->var & 64)) gm_ln_rows(F, ow, OW, Zb, K->in[I_GMNW] + (size_t)l * 1024, K->in[I_GMNB] + (size_t)l * 1024, WSP(bf16, WS_VNB), K->out + O_GMV + (size_t)l * 128 * 1024, K->in[I_GMWS] + (size_t)l * 4 * 128 * 128, K->in[I_GMBS] + (size_t)l * 4 * 128, WSP(bf16, WS_OABC));
                        if (!(K->var & 128)) for (int u = ow; u < 256; u += OW) swa_unit(F, u, Zb, K->in[I_SINK] + (size_t)l * 16, WSP(bf16, WS_OABC));
                        __syncthreads();
                        if (!(K->var & 256)) for (int it = ow * NWAVES + tix().wave; it < MS * 16; it += OW * NWAVES) swa_sample_wave(F, it, Zb, K->in[I_SINK] + (size_t)l * 16, K->in[I_CK] + (size_t)l * 128 * 128 * 256, K->in[I_CV] + (size_t)l * 128 * 128 * 256, WSP(bf16, WS_OABC));
                        __syncthreads();
                        cache_outs(F, ow, OW, l, Zb, K->out);
                    }
                }
            }
        }
        SEAM(pb + 2);
        if (IN(pb + 3)) {
            PH_BEGIN
            if (EN_GLAN) for (int w = (int)blockIdx.x; w < 256; w += F.G) gla_pass<false>(F, w, WSP(const bf16, WS_Z), WSP(const bf16, WS_QT), WSP(const bf16, WS_KH), WSP(const bf16, WS_AI), WSP(const float, WS_GAM), WSP(float, WS_GST), WSP(float, WS_GAMS), nullptr, nullptr);
            if (EN_MIXB) for (int u = (int)blockIdx.x; u < 256; u += F.G) gm_mix_unit(F, u, WSP(const bf16, WS_Z), WSP(const bf16, WS_VNB), K->in[I_GMWS] + (size_t)l * 4 * 128 * 128, K->in[I_GMBS] + (size_t)l * 4 * 128, WSP(bf16, WS_OABC));
        }
        SEAM(pb + 3);
        if (EN_GLAN && IN(pb + 4)) { PH_BEGIN gla_scan(F, WSP(float, WS_GST), WSP(const float, WS_GAMS)); }
        SEAM(pb + 4);
        if (IN(pb + 5)) {
            PH_BEGIN
            if (EN_GLAN) for (int w = (int)blockIdx.x; w < 256; w += F.G) gla_pass<true>(F, w, WSP(const bf16, WS_Z), WSP(const bf16, WS_QT), WSP(const bf16, WS_KH), WSP(const bf16, WS_AI), WSP(const float, WS_GAM), WSP(float, WS_GST), WSP(float, WS_GAMS), WSP(float, WS_OB), K->out + O_SGP + (size_t)l * 2 * 4 * 256 * 512);
        }
        SEAM(pb + 5);
        if (EN_MIXB && IN(pb + 6)) { PH_BEGIN gla_fin(F, WSP(const float, WS_OB), WSP(const bf16, WS_Z), K->in[I_GLANW] + (size_t)l * 512, WSP(bf16, WS_OABC)); }
        SEAM(pb + 6);
        if (EN_PROJ && IN(pb + 7)) {
            PH_BEGIN
            pg8::Gemm g{WSP(const bf16, WS_OABC), WSP(const bf16, WS_WPRJ) + (size_t)l * D * 4096, MT, D, 4096, 4096};
            pg8::MiniOrder S; S.init(F.G, (int)blockIdx.x, 4096, 8, K->var);
            pg8::EpiProjR E{WSP(const bf16, WS_Z), NZ, ZGT, WSP(float, WS_PART), WSP(bf16, WS_MG), MP, K->var};
            pg8::gemm_phase<pg8::EpiProjR, pg8::MiniOrder, true, true>(F.lds, g, S, E);
        }
        SEAM(pb + 7);
        if (EN_WO && IN(pb + 8)) {
            PH_BEGIN
            pg8::Gemm g{WSP(const bf16, WS_MG), WSP(const bf16, WS_WO) + (size_t)l * D * D, MT, D, D, D};
            pg8::MiniOrder S; S.init(F.G, (int)blockIdx.x, D, 4, K->var);
            {
              const Tix T = tix(); pg8::Unit u;
              for (int i = 0; S.next(i, u); ++i) if (u.pm >= 32) { const int k0 = 64 * u.kt0, kw = 16 * u.nt;
                  for (int idx0 = T.tid; idx0 < 128 * kw; idx0 += 4 * NT) {
                      f32x4 pv[4][8];
#pragma unroll
                      for (int q = 0; q < 4; ++q) { const int idx = idx0 + q * NT, r = idx / kw, c = k0 + 4 * (idx % kw);
#pragma unroll
                          for (int s = 0; s < 8; ++s) pv[q][s] = *(const f32x4*)(WSP(const float, WS_PART) + ((size_t)s * 128 + r) * D + c); }
#pragma unroll
                      for (int q = 0; q < 4; ++q) { const int idx = idx0 + q * NT, r = idx / kw, c = k0 + 4 * (idx % kw);
                          const f32x4 v = ((pv[q][0] + pv[q][1]) + (pv[q][2] + pv[q][3])) + ((pv[q][4] + pv[q][5]) + (pv[q][6] + pv[q][7]));
                          v2u w; w.x = pk2(v.x, v.y); w.y = pk2(v.z, v.w); *(v2u*)(WSP(bf16, WS_MG) + (size_t)(MP + r) * D + c) = w; } }
                  for (int idx = T.tid; idx < 128 * kw; idx += NT) { const int r = 128 + idx / kw, c = k0 + 4 * (idx % kw); *(v2u*)(WSP(bf16, WS_MG) + (size_t)(MP + r) * D + c) = (v2u){0u, 0u}; } }
              VM_WAIT(); __syncthreads(); }
            pg8::EpiResid E{WSP(float, WS_X), WSP(const float, WS_MOD) + (size_t)l * 256 * NADA + MOD_G1, NADA, WSP(float, WS_PART + 8 * MiB), MP, K->var};
            pg8::gemm_phase<pg8::EpiResid, pg8::MiniOrder, true, true>(F.lds, g, S, E);
        }
        SEAM(pb + 8);
        if (EN_NORM && IN(pb + 9)) { PH_BEGIN phase_norm_t<false>(F, WSP(float, WS_X), K->in[I_N2W] + (size_t)l * D, WSP(const float, WS_MOD) + (size_t)l * 256 * NADA, MOD_SH2, MOD_SC2, WSP(bf16, WS_H), nullptr, WSP(const float, WS_PART + 8 * MiB), 8); }
        SEAM(pb + 9);
        if (EN_FFI && IN(pb + 10)) {
            PH_BEGIN
            pg8::Gemm g{WSP(const bf16, WS_H), WSP(const bf16, WS_WFI) + (size_t)l * 2 * FF * D, MT, 2 * FF, D, D};
            pg8::StaticOrder S; S.init(MT, 2 * FF, F.G, (int)blockIdx.x, D);
            pg8::EpiSwiGLU E{WSP(bf16, WS_ACT), FF};
            pg8::gemm_phase<pg8::EpiSwiGLU, pg8::StaticOrder, true, true>(F.lds, g, S, E);
        }
        SEAM(pb + 10);
        if (EN_FFO && IN(pb + 11)) {
            PH_BEGIN
            pg8::Gemm g{WSP(const bf16, WS_ACT), WSP(const bf16, WS_WFO) + (size_t)l * D * FF, MT, D, FF, FF};
            pg8::MiniOrder S; S.init(F.G, (int)blockIdx.x, FF, 8, K->var);
            pg8::EpiResid E{WSP(float, WS_X), WSP(const float, WS_MOD) + (size_t)l * 256 * NADA + MOD_G2, NADA, WSP(float, WS_PART + 16 * MiB), MP, K->var};
            pg8::gemm_phase<pg8::EpiResid, pg8::MiniOrder, true, true>(F.lds, g, S, E);
        }
        SEAM(pb + 11);
    }
    if (EN_FINAL && IN(26)) { PH_BEGIN phase_norm_t<true>(F, WSP(float, WS_X), K->in[I_FNW], nullptr, 0, 0, nullptr, K->out, WSP(const float, WS_PART + 16 * MiB), 11); }
#undef IN
#undef SEAM
}

extern "C" void kernel_launch(void* const* d_in, const int* in_sizes, int n_in, void* d_out, int out_size, void* d_ws, size_t ws_size, hipStream_t stream) {
    static int grid = 0;
    if (grid == 0) {
        if (n_in != N_IN || (size_t)out_size != O_END || ws_size < WS_END) { fprintf(stderr, "kernel_launch: unexpected problem (n_in %d, out %d, ws %zu); nothing launched\n", n_in, out_size, ws_size); grid = -1; return; }
        int dev = 0, cus = 0, per_cu = 0;
        if (hipGetDevice(&dev) != hipSuccess || hipDeviceGetAttribute(&cus, hipDeviceAttributeMultiprocessorCount, dev) != hipSuccess) { grid = -1; return; }
        if (hipFuncSetAttribute((const void*)mega_fwd, hipFuncAttributeMaxDynamicSharedMemorySize, LDS_BYTES) != hipSuccess) { fprintf(stderr, "kernel_launch: hipFuncSetAttribute failed\n"); grid = -1; return; }
        if (hipOccupancyMaxActiveBlocksPerMultiprocessor(&per_cu, (const void*)mega_fwd, NT, LDS_BYTES) != hipSuccess || per_cu < 1) { fprintf(stderr, "kernel_launch: occupancy query says %d\n", per_cu); }
        (void)hipGetLastError();
        grid = cus;
        if (grid < 128) { fprintf(stderr, "kernel_launch: this build needs >= 128 CUs (mini-unit deal)\n"); grid = -1; return; }
    }
    if (grid < 0) return;
    (void)hipMemsetAsync((char*)d_ws + WS_CTL, 0, CTL_ZERO_BYTES, stream);
    Prm p{};
    for (int i = 0; i < N_IN; ++i) p.in[i] = (const float*)d_in[i];
    p.out = (float*)d_out; p.ws = (unsigned char*)d_ws;
#if MK_ONE_LAUNCH
    p.ph_lo = 0; p.ph_hi = NPH;
    hipLaunchKernelGGL(mega_fwd, dim3(grid), dim3(NT), LDS_BYTES, stream, p);
#if MK_PROBE
    for (int i = 0; i < MK_REP_N; ++i) { p.ph_lo = MK_REP_K; p.ph_hi = MK_REP_K + 1; p.var = MK_REP_VAR; hipLaunchKernelGGL(mega_fwd, dim3(grid), dim3(NT), LDS_BYTES, stream, p); }
#endif
#else
    for (int k = 0; k < NPH; ++k) { p.ph_lo = k; p.ph_hi = k + 1; hipLaunchKernelGGL(mega_fwd, dim3(grid), dim3(NT), LDS_BYTES, stream, p); }
#endif
}
```

```cpp
#include <hip/hip_runtime.h>
#include <cstdio>
#include <cstdint>
namespace pg8 {
#define PG8_LAS __attribute__((address_space(3)))
typedef unsigned short bf16_t;
typedef short bf16x8 __attribute__((ext_vector_type(8)));
typedef float f32x4 __attribute__((ext_vector_type(4)));
typedef unsigned u32x4 __attribute__((ext_vector_type(4)));
constexpr int BM = 256, BK = 64, HALF = 128, HTB = HALF * BK * 2  , STAGE_BYTES = 8 * HTB, NXCD = 8, WGM = 8;

__host__ __device__ __forceinline__ int lds_byte(int r, int c) { const int st = (r >> 4) * 2 + (c >> 5), rr = r & 15, cc = c & 31, ob = rr * 64 + cc * 2; return st * 1024 + (ob ^ (((ob >> 9) & 1) << 5)); }
__host__ __device__ __forceinline__ void stage_rc(int b, int& R, int& C) { const int st = b / 1024, sb = b % 1024, swz = sb ^ (((sb >> 9) & 1) << 5); R = (st >> 1) * 16 + swz / 64; C = (st & 1) * 32 + (swz % 64) / 2; }
__host__ __device__ __forceinline__ int perm32(int rho) { const int n = rho >> 4, i = rho & 15; return 8 * (i >> 2) + 4 * n + (i & 3); }

struct Unit { int pm, pn, kt0, nt; };
struct Gemm { const bf16_t* A; const bf16_t* Bt; int M, N, K, ld; };

struct StaticOrder {
    int nM, nN, nwg, G, c, ntf;
    __host__ __device__ __forceinline__ void init(int M, int N, int G_, int c_, int K) { nM = M / BM; nN = N / BM; nwg = nM * nN; G = G_; c = c_; ntf = K / BK; }
    __host__ __device__ __forceinline__ bool next(int i, Unit& u) const {
        const long L = (long)i * G + c; if (L >= nwg) return false;
        int wgid = (int)L; { const int q = nwg / NXCD, r = nwg % NXCD, xcd = wgid % NXCD, off = wgid / NXCD; wgid = (xcd < r ? xcd * (q + 1) : r * (q + 1) + (xcd - r) * q) + off; }
        const int nig = WGM * nN, gid = wgid / nig, fm = gid * WGM, gsz = (nM - fm) < WGM ? (nM - fm) : WGM;
        u.pm = fm + ((wgid % nig) % gsz); u.pn = (wgid % nig) / gsz; u.kt0 = 0; u.nt = ntf; return true;
    }
    __device__ __forceinline__ void a_ready(const Unit&) const {}
    __device__ __forceinline__ void done(const Unit&) const {}
};
struct MiniOrder {
    StaticOrder main; int nmini, ntm;
    __host__ __device__ __forceinline__ void init(int G_, int c_, int K, int ntm_, int var = 0) { main.init(32 * BM, 2048, G_, c_, K); ntm = ntm_; nmini = (var & 4) ? 0 : 8 * ((K / BK) / ntm_); }
    __host__ __device__ __forceinline__ bool next(int i, Unit& u) const {
        const bool has_mini = main.c < nmini;
        if (has_mini && i == 0) { const int m = main.c; u.pm = 32; u.pn = m & 7; u.kt0 = ntm * (m >> 3); u.nt = ntm; return true; }
        return main.next(has_mini ? i - 1 : i, u);
    }
    __device__ __forceinline__ void a_ready(const Unit&) const {}
    __device__ __forceinline__ void done(const Unit&) const {}
};


typedef __bf16 bf16x2_t __attribute__((ext_vector_type(2)));
__device__ __forceinline__ unsigned cvt_pk_bf16(float lo, float hi) { bf16x2_t v; v[0] = (__bf16)lo; v[1] = (__bf16)hi; return __builtin_bit_cast(unsigned, v); }
typedef float f32x2 __attribute__((ext_vector_type(2)));
__device__ __forceinline__ f32x2 gelu_pk(f32x2 v) {
    const f32x2 av = __builtin_elementwise_abs(v), d = av * 0.2316418882f + 1.0f;
    f32x2 t; t.x = __builtin_amdgcn_rcpf(d.x); t.y = __builtin_amdgcn_rcpf(d.y);
    f32x2 q = t * 0.5307027145f + (-0.7265760135f); q = q * t + 0.7107068705f; q = q * t + (-0.142248368f); q = q * t + 0.127414796f; q = q * t;
    const f32x2 s = (v * v) * (-0.72134752044f);
    f32x2 e; e.x = __builtin_amdgcn_exp2f(s.x); e.y = __builtin_amdgcn_exp2f(s.y);
    const f32x2 m = v * (q * e), r = v - m;
    f32x2 o; o.x = v.x < 0.f ? m.x : r.x; o.y = v.y < 0.f ? m.y : r.y; return o;
}

template <int ACT  > struct EpiBf16 {
    static constexpr bool PERM = true, AFTER_DRAIN = false, HAS_HOOK = false; static_assert(ACT == 0 || ACT == 1, "EpiBf16: ACT is 0 (none) or 1 (gelu_pk)");
    bf16_t* O; int ldc; const float* bias; int split_cols; size_t split_stride; float scale0;
    __device__ __forceinline__ void operator()(const f32x4 (&acc)[2][2][4][2], const Unit& u, int wr, int wc, int fr, int fq) const {
        const int row0 = u.pm * BM + wr * 64 + fr; int colt = u.pn * BM; bf16_t* base = O;
        float sc = 1.f; if (split_cols) { const int t = colt / split_cols; base += (size_t)t * split_stride; colt -= t * split_cols; if (t == 0) sc = scale0; }
        const int col0 = colt + wc * 32 + 8 * fq, bcol0 = u.pn * BM + wc * 32 + 8 * fq;
        f32x4 bv[2][2];
#pragma unroll
        for (int bj = 0; bj < 2; ++bj)
#pragma unroll
            for (int n = 0; n < 2; ++n) bv[bj][n] = bias ? *(const f32x4*)(bias + bcol0 + bj * HALF + 4 * n) : (f32x4){0.f, 0.f, 0.f, 0.f};
#pragma unroll
        for (int ai = 0; ai < 2; ++ai)
#pragma unroll
            for (int m = 0; m < 4; ++m) { bf16_t* rowp = base + (size_t)(row0 + ai * HALF + m * 16) * ldc + col0;
#pragma unroll
                for (int bj = 0; bj < 2; ++bj) { f32x4 v0 = acc[ai][bj][m][0] + bv[bj][0], v1 = acc[ai][bj][m][1] + bv[bj][1];
                    if (ACT == 1) { f32x2 a = gelu_pk((f32x2){v0[0], v0[1]}), b = gelu_pk((f32x2){v0[2], v0[3]}), c = gelu_pk((f32x2){v1[0], v1[1]}), d = gelu_pk((f32x2){v1[2], v1[3]});
                        v0 = (f32x4){a.x, a.y, b.x, b.y}; v1 = (f32x4){c.x, c.y, d.x, d.y}; }
                    v0 = v0 * sc; v1 = v1 * sc; u32x4 w; w.x = cvt_pk_bf16(v0[0], v0[1]); w.y = cvt_pk_bf16(v0[2], v0[3]); w.z = cvt_pk_bf16(v1[0], v1[1]); w.w = cvt_pk_bf16(v1[2], v1[3]);
                    *(u32x4*)(rowp + bj * HALF) = w; } }
    }
};
struct EpiF32 {
    static constexpr bool PERM = false, AFTER_DRAIN = false, HAS_HOOK = false;
    float* C; int ldc; const float* bias;
    __device__ __forceinline__ void operator()(const f32x4 (&acc)[2][2][4][2], const Unit& u, int wr, int wc, int fr, int fq) const {
        const int row0 = u.pm * BM + wr * 64 + fr, col0 = u.pn * BM + wc * 32 + 4 * fq;
        f32x4 bv[2][2];
#pragma unroll
        for (int bj = 0; bj < 2; ++bj)
#pragma unroll
            for (int n = 0; n < 2; ++n) bv[bj][n] = bias ? *(const f32x4*)(bias + col0 + bj * HALF + n * 16) : (f32x4){0.f, 0.f, 0.f, 0.f};
#pragma unroll
        for (int ai = 0; ai < 2; ++ai)
#pragma unroll
            for (int m = 0; m < 4; ++m) { float* rowp = C + (size_t)(row0 + ai * HALF + m * 16) * ldc + col0;
#pragma unroll
                for (int bj = 0; bj < 2; ++bj)
#pragma unroll
                    for (int n = 0; n < 2; ++n) *(f32x4*)(rowp + bj * HALF + n * 16) = acc[ai][bj][m][n] + bv[bj][n]; }
    }
};
__device__ __forceinline__ float bf_lo(unsigned w) { return __uint_as_float(w << 16); }
__device__ __forceinline__ float bf_hi(unsigned w) { return __uint_as_float(w & 0xffff0000u); }
__device__ __forceinline__ float fsigmoid(float x) { return __builtin_amdgcn_rcpf(1.0f + __expf(-x)); }
__device__ __forceinline__ float fsilu(float x) { return x * fsigmoid(x); }
__device__ __forceinline__ int batch_of_row(int row) { return row < 4096 ? 0 : (row < 8192 ? 1 : (row - 8192 < 128 ? row - 8190 : 129)); }
typedef unsigned u32x2 __attribute__((ext_vector_type(2)));

struct EpiZ {
    static constexpr bool PERM = true, AFTER_DRAIN = false, HAS_HOOK = false;
    bf16_t* O; int ldc; int gate_pn0; int var;
    __device__ __forceinline__ void operator()(const f32x4 (&acc)[2][2][4][2], const Unit& u, int wr, int wc, int fr, int fq) const {
        if (var & 1) return;
        const int row0 = u.pm * BM + wr * 64 + fr, col0 = u.pn * BM + wc * 32 + 8 * fq; const bool gt = (u.pn >= gate_pn0) && !(var & 2);
#pragma unroll
        for (int ai = 0; ai < 2; ++ai)
#pragma unroll
            for (int m = 0; m < 4; ++m) { bf16_t* rowp = O + (size_t)(row0 + ai * HALF + m * 16) * ldc + col0;
#pragma unroll
                for (int bj = 0; bj < 2; ++bj) { f32x4 v0 = acc[ai][bj][m][0], v1 = acc[ai][bj][m][1];
                    if (gt) {
#pragma unroll
                        for (int j = 0; j < 4; ++j) { v0[j] = 1.0f + __expf(-fminf(fmaxf(v0[j], -40.f), 40.f)); v1[j] = 1.0f + __expf(-fminf(fmaxf(v1[j], -40.f), 40.f)); } }
                    u32x4 w; w.x = cvt_pk_bf16(v0[0], v0[1]); w.y = cvt_pk_bf16(v0[2], v0[3]); w.z = cvt_pk_bf16(v1[0], v1[1]); w.w = cvt_pk_bf16(v1[2], v1[3]);
                    *(u32x4*)(rowp + bj * HALF) = w; } }
    }
};
struct EpiProjR {
    static constexpr bool PERM = false, AFTER_DRAIN = false, HAS_HOOK = true;
    const bf16_t* Z; int ldz; int gcol0; float* PART; bf16_t* MG; int mp0; int var;
    __device__ __forceinline__ bool hook_at(const Unit& u, int t) const { return u.nt == 64 && (t == 32 || t == 48) && !(var & 2); }
    __device__ __forceinline__ void hook(f32x4 (&acc)[2][2][4][2], const Unit& u, int t, int wr, int wc, int fr, int fq) const {
        int row0 = u.pm * BM + wr * 64 + fr, col0 = u.pn * BM + wc * 32 + 4 * fq; asm volatile("" : "+v"(row0), "+v"(col0));
        const int gp = gcol0 + (t == 32 ? 0 : 2048);
#pragma unroll
        for (int ai = 0; ai < 2; ++ai) {
            u32x2 gprev[4][4], gnext[4][4];
#pragma unroll
            for (int m = 0; m < 4; ++m) { const bf16_t* zp = Z + (size_t)(row0 + ai * HALF + m * 16) * ldz + gp + col0;
#pragma unroll
                for (int q = 0; q < 4; ++q) { gprev[m][q] = *(const u32x2*)(zp + (q >> 1) * HALF + (q & 1) * 16); gnext[m][q] = *(const u32x2*)(zp + 2048 + (q >> 1) * HALF + (q & 1) * 16); } }
#pragma unroll
            for (int m = 0; m < 4; ++m)
#pragma unroll
                for (int q = 0; q < 4; ++q) { const u32x2 gpv = gprev[m][q], gnx = gnext[m][q];
                    f32x4 r; r[0] = bf_lo(gnx.x) * __builtin_amdgcn_rcpf(bf_lo(gpv.x)); r[1] = bf_hi(gnx.x) * __builtin_amdgcn_rcpf(bf_hi(gpv.x));
                    r[2] = bf_lo(gnx.y) * __builtin_amdgcn_rcpf(bf_lo(gpv.y)); r[3] = bf_hi(gnx.y) * __builtin_amdgcn_rcpf(bf_hi(gpv.y));
                    acc[ai][q >> 1][m][q & 1] = acc[ai][q >> 1][m][q & 1] * r; }
            asm volatile("" ::: "memory"); }
        asm volatile("s_waitcnt vmcnt(0)" ::: "memory");
    }
    __device__ __forceinline__ void operator()(const f32x4 (&acc)[2][2][4][2], const Unit& u, int wr, int wc, int fr, int fq) const {
        if (var & 1) return;
        int row0 = u.pm * BM + wr * 64 + fr, col0 = u.pn * BM + wc * 32 + 4 * fq; asm volatile("" : "+v"(row0), "+v"(col0));
        const bool mini = u.nt != 64; const int br = mini ? (u.kt0 < 32 ? 0 : (u.kt0 < 48 ? 1 : 2)) : 2;
#pragma unroll
        for (int ai = 0; ai < 2; ++ai) {
            u32x2 gw[4][4];
#pragma unroll
            for (int m = 0; m < 4; ++m) { const bf16_t* zp = Z + (size_t)(row0 + ai * HALF + m * 16) * ldz + gcol0 + br * 2048 + col0;
#pragma unroll
                for (int q = 0; q < 4; ++q) gw[m][q] = *(const u32x2*)(zp + (q >> 1) * HALF + (q & 1) * 16); }
#pragma unroll
            for (int m = 0; m < 4; ++m) { const int row = row0 + ai * HALF + m * 16;
#pragma unroll
                for (int q = 0; q < 4; ++q) { const int col = col0 + (q >> 1) * HALF + (q & 1) * 16; const u32x2 gq = gw[m][q];
                    f32x4 g; g[0] = __builtin_amdgcn_rcpf(bf_lo(gq.x)); g[1] = __builtin_amdgcn_rcpf(bf_hi(gq.x)); g[2] = __builtin_amdgcn_rcpf(bf_lo(gq.y)); g[3] = __builtin_amdgcn_rcpf(bf_hi(gq.y));
                    const f32x4 v = acc[ai][q >> 1][m][q & 1] * g;
                    if (!mini) { u32x2 w; w.x = cvt_pk_bf16(v[0], v[1]); w.y = cvt_pk_bf16(v[2], v[3]); *(u32x2*)(MG + (size_t)row * 2048 + col) = w; }
                    else if (ai == 0) *(f32x4*)(PART + ((size_t)(u.kt0 / u.nt) * 128 + (row - mp0)) * 2048 + col) = v; } }
            asm volatile("" ::: "memory"); }
    }
};
struct EpiResid {
    static constexpr bool PERM = false, AFTER_DRAIN = false, HAS_HOOK = false;
    float* X; const float* gate; int ldg; float* PART; int mp0; int var;
    __device__ __forceinline__ void operator()(const f32x4 (&acc)[2][2][4][2], const Unit& u, int wr, int wc, int fr, int fq) const {
        if (var & 1) return;
        int row0 = u.pm * BM + wr * 64 + fr, col0 = u.pn * BM + wc * 32 + 4 * fq; asm volatile("" : "+v"(row0), "+v"(col0)); const bool mini = u.pm >= 32;
#pragma unroll
        for (int ai = 0; ai < 2; ++ai)
#pragma unroll
            for (int mp = 0; mp < 2; ++mp) {
                f32x4 gg[2][4], xx[2][4];
#pragma unroll
                for (int mm = 0; mm < 2; ++mm) { const int row = row0 + ai * HALF + (2 * mp + mm) * 16; const float* gp = gate + (size_t)batch_of_row(row) * ldg + col0; const float* xp = X + (size_t)row * 2048 + col0;
#pragma unroll
                    for (int q = 0; q < 4; ++q) { gg[mm][q] = *(const f32x4*)(gp + (q >> 1) * HALF + (q & 1) * 16); if (!mini) xx[mm][q] = *(const f32x4*)(xp + (q >> 1) * HALF + (q & 1) * 16); } }
#pragma unroll
                for (int mm = 0; mm < 2; ++mm) { const int m = 2 * mp + mm, row = row0 + ai * HALF + m * 16; float* xp = X + (size_t)row * 2048 + col0;
#pragma unroll
                    for (int q = 0; q < 4; ++q) { float* xq = xp + (q >> 1) * HALF + (q & 1) * 16; const f32x4 v = gg[mm][q] * acc[ai][q >> 1][m][q & 1];
                        if (!mini) *(f32x4*)xq = xx[mm][q] + v;
                        else if (ai == 0) *(f32x4*)(PART + ((size_t)(u.kt0 / u.nt) * 128 + (row - mp0)) * 2048 + col0 + (q >> 1) * HALF + (q & 1) * 16) = v; } }
                asm volatile("" ::: "memory"); }
    }
};
struct EpiSwiGLU {
    static constexpr bool PERM = true, AFTER_DRAIN = false, HAS_HOOK = false;
    bf16_t* ACT; int ldc;
    __device__ __forceinline__ void operator()(const f32x4 (&acc)[2][2][4][2], const Unit& u, int wr, int wc, int fr, int fq) const {
        const int row0 = u.pm * BM + wr * 64 + fr, col0 = u.pn * HALF + wc * 32 + 8 * fq;
#pragma unroll
        for (int ai = 0; ai < 2; ++ai)
#pragma unroll
            for (int m = 0; m < 4; ++m) { bf16_t* rowp = ACT + (size_t)(row0 + ai * HALF + m * 16) * ldc + col0;
                const f32x4 a0 = acc[ai][0][m][0], a1 = acc[ai][0][m][1], b0 = acc[ai][1][m][0], b1 = acc[ai][1][m][1];
                u32x4 w; w.x = cvt_pk_bf16(fsilu(a0[0]) * b0[0], fsilu(a0[1]) * b0[1]); w.y = cvt_pk_bf16(fsilu(a0[2]) * b0[2], fsilu(a0[3]) * b0[3]);
                w.z = cvt_pk_bf16(fsilu(a1[0]) * b1[0], fsilu(a1[1]) * b1[1]); w.w = cvt_pk_bf16(fsilu(a1[2]) * b1[2], fsilu(a1[3]) * b1[3]);
                *(u32x4*)rowp = w; }
    }
};
template <class Epi, class Sched, bool ALIGN_EPI = false, bool SP2 = false>
__device__ __forceinline__ void gemm_phase(PG8_LAS unsigned char* lds, const Gemm g, const Sched& S, const Epi& E) {
    int tid_ = threadIdx.x; asm volatile("" : "+v"(tid_));
    const int tid = tid_, wid = __builtin_amdgcn_readfirstlane(tid >> 6), lane = tid & 63, wr = wid >> 2, wc = wid & 3, fr = lane & 15, fq = lane >> 4;
    const int LD = g.ld;
    unsigned voffA[2], voffB[2];
#pragma unroll
    for (int i = 0; i < 2; ++i) { int R, C; stage_rc(tid * 16 + i * 8192, R, C); const int Rb = Epi::PERM ? ((R & ~31) + perm32(R & 31)) : R;
        voffA[i] = (unsigned)(R * LD + C) * 2u; voffB[i] = (unsigned)(Rb * LD + C) * 2u; }
    const size_t kstep = (size_t)(BK * 2);
    const size_t hstep = (size_t)HALF * LD * 2;
    const size_t tstep = 2 * hstep;
    const unsigned ldsw = (unsigned)wid * 1024u;
    const int aoff = lds_byte(wr * 64 + fr, fq * 8), boff = lds_byte(wc * 32 + fr, fq * 8);
#define PG8_SA(b, h) (((b) * 2 + (h)) * HTB)
#define PG8_SB(b, h) ((4 + (b) * 2 + (h)) * HTB)
#define PG8_STAGE(bufoff, gbase, voff) do { _Pragma("unroll") for (int _i = 0; _i < 2; ++_i) \
        __builtin_amdgcn_global_load_lds((const unsigned*)((const char*)(gbase) + (voff)[_i]), (PG8_LAS unsigned*)(lds + (bufoff) + ldsw + _i * 8192), 16, 0, 0); } while (0)
#define PG8_LDA(dst, b, h) do { _Pragma("unroll") for (int m = 0; m < 4; ++m) _Pragma("unroll") for (int k = 0; k < 2; ++k) dst[m][k] = *(const PG8_LAS bf16x8*)(lds + PG8_SA(b, h) + aoff + m * 2048 + k * 1024); } while (0)
#define PG8_LDB(dst, b, h) do { _Pragma("unroll") for (int n = 0; n < 2; ++n) _Pragma("unroll") for (int k = 0; k < 2; ++k) dst[n][k] = *(const PG8_LAS bf16x8*)(lds + PG8_SB(b, h) + boff + n * 2048 + k * 1024); } while (0)
#define PG8_MMA(ai, bj, At, Bt) do { __builtin_amdgcn_s_setprio(1); _Pragma("unroll") for (int m = 0; m < 4; ++m) _Pragma("unroll") for (int n = 0; n < 2; ++n) _Pragma("unroll") for (int k = 0; k < 2; ++k) \
        acc[ai][bj][m][n] = __builtin_amdgcn_mfma_f32_16x16x32_bf16(Bt[n][k], At[m][k], acc[ai][bj][m][n], 0, 0, 0); __builtin_amdgcn_s_setprio(0); } while (0)
#define PG8_WAIT_V(n) asm volatile("s_waitcnt vmcnt(" #n ")" ::: "memory")
#define PG8_WAIT_L(n) asm volatile("s_waitcnt lgkmcnt(" #n ")" ::: "memory")
#define PG8_BAR __builtin_amdgcn_s_barrier()
#define PG8_SCHED __builtin_amdgcn_sched_barrier(0)
    Unit cur, nxt; int ui = 0;
    if (!S.next(0, cur)) return;
    f32x4 acc[2][2][4][2];
#pragma unroll
    for (int a = 0; a < 2; ++a)
#pragma unroll
        for (int b = 0; b < 2; ++b)
#pragma unroll
            for (int m = 0; m < 4; ++m)
#pragma unroll
                for (int n = 0; n < 2; ++n) acc[a][b][m][n] = (f32x4){0.f, 0.f, 0.f, 0.f};
    bf16x8 At[4][2], B0[2][2], B1[2][2];
    const char* cA = (const char*)g.A + (size_t)cur.pm * tstep + (size_t)cur.kt0 * kstep; const char* cB = (const char*)g.Bt + (size_t)cur.pn * tstep + (size_t)cur.kt0 * kstep;
    S.a_ready(cur);
    if constexpr (SP2) {
        PG8_STAGE(PG8_SB(0, 0), cB, voffB); PG8_STAGE(PG8_SB(0, 1), cB + hstep, voffB); PG8_STAGE(PG8_SA(0, 0), cA, voffA); PG8_STAGE(PG8_SA(0, 1), cA + hstep, voffA);
        if (wr == 1) PG8_BAR;
        PG8_WAIT_V(2); PG8_BAR;
        PG8_STAGE(PG8_SB(1, 0), cB + kstep, voffB); PG8_STAGE(PG8_SA(1, 0), cA + kstep, voffA); PG8_STAGE(PG8_SB(1, 1), cB + hstep + kstep, voffB);
        PG8_WAIT_V(6); PG8_BAR;
    } else {
        PG8_STAGE(PG8_SB(0, 0), cB, voffB); PG8_STAGE(PG8_SA(0, 0), cA, voffA); PG8_STAGE(PG8_SB(0, 1), cB + hstep, voffB); PG8_STAGE(PG8_SA(0, 1), cA + hstep, voffA);
        if (wr == 1) PG8_BAR;
        PG8_WAIT_V(4); PG8_BAR;
        PG8_STAGE(PG8_SB(1, 0), cB + kstep, voffB); PG8_STAGE(PG8_SA(1, 0), cA + kstep, voffA); PG8_STAGE(PG8_SB(1, 1), cB + hstep + kstep, voffB);
        PG8_WAIT_V(6); PG8_BAR;
    }
    for (;;) {
        const bool has_next = S.next(ui + 1, nxt);
        const char* nA = has_next ? (const char*)g.A + (size_t)nxt.pm * tstep + (size_t)nxt.kt0 * kstep : cA; const char* nB = has_next ? (const char*)g.Bt + (size_t)nxt.pn * tstep + (size_t)nxt.kt0 * kstep : cB;
        const int nt = cur.nt;
        for (int t = 0; t < nt; t += 2) {
            const bool last = (t == nt - 2);
            if constexpr (Epi::HAS_HOOK) { if (E.hook_at(cur, t)) E.hook(acc, cur, t, wr, wc, fr, fq); }
            const char* a1 = cA + (size_t)(t + 1) * kstep;
            const char* a2 = last ? nA : cA + (size_t)(t + 2) * kstep; const char* b2 = last ? nB : cB + (size_t)(t + 2) * kstep;
            const char* a3 = a2 + kstep; const char* b3 = b2 + kstep;
            if (last && has_next) S.a_ready(nxt);
            if constexpr (SP2) {
            PG8_LDB(B0, 0, 0); PG8_LDB(B1, 0, 1); PG8_SCHED; PG8_LDA(At, 0, 0); PG8_STAGE(PG8_SA(1, 1), a1 + hstep, voffA);
            PG8_WAIT_V(8); PG8_WAIT_L(0); PG8_BAR; PG8_MMA(0, 0, At, B0); PG8_MMA(0, 1, At, B1); PG8_BAR; PG8_SCHED;
            PG8_LDA(At, 0, 1); PG8_STAGE(PG8_SB(0, 0), b2, voffB); PG8_STAGE(PG8_SB(0, 1), b2 + hstep, voffB); PG8_STAGE(PG8_SA(0, 0), a2, voffA);
            PG8_WAIT_V(8); PG8_WAIT_L(0); PG8_BAR; PG8_MMA(1, 0, At, B0); PG8_MMA(1, 1, At, B1); PG8_BAR; PG8_SCHED;
            PG8_LDB(B0, 1, 0); PG8_LDB(B1, 1, 1); PG8_SCHED; PG8_LDA(At, 1, 0); PG8_STAGE(PG8_SA(0, 1), a2 + hstep, voffA);
            PG8_WAIT_V(8); PG8_WAIT_L(0); PG8_BAR; PG8_MMA(0, 0, At, B0); PG8_MMA(0, 1, At, B1); PG8_BAR; PG8_SCHED;
            PG8_LDA(At, 1, 1); PG8_STAGE(PG8_SB(1, 0), b3, voffB); PG8_STAGE(PG8_SB(1, 1), b3 + hstep, voffB); PG8_STAGE(PG8_SA(1, 0), a3, voffA);
            PG8_WAIT_V(8); PG8_WAIT_L(0); PG8_BAR; PG8_MMA(1, 0, At, B0); PG8_MMA(1, 1, At, B1); PG8_BAR; PG8_SCHED;
            } else {
            PG8_LDB(B0, 0, 0); PG8_SCHED; PG8_LDA(At, 0, 0); PG8_STAGE(PG8_SA(1, 1), a1 + hstep, voffA);
            PG8_WAIT_L(8); PG8_BAR; PG8_WAIT_L(0); PG8_MMA(0, 0, At, B0); PG8_BAR; PG8_SCHED;
            PG8_LDB(B1, 0, 1); PG8_STAGE(PG8_SB(0, 0), b2, voffB);
            PG8_BAR; PG8_WAIT_L(0); PG8_MMA(0, 1, At, B1); PG8_BAR;
            PG8_LDA(At, 0, 1); PG8_STAGE(PG8_SA(0, 0), a2, voffA);
            PG8_BAR; PG8_WAIT_L(0); PG8_MMA(1, 0, At, B0); PG8_BAR; PG8_SCHED;
            PG8_STAGE(PG8_SB(0, 1), b2 + hstep, voffB);
            PG8_WAIT_V(6); PG8_BAR; PG8_MMA(1, 1, At, B1); PG8_BAR;
            PG8_LDB(B0, 1, 0); PG8_SCHED; PG8_LDA(At, 1, 0); PG8_STAGE(PG8_SA(0, 1), a2 + hstep, voffA);
            PG8_WAIT_L(8); PG8_BAR; PG8_WAIT_L(0); PG8_MMA(0, 0, At, B0); PG8_BAR; PG8_SCHED;
            PG8_LDB(B1, 1, 1); PG8_STAGE(PG8_SB(1, 0), b3, voffB);
            PG8_BAR; PG8_WAIT_L(0); PG8_MMA(0, 1, At, B1); PG8_BAR;
            PG8_LDA(At, 1, 1); PG8_STAGE(PG8_SA(1, 0), a3, voffA);
            PG8_BAR; PG8_WAIT_L(0); PG8_MMA(1, 0, At, B0); PG8_BAR; PG8_SCHED;
            PG8_STAGE(PG8_SB(1, 1), b3 + hstep, voffB);
            PG8_WAIT_V(6); PG8_BAR; PG8_MMA(1, 1, At, B1); PG8_BAR;
            }
        }
        if constexpr (ALIGN_EPI) { if (wr == 0) PG8_BAR; }
        if constexpr (!Epi::AFTER_DRAIN) { E(acc, cur, wr, wc, fr, fq); S.done(cur); }
        if (!has_next) break;
#pragma unroll
        for (int a = 0; a < 2; ++a)
#pragma unroll
            for (int b = 0; b < 2; ++b)
#pragma unroll
                for (int m = 0; m < 4; ++m)
#pragma unroll
                    for (int n = 0; n < 2; ++n) acc[a][b][m][n] = (f32x4){0.f, 0.f, 0.f, 0.f};
        cur = nxt; cA = nA; cB = nB; ++ui;
        if constexpr (ALIGN_EPI) { if (wr == 1) PG8_BAR; }
    }
    PG8_WAIT_V(0);
    if constexpr (!ALIGN_EPI) { if (wr == 0) PG8_BAR; }
    PG8_BAR;
    if constexpr (Epi::AFTER_DRAIN) { E.fused(acc, cur, wr, wc, fr, fq, lds, wid, lane); S.done(cur); }
#undef PG8_SA
#undef PG8_SB
#undef PG8_STAGE
#undef PG8_LDA
#undef PG8_LDB
#undef PG8_MMA
#undef PG8_WAIT_V
#undef PG8_WAIT_L
#undef PG8_BAR
#undef PG8_SCHED
}
}
constexpr int NWAVES = 8, NT = NWAVES * 64;
constexpr int D = 2048, MP = 8192, MS = 128, MR = MP + MS, MT = 8448;
constexpr int SEQ = 4096;
constexpr int NZ = 15872;
constexpr int NZW = 16128;
constexpr int ZQA = 0, ZKA = 1024, ZVA = 2048, ZGA = 4096, ZUB = 6144, ZVB = 7168, ZQC = 8192, ZKC = 9216, ZVC = 9472, ZGT = 9728, ZLR = 15872;
constexpr int NIN = 15888, FF = 5632, NADA = 12288;
constexpr int MOD_SH1 = 0, MOD_SC1 = 2048, MOD_G1 = 4096, MOD_SH2 = 6144, MOD_SC2 = 8192, MOD_G2 = 10240;
constexpr float EPS = 1e-6f;
constexpr size_t O_YP = 0, O_YS = 16777216, O_SGP = 17039360, O_SGS = 19136512, O_CKP = 153354240, O_CVP = 153485312, O_CKS = 153616384, O_CVS = 153681920, O_GMV = 153747456, O_END = 154009600;
enum { I_XP = 0, I_XS, I_CP, I_CS, I_SGLA, I_CK, I_CV, I_WADA, I_BADA, I_N1W, I_N2W, I_WIN, I_WGK2, I_BGK, I_GLANW, I_GMNW, I_GMNB, I_GMWS, I_GMBS, I_SINK, I_WPA, I_WPB, I_WPC, I_WO, I_WFI, I_WFO, I_FNW, N_IN };

constexpr size_t MiB = 1u << 20;
constexpr size_t WS_CTL = 0, CTL_ZERO_BYTES = 1 * MiB;
constexpr size_t WS_WADA = 2 * MiB;
constexpr size_t WS_CA   = WS_WADA + 2 * 48 * MiB;
constexpr size_t WS_MOD  = WS_CA + 1 * MiB;
constexpr size_t WS_WIN  = WS_MOD + 24 * MiB;
constexpr size_t WS_WPRJ = WS_WIN + 2 * 63 * MiB;
constexpr size_t WS_WO   = WS_WPRJ + 32 * MiB;
constexpr size_t WS_WFI  = WS_WO + 16 * MiB;
constexpr size_t WS_WFO  = WS_WFI + 88 * MiB;
constexpr size_t WS_X    = WS_WFO + 44 * MiB;
constexpr size_t WS_H    = WS_X + 66 * MiB;
constexpr size_t WS_Z    = WS_H + 33 * MiB;
constexpr size_t WS_OABC = WS_Z + 260 * MiB;
constexpr size_t WS_M32  = WS_OABC + 66 * MiB;
constexpr size_t WS_MG   = WS_M32 + 66 * MiB;
constexpr size_t WS_ACT  = WS_MG + 33 * MiB;
constexpr size_t WS_GK   = WS_ACT + 91 * MiB;
constexpr size_t WS_OB   = WS_GK + 33 * MiB;
constexpr size_t WS_VN   = WS_OB + 65 * MiB;
constexpr size_t WS_QT   = WS_VN + 33 * MiB;
constexpr size_t WS_KH   = WS_QT + 16 * MiB;
constexpr size_t WS_AI   = WS_KH + 16 * MiB;
constexpr size_t WS_GAM  = WS_AI + 4 * MiB;
constexpr size_t WS_GST  = WS_GAM + 1 * MiB;
constexpr size_t WS_GAMS = WS_GST + 32 * MiB;
constexpr size_t WS_VNB  = WS_GAMS + 1 * MiB;
constexpr size_t WS_PART = WS_VNB + 16 * MiB;
constexpr size_t WS_END  = WS_PART + 32 * MiB;
static_assert((size_t)MT * NZ * 2 <= 260 * MiB && (size_t)MT * FF * 2 <= 91 * MiB && (size_t)NZW * D * 2 <= 63 * MiB, "ws map");
constexpr int CW_BAR = 4096;

constexpr int RING_BYTES = 131072;
constexpr int MISC_OFF = 150 * 1024;
constexpr int LDS_BYTES = 152 * 1024;

#define GAS __attribute__((address_space(1)))
#define LAS __attribute__((address_space(3)))
typedef unsigned short bf16;
typedef unsigned v4u __attribute__((ext_vector_type(4)));
typedef unsigned v2u __attribute__((ext_vector_type(2)));
typedef float f32x4 __attribute__((ext_vector_type(4)));
#define LDS_WAIT() asm volatile("s_waitcnt lgkmcnt(0)" ::: "memory")
#define VM_WAIT() asm volatile("s_waitcnt vmcnt(0)" ::: "memory")
typedef __bf16 bf16x2_t __attribute__((ext_vector_type(2)));
__device__ __forceinline__ unsigned pk2(float lo, float hi) { bf16x2_t v; v[0] = (__bf16)lo; v[1] = (__bf16)hi; return __builtin_bit_cast(unsigned, v); }
__device__ __forceinline__ unsigned f2bf(float f) { return pk2(f, 0.f) & 0xffffu; }
__device__ __forceinline__ float bf2f(bf16 b) { return __uint_as_float(((unsigned)b) << 16); }
__device__ __forceinline__ float wave_sum(float v) {
#pragma unroll
    for (int o = 1; o < 64; o <<= 1) v += __shfl_xor(v, o);
    return v;
}
__device__ __forceinline__ float sigmoidf_(float x) { return 1.0f / (1.0f + __expf(-x)); }
__device__ __forceinline__ float siluf_(float x) { return x * sigmoidf_(x); }
__device__ __forceinline__ float geluf_(float x) { return x * sigmoidf_(1.5957691216057308f * (x + 0.044715f * x * x * x)); }
__device__ __forceinline__ float logsigmoidf_(float x) { return fminf(x, 0.f) - log1pf(expf(-fabsf(x))); }
#define XB_TMO      128
#define XB_XCNT(j)  (256  + 64 * (j))
#define XB_XSUB(j)  (1280 + 64 * (j))
#define XB_XGEN(j)  (2304 + 64 * (j))
#define XB_TOP      3328
#define XB_TOPGEN   3392
#define XCD_BAR_WORDS 3456
#define XB_SPIN_CAP (1u << 18)

__device__ __forceinline__ unsigned xb_ld(unsigned* p)              { return __hip_atomic_load(p, __ATOMIC_RELAXED, __HIP_MEMORY_SCOPE_AGENT); }
__device__ __forceinline__ unsigned xb_add(unsigned* p, unsigned v) { return __hip_atomic_fetch_add(p, v, __ATOMIC_RELAXED, __HIP_MEMORY_SCOPE_AGENT); }
__device__ __forceinline__ unsigned xb_xcc_id() { return (unsigned)__builtin_amdgcn_s_getreg((3 << 11) | 20) & 0xFu; }
#define XB_SPIN(cond, bar) do { unsigned _sp = 0; while (cond) { __builtin_amdgcn_s_sleep(1); \
    if ((++_sp & 255u) == 0u) { if (xb_ld(&(bar)[XB_TMO])) break; if (_sp > XB_SPIN_CAP) { atomicAdd(&(bar)[XB_TMO], 1u); break; } } } } while (0)

struct XcdBarrier {
    unsigned* bar; unsigned x;
    volatile LAS unsigned* st;
};

__device__ __forceinline__ XcdBarrier xcd_barrier_post(unsigned* bar, volatile LAS unsigned* st) {
    XcdBarrier b; b.bar = bar; b.x = xb_xcc_id(); b.st = st;
    if (threadIdx.x == 0) (void)xb_add(&bar[XB_XCNT(b.x)], 1u);
    return b;
}
__device__ __forceinline__ void xcd_barrier_complete(unsigned* bar, unsigned x, unsigned& nloc, unsigned& nx) {
    const unsigned G = gridDim.x * gridDim.y * gridDim.z;
    unsigned sum, cnt, mine, sp = 0u;
    for (;;) {
        sum = 0u; cnt = 0u; mine = 0u;
#pragma unroll
        for (unsigned j = 0; j < 16; ++j) { const unsigned c = xb_ld(&bar[XB_XCNT(j)]); sum += c; cnt += (c > 0u) ? 1u : 0u; mine = (j == x) ? c : mine; }
        if (sum == G) break;
        __builtin_amdgcn_s_sleep(1);
        if ((++sp & 255u) == 0u) { if (xb_ld(&bar[XB_TMO])) break; if (sp > XB_SPIN_CAP) { atomicAdd(&bar[XB_TMO], 1u); break; } }
    }
    nloc = mine > 0u ? mine : 1u; nx = cnt > 0u ? cnt : 1u;
}

__device__ __forceinline__ void xcd_barrier(const XcdBarrier& b) {
    asm volatile("s_waitcnt vmcnt(0)" ::: "memory");
    __syncthreads();
    if (threadIdx.x == 0) {
        unsigned* bar = b.bar;
        __builtin_amdgcn_s_waitcnt(0);
        unsigned nloc = b.st[0], nx = b.st[1];
        if (nloc == 0u) { xcd_barrier_complete(bar, b.x, nloc, nx); b.st[0] = nloc; b.st[1] = nx; }
        const unsigned old = xb_add(&bar[XB_XSUB(b.x)], 1u);
        const unsigned gen = old / nloc;
        if (old + 1u == (gen + 1u) * nloc) {
            __builtin_amdgcn_fence(__ATOMIC_RELEASE, "agent");
            asm volatile("s_waitcnt vmcnt(0)" ::: "memory");
            const unsigned og = xb_add(&bar[XB_TOP], 1u);
            const unsigned tg = og / nx;
            if (og + 1u == (tg + 1u) * nx) xb_add(&bar[XB_TOPGEN], 1u);
            else XB_SPIN(xb_ld(&bar[XB_TOPGEN]) == tg, bar);
            __builtin_amdgcn_fence(__ATOMIC_ACQUIRE, "agent");
            xb_add(&bar[XB_XGEN(b.x)], 1u);
            asm volatile("s_waitcnt vmcnt(0)" ::: "memory");
        } else {
            XB_SPIN(xb_ld(&bar[XB_XGEN(b.x)]) == gen, bar);
            __builtin_amdgcn_fence(__ATOMIC_ACQUIRE, "agent");
            asm volatile("s_waitcnt vmcnt(0)" ::: "memory");
        }
    }
    __syncthreads();
}
struct Prm { const float* in[N_IN]; float* out; unsigned char* ws; int ph_lo, ph_hi, var, pad; };
static_assert(sizeof(Prm) == N_IN * 8 + 32, "Prm has no padding bytes");
struct Frame {
    LAS unsigned char* lds;
    int vcu, G;
};
struct Tix { int tid, lane, wave; };
__device__ __forceinline__ Tix tix() { int t = threadIdx.x; asm volatile("" : "+v"(t)); Tix r; r.tid = t; r.lane = t & 63; r.wave = __builtin_amdgcn_readfirstlane(t >> 6); return r; }

__device__ __forceinline__ int map_col(int mode, int n) {
    if (mode == 1) return n < 6144 ? n : (n < 6160 ? ZLR + (n - 6144) : n - 16);
    if (mode == 2) return n < FF ? ((n >> 7) * 256 + (n & 127)) : ((((n - FF) >> 7) * 256) + 128 + ((n - FF) & 127));
    return n;
}
__device__ __forceinline__ void conv_item(const float* W, int K, int N, bf16* WT, int ld, int koff, int mode, LAS float* scr, int item, int lane) {
    const int nkb = K / 64, nb = item / nkb, kb = item % nkb, k0 = 64 * kb, n0 = 64 * nb;
    const int q = lane & 15, kr = lane >> 4; const bool okc = (n0 + 4 * q) < N;
    f32x4 v[16];
#pragma unroll
    for (int i = 0; i < 16; ++i) v[i] = okc ? *(const f32x4*)(W + (size_t)(k0 + 4 * i + kr) * N + n0 + 4 * q) : (f32x4){0.f, 0.f, 0.f, 0.f};
#pragma unroll
    for (int i = 0; i < 16; ++i) { LAS float* s = scr + (4 * i + kr) * 65 + 4 * q; s[0] = v[i].x; s[1] = v[i].y; s[2] = v[i].z; s[3] = v[i].w; }
    LDS_WAIT(); asm volatile("" ::: "memory");
    const int c = lane & 7;
#pragma unroll
    for (int j = 0; j < 8; ++j) { const int n = (lane >> 3) + 8 * j; const LAS float* s = scr + (8 * c) * 65 + n;
        v4u o; o.x = pk2(s[0 * 65], s[1 * 65]); o.y = pk2(s[2 * 65], s[3 * 65]); o.z = pk2(s[4 * 65], s[5 * 65]); o.w = pk2(s[6 * 65], s[7 * 65]);
        if (n0 + n < N) *(GAS v4u*)(WT + (size_t)map_col(mode, n0 + n) * ld + koff + k0 + 8 * c) = o; }
    LDS_WAIT(); asm volatile("" ::: "memory");
}
struct ConvDesc { const float* W; bf16* WT; int K, N, ld, koff, mode, items; };

__device__ __forceinline__ void phase_convert(Frame& F) {
    const Tix T = tix();
    const __attribute__((address_space(4))) Prm* Pk = (const __attribute__((address_space(4))) Prm*)__builtin_amdgcn_kernarg_segment_ptr(); asm volatile("" : "+s"(Pk));
    LAS float* scr = (LAS float*)(F.lds + T.wave * 16640);
    const int gw = F.vcu * NWAVES + T.wave, NGW = F.G * NWAVES;
    unsigned char* ws = Pk->ws;
    for (int l = 0; l < 2; ++l) {
        for (int mi = 1; mi < 8; ++mi) {
            ConvDesc d;
            if (mi == 0)      { d.W = Pk->in[I_WADA] + (size_t)l * D * NADA; d.WT = (bf16*)(ws + WS_WADA) + (size_t)l * NADA * D; d.K = D; d.N = NADA; d.ld = D; d.koff = 0; d.mode = 0; }
            else if (mi == 1) { d.W = Pk->in[I_WIN] + (size_t)l * D * NIN;   d.WT = (bf16*)(ws + WS_WIN) + (size_t)l * NZW * D;    d.K = D; d.N = NIN;  d.ld = D; d.koff = 0; d.mode = 1; }
            else if (mi == 2) { d.W = Pk->in[I_WPA] + (size_t)l * 2048 * D;  d.WT = (bf16*)(ws + WS_WPRJ) + (size_t)l * D * 4096; d.K = 2048; d.N = D; d.ld = 4096; d.koff = 0; d.mode = 0; }
            else if (mi == 3) { d.W = Pk->in[I_WPB] + (size_t)l * 1024 * D;  d.WT = (bf16*)(ws + WS_WPRJ) + (size_t)l * D * 4096; d.K = 1024; d.N = D; d.ld = 4096; d.koff = 2048; d.mode = 0; }
            else if (mi == 4) { d.W = Pk->in[I_WPC] + (size_t)l * 1024 * D;  d.WT = (bf16*)(ws + WS_WPRJ) + (size_t)l * D * 4096; d.K = 1024; d.N = D; d.ld = 4096; d.koff = 3072; d.mode = 0; }
            else if (mi == 5) { d.W = Pk->in[I_WO] + (size_t)l * D * D;      d.WT = (bf16*)(ws + WS_WO) + (size_t)l * D * D;      d.K = D; d.N = D; d.ld = D; d.koff = 0; d.mode = 0; }
            else if (mi == 6) { d.W = Pk->in[I_WFI] + (size_t)l * D * 2 * FF; d.WT = (bf16*)(ws + WS_WFI) + (size_t)l * 2 * FF * D; d.K = D; d.N = 2 * FF; d.ld = D; d.koff = 0; d.mode = 2; }
            else              { d.W = Pk->in[I_WFO] + (size_t)l * FF * D;    d.WT = (bf16*)(ws + WS_WFO) + (size_t)l * D * FF;    d.K = FF; d.N = D; d.ld = FF; d.koff = 0; d.mode = 0; }
            d.items = (d.K / 64) * ((d.N + 63) / 64);
            for (int it = gw; it < d.items; it += NGW) conv_item(d.W, d.K, d.N, d.WT, d.ld, d.koff, d.mode, scr, it, T.lane);
        }
    }
    { bf16* CA = (bf16*)(ws + WS_CA);
      for (int i = blockIdx.x * NT + T.tid; i < 256 * D; i += F.G * NT) { const int r = i >> 11, c = i & 2047; float v = 0.f;
          if (r < 2) v = Pk->in[I_CP][r * D + c]; else if (r < 130) v = Pk->in[I_CS][(r - 2) * D + c];
          CA[i] = (bf16)f2bf(r < 130 ? siluf_(v) : 0.f); } }
    { f32x4* X4 = (f32x4*)(ws + WS_X); const f32x4* xp = (const f32x4*)Pk->in[I_XP]; const f32x4* xs = (const f32x4*)Pk->in[I_XS];
      for (int i = blockIdx.x * NT + T.tid; i < MT * D / 4; i += F.G * NT) { const int r = i >> 9;
          X4[i] = r < MP ? xp[i] : (r < MR ? xs[i - MP * D / 4] : (f32x4){0.f, 0.f, 0.f, 0.f}); } }
}

template <bool FINAL>
__device__ __forceinline__ void phase_norm_t(Frame& F, float* X, const float* nw, const float* mod, int sh_off, int sc_off, bf16* H, float* out, const float* part, int nsl) {
    const Tix T = tix();
    const int gw = F.vcu * NWAVES + T.wave, NGW = F.G * NWAVES;
    const int nit = FINAL ? MP : MP + (MT - MR);
    f32x4 vn[8];
    if (gw < nit) { const int row = gw < MP ? gw : gw + MS; const f32x4* xr = (const f32x4*)(X + (size_t)row * D) + T.lane;
#pragma unroll
        for (int j = 0; j < 8; ++j) vn[j] = xr[64 * j]; }
    for (int it = gw; it < nit; it += NGW) {
        const int row = it < MP ? it : it + MS;
        f32x4 v[8]; float s = 0.f;
#pragma unroll
        for (int j = 0; j < 8; ++j) v[j] = vn[j];
        if (it + NGW < nit) { const int it2 = it + NGW, row2 = it2 < MP ? it2 : it2 + MS; const f32x4* xr = (const f32x4*)(X + (size_t)row2 * D) + T.lane;
#pragma unroll
            for (int j = 0; j < 8; ++j) vn[j] = xr[64 * j]; }
#pragma unroll
        for (int j = 0; j < 8; ++j) s += (v[j].x * v[j].x + v[j].y * v[j].y) + (v[j].z * v[j].z + v[j].w * v[j].w);
        const float rstd = 1.0f / sqrtf(wave_sum(s) * (1.0f / D) + EPS);
        if (FINAL) { f32x4* o = (f32x4*)(out + (size_t)row * D) + T.lane;
#pragma unroll
            for (int j = 0; j < 8; ++j) { const f32x4 w = *(const f32x4*)(nw + 4 * (T.lane + 64 * j)); o[64 * j] = (v[j] * rstd) * w; } }
        else { const float* md = mod + (size_t)pg8::batch_of_row(row) * NADA; v2u* o = (v2u*)(H + (size_t)row * D) + T.lane;
#pragma unroll
            for (int j = 0; j < 8; ++j) { const int c = 4 * (T.lane + 64 * j);
                const f32x4 w = *(const f32x4*)(nw + c), sc = *(const f32x4*)(md + sc_off + c), sh = *(const f32x4*)(md + sh_off + c);
                const f32x4 y = (v[j] * rstd) * w * (sc + 1.0f) + sh;
                v2u q; q.x = pk2(y.x, y.y); q.y = pk2(y.z, y.w); o[64 * j] = q; } }
    }
    LAS float* red = (LAS float*)F.lds;
    for (int sr = (int)blockIdx.x; sr < MS; sr += F.G) {
        const int row = MP + sr, c = 4 * T.tid;
        f32x4 x = *(const f32x4*)(X + (size_t)row * D + c);
        { f32x4 pp[11];
#pragma unroll
          for (int s = 0; s < 11; ++s) pp[s] = s < nsl ? *(const f32x4*)(part + ((size_t)s * 128 + sr) * D + c) : (f32x4){0.f, 0.f, 0.f, 0.f};
#pragma unroll
          for (int s = 0; s < 11; ++s) x += pp[s]; }
        if (nsl > 0) *(f32x4*)(X + (size_t)row * D + c) = x;
        const float ss = wave_sum((x.x * x.x + x.y * x.y) + (x.z * x.z + x.w * x.w));
        __syncthreads();
        if (T.lane == 0) red[T.wave] = ss;
        __syncthreads();
        const float tot = ((red[0] + red[1]) + (red[2] + red[3])) + ((red[4] + red[5]) + (red[6] + red[7]));
        const float rstd = 1.0f / sqrtf(tot * (1.0f / D) + EPS);
        const f32x4 w = *(const f32x4*)(nw + c);
        if (FINAL) *(f32x4*)(out + (size_t)row * D + c) = (x * rstd) * w;
        else { const float* md = mod + (size_t)pg8::batch_of_row(row) * NADA; const f32x4 sc = *(const f32x4*)(md + sc_off + c), sh = *(const f32x4*)(md + sh_off + c);
            const f32x4 y = (x * rstd) * w * (sc + 1.0f) + sh; v2u q; q.x = pk2(y.x, y.y); q.y = pk2(y.z, y.w); *(v2u*)(H + (size_t)row * D + c) = q; }
    }
    __syncthreads();
}

__device__ __forceinline__ void gla_sample_unit(Frame& F, int unit, const bf16* Z, const bf16* H, const bf16* WlraT, const float* wgk2, const float* bgk, const float* Sin  , float* Sout, const float* gnw, bf16* OABC) {
    const Tix T = tix();
    const int b = unit >> 2, h = unit & 3; const size_t row = MP + b;
    LAS float* sq = (LAS float*)F.lds; LAS float* sk = sq + 256; LAS float* se = sk + 256; LAS float* red = se + 256;
    LAS float* lrs = red + 2048;
    __syncthreads();
    { const int rr = T.tid & 15, ksg = T.tid >> 4; float a = 0.f;
      const bf16* hp = H + row * D + 64 * ksg; const bf16* wp = WlraT + (size_t)rr * D + 64 * ksg;
#pragma unroll
      for (int i = 0; i < 8; ++i) { const v4u hv = *(const v4u*)(hp + 8 * i), wv = *(const v4u*)(wp + 8 * i);
          a += (__uint_as_float(hv.x << 16) * __uint_as_float(wv.x << 16) + __uint_as_float(hv.x & 0xffff0000u) * __uint_as_float(wv.x & 0xffff0000u)) + (__uint_as_float(hv.y << 16) * __uint_as_float(wv.y << 16) + __uint_as_float(hv.y & 0xffff0000u) * __uint_as_float(wv.y & 0xffff0000u))
             + (__uint_as_float(hv.z << 16) * __uint_as_float(wv.z << 16) + __uint_as_float(hv.z & 0xffff0000u) * __uint_as_float(wv.z & 0xffff0000u)) + (__uint_as_float(hv.w << 16) * __uint_as_float(wv.w << 16) + __uint_as_float(hv.w & 0xffff0000u) * __uint_as_float(wv.w & 0xffff0000u)); }
      lrs[ksg * 16 + rr] = a; }
    __syncthreads();
    if (T.tid < 16) { float a = 0.f;
#pragma unroll
        for (int s = 0; s < 32; ++s) a += lrs[s * 16 + T.tid];
        lrs[512 + T.tid] = a; }
    __syncthreads();
    if (T.tid < 256) { const int d = T.tid; sq[d] = bf2f(Z[row * NZ + ZQA + h * 256 + d]) * 0.0625f; sk[d] = bf2f(Z[row * NZ + ZKA + h * 256 + d]);
        float x = bgk[h * 256 + d];
#pragma unroll
        for (int rr = 0; rr < 16; ++rr) x += lrs[512 + rr] * wgk2[rr * 1024 + h * 256 + d];
        se[d] = __expf((fminf(x, 0.f) - __logf(1.0f + __expf(-fabsf(x)))) * (1.0f / 16.0f)); }
    __syncthreads();
    const int c4 = T.tid & 127, rg = T.tid >> 7;
    f32x4 v; { const bf16* vp = Z + row * NZ + ZVA + h * 512 + 4 * c4; v.x = bf2f(vp[0]); v.y = bf2f(vp[1]); v.z = bf2f(vp[2]); v.w = bf2f(vp[3]); }
    const size_t base = ((size_t)b * 4 + h) * 256 * 512;
    f32x4 o = (f32x4){0.f, 0.f, 0.f, 0.f};
    for (int it0 = 0; it0 < 64; it0 += 16) {
        f32x4 sv[16];
#pragma unroll
        for (int u = 0; u < 16; ++u) sv[u] = __builtin_nontemporal_load((const f32x4*)(Sin + base + (size_t)(rg + 4 * (it0 + u)) * 512 + 4 * c4));
#pragma unroll
        for (int u = 0; u < 16; ++u) { const int dk = rg + 4 * (it0 + u);
            const f32x4 sn = sv[u] * se[dk] + v * sk[dk];
            __builtin_nontemporal_store(sn, (f32x4*)(Sout + base + (size_t)dk * 512 + 4 * c4));
            o += sn * sq[dk]; } }
    *(LAS f32x4*)(red + rg * 512 + 4 * c4) = o;
    __syncthreads();
    { const int c = T.tid; const float t = (red[c] + red[512 + c]) + (red[1024 + c] + red[1536 + c]);
      const float ss = wave_sum(t * t);
      if (T.lane == 0) lrs[600 + T.wave] = ss;
      __syncthreads();
      const float tot = ((lrs[600] + lrs[601]) + (lrs[602] + lrs[603])) + ((lrs[604] + lrs[605]) + (lrs[606] + lrs[607]));
      const float rstd = 1.0f / sqrtf(tot * (1.0f / 512.0f) + EPS);
      OABC[row * 4096 + h * 512 + c] = (bf16)f2bf(t * rstd * gnw[c] * siluf_(bf2f(Z[row * NZ + ZGA + h * 512 + c]))); }
}

__device__ __forceinline__ void gm_ln_row(const Tix& T, int row, const v2u (&vw)[4], const bf16* Z, const float* nw, const float* nb, bf16* VNB, float* gmv_out  , const float* ws_, const float* bs, bf16* OABC) {
    float x[16]; float s = 0.f;
#pragma unroll
    for (int j = 0; j < 4; ++j) { const v2u w = vw[j];
        x[4 * j + 0] = geluf_(__uint_as_float(w.x << 16)); x[4 * j + 1] = geluf_(__uint_as_float(w.x & 0xffff0000u)); x[4 * j + 2] = geluf_(__uint_as_float(w.y << 16)); x[4 * j + 3] = geluf_(__uint_as_float(w.y & 0xffff0000u));
        s += (x[4 * j] + x[4 * j + 1]) + (x[4 * j + 2] + x[4 * j + 3]); }
    const float mu = wave_sum(s) * (1.0f / 1024.0f); float q = 0.f;
#pragma unroll
    for (int i = 0; i < 16; ++i) { x[i] -= mu; q += x[i] * x[i]; }
    const float rstd = 1.0f / sqrtf(wave_sum(q) * (1.0f / 1024.0f) + EPS);
#pragma unroll
    for (int j = 0; j < 4; ++j) { const int c = 4 * (T.lane + 64 * j); const f32x4 w = *(const f32x4*)(nw + c), bb = *(const f32x4*)(nb + c);
        f32x4 y; y.x = x[4 * j] * rstd * w.x + bb.x; y.y = x[4 * j + 1] * rstd * w.y + bb.y; y.z = x[4 * j + 2] * rstd * w.z + bb.z; y.w = x[4 * j + 3] * rstd * w.w + bb.w;
        if (row < MP) { v2u o; o.x = pk2(y.x, y.y); o.y = pk2(y.z, y.w); *(v2u*)(VNB + (size_t)row * 1024 + c) = o; }
        else { *(f32x4*)(gmv_out + (size_t)(row - MP) * 1024 + c) = y;
            const int g = c >> 8; const float w00 = ws_[(size_t)g * 128 * 128], b0 = bs[g * 128];
            const v2u uq = *(const v2u*)(Z + (size_t)row * NZ + ZUB + c);
            v2u o; o.x = pk2(geluf_(__uint_as_float(uq.x << 16)) * (w00 * y.x + b0), geluf_(__uint_as_float(uq.x & 0xffff0000u)) * (w00 * y.y + b0));
            o.y = pk2(geluf_(__uint_as_float(uq.y << 16)) * (w00 * y.z + b0), geluf_(__uint_as_float(uq.y & 0xffff0000u)) * (w00 * y.w + b0));
            *(v2u*)(OABC + (size_t)row * 4096 + 2048 + c) = o; } }
}
__device__ __forceinline__ void gm_ln_rows(Frame& F, int ow, int OW, const bf16* Z, const float* nw, const float* nb, bf16* VNB, float* gmv_out, const float* ws_, const float* bs, bf16* OABC) {
    const Tix T = tix();
    const int w0 = ow * NWAVES + T.wave, stride = OW * NWAVES;
    v2u nx[4];
    if (w0 < MR) {
#pragma unroll
        for (int j = 0; j < 4; ++j) nx[j] = *(const v2u*)(Z + (size_t)w0 * NZ + ZVB + 4 * (T.lane + 64 * j)); }
    for (int row = w0; row < MR; row += stride) {
        v2u cur[4];
#pragma unroll
        for (int j = 0; j < 4; ++j) cur[j] = nx[j];
        if (row + stride < MR) {
#pragma unroll
            for (int j = 0; j < 4; ++j) nx[j] = *(const v2u*)(Z + (size_t)(row + stride) * NZ + ZVB + 4 * (T.lane + 64 * j)); }
        gm_ln_row(T, row, cur, Z, nw, nb, VNB, gmv_out, ws_, bs, OABC);
    }
}

__device__ __forceinline__ void cache_outs(Frame& F, int wg, int nwg, int l, const bf16* Z, float* out) {
    const Tix T = tix();
    for (int idx = wg * NT + T.tid; idx < 2 * 128 * 512; idx += nwg * NT) {
        const int c = idx & 511, r = (idx >> 9) & 127, b = idx >> 16; const size_t row = (size_t)b * SEQ + (SEQ - 128) + r;
        const float v = bf2f(Z[row * NZ + ZKC + c]);
        if (c < 256) out[O_CKP + ((size_t)(l * 2 + b) * 128 + r) * 256 + c] = v; else out[O_CVP + ((size_t)(l * 2 + b) * 128 + r) * 256 + (c - 256)] = v;
    }
    for (int idx = wg * NT + T.tid; idx < 128 * 512; idx += nwg * NT) {
        const int c = idx & 511, b = idx >> 9; const float v = bf2f(Z[(size_t)(MP + b) * NZ + ZKC + c]);
        if (c < 256) out[O_CKS + (size_t)(l * 128 + b) * 256 + c] = v; else out[O_CVS + (size_t)(l * 128 + b) * 256 + (c - 256)] = v;
    }
}

__device__ __forceinline__ void gla_fin(Frame& F, const float* OBf, const bf16* Z, const float* gnw, bf16* OABC) {
    const Tix T = tix();
    const bf16* OB = (const bf16*)OBf;
    const int gw = F.vcu * NWAVES + T.wave, NGW = F.G * NWAVES;
    v2u on[8], gn[8];
#define FIN_LOAD(rw) do { const bf16* op_ = OB + (size_t)(rw) * 2048 + 4 * T.lane; const bf16* gp_ = Z + (size_t)(rw) * NZ + ZGA + 4 * T.lane; \
        _Pragma("unroll") for (int j = 0; j < 8; ++j) { on[j] = *(const v2u*)(op_ + 256 * j); gn[j] = *(const v2u*)(gp_ + 256 * j); } } while (0)
    if (gw < MP) FIN_LOAD(gw);
    for (int row = gw; row < MP; row += NGW) {
        f32x4 o[8]; v2u gq[8];
#pragma unroll
        for (int j = 0; j < 8; ++j) { o[j] = (f32x4){__uint_as_float(on[j].x << 16), __uint_as_float(on[j].x & 0xffff0000u), __uint_as_float(on[j].y << 16), __uint_as_float(on[j].y & 0xffff0000u)}; gq[j] = gn[j]; }
        if (row + NGW < MP) FIN_LOAD(row + NGW);
#pragma unroll
        for (int h = 0; h < 4; ++h) { const f32x4 a = o[2 * h], b = o[2 * h + 1];
            const float s = (a.x * a.x + a.y * a.y) + (a.z * a.z + a.w * a.w) + (b.x * b.x + b.y * b.y) + (b.z * b.z + b.w * b.w);
            const float rstd = 1.0f / sqrtf(wave_sum(s) * (1.0f / 512.0f) + EPS);
#pragma unroll
            for (int jj = 0; jj < 2; ++jj) { const int j = 2 * h + jj, c = 4 * T.lane + 256 * jj; const f32x4 ov = o[j]; const f32x4 w = *(const f32x4*)(gnw + c);
                const float g0 = siluf_(__uint_as_float(gq[j].x << 16)), g1 = siluf_(__uint_as_float(gq[j].x & 0xffff0000u)), g2 = siluf_(__uint_as_float(gq[j].y << 16)), g3 = siluf_(__uint_as_float(gq[j].y & 0xffff0000u));
                v2u r; r.x = pk2(ov.x * rstd * w.x * g0, ov.y * rstd * w.y * g1); r.y = pk2(ov.z * rstd * w.z * g2, ov.w * rstd * w.w * g3);
                *(v2u*)(OABC + (size_t)row * 4096 + h * 512 + c) = r; } }
    }
#undef FIN_LOAD
}
typedef short bf16x8 __attribute__((ext_vector_type(8)));
typedef unsigned short u16x4 __attribute__((ext_vector_type(4)));
__device__ __forceinline__ unsigned offb(unsigned row, unsigned ch) { return 256u * row + 16u * (ch ^ (((row & 3u) << 2) | ((row >> 2) & 3u))); }
__device__ __forceinline__ unsigned tr_addr16(unsigned lane, unsigned c, unsigned ks, unsigned t) {
    const unsigned g = lane >> 4, q = (lane & 15u) >> 2, p = lane & 3u; return offb(32u * ks + 8u * g + 4u * t + q, 2u * c + (p >> 1)) + 8u * (p & 1u); }
struct TrLane { unsigned L0, L1, X0, X1; };
__device__ __forceinline__ TrLane tr_lane(unsigned lane) {
    const unsigned g = lane >> 4, q = (lane & 15u) >> 2, p = lane & 3u; TrLane t;
    const unsigned m0 = (q << 2) | ((2u * g) & 3u), m1 = (q << 2) | ((2u * g + 1u) & 3u);
    t.L0 = 2048u * g + 256u * q + 8u * (p & 1u) + 16u * ((p >> 1) ^ (m0 & 1u)); t.L1 = 2048u * g + 1024u + 256u * q + 8u * (p & 1u) + 16u * ((p >> 1) ^ (m1 & 1u));
    t.X0 = (m0 >> 1) << 5; t.X1 = (m1 >> 1) << 5; return t;
}
__device__ __forceinline__ void tr_frag2(unsigned base, const TrLane& tl, unsigned c, bf16x8& f0, bf16x8& f1) {
    const unsigned a0 = base + tl.L0 + ((c << 5) ^ tl.X0), a1 = base + tl.L1 + ((c << 5) ^ tl.X1);
    u16x4 r0, r1, r2, r3;
    asm volatile("ds_read_b64_tr_b16 %0, %4\n\tds_read_b64_tr_b16 %1, %5\n\tds_read_b64_tr_b16 %2, %4 offset:8192\n\tds_read_b64_tr_b16 %3, %5 offset:8192\n\ts_waitcnt lgkmcnt(0)"
                 : "=&v"(r0), "=&v"(r1), "=&v"(r2), "=&v"(r3) : "v"(a0), "v"(a1) : "memory");
    f0 = (bf16x8){(short)r0[0], (short)r0[1], (short)r0[2], (short)r0[3], (short)r1[0], (short)r1[1], (short)r1[2], (short)r1[3]};
    f1 = (bf16x8){(short)r2[0], (short)r2[1], (short)r2[2], (short)r2[3], (short)r3[0], (short)r3[1], (short)r3[2], (short)r3[3]};
}
__device__ __forceinline__ void tr_frag4(unsigned base, const TrLane& tl, unsigned c, bf16x8& f0, bf16x8& f1, bf16x8& f2, bf16x8& f3) {
    const unsigned a0 = base + tl.L0 + ((c << 5) ^ tl.X0), a1 = base + tl.L1 + ((c << 5) ^ tl.X1), a2 = base + tl.L0 + (((c + 1u) << 5) ^ tl.X0), a3 = base + tl.L1 + (((c + 1u) << 5) ^ tl.X1);
    u16x4 r0, r1, r2, r3, r4, r5, r6, r7;
    asm volatile("ds_read_b64_tr_b16 %0, %8\n\tds_read_b64_tr_b16 %1, %9\n\tds_read_b64_tr_b16 %2, %8 offset:8192\n\tds_read_b64_tr_b16 %3, %9 offset:8192\n\t"
                 "ds_read_b64_tr_b16 %4, %10\n\tds_read_b64_tr_b16 %5, %11\n\tds_read_b64_tr_b16 %6, %10 offset:8192\n\tds_read_b64_tr_b16 %7, %11 offset:8192\n\ts_waitcnt lgkmcnt(0)"
                 : "=&v"(r0), "=&v"(r1), "=&v"(r2), "=&v"(r3), "=&v"(r4), "=&v"(r5), "=&v"(r6), "=&v"(r7) : "v"(a0), "v"(a1), "v"(a2), "v"(a3) : "memory");
    f0 = (bf16x8){(short)r0[0], (short)r0[1], (short)r0[2], (short)r0[3], (short)r1[0], (short)r1[1], (short)r1[2], (short)r1[3]};
    f1 = (bf16x8){(short)r2[0], (short)r2[1], (short)r2[2], (short)r2[3], (short)r3[0], (short)r3[1], (short)r3[2], (short)r3[3]};
    f2 = (bf16x8){(short)r4[0], (short)r4[1], (short)r4[2], (short)r4[3], (short)r5[0], (short)r5[1], (short)r5[2], (short)r5[3]};
    f3 = (bf16x8){(short)r6[0], (short)r6[1], (short)r6[2], (short)r6[3], (short)r7[0], (short)r7[1], (short)r7[2], (short)r7[3]};
}
__device__ __forceinline__ unsigned cvtpk(float lo, float hi) { return pk2(lo, hi); }
__device__ __forceinline__ unsigned cvtpk_pin(float lo, float hi) { unsigned r; asm volatile("v_cvt_pk_bf16_f32 %0, %1, %2\n\ts_nop 1" : "=v"(r) : "v"(lo), "v"(hi)); return r; }

constexpr int GLA_PREP_STRIDE = 264;

__device__ __forceinline__ void gla_prep_unit(Frame& F, int unit, const bf16* Z, const bf16* H, const bf16* WlraT, const float* wgk2, const float* bgk, bf16* QT, bf16* KH, bf16* AI, float* GAM) {
    const Tix T = tix();
    const int b = unit >> 8, h = (unit >> 6) & 3, c = unit & 63;
    const int d4 = 4 * T.lane, seg = T.wave;
    const int r = T.lane & 15, g = T.lane >> 4;
    LAS bf16* QA = (LAS bf16*)F.lds; LAS bf16* KA = QA + 64 * GLA_PREP_STRIDE; LAS float* tots = (LAS float*)(KA + 64 * GLA_PREP_STRIDE);
    LAS float* lrp = tots + 2048;
    const size_t rowc = (size_t)b * SEQ + c * 64;
    __syncthreads();
    {
      const int tl = T.wave & 3, kh = T.wave >> 2; f32x4 acc = (f32x4){0.f, 0.f, 0.f, 0.f};
      const bf16* hp = H + (rowc + 16 * tl + r) * D + kh * 1024 + 8 * g; const bf16* wp = WlraT + (size_t)r * D + kh * 1024 + 8 * g;
#pragma unroll 16
      for (int s = 0; s < 32; ++s) acc = __builtin_amdgcn_mfma_f32_16x16x32_bf16(*(const bf16x8*)(hp + 32 * s), *(const bf16x8*)(wp + 32 * s), acc, 0, 0, 0);
#pragma unroll
      for (int e = 0; e < 4; ++e) lrp[(kh * 64 + 16 * tl + 4 * g + e) * 16 + r] = acc[e]; }
    const size_t row0 = rowc + seg * 8;
    v2u qv[8], kv[8];
#pragma unroll
    for (int t = 0; t < 8; ++t) { qv[t] = *(const v2u*)(Z + (row0 + t) * NZ + ZQA + h * 256 + d4); kv[t] = *(const v2u*)(Z + (row0 + t) * NZ + ZKA + h * 256 + d4); }
    __syncthreads();
    f32x4 cum[8]; f32x4 run = (f32x4){0.f, 0.f, 0.f, 0.f};
    { f32x4 w[16];
#pragma unroll
      for (int rr = 0; rr < 16; ++rr) w[rr] = *(const f32x4*)(wgk2 + rr * 1024 + h * 256 + d4);
      const f32x4 bb = *(const f32x4*)(bgk + h * 256 + d4);
#pragma unroll
      for (int t = 0; t < 8; ++t) { const int tk = seg * 8 + t; f32x4 x = bb;
#pragma unroll
          for (int r4 = 0; r4 < 4; ++r4) { const f32x4 l0 = *(const LAS f32x4*)(lrp + tk * 16 + 4 * r4), l1 = *(const LAS f32x4*)(lrp + (64 + tk) * 16 + 4 * r4);
              x += (l0.x + l1.x) * w[4 * r4] + (l0.y + l1.y) * w[4 * r4 + 1] + (l0.z + l1.z) * w[4 * r4 + 2] + (l0.w + l1.w) * w[4 * r4 + 3]; }
#pragma unroll
          for (int j = 0; j < 4; ++j) run[j] += (fminf(x[j], 0.f) - __logf(1.0f + __expf(-fabsf(x[j])))) * (1.0f / 16.0f);
          cum[t] = run; } }
    *(LAS f32x4*)(tots + seg * 256 + d4) = run;
    __syncthreads();
    f32x4 add = (f32x4){0.f, 0.f, 0.f, 0.f}, bmid = add, bl = add;
#pragma unroll
    for (int s = 0; s < 8; ++s) { const f32x4 ts = *(const LAS f32x4*)(tots + s * 256 + d4); if (s < seg) add += ts; if (s < 4) bmid += ts; bl += ts; }
#pragma unroll
    for (int t = 0; t < 8; ++t) { const f32x4 bt = cum[t] + add; const size_t row = row0 + t; const int tk = seg * 8 + t;
        f32x4 q, k; q[0] = __uint_as_float(qv[t].x << 16); q[1] = __uint_as_float(qv[t].x & 0xffff0000u); q[2] = __uint_as_float(qv[t].y << 16); q[3] = __uint_as_float(qv[t].y & 0xffff0000u);
        k[0] = __uint_as_float(kv[t].x << 16); k[1] = __uint_as_float(kv[t].x & 0xffff0000u); k[2] = __uint_as_float(kv[t].y << 16); k[3] = __uint_as_float(kv[t].y & 0xffff0000u);
        q = q * 0.0625f;
        f32x4 o0, o1, o2, o3;
#pragma unroll
        for (int j = 0; j < 4; ++j) { o0[j] = q[j] * __expf(bt[j]); o1[j] = k[j] * __expf(bl[j] - bt[j]); o2[j] = q[j] * __expf(bt[j] - bmid[j]); o3[j] = k[j] * __expf(bmid[j] - bt[j]); }
        v2u w0, w1, w2, w3; w0.x = pk2(o0[0], o0[1]); w0.y = pk2(o0[2], o0[3]); w1.x = pk2(o1[0], o1[1]); w1.y = pk2(o1[2], o1[3]); w2.x = pk2(o2[0], o2[1]); w2.y = pk2(o2[2], o2[3]); w3.x = pk2(o3[0], o3[1]); w3.y = pk2(o3[2], o3[3]);
        *(v2u*)(QT + row * 1024 + h * 256 + d4) = w0; *(v2u*)(KH + row * 1024 + h * 256 + d4) = w1;
        *(LAS v2u*)(QA + tk * GLA_PREP_STRIDE + d4) = w2; *(LAS v2u*)(KA + tk * GLA_PREP_STRIDE + d4) = w3; }
    if (seg == 0) { f32x4 eg; eg[0] = __expf(bl[0]); eg[1] = __expf(bl[1]); eg[2] = __expf(bl[2]); eg[3] = __expf(bl[3]); *(f32x4*)(GAM + (size_t)unit * 256 + d4) = eg; }
    __syncthreads();
#pragma unroll
    for (int x = 0; x < 2; ++x) { const int tt = 2 * T.wave + x, j = tt >> 2, sb = tt & 3;
        f32x4 acc = (f32x4){0.f, 0.f, 0.f, 0.f};
        if (sb <= j) {
#pragma unroll
            for (int ks = 0; ks < 8; ++ks) { const bf16x8 a = *(const LAS bf16x8*)(QA + (16 * j + r) * GLA_PREP_STRIDE + 32 * ks + 8 * g), bb = *(const LAS bf16x8*)(KA + (16 * sb + r) * GLA_PREP_STRIDE + 32 * ks + 8 * g);
                acc = __builtin_amdgcn_mfma_f32_16x16x32_bf16(a, bb, acc, 0, 0, 0); } }
        bf16* ap = AI + (size_t)unit * 4096;
#pragma unroll
        for (int e = 0; e < 4; ++e) { const int t = 16 * j + 4 * g + e, s = 16 * sb + r; ap[t * 64 + s] = (bf16)f2bf(s <= t ? acc[e] : 0.f); } }
}

constexpr int GL_KH = 0, GL_QT = 32768, GL_V = 65536, GL_A = 81920, GL_GAM = 90112, GL_END = 91136;
template <bool OUT>
__device__ __forceinline__ void gla_pass(Frame& F, int worker, const bf16* Z, const bf16* QT, const bf16* KH, const bf16* AI, const float* GAM, float* GST, float* GAMS, float* OB, float* state_out) {
    const Tix T = tix();
    const int lane = T.lane, wave = T.wave, r = lane & 15, g = lane >> 4;
    const int grp = worker >> 2, qs = worker & 3, b = grp >> 5, h = (grp >> 3) & 3, sc = grp & 7;
    const unsigned lbase = (unsigned)(size_t)F.lds; const TrLane tl = tr_lane((unsigned)lane);
    f32x4 S[16];
#pragma unroll
    for (int i = 0; i < 16; ++i) S[i] = (f32x4){0.f, 0.f, 0.f, 0.f};
    if (OUT) {
        const f32x4* gp = (const f32x4*)(GST + ((((size_t)grp * 4 + qs) * 8 + wave) * 16) * 256) + lane;
#pragma unroll
        for (int i = 0; i < 16; ++i) S[i] = gp[64 * i];
    }
    const int srow = T.tid >> 4, sch = T.tid & 15;
    v4u pk[2][2], pq[2][2], pv[2], pa; f32x4 pg;
    const size_t seq0 = (size_t)b * SEQ + sc * 512;
    const unsigned tko = (unsigned)(srow * 1024 + 8 * sch) * 2u, tvo = (unsigned)(srow * NZ + 8 * sch) * 2u;
#define GLA_LOAD(cc) do { const size_t rw = seq0 + (cc) * 64; const size_t un = (size_t)((b * 4 + h) * 64 + sc * 8 + (cc)); \
        const char* kb = (const char*)(KH + rw * 1024 + h * 256); const char* qb = (const char*)(QT + rw * 1024 + h * 256); const char* vb = (const char*)(Z + rw * NZ + ZVA + h * 512 + qs * 128); \
        _Pragma("unroll") for (int hh = 0; hh < 2; ++hh) _Pragma("unroll") for (int u = 0; u < 2; ++u) { \
            pk[hh][u] = *(const v4u*)(kb + (hh * 256 + u * 65536) + tko); \
            if (OUT) pq[hh][u] = *(const v4u*)(qb + (hh * 256 + u * 65536) + tko); } \
        _Pragma("unroll") for (int u = 0; u < 2; ++u) pv[u] = *(const v4u*)(vb + (size_t)u * (32 * NZ * 2) + tvo); \
        if (OUT) pa = *(const v4u*)((const char*)(AI + un * 4096) + (unsigned)T.tid * 16u); \
        if (T.tid < 64) pg = *(const f32x4*)((const char*)(GAM + un * 256) + (unsigned)T.tid * 16u); } while (0)
    GLA_LOAD(0);
    for (int c = 0; c < 8; ++c) {
        __syncthreads();
#pragma unroll
        for (int hh = 0; hh < 2; ++hh)
#pragma unroll
            for (int u = 0; u < 2; ++u) { *(LAS v4u*)(F.lds + GL_KH + hh * 16384 + offb(srow + 32 * u, sch)) = pk[hh][u]; if (OUT) *(LAS v4u*)(F.lds + GL_QT + hh * 16384 + offb(srow + 32 * u, sch)) = pq[hh][u]; }
#pragma unroll
        for (int u = 0; u < 2; ++u) *(LAS v4u*)(F.lds + GL_V + offb(srow + 32 * u, sch)) = pv[u];
        if (OUT) { const int ar = T.tid >> 3, ach = T.tid & 7; *(LAS v4u*)(F.lds + GL_A + 128 * ar + 16 * (ach ^ (ar & 7))) = pa; }
        if (T.tid < 64) *(LAS f32x4*)(F.lds + GL_GAM + 16 * T.tid) = pg;
        __syncthreads();
        if (c + 1 < 8) GLA_LOAD(c + 1);
        bf16x8 V0, V1; tr_frag2(lbase + GL_V, tl, (unsigned)wave, V0, V1);
        if (OUT) {
            const size_t orow0 = seq0 + c * 64;
            const unsigned mr = ((unsigned)(r & 3) << 2) | ((unsigned)(r >> 2) & 3u);
            const unsigned ql0 = 256u * r + 8u * (g & 1) + 16u * (((unsigned)(g >> 1)) ^ (mr & 3u)), ql1 = 256u * r + 8u * (g & 1) + 16u * ((((unsigned)(g >> 1)) | 2u) ^ (mr & 3u)), qx = (mr >> 2) << 6;
            const unsigned al0 = 128u * r + 16u * (((unsigned)g) ^ (unsigned)(r & 7)), al1 = 128u * r + 16u * ((4u + (unsigned)g) ^ (unsigned)(r & 7));
#pragma unroll 1
            for (int j = 0; j < 4; ++j) {
                f32x4 acc = (f32x4){0.f, 0.f, 0.f, 0.f};
                { const bf16x8 a0 = *(const LAS bf16x8*)(F.lds + GL_A + 2048 * j + al0), a1 = *(const LAS bf16x8*)(F.lds + GL_A + 2048 * j + al1);
                  acc = __builtin_amdgcn_mfma_f32_16x16x32_bf16(V0, a0, acc, 0, 0, 0); acc = __builtin_amdgcn_mfma_f32_16x16x32_bf16(V1, a1, acc, 0, 0, 0); }
#pragma unroll
                for (int s = 0; s < 8; ++s) {
                    const unsigned qo = GL_QT + (unsigned)(s >> 2) * 16384u + 4096u * j + ((64u * (s & 3)) ^ qx);
                    const v2u lo = *(const LAS v2u*)(F.lds + qo + ql0), hi = *(const LAS v2u*)(F.lds + qo + ql1);
                    const v4u w = (v4u){lo.x, lo.y, hi.x, hi.y};
                    const v4u sw = (v4u){cvtpk_pin(S[2 * s][0], S[2 * s][1]), cvtpk_pin(S[2 * s][2], S[2 * s][3]), cvtpk_pin(S[2 * s + 1][0], S[2 * s + 1][1]), cvtpk_pin(S[2 * s + 1][2], S[2 * s + 1][3])};
                    acc = __builtin_amdgcn_mfma_f32_16x16x32_bf16(__builtin_bit_cast(bf16x8, sw), __builtin_bit_cast(bf16x8, w), acc, 0, 0, 0); }
                { v2u ow; ow.x = pk2(acc[0], acc[1]); ow.y = pk2(acc[2], acc[3]);     *(v2u*)((bf16*)OB + (orow0 + 16 * j + r) * 2048 + h * 512 + qs * 128 + 16 * wave + 4 * g) = ow; }
            }
        }
#pragma unroll
        for (int i = 0; i < 16; i += 2) {
            const f32x4 gm0 = *(const LAS f32x4*)(F.lds + GL_GAM + 4 * (16 * i + 4 * g)), gm1 = *(const LAS f32x4*)(F.lds + GL_GAM + 4 * (16 * (i + 1) + 4 * g));
            bf16x8 k0, k1, k2, k3; tr_frag4(lbase + GL_KH + (i >> 3) * 16384, tl, (unsigned)(i & 7), k0, k1, k2, k3);
            f32x4 s0 = S[i] * gm0, s1 = S[i + 1] * gm1;
            s0 = __builtin_amdgcn_mfma_f32_16x16x32_bf16(k0, V0, s0, 0, 0, 0); s1 = __builtin_amdgcn_mfma_f32_16x16x32_bf16(k2, V0, s1, 0, 0, 0);
            S[i] = __builtin_amdgcn_mfma_f32_16x16x32_bf16(k1, V1, s0, 0, 0, 0); S[i + 1] = __builtin_amdgcn_mfma_f32_16x16x32_bf16(k3, V1, s1, 0, 0, 0);
        }
    }
#undef GLA_LOAD
    if (!OUT) {
        f32x4* gp = (f32x4*)(GST + ((((size_t)grp * 4 + qs) * 8 + wave) * 16) * 256) + lane;
#pragma unroll
        for (int i = 0; i < 16; ++i) gp[64 * i] = S[i];
        if (qs == 0 && wave == 0) {
            f32x4 gt = (f32x4){1.f, 1.f, 1.f, 1.f};
            for (int c = 0; c < 8; ++c) gt = gt * *(const f32x4*)(GAM + ((size_t)((b * 4 + h) * 64 + sc * 8 + c)) * 256 + 4 * lane);
            *(f32x4*)(GAMS + (size_t)grp * 256 + 4 * lane) = gt; }
    } else if (sc == 7) {
#pragma unroll
        for (int i = 0; i < 16; ++i)
#pragma unroll
            for (int e = 0; e < 4; ++e) state_out[(((size_t)b * 4 + h) * 256 + 16 * i + 4 * g + e) * 512 + qs * 128 + 16 * wave + r] = S[i][e];
    }
    __syncthreads();
}

constexpr int GM_W = 0, GM_V = 32768, GM_END = 98304;
__device__ __forceinline__ void gm_mix_unit(Frame& F, int unit, const bf16* Z, const bf16* VNB, const float* ws_, const float* bs, bf16* OABC) {
    const Tix T = tix();
    const int lane = T.lane, wave = T.wave, r = lane & 15, g4 = lane >> 4;
    const int n = unit >> 2, grp = unit & 3; const size_t row0 = (size_t)n * 128;
    __syncthreads();
#pragma unroll
    for (int i = 0; i < 4; ++i) { const int ci = T.tid + 512 * i, row = ci >> 4, ch = ci & 15; const float* wp = ws_ + ((size_t)grp * 128 + row) * 128 + 8 * ch;
        const f32x4 a = *(const f32x4*)wp, b = *(const f32x4*)(wp + 4); const int s0 = 8 * ch;
        v4u o; o.x = pk2(s0 + 0 <= row ? a.x : 0.f, s0 + 1 <= row ? a.y : 0.f); o.y = pk2(s0 + 2 <= row ? a.z : 0.f, s0 + 3 <= row ? a.w : 0.f);
        o.z = pk2(s0 + 4 <= row ? b.x : 0.f, s0 + 5 <= row ? b.y : 0.f); o.w = pk2(s0 + 6 <= row ? b.z : 0.f, s0 + 7 <= row ? b.w : 0.f);
        *(LAS v4u*)(F.lds + GM_W + offb((unsigned)row, (unsigned)ch)) = o; }
#pragma unroll
    for (int i = 0; i < 8; ++i) { const int ci = T.tid + 512 * i, row = ci >> 5, c32 = ci & 31;
        const v4u v = *(const v4u*)(VNB + (row0 + row) * 1024 + grp * 256 + 8 * c32);
        *(LAS v4u*)(F.lds + GM_V + (c32 >> 4) * 32768 + offb((unsigned)row, (unsigned)(c32 & 15))) = v; }
    __syncthreads();
    const unsigned lbase = (unsigned)(size_t)F.lds; const TrLane tl = tr_lane((unsigned)lane);
    bf16x8 Bf[2][4];
#pragma unroll
    for (int x = 0; x < 2; ++x) { const unsigned ct = 2u * wave + x;
        const unsigned vb = lbase + GM_V + (ct >> 3) * 32768u;
        tr_frag2(vb, tl, ct & 7u, Bf[x][0], Bf[x][1]); tr_frag2(vb + 16384u, tl, ct & 7u, Bf[x][2], Bf[x][3]); }
    const unsigned mr = ((unsigned)(r & 3) << 2) | ((unsigned)(r >> 2) & 3u);
#pragma unroll
    for (int j = 0; j < 8; ++j) {
        f32x4 acc0 = (f32x4){0.f, 0.f, 0.f, 0.f}, acc1 = acc0;
#pragma unroll
        for (int ks = 0; ks <= (j >> 1); ++ks) {
            const bf16x8 a = *(const LAS bf16x8*)(F.lds + GM_W + 256u * (16 * j + r) + 16u * (((unsigned)(4 * ks + g4)) ^ mr));
            acc0 = __builtin_amdgcn_mfma_f32_16x16x32_bf16(Bf[0][ks], a, acc0, 0, 0, 0); acc1 = __builtin_amdgcn_mfma_f32_16x16x32_bf16(Bf[1][ks], a, acc1, 0, 0, 0); }
        const int t = 16 * j + r; const size_t row = row0 + t; const float bb = bs[grp * 128 + t];
#pragma unroll
        for (int x = 0; x < 2; ++x) { const int c = grp * 256 + 32 * wave + 16 * x + 4 * g4; const f32x4 av = x ? acc1 : acc0;
            const v2u uq = *(const v2u*)(Z + row * NZ + ZUB + c);
            v2u o; o.x = pk2(geluf_(__uint_as_float(uq.x << 16)) * (av[0] + bb), geluf_(__uint_as_float(uq.x & 0xffff0000u)) * (av[1] + bb));
            o.y = pk2(geluf_(__uint_as_float(uq.y << 16)) * (av[2] + bb), geluf_(__uint_as_float(uq.y & 0xffff0000u)) * (av[3] + bb));
            *(v2u*)(OABC + row * 4096 + 2048 + c) = o; }
    }
}

constexpr int SW_K = 0, SW_V = 32768, SW_END = 65536;
__device__ __forceinline__ void swa_unit(Frame& F, int unit, const bf16* Z, const float* sinks, bf16* OABC) {
    const Tix T = tix();
    const int lane = T.lane, wave = T.wave, r = lane & 15, g = lane >> 4;
    const int kv = unit & 3, n = (unit >> 2) & 31, b = unit >> 7;
    const size_t rowq0 = (size_t)b * SEQ + n * 128;
    __syncthreads();
#pragma unroll
    for (int i = 0; i < 4; ++i) { const int ci = T.tid + 512 * i, key = ci >> 3, ch = ci & 7;
        v4u kk = (v4u){0u, 0u, 0u, 0u}, vv = kk;
        if (n > 0 || key >= 128) { const bf16* zp = Z + (rowq0 - 128 + key) * NZ + kv * 64 + 8 * ch; kk = *(const v4u*)(zp + ZKC); vv = *(const v4u*)(zp + ZVC); }
        const unsigned o = 128u * key + 16u * ((unsigned)ch ^ (unsigned)(key & 7));
        *(LAS v4u*)(F.lds + SW_K + o) = kk; *(LAS v4u*)(F.lds + SW_V + o) = vv; }
    __syncthreads();
    const int head = kv * 4 + (wave >> 1), qh = wave & 1;
    const float slope = exp2f(-0.5f * (float)(head + 1)), sink = sinks[head];
    const unsigned lbase = (unsigned)(size_t)F.lds;
    bf16x8 qfa[4][2];
#pragma unroll
    for (int qt = 0; qt < 4; ++qt)
#pragma unroll
        for (int ks = 0; ks < 2; ++ks) qfa[qt][ks] = *(const bf16x8*)(Z + (rowq0 + 64 * qh + 16 * qt + r) * NZ + ZQC + head * 64 + 32 * ks + 8 * g);
#pragma unroll
    for (int qt = 0; qt < 4; ++qt) {
        const int i0 = 64 * qh + 16 * qt, a = i0 >> 4;
        const size_t qrow = rowq0 + i0 + r;
        bf16x8 qf[2]; qf[0] = qfa[qt][0]; qf[1] = qfa[qt][1];
        f32x4 st[10];
#pragma unroll
        for (int t = 0; t < 9; ++t) { const int krow = 16 * (a + t) + r; f32x4 acc = (f32x4){0.f, 0.f, 0.f, 0.f};
#pragma unroll
            for (int ks = 0; ks < 2; ++ks) { const bf16x8 kf = *(const LAS bf16x8*)(F.lds + SW_K + 128u * krow + 16u * (((unsigned)(4 * ks + g)) ^ (unsigned)(krow & 7)));
                acc = __builtin_amdgcn_mfma_f32_16x16x32_bf16(kf, qf[ks], acc, 0, 0, 0); }
            st[t] = acc; }
        st[9] = (f32x4){0.f, 0.f, 0.f, 0.f};
        const int iq = i0 + r; float mx = sink;
#pragma unroll
        for (int t = 0; t < 9; ++t)
#pragma unroll
            for (int e = 0; e < 4; ++e) { const int j = 16 * (a + t) + 4 * g + e, dist = 128 + iq - j; const bool ok = dist >= 0 && dist < 128 && (n > 0 || j >= 128);
                const float s = ok ? st[t][e] * 0.125f - slope * (float)dist : -1e30f; st[t][e] = s; mx = fmaxf(mx, s); }
        mx = fmaxf(mx, __shfl_xor(mx, 16)); mx = fmaxf(mx, __shfl_xor(mx, 32));
        float sum = 0.f;
#pragma unroll
        for (int t = 0; t < 9; ++t)
#pragma unroll
            for (int e = 0; e < 4; ++e) { const float p = __expf(st[t][e] - mx); st[t][e] = p; sum += p; }
        sum += __shfl_xor(sum, 16); sum += __shfl_xor(sum, 32);
        const float inv = 1.0f / (sum + __expf(sink - mx));
        f32x4 o[4];
#pragma unroll
        for (int dt = 0; dt < 4; ++dt) o[dt] = (f32x4){0.f, 0.f, 0.f, 0.f};
#pragma unroll
        for (int pr = 0; pr < 5; ++pr) {
            const v4u pw = (v4u){cvtpk(st[2 * pr][0], st[2 * pr][1]), cvtpk(st[2 * pr][2], st[2 * pr][3]), cvtpk(st[2 * pr + 1][0], st[2 * pr + 1][1]), cvtpk(st[2 * pr + 1][2], st[2 * pr + 1][3])};
            const bf16x8 pf = __builtin_bit_cast(bf16x8, pw);
            const int q4 = r >> 2, p4 = r & 3;
            const int k0 = 16 * (a + 2 * pr) + 4 * g + q4; int k1 = k0 + 16; if (k1 > 255) k1 = 255;
            const unsigned b0 = lbase + SW_V + 128u * k0 + 8u * (p4 & 1), b1 = lbase + SW_V + 128u * k1 + 8u * (p4 & 1);
            const unsigned x0 = (unsigned)(k0 & 7), x1 = (unsigned)(k1 & 7), ph = (unsigned)(p4 >> 1);
            u16x4 r0, r1, r2, r3, r4, r5, r6, r7;
            asm volatile("ds_read_b64_tr_b16 %0, %8\n\tds_read_b64_tr_b16 %1, %9\n\tds_read_b64_tr_b16 %2, %10\n\tds_read_b64_tr_b16 %3, %11\n\t"
                         "ds_read_b64_tr_b16 %4, %12\n\tds_read_b64_tr_b16 %5, %13\n\tds_read_b64_tr_b16 %6, %14\n\tds_read_b64_tr_b16 %7, %15\n\ts_waitcnt lgkmcnt(0)"
                         : "=&v"(r0), "=&v"(r1), "=&v"(r2), "=&v"(r3), "=&v"(r4), "=&v"(r5), "=&v"(r6), "=&v"(r7)
                         : "v"(b0 + 16u * ((0u + ph) ^ x0)), "v"(b1 + 16u * ((0u + ph) ^ x1)), "v"(b0 + 16u * ((2u + ph) ^ x0)), "v"(b1 + 16u * ((2u + ph) ^ x1)),
                           "v"(b0 + 16u * ((4u + ph) ^ x0)), "v"(b1 + 16u * ((4u + ph) ^ x1)), "v"(b0 + 16u * ((6u + ph) ^ x0)), "v"(b1 + 16u * ((6u + ph) ^ x1)) : "memory");
            const bf16x8 v0 = (bf16x8){(short)r0[0], (short)r0[1], (short)r0[2], (short)r0[3], (short)r1[0], (short)r1[1], (short)r1[2], (short)r1[3]};
            const bf16x8 v1 = (bf16x8){(short)r2[0], (short)r2[1], (short)r2[2], (short)r2[3], (short)r3[0], (short)r3[1], (short)r3[2], (short)r3[3]};
            const bf16x8 v2 = (bf16x8){(short)r4[0], (short)r4[1], (short)r4[2], (short)r4[3], (short)r5[0], (short)r5[1], (short)r5[2], (short)r5[3]};
            const bf16x8 v3 = (bf16x8){(short)r6[0], (short)r6[1], (short)r6[2], (short)r6[3], (short)r7[0], (short)r7[1], (short)r7[2], (short)r7[3]};
            o[0] = __builtin_amdgcn_mfma_f32_16x16x32_bf16(v0, pf, o[0], 0, 0, 0); o[1] = __builtin_amdgcn_mfma_f32_16x16x32_bf16(v1, pf, o[1], 0, 0, 0);
            o[2] = __builtin_amdgcn_mfma_f32_16x16x32_bf16(v2, pf, o[2], 0, 0, 0); o[3] = __builtin_amdgcn_mfma_f32_16x16x32_bf16(v3, pf, o[3], 0, 0, 0);
        }
        bf16* op = OABC + qrow * 4096 + 3072 + head * 64 + 4 * g;
#pragma unroll
        for (int dt = 0; dt < 4; ++dt) { v2u w; w.x = pk2(o[dt][0] * inv, o[dt][1] * inv); w.y = pk2(o[dt][2] * inv, o[dt][3] * inv); *(v2u*)(op + 16 * dt) = w; }
    }
}

__device__ __forceinline__ void swa_sample_wave(Frame& F, int item, const bf16* Z, const float* sinks, const float* ck, const float* cv, bf16* OABC) {
    const Tix T = tix();
    const int lane = T.lane, b = item >> 4, head = item & 15, kv = head >> 2; const size_t row = MP + b;
    LAS float* sq = (LAS float*)(F.lds + T.wave * 1024); LAS float* sp = sq + 64;
    const float slope = exp2f(-0.5f * (float)(head + 1)), sink = sinks[head];
    sq[lane] = bf2f(Z[row * NZ + ZQC + head * 64 + lane]);
    LDS_WAIT();
    float s2[2];
#pragma unroll
    for (int u = 0; u < 2; ++u) { const int j = 1 + lane + 64 * u;
        float s = 0.f;
        if (j < 128) { const float* kp = ck + ((size_t)(b * 128 + j) * 4 + kv) * 64;
#pragma unroll
            for (int d4 = 0; d4 < 16; ++d4) { const f32x4 kk = *(const f32x4*)(kp + 4 * d4); const f32x4 qq = *(const LAS f32x4*)(sq + 4 * d4); s += (qq.x * kk.x + qq.y * kk.y) + (qq.z * kk.z + qq.w * kk.w); } }
        else { const bf16* kp = Z + row * NZ + ZKC + kv * 64;
#pragma unroll
            for (int d = 0; d < 64; ++d) s += sq[d] * bf2f(kp[d]); }
        s2[u] = s * 0.125f - slope * (float)(128 - j); }
    float mx = fmaxf(fmaxf(s2[0], s2[1]), sink);
#pragma unroll
    for (int o = 1; o < 64; o <<= 1) mx = fmaxf(mx, __shfl_xor(mx, o));
    const float p0 = __expf(s2[0] - mx), p1 = __expf(s2[1] - mx);
    const float inv = 1.0f / (wave_sum(p0 + p1) + __expf(sink - mx));
    sp[lane] = p0; sp[64 + lane] = p1;
    LDS_WAIT();
    { const int jq = lane >> 4, d4 = 4 * (lane & 15); f32x4 acc = (f32x4){0.f, 0.f, 0.f, 0.f};
      f32x4 vv[32];
#pragma unroll
      for (int i = 0; i < 32; ++i) { const int jj = 4 * i + jq;
          if (jj < 127) vv[i] = *(const f32x4*)(cv + ((size_t)(b * 128 + jj + 1) * 4 + kv) * 64 + d4);
          else { const v2u w = *(const v2u*)(Z + row * NZ + ZVC + kv * 64 + d4); vv[i] = (f32x4){__uint_as_float(w.x << 16), __uint_as_float(w.x & 0xffff0000u), __uint_as_float(w.y << 16), __uint_as_float(w.y & 0xffff0000u)}; } }
#pragma unroll
      for (int i = 0; i < 32; ++i) acc += vv[i] * sp[4 * i + jq];
#pragma unroll
      for (int j = 0; j < 4; ++j) { acc[j] += __shfl_xor(acc[j], 16); acc[j] += __shfl_xor(acc[j], 32); }
      if (jq == 0) { v2u w; w.x = pk2(acc[0] * inv, acc[1] * inv); w.y = pk2(acc[2] * inv, acc[3] * inv); *(v2u*)(OABC + row * 4096 + 3072 + head * 64 + d4) = w; } }
    LDS_WAIT();
}

constexpr int MD_PITCH = 208;
__device__ __forceinline__ void mod_direct(Frame& F, const bf16* CA  , const float* wada  , const float* bada  , float* MOD  ) {
    const Tix T = tix();
    const int lane = T.lane, wave = T.wave, r = lane & 15, g = lane >> 4;
    for (int sl = (int)blockIdx.x; sl < 256; sl += F.G) {
        const int l = sl >> 7, n0 = (sl & 127) * 96;
        const float* W = wada + (size_t)l * D * NADA + n0;
        f32x4 acc[7];
#pragma unroll
        for (int i = 0; i < 7; ++i) acc[i] = (f32x4){0.f, 0.f, 0.f, 0.f};
        f32x4 pw[6];
        const unsigned sk0 = (unsigned)(T.tid / 24), sq0 = (unsigned)(T.tid % 24);
#define MD_LOAD(kb) do { unsigned kk = sk0, q = sq0; _Pragma("unroll") for (int i = 0; i < 6; ++i) { pw[i] = *(const f32x4*)(W + (size_t)((kb) * 128 + kk) * NADA + 4 * q); q += 8; kk += 21; if (q >= 24) { q -= 24; kk += 1; } } } while (0)
        MD_LOAD(0);
        const unsigned lbase = (unsigned)(size_t)F.lds;
        for (int kb = 0; kb < 16; ++kb) {
            __syncthreads();
            { unsigned kk = sk0, q = sq0;
#pragma unroll
              for (int i = 0; i < 6; ++i) { v2u w; w.x = pk2(pw[i].x, pw[i].y); w.y = pk2(pw[i].z, pw[i].w); *(LAS v2u*)(F.lds + kk * MD_PITCH + 8 * q) = w; q += 8; kk += 21; if (q >= 24) { q -= 24; kk += 1; } } }
            __syncthreads();
            if (kb + 1 < 16) MD_LOAD(kb + 1);
            bf16x8 af[4], ag[4];
#pragma unroll
            for (int k4 = 0; k4 < 4; ++k4) { af[k4] = *(const bf16x8*)(CA + (size_t)(16 * wave + r) * D + kb * 128 + 32 * k4 + 8 * g); ag[k4] = *(const bf16x8*)(CA + (size_t)(128 + r) * D + kb * 128 + 32 * k4 + 8 * g); }
#pragma unroll
            for (int ks = 0; ks < 4; ++ks) {
                const bf16x8 a0 = af[ks], a8 = ag[ks];
                const unsigned q4 = (unsigned)(r >> 2), p4 = (unsigned)(r & 3);
                const unsigned a_lo = lbase + (32u * ks + 8u * g + q4) * MD_PITCH + 8u * p4, a_hi = a_lo + 4u * MD_PITCH;
                u16x4 t0, t1, t2, t3, t4, t5, t6, t7, t8, t9, ta, tb;
                asm volatile("ds_read_b64_tr_b16 %0, %12\n\tds_read_b64_tr_b16 %1, %13\n\tds_read_b64_tr_b16 %2, %12 offset:32\n\tds_read_b64_tr_b16 %3, %13 offset:32\n\t"
                             "ds_read_b64_tr_b16 %4, %12 offset:64\n\tds_read_b64_tr_b16 %5, %13 offset:64\n\tds_read_b64_tr_b16 %6, %12 offset:96\n\tds_read_b64_tr_b16 %7, %13 offset:96\n\t"
                             "ds_read_b64_tr_b16 %8, %12 offset:128\n\tds_read_b64_tr_b16 %9, %13 offset:128\n\tds_read_b64_tr_b16 %10, %12 offset:160\n\tds_read_b64_tr_b16 %11, %13 offset:160\n\ts_waitcnt lgkmcnt(0)"
                             : "=&v"(t0), "=&v"(t1), "=&v"(t2), "=&v"(t3), "=&v"(t4), "=&v"(t5), "=&v"(t6), "=&v"(t7), "=&v"(t8), "=&v"(t9), "=&v"(ta), "=&v"(tb) : "v"(a_lo), "v"(a_hi) : "memory");
#define MD_FR(lo, hi) (bf16x8){(short)lo[0], (short)lo[1], (short)lo[2], (short)lo[3], (short)hi[0], (short)hi[1], (short)hi[2], (short)hi[3]}
                const bf16x8 bfr[6] = {MD_FR(t0, t1), MD_FR(t2, t3), MD_FR(t4, t5), MD_FR(t6, t7), MD_FR(t8, t9), MD_FR(ta, tb)};
#undef MD_FR
#pragma unroll
                for (int nt = 0; nt < 6; ++nt) {
                    acc[nt] = __builtin_amdgcn_mfma_f32_16x16x32_bf16(a0, bfr[nt], acc[nt], 0, 0, 0);
                    if (nt == wave) acc[6] = __builtin_amdgcn_mfma_f32_16x16x32_bf16(a8, bfr[nt], acc[6], 0, 0, 0);
                }
            }
        }
#undef MD_LOAD
        float* mo = MOD + (size_t)l * 256 * NADA; const float* bb = bada + (size_t)l * NADA;
#pragma unroll
        for (int nt = 0; nt < 6; ++nt) { const int col = n0 + 16 * nt + r; const float bv = bb[col];
#pragma unroll
            for (int e = 0; e < 4; ++e) mo[(size_t)(16 * wave + 4 * g + e) * NADA + col] = acc[nt][e] + bv; }
        if (wave < 6) { const int col = n0 + 16 * wave + r; const float bv = bb[col];
#pragma unroll
            for (int e = 0; e < 4; ++e) mo[(size_t)(128 + 4 * g + e) * NADA + col] = acc[6][e] + bv; }
        __syncthreads();
    }
}

__device__ __forceinline__ void gla_scan(Frame& F, float* GST, const float* GAMS) {
    const Tix T = tix();
    const int gw = F.vcu * NWAVES + T.wave, NGW = F.G * NWAVES, g = T.lane >> 4;
    for (int item = gw; item < 8 * 4 * 8 * 16; item += NGW) {
        const int i = item & 15, w = (item >> 4) & 7, qs = (item >> 7) & 3, bh = item >> 9;
        f32x4 G[8], Gm[8];
#pragma unroll
        for (int sc = 0; sc < 8; ++sc) { const int grp = bh * 8 + sc;
            G[sc] = *((const f32x4*)(GST + ((((size_t)grp * 4 + qs) * 8 + w) * 16 + i) * 256) + T.lane);
            Gm[sc] = *(const f32x4*)(GAMS + (size_t)grp * 256 + 16 * i + 4 * g); }
        f32x4 S = G[0] * 0.0f;
#pragma unroll
        for (int sc = 0; sc < 8; ++sc) { const int grp = bh * 8 + sc;
            *((f32x4*)(GST + ((((size_t)grp * 4 + qs) * 8 + w) * 16 + i) * 256) + T.lane) = S;
            S = Gm[sc] * S + G[sc]; }
    }
}
constexpr int NPH = 27;
#ifndef EN_CONV
#define EN_CONV 1
#endif
#ifndef EN_MOD
#define EN_MOD 1
#endif
#ifndef EN_NORM
#define EN_NORM 1
#endif
#ifndef EN_WIN
#define EN_WIN 1
#endif
#ifndef EN_GK
#define EN_GK 1
#endif
#ifndef EN_GLAN
#define EN_GLAN 1
#endif
#ifndef EN_MIXA
#define EN_MIXA 1
#endif
#ifndef EN_MIXB
#define EN_MIXB 1
#endif
#ifndef EN_PROJ
#define EN_PROJ 1
#endif
#ifndef EN_WO
#define EN_WO 1
#endif
#ifndef EN_FFI
#define EN_FFI 1
#endif
#ifndef EN_FFO
#define EN_FFO 1
#endif
#ifndef EN_FINAL
#define EN_FINAL 1
#endif
#ifndef MK_PROBE
#define MK_PROBE 0
#endif
#ifndef MK_REP_K
#define MK_REP_K 0
#endif
#ifndef MK_REP_N
#define MK_REP_N 0
#endif
#ifndef MK_REP_VAR
#define MK_REP_VAR 0
#endif
#ifndef MK_ONE_LAUNCH
#define MK_ONE_LAUNCH 1
#endif
typedef const __attribute__((address_space(4))) Prm* KPrm;
__device__ __forceinline__ KPrm kargs() { KPrm p = (KPrm)__builtin_amdgcn_kernarg_segment_ptr(); asm volatile("" : "+s"(p)); return p; }
#define PH_BEGIN KPrm K = kargs(); unsigned char* ws = K->ws; (void)ws;
__global__ void __launch_bounds__(NT, 2) mega_fwd(Prm P_unused) {
    extern __shared__ __attribute__((aligned(16))) unsigned char lds_raw[];
    Frame F;
    F.lds = (LAS unsigned char*)lds_raw;
    F.G = gridDim.x; { const int bx = blockIdx.x; F.vcu = (F.G % 8 == 0) ? (bx % 8) * (F.G / 8) + bx / 8 : bx; }
    volatile LAS unsigned* MISC = (volatile LAS unsigned*)(F.lds + MISC_OFF);
    if (threadIdx.x < 64) MISC[threadIdx.x] = 0u;
    __syncthreads();
    int lo, hi;
    XcdBarrier bar;
    { KPrm K = kargs(); lo = K->ph_lo; hi = K->ph_hi; unsigned* ctl = (unsigned*)(K->ws + WS_CTL);
      bar.bar = ctl + CW_BAR; bar.x = 0; bar.st = nullptr;
      if (hi - lo > 1) bar = xcd_barrier_post(ctl + CW_BAR, MISC + 8); }
#define IN(k) (lo <= (k) && (k) < hi)
#define SEAM(k) do { if (IN(k) && IN((k) + 1)) xcd_barrier(bar); } while (0)
#define WSP(T, off) ((T*)(ws + (off)))

    if (EN_CONV && IN(0)) { phase_convert(F); }
    SEAM(0);
    if (EN_MOD && IN(1)) { PH_BEGIN mod_direct(F, WSP(const bf16, WS_CA), K->in[I_WADA], K->in[I_BADA], WSP(float, WS_MOD)); }
    SEAM(1);
#if 0
    SEAM(0);
    if (EN_MOD && IN(1)) {
        PH_BEGIN
        const int c = (int)blockIdx.x, l = c / 48;
        if (l < 2) {
            pg8::Gemm g{WSP(const bf16, WS_CA), WSP(const bf16, WS_WADA) + (size_t)l * NADA * D, 256, NADA, D, D};
            pg8::StaticOrder S; S.init(256, NADA, 1 << 20, c - 48 * l, D);
            pg8::EpiF32 E{WSP(float, WS_MOD) + (size_t)l * 256 * NADA, NADA, K->in[I_BADA] + (size_t)l * NADA};
            pg8::gemm_phase<pg8::EpiF32, pg8::StaticOrder, true, true>(F.lds, g, S, E);
        }
    }
    SEAM(1);
#endif

    for (int l = 0; l < 2; ++l) {
        const int pb = 2 + 12 * l;
        if (EN_NORM && IN(pb + 0)) { PH_BEGIN phase_norm_t<false>(F, WSP(float, WS_X), K->in[I_N1W] + (size_t)l * D, WSP(const float, WS_MOD) + (size_t)l * 256 * NADA, MOD_SH1, MOD_SC1, WSP(bf16, WS_H), nullptr, WSP(const float, WS_PART + 16 * MiB), l == 0 ? 0 : 11); }
        SEAM(pb + 0);
        if (EN_WIN && IN(pb + 1)) {
            PH_BEGIN
            pg8::Gemm g{WSP(const bf16, WS_H), WSP(const bf16, WS_WIN) + (size_t)l * NZW * D, MT, NZ, D, D};
            pg8::StaticOrder S; S.init(MT, NZ, F.G, (int)blockIdx.x, D);
            pg8::EpiZ E{WSP(bf16, WS_Z), NZ, ZGT / 256, K->var};
            pg8::gemm_phase<pg8::EpiZ, pg8::StaticOrder, true, true>(F.lds, g, S, E);
        }
        SEAM(pb + 1);
        if (IN(pb + 2)) {
            PH_BEGIN
            const bf16* Zb = WSP(const bf16, WS_Z); const bf16* Hb = WSP(const bf16, WS_H); const bf16* Wl = WSP(const bf16, WS_WIN) + (size_t)l * NZW * D + (size_t)ZLR * D;
            const float* wgk2 = K->in[I_WGK2] + (size_t)l * 16 * 1024; const float* bgk = K->in[I_BGK] + (size_t)l * 1024;
            const int ow = (int)blockIdx.x, OW = F.G;
            for (int half = 0; half < 2; ++half) {
                if ((half == 0) == ((ow & 1) == 1)) {
                    if (EN_MIXA && !(K->var & 8)) for (int u = ow; u < 512; u += OW) gla_sample_unit(F, u, Zb, Hb, Wl, wgk2, bgk, K->in[I_SGLA] + (size_t)l * 128 * 4 * 256 * 512, K->out + O_SGS + (size_t)l * 128 * 4 * 256 * 512, K->in[I_GLANW] + (size_t)l * 512, WSP(bf16, WS_OABC));
                } else {
                    if (EN_GLAN && !(K->var & 16)) for (int u = ow; u < 512; u += OW) gla_prep_unit(F, u, Zb, Hb, Wl, wgk2, bgk, WSP(bf16, WS_QT), WSP(bf16, WS_KH), WSP(bf16, WS_AI), WSP(float, WS_GAM));
                    if (EN_MIXA && !(K->var & 32)) {
                        __syncthreads();
                        if (!(K->var & 64)) gm_ln_rows(F, ow, OW, Zb, K->in[I_GMNW] + (size_t)l * 1024, K->in[I_GMNB] + (size_t)l * 1024, WSP(bf16, WS_VNB), K->out + O_GMV + (size_t)l * 128 * 1024, K->in[I_GMWS] + (size_t)l * 4 * 128 * 128, K->in[I_GMBS] + (size_t)l * 4 * 128, WSP(bf16, WS_OABC));
                        if (!(K->var & 128)) for (int u = ow; u < 256; u += OW) swa_unit(F, u, Zb, K->in[I_SINK] + (size_t)l * 16, WSP(bf16, WS_OABC));
                        __syncthreads();
                        if (!(K->var & 256)) for (int it = ow * NWAVES + tix().wave; it < MS * 16; it += OW * NWAVES) swa_sample_wave(F, it, Zb, K->in[I_SINK] + (size_t)l * 16, K->in[I_CK] + (size_t)l * 128 * 128 * 256, K->in[I_CV] + (size_t)l * 128 * 128 * 256, WSP(bf16, WS_OABC));
                        __syncthreads();
                        cache_outs(F, ow, OW, l, Zb, K->out);
                    }
                }
            }
        }
        SEAM(pb + 2);
        if (IN(pb + 3)) {
            PH_BEGIN
            if (EN_GLAN) for (int w = (int)blockIdx.x; w < 256; w += F.G) gla_pass<false>(F, w, WSP(const bf16, WS_Z), WSP(const bf16, WS_QT), WSP(const bf16, WS_KH), WSP(const bf16, WS_AI), WSP(const float, WS_GAM), WSP(float, WS_GST), WSP(float, WS_GAMS), nullptr, nullptr);
            if (EN_MIXB) for (int u = (int)blockIdx.x; u < 256; u += F.G) gm_mix_unit(F, u, WSP(const bf16, WS_Z), WSP(const bf16, WS_VNB), K->in[I_GMWS] + (size_t)l * 4 * 128 * 128, K->in[I_GMBS] + (size_t)l * 4 * 128, WSP(bf16, WS_OABC));
        }
        SEAM(pb + 3);
        if (EN_GLAN && IN(pb + 4)) { PH_BEGIN gla_scan(F, WSP(float, WS_GST), WSP(const float, WS_GAMS)); }
        SEAM(pb + 4);
        if (IN(pb + 5)) {
            PH_BEGIN
            if (EN_GLAN) for (int w = (int)blockIdx.x; w < 256; w += F.G) gla_pass<true>(F, w, WSP(const bf16, WS_Z), WSP(const bf16, WS_QT), WSP(const bf16, WS_KH), WSP(const bf16, WS_AI), WSP(const float, WS_GAM), WSP(float, WS_GST), WSP(float, WS_GAMS), WSP(float, WS_OB), K->out + O_SGP + (size_t)l * 2 * 4 * 256 * 512);
        }
        SEAM(pb + 5);
        if (EN_MIXB && IN(pb + 6)) { PH_BEGIN gla_fin(F, WSP(const float, WS_OB), WSP(const bf16, WS_Z), K->in[I_GLANW] + (size_t)l * 512, WSP(bf16, WS_OABC)); }
        SEAM(pb + 6);
        if (EN_PROJ && IN(pb + 7)) {
            PH_BEGIN
            pg8::Gemm g{WSP(const bf16, WS_OABC), WSP(const bf16, WS_WPRJ) + (size_t)l * D * 4096, MT, D, 4096, 4096};
            pg8::MiniOrder S; S.init(F.G, (int)blockIdx.x, 4096, 8, K->var);
            pg8::EpiProjR E{WSP(const bf16, WS_Z), NZ, ZGT, WSP(float, WS_PART), WSP(bf16, WS_MG), MP, K->var};
            pg8::gemm_phase<pg8::EpiProjR, pg8::MiniOrder, true, true>(F.lds, g, S, E);
        }
        SEAM(pb + 7);
        if (EN_WO && IN(pb + 8)) {
            PH_BEGIN
            pg8::Gemm g{WSP(const bf16, WS_MG), WSP(const bf16, WS_WO) + (size_t)l * D * D, MT, D, D, D};
            pg8::MiniOrder S; S.init(F.G, (int)blockIdx.x, D, 4, K->var);
            {
              const Tix T = tix(); pg8::Unit u;
              for (int i = 0; S.next(i, u); ++i) if (u.pm >= 32) { const int k0 = 64 * u.kt0, kw = 16 * u.nt;
                  for (int idx0 = T.tid; idx0 < 128 * kw; idx0 += 4 * NT) {
                      f32x4 pv[4][8];
#pragma unroll
                      for (int q = 0; q < 4; ++q) { const int idx = idx0 + q * NT, r = idx / kw, c = k0 + 4 * (idx % kw);
#pragma unroll
                          for (int s = 0; s < 8; ++s) pv[q][s] = *(const f32x4*)(WSP(const float, WS_PART) + ((size_t)s * 128 + r) * D + c); }
#pragma unroll
                      for (int q = 0; q < 4; ++q) { const int idx = idx0 + q * NT, r = idx / kw, c = k0 + 4 * (idx % kw);
                          const f32x4 v = ((pv[q][0] + pv[q][1]) + (pv[q][2] + pv[q][3])) + ((pv[q][4] + pv[q][5]) + (pv[q][6] + pv[q][7]));
                          v2u w; w.x = pk2(v.x, v.y); w.y = pk2(v.z, v.w); *(v2u*)(WSP(bf16, WS_MG) + (size_t)(MP + r) * D + c) = w; } }
                  for (int idx = T.tid; idx < 128 * kw; idx += NT) { const int r = 128 + idx / kw, c = k0 + 4 * (idx % kw); *(v2u*)(WSP(bf16, WS_MG) + (size_t)(MP + r) * D + c) = (v2u){0u, 0u}; } }
              VM_WAIT(); __syncthreads(); }
            pg8::EpiResid E{WSP(float, WS_X), WSP(const float, WS_MOD) + (size_t)l * 256 * NADA + MOD_G1, NADA, WSP(float, WS_PART + 8 * MiB), MP, K->var};
            pg8::gemm_phase<pg8::EpiResid, pg8::MiniOrder, true, true>(F.lds, g, S, E);
        }
        SEAM(pb + 8);
        if (EN_NORM && IN(pb + 9)) { PH_BEGIN phase_norm_t<false>(F, WSP(float, WS_X), K->in[I_N2W] + (size_t)l * D, WSP(const float, WS_MOD) + (size_t)l * 256 * NADA, MOD_SH2, MOD_SC2, WSP(bf16, WS_H), nullptr, WSP(const float, WS_PART + 8 * MiB), 8); }
        SEAM(pb + 9);
        if (EN_FFI && IN(pb + 10)) {
            PH_BEGIN
            pg8::Gemm g{WSP(const bf16, WS_H), WSP(const bf16, WS_WFI) + (size_t)l * 2 * FF * D, MT, 2 * FF, D, D};
            pg8::StaticOrder S; S.init(MT, 2 * FF, F.G, (int)blockIdx.x, D);
            pg8::EpiSwiGLU E{WSP(bf16, WS_ACT), FF};
            pg8::gemm_phase<pg8::EpiSwiGLU, pg8::StaticOrder, true, true>(F.lds, g, S, E);
        }
        SEAM(pb + 10);
        if (EN_FFO && IN(pb + 11)) {
            PH_BEGIN
            pg8::Gemm g{WSP(const bf16, WS_ACT), WSP(const bf16, WS_WFO) + (size_t)l * D * FF, MT, D, FF, FF};
            pg8::MiniOrder S; S.init(F.G, (int)blockIdx.x, FF, 8, K->var);
            pg8::EpiResid E{WSP(float, WS_X), WSP(const float, WS_MOD) + (size_t)l * 256 * NADA + MOD_G2, NADA, WSP(float, WS_PART + 16 * MiB), MP, K->var};
            pg8::gemm_phase<pg8::EpiResid, pg8::MiniOrder, true, true>(F.lds, g, S, E);
        }
        SEAM(pb + 11);
    }
    if (EN_FINAL && IN(26)) { PH_BEGIN phase_norm_t<true>(F, WSP(float, WS_X), K->in[I_FNW], nullptr, 0, 0, nullptr, K->out, WSP(const float, WS_PART + 16 * MiB), 11); }
#undef IN
#undef SEAM
}

extern "C" void kernel_launch(void* const* d_in, const int* in_sizes, int n_in, void* d_out, int out_size, void* d_ws, size_t ws_size, hipStream_t stream) {
    static int grid = 0;
    if (grid == 0) {
        if (n_in != N_IN || (size_t)out_size != O_END || ws_size < WS_END) { fprintf(stderr, "kernel_launch: unexpected problem (n_in %d, out %d, ws %zu); nothing launched\n", n_in, out_size, ws_size); grid = -1; return; }
        int dev = 0, cus = 0, per_cu = 0;
        if (hipGetDevice(&dev) != hipSuccess || hipDeviceGetAttribute(&cus, hipDeviceAttributeMultiprocessorCount, dev) != hipSuccess) { grid = -1; return; }
        if (hipFuncSetAttribute((const void*)mega_fwd, hipFuncAttributeMaxDynamicSharedMemorySize, LDS_BYTES) != hipSuccess) { fprintf(stderr, "kernel_launch: hipFuncSetAttribute failed\n"); grid = -1; return; }
        if (hipOccupancyMaxActiveBlocksPerMultiprocessor(&per_cu, (const void*)mega_fwd, NT, LDS_BYTES) != hipSuccess || per_cu < 1) { fprintf(stderr, "kernel_launch: occupancy query says %d\n", per_cu); }
        (void)hipGetLastError();
        grid = cus;
        if (grid < 128) { fprintf(stderr, "kernel_launch: this build needs >= 128 CUs (mini-unit deal)\n"); grid = -1; return; }
    }
    if (grid < 0) return;
    (void)hipMemsetAsync((char*)d_ws + WS_CTL, 0, CTL_ZERO_BYTES, stream);
    Prm p{};
    for (int i = 0; i < N_IN; ++i) p.in[i] = (const float*)d_in[i];
    p.out = (float*)d_out; p.ws = (unsigned char*)d_ws;
#if MK_ONE_LAUNCH
    p.ph_lo = 0; p.ph_hi = NPH;
    hipLaunchKernelGGL(mega_fwd, dim3(grid), dim3(NT), LDS_BYTES, stream, p);
#if MK_PROBE
    for (int i = 0; i < MK_REP_N; ++i) { p.ph_lo = MK_REP_K; p.ph_hi = MK_REP_K + 1; p.var = MK_REP_VAR; hipLaunchKernelGGL(mega_fwd, dim3(grid), dim3(NT), LDS_BYTES, stream, p); }
#endif
#else
    for (int k = 0; k < NPH; ++k) { p.ph_lo = k; p.ph_hi = k + 1; hipLaunchKernelGGL(mega_fwd, dim3(grid), dim3(NT), LDS_BYTES, stream, p); }
#endif
}
```

```cpp
#include <hip/hip_runtime.h>
#include <cstdio>
#include <cstdint>
namespace pg8 {
#define PG8_LAS __attribute__((address_space(3)))
typedef unsigned short bf16_t;
typedef short bf16x8 __attribute__((ext_vector_type(8)));
typedef float f32x4 __attribute__((ext_vector_type(4)));
typedef unsigned u32x4 __attribute__((ext_vector_type(4)));
constexpr int BM = 256, BK = 64, HALF = 128, HTB = HALF * BK * 2  , STAGE_BYTES = 8 * HTB, NXCD = 8, WGM = 8;

__host__ __device__ __forceinline__ int lds_byte(int r, int c) { const int st = (r >> 4) * 2 + (c >> 5), rr = r & 15, cc = c & 31, ob = rr * 64 + cc * 2; return st * 1024 + (ob ^ (((ob >> 9) & 1) << 5)); }
__host__ __device__ __forceinline__ void stage_rc(int b, int& R, int& C) { const int st = b / 1024, sb = b % 1024, swz = sb ^ (((sb >> 9) & 1) << 5); R = (st >> 1) * 16 + swz / 64; C = (st & 1) * 32 + (swz % 64) / 2; }
__host__ __device__ __forceinline__ int perm32(int rho) { const int n = rho >> 4, i = rho & 15; return 8 * (i >> 2) + 4 * n + (i & 3); }

struct Unit { int pm, pn, kt0, nt; };
struct Gemm { const bf16_t* A; const bf16_t* Bt; int M, N, K, ld; };

struct StaticOrder {
    int nM, nN, nwg, G, c, ntf;
    __host__ __device__ __forceinline__ void init(int M, int N, int G_, int c_, int K) { nM = M / BM; nN = N / BM; nwg = nM * nN; G = G_; c = c_; ntf = K / BK; }
    __host__ __device__ __forceinline__ bool next(int i, Unit& u) const {
        const long L = (long)i * G + c; if (L >= nwg) return false;
        int wgid = (int)L; { const int q = nwg / NXCD, r = nwg % NXCD, xcd = wgid % NXCD, off = wgid / NXCD; wgid = (xcd < r ? xcd * (q + 1) : r * (q + 1) + (xcd - r) * q) + off; }
        const int nig = WGM * nN, gid = wgid / nig, fm = gid * WGM, gsz = (nM - fm) < WGM ? (nM - fm) : WGM;
        u.pm = fm + ((wgid % nig) % gsz); u.pn = (wgid % nig) / gsz; u.kt0 = 0; u.nt = ntf; return true;
    }
    __device__ __forceinline__ void a_ready(const Unit&) const {}
    __device__ __forceinline__ void done(const Unit&) const {}
};
struct MiniOrder {
    StaticOrder main; int nmini, ntm;
    __host__ __device__ __forceinline__ void init(int G_, int c_, int K, int ntm_, int var = 0) { main.init(32 * BM, 2048, G_, c_, K); ntm = ntm_; nmini = (var & 4) ? 0 : 8 * ((K / BK) / ntm_); }
    __host__ __device__ __forceinline__ bool next(int i, Unit& u) const {
        const bool has_mini = main.c < nmini;
        if (has_mini && i == 0) { const int m = main.c; u.pm = 32; u.pn = m & 7; u.kt0 = ntm * (m >> 3); u.nt = ntm; return true; }
        return main.next(has_mini ? i - 1 : i, u);
    }
    __device__ __forceinline__ void a_ready(const Unit&) const {}
    __device__ __forceinline__ void done(const Unit&) const {}
};


typedef __bf16 bf16x2_t __attribute__((ext_vector_type(2)));
__device__ __forceinline__ unsigned cvt_pk_bf16(float lo, float hi) { bf16x2_t v; v[0] = (__bf16)lo; v[1] = (__bf16)hi; return __builtin_bit_cast(unsigned, v); }
typedef float f32x2 __attribute__((ext_vector_type(2)));
__device__ __forceinline__ f32x2 gelu_pk(f32x2 v) {
    const f32x2 av = __builtin_elementwise_abs(v), d = av * 0.2316418882f + 1.0f;
    f32x2 t; t.x = __builtin_amdgcn_rcpf(d.x); t.y = __builtin_amdgcn_rcpf(d.y);
    f32x2 q = t * 0.5307027145f + (-0.7265760135f); q = q * t + 0.7107068705f; q = q * t + (-0.142248368f); q = q * t + 0.127414796f; q = q * t;
    const f32x2 s = (v * v) * (-0.72134752044f);
    f32x2 e; e.x = __builtin_amdgcn_exp2f(s.x); e.y = __builtin_amdgcn_exp2f(s.y);
    const f32x2 m = v * (q * e), r = v - m;
    f32x2 o; o.x = v.x < 0.f ? m.x : r.x; o.y = v.y < 0.f ? m.y : r.y; return o;
}

template <int ACT  > struct EpiBf16 {
    static constexpr bool PERM = true, AFTER_DRAIN = false, HAS_HOOK = false; static_assert(ACT == 0 || ACT == 1, "EpiBf16: ACT is 0 (none) or 1 (gelu_pk)");
    bf16_t* O; int ldc; const float* bias; int split_cols; size_t split_stride; float scale0;
    __device__ __forceinline__ void operator()(const f32x4 (&acc)[2][2][4][2], const Unit& u, int wr, int wc, int fr, int fq) const {
        const int row0 = u.pm * BM + wr * 64 + fr; int colt = u.pn * BM; bf16_t* base = O;
        float sc = 1.f; if (split_cols) { const int t = colt / split_cols; base += (size_t)t * split_stride; colt -= t * split_cols; if (t == 0) sc = scale0; }
        const int col0 = colt + wc * 32 + 8 * fq, bcol0 = u.pn * BM + wc * 32 + 8 * fq;
        f32x4 bv[2][2];
#pragma unroll
        for (int bj = 0; bj < 2; ++bj)
#pragma unroll
            for (int n = 0; n < 2; ++n) bv[bj][n] = bias ? *(const f32x4*)(bias + bcol0 + bj * HALF + 4 * n) : (f32x4){0.f, 0.f, 0.f, 0.f};
#pragma unroll
        for (int ai = 0; ai < 2; ++ai)
#pragma unroll
            for (int m = 0; m < 4; ++m) { bf16_t* rowp = base + (size_t)(row0 + ai * HALF + m * 16) * ldc + col0;
#pragma unroll
                for (int bj = 0; bj < 2; ++bj) { f32x4 v0 = acc[ai][bj][m][0] + bv[bj][0], v1 = acc[ai][bj][m][1] + bv[bj][1];
                    if (ACT == 1) { f32x2 a = gelu_pk((f32x2){v0[0], v0[1]}), b = gelu_pk((f32x2){v0[2], v0[3]}), c = gelu_pk((f32x2){v1[0], v1[1]}), d = gelu_pk((f32x2){v1[2], v1[3]});
                        v0 = (f32x4){a.x, a.y, b.x, b.y}; v1 = (f32x4){c.x, c.y, d.x, d.y}; }
                    v0 = v0 * sc; v1 = v1 * sc; u32x4 w; w.x = cvt_pk_bf16(v0[0], v0[1]); w.y = cvt_pk_bf16(v0[2], v0[3]); w.z = cvt_pk_bf16(v1[0], v1[1]); w.w = cvt_pk_bf16(v1[2], v1[3]);
                    *(u32x4*)(rowp + bj * HALF) = w; } }
    }
};
struct EpiF32 {
    static constexpr bool PERM = false, AFTER_DRAIN = false, HAS_HOOK = false;
    float* C; int ldc; const float* bias;
    __device__ __forceinline__ void operator()(const f32x4 (&acc)[2][2][4][2], const Unit& u, int wr, int wc, int fr, int fq) const {
        const int row0 = u.pm * BM + wr * 64 + fr, col0 = u.pn * BM + wc * 32 + 4 * fq;
        f32x4 bv[2][2];
#pragma unroll
        for (int bj = 0; bj < 2; ++bj)
#pragma unroll
            for (int n = 0; n < 2; ++n) bv[bj][n] = bias ? *(const f32x4*)(bias + col0 + bj * HALF + n * 16) : (f32x4){0.f, 0.f, 0.f, 0.f};
#pragma unroll
        for (int ai = 0; ai < 2; ++ai)
#pragma unroll
            for (int m = 0; m < 4; ++m) { float* rowp = C + (size_t)(row0 + ai * HALF + m * 16) * ldc + col0;
#pragma unroll
                for (int bj = 0; bj < 2; ++bj)
#pragma unroll
                    for (int n = 0; n < 2; ++n) *(f32x4*)(rowp + bj * HALF + n * 16) = acc[ai][bj][m][n] + bv[bj][n]; }
    }
};
__device__ __forceinline__ float bf_lo(unsigned w) { return __uint_as_float(w << 16); }
__device__ __forceinline__ float bf_hi(unsigned w) { return __uint_as_float(w & 0xffff0000u); }
__device__ __forceinline__ float fsigmoid(float x) { return __builtin_amdgcn_rcpf(1.0f + __expf(-x)); }
__device__ __forceinline__ float fsilu(float x) { return x * fsigmoid(x); }
__device__ __forceinline__ int batch_of_row(int row) { return row < 4096 ? 0 : (row < 8192 ? 1 : (row - 8192 < 128 ? row - 8190 : 129)); }
typedef unsigned u32x2 __attribute__((ext_vector_type(2)));

struct EpiZ {
    static constexpr bool PERM = true, AFTER_DRAIN = false, HAS_HOOK = false;
    bf16_t* O; int ldc; int gate_pn0; int var;
    __device__ __forceinline__ void operator()(const f32x4 (&acc)[2][2][4][2], const Unit& u, int wr, int wc, int fr, int fq) const {
        if (var & 1) return;
        const int row0 = u.pm * BM + wr * 64 + fr, col0 = u.pn * BM + wc * 32 + 8 * fq; const bool gt = (u.pn >= gate_pn0) && !(var & 2);
#pragma unroll
        for (int ai = 0; ai < 2; ++ai)
#pragma unroll
            for (int m = 0; m < 4; ++m) { bf16_t* rowp = O + (size_t)(row0 + ai * HALF + m * 16) * ldc + col0;
#pragma unroll
                for (int bj = 0; bj < 2; ++bj) { f32x4 v0 = acc[ai][bj][m][0], v1 = acc[ai][bj][m][1];
                    if (gt) {
#pragma unroll
                        for (int j = 0; j < 4; ++j) { v0[j] = 1.0f + __expf(-fminf(fmaxf(v0[j], -40.f), 40.f)); v1[j] = 1.0f + __expf(-fminf(fmaxf(v1[j], -40.f), 40.f)); } }
                    u32x4 w; w.x = cvt_pk_bf16(v0[0], v0[1]); w.y = cvt_pk_bf16(v0[2], v0[3]); w.z = cvt_pk_bf16(v1[0], v1[1]); w.w = cvt_pk_bf16(v1[2], v1[3]);
                    *(u32x4*)(rowp + bj * HALF) = w; } }
    }
};
struct EpiProjR {
    static constexpr bool PERM = true, AFTER_DRAIN = false, HAS_HOOK = true;
    const bf16_t* Z; int ldz; int gcol0; float* PART; bf16_t* MG; int mp0; int var;
    __device__ __forceinline__ bool hook_at(const Unit& u, int t) const { return u.nt == 64 && (t == 32 || t == 48) && !(var & 2); }
    __device__ __forceinline__ void hook(f32x4 (&acc)[2][2][4][2], const Unit& u, int t, int wr, int wc, int fr, int fq) const {
        int row0 = u.pm * BM + wr * 64 + fr, col0 = u.pn * BM + wc * 32 + 8 * fq; asm volatile("" : "+v"(row0), "+v"(col0));
        const int gp = gcol0 + (t == 32 ? 0 : 2048);
#pragma unroll
        for (int ai = 0; ai < 2; ++ai) {
            u32x4 gprev[4][2], gnext[4][2];
#pragma unroll
            for (int m = 0; m < 4; ++m) { const bf16_t* zp = Z + (size_t)(row0 + ai * HALF + m * 16) * ldz + gp + col0;
#pragma unroll
                for (int bj = 0; bj < 2; ++bj) { gprev[m][bj] = *(const u32x4*)(zp + bj * HALF); gnext[m][bj] = *(const u32x4*)(zp + 2048 + bj * HALF); } }
#pragma unroll
            for (int m = 0; m < 4; ++m)
#pragma unroll
                for (int bj = 0; bj < 2; ++bj) { const u32x4 gpv = gprev[m][bj], gnx = gnext[m][bj];
                    f32x4 r0, r1; r0[0] = bf_lo(gnx.x) * __builtin_amdgcn_rcpf(bf_lo(gpv.x)); r0[1] = bf_hi(gnx.x) * __builtin_amdgcn_rcpf(bf_hi(gpv.x));
                    r0[2] = bf_lo(gnx.y) * __builtin_amdgcn_rcpf(bf_lo(gpv.y)); r0[3] = bf_hi(gnx.y) * __builtin_amdgcn_rcpf(bf_hi(gpv.y));
                    r1[0] = bf_lo(gnx.z) * __builtin_amdgcn_rcpf(bf_lo(gpv.z)); r1[1] = bf_hi(gnx.z) * __builtin_amdgcn_rcpf(bf_hi(gpv.z));
                    r1[2] = bf_lo(gnx.w) * __builtin_amdgcn_rcpf(bf_lo(gpv.w)); r1[3] = bf_hi(gnx.w) * __builtin_amdgcn_rcpf(bf_hi(gpv.w));
                    acc[ai][bj][m][0] = acc[ai][bj][m][0] * r0; acc[ai][bj][m][1] = acc[ai][bj][m][1] * r1; }
            asm volatile("" ::: "memory"); }
        asm volatile("s_waitcnt vmcnt(0)" ::: "memory");
    }
    __device__ __forceinline__ void operator()(const f32x4 (&acc)[2][2][4][2], const Unit& u, int wr, int wc, int fr, int fq) const {
        if (var & 1) return;
        int row0 = u.pm * BM + wr * 64 + fr, col0 = u.pn * BM + wc * 32 + 8 * fq; asm volatile("" : "+v"(row0), "+v"(col0));
        const bool mini = u.nt != 64; const int br = mini ? (u.kt0 < 32 ? 0 : (u.kt0 < 48 ? 1 : 2)) : 2;
#pragma unroll
        for (int ai = 0; ai < 2; ++ai) {
            u32x4 gw[4][2];
#pragma unroll
            for (int m = 0; m < 4; ++m) { const bf16_t* zp = Z + (size_t)(row0 + ai * HALF + m * 16) * ldz + gcol0 + br * 2048 + col0;
#pragma unroll
                for (int bj = 0; bj < 2; ++bj) gw[m][bj] = *(const u32x4*)(zp + bj * HALF); }
#pragma unroll
            for (int m = 0; m < 4; ++m) { const int row = row0 + ai * HALF + m * 16;
#pragma unroll
                for (int bj = 0; bj < 2; ++bj) { const int col = col0 + bj * HALF; const u32x4 gq = gw[m][bj];
                    f32x4 g0, g1; g0[0] = __builtin_amdgcn_rcpf(bf_lo(gq.x)); g0[1] = __builtin_amdgcn_rcpf(bf_hi(gq.x)); g0[2] = __builtin_amdgcn_rcpf(bf_lo(gq.y)); g0[3] = __builtin_amdgcn_rcpf(bf_hi(gq.y));
                    g1[0] = __builtin_amdgcn_rcpf(bf_lo(gq.z)); g1[1] = __builtin_amdgcn_rcpf(bf_hi(gq.z)); g1[2] = __builtin_amdgcn_rcpf(bf_lo(gq.w)); g1[3] = __builtin_amdgcn_rcpf(bf_hi(gq.w));
                    const f32x4 v0 = acc[ai][bj][m][0] * g0, v1 = acc[ai][bj][m][1] * g1;
                    if (!mini) { u32x4 w; w.x = cvt_pk_bf16(v0[0], v0[1]); w.y = cvt_pk_bf16(v0[2], v0[3]); w.z = cvt_pk_bf16(v1[0], v1[1]); w.w = cvt_pk_bf16(v1[2], v1[3]); *(u32x4*)(MG + (size_t)row * 2048 + col) = w; }
                    else if (ai == 0) { float* pp = PART + ((size_t)(u.kt0 / u.nt) * 128 + (row - mp0)) * 2048 + col; *(f32x4*)pp = v0; *(f32x4*)(pp + 4) = v1; } } }
            asm volatile("" ::: "memory"); }
    }
};
struct EpiResid {
    static constexpr bool PERM = false, AFTER_DRAIN = false, HAS_HOOK = false;
    float* X; const float* gate; int ldg; float* PART; int mp0; int var;
    __device__ __forceinline__ void operator()(const f32x4 (&acc)[2][2][4][2], const Unit& u, int wr, int wc, int fr, int fq) const {
        if (var & 1) return;
        int row0 = u.pm * BM + wr * 64 + fr, col0 = u.pn * BM + wc * 32 + 4 * fq; asm volatile("" : "+v"(row0), "+v"(col0)); const bool mini = u.pm >= 32;
#pragma unroll
        for (int ai = 0; ai < 2; ++ai)
#pragma unroll
            for (int mp = 0; mp < 2; ++mp) {
                f32x4 gg[2][4], xx[2][4];
#pragma unroll
                for (int mm = 0; mm < 2; ++mm) { const int row = row0 + ai * HALF + (2 * mp + mm) * 16; const float* gp = gate + (size_t)batch_of_row(row) * ldg + col0; const float* xp = X + (size_t)row * 2048 + col0;
#pragma unroll
                    for (int q = 0; q < 4; ++q) { gg[mm][q] = *(const f32x4*)(gp + (q >> 1) * HALF + (q & 1) * 16); if (!mini) xx[mm][q] = *(const f32x4*)(xp + (q >> 1) * HALF + (q & 1) * 16); } }
#pragma unroll
                for (int mm = 0; mm < 2; ++mm) { const int m = 2 * mp + mm, row = row0 + ai * HALF + m * 16; float* xp = X + (size_t)row * 2048 + col0;
#pragma unroll
                    for (int q = 0; q < 4; ++q) { float* xq = xp + (q >> 1) * HALF + (q & 1) * 16; const f32x4 v = gg[mm][q] * acc[ai][q >> 1][m][q & 1];
                        if (!mini) *(f32x4*)xq = xx[mm][q] + v;
                        else if (ai == 0) *(f32x4*)(PART + ((size_t)(u.kt0 / u.nt) * 128 + (row - mp0)) * 2048 + col0 + (q >> 1) * HALF + (q & 1) * 16) = v; } }
                asm volatile("" ::: "memory"); }
    }
};
struct EpiSwiGLU {
    static constexpr bool PERM = true, AFTER_DRAIN = false, HAS_HOOK = false;
    bf16_t* ACT; int ldc;
    __device__ __forceinline__ void operator()(const f32x4 (&acc)[2][2][4][2], const Unit& u, int wr, int wc, int fr, int fq) const {
        const int row0 = u.pm * BM + wr * 64 + fr, col0 = u.pn * HALF + wc * 32 + 8 * fq;
#pragma unroll
        for (int ai = 0; ai < 2; ++ai)
#pragma unroll
            for (int m = 0; m < 4; ++m) { bf16_t* rowp = ACT + (size_t)(row0 + ai * HALF + m * 16) * ldc + col0;
                const f32x4 a0 = acc[ai][0][m][0], a1 = acc[ai][0][m][1], b0 = acc[ai][1][m][0], b1 = acc[ai][1][m][1];
                u32x4 w; w.x = cvt_pk_bf16(fsilu(a0[0]) * b0[0], fsilu(a0[1]) * b0[1]); w.y = cvt_pk_bf16(fsilu(a0[2]) * b0[2], fsilu(a0[3]) * b0[3]);
                w.z = cvt_pk_bf16(fsilu(a1[0]) * b1[0], fsilu(a1[1]) * b1[1]); w.w = cvt_pk_bf16(fsilu(a1[2]) * b1[2], fsilu(a1[3]) * b1[3]);
                *(u32x4*)rowp = w; }
    }
};
template <class Epi, class Sched, bool ALIGN_EPI = false, bool SP2 = false>
__device__ __forceinline__ void gemm_phase(PG8_LAS unsigned char* lds, const Gemm g, const Sched& S, const Epi& E) {
    int tid_ = threadIdx.x; asm volatile("" : "+v"(tid_));
    const int tid = tid_, wid = __builtin_amdgcn_readfirstlane(tid >> 6), lane = tid & 63, wr = wid >> 2, wc = wid & 3, fr = lane & 15, fq = lane >> 4;
    const int LD = g.ld;
    unsigned voffA[2], voffB[2];
#pragma unroll
    for (int i = 0; i < 2; ++i) { int R, C; stage_rc(tid * 16 + i * 8192, R, C); const int Rb = Epi::PERM ? ((R & ~31) + perm32(R & 31)) : R;
        voffA[i] = (unsigned)(R * LD + C) * 2u; voffB[i] = (unsigned)(Rb * LD + C) * 2u; }
    const size_t kstep = (size_t)(BK * 2);
    const size_t hstep = (size_t)HALF * LD * 2;
    const size_t tstep = 2 * hstep;
    const unsigned ldsw = (unsigned)wid * 1024u;
    const int aoff = lds_byte(wr * 64 + fr, fq * 8), boff = lds_byte(wc * 32 + fr, fq * 8);
#define PG8_SA(b, h) (((b) * 2 + (h)) * HTB)
#define PG8_SB(b, h) ((4 + (b) * 2 + (h)) * HTB)
#define PG8_STAGE(bufoff, gbase, voff) do { _Pragma("unroll") for (int _i = 0; _i < 2; ++_i) \
        __builtin_amdgcn_global_load_lds((const unsigned*)((const char*)(gbase) + (voff)[_i]), (PG8_LAS unsigned*)(lds + (bufoff) + ldsw + _i * 8192), 16, 0, 0); } while (0)
#define PG8_LDA(dst, b, h) do { _Pragma("unroll") for (int m = 0; m < 4; ++m) _Pragma("unroll") for (int k = 0; k < 2; ++k) dst[m][k] = *(const PG8_LAS bf16x8*)(lds + PG8_SA(b, h) + aoff + m * 2048 + k * 1024); } while (0)
#define PG8_LDB(dst, b, h) do { _Pragma("unroll") for (int n = 0; n < 2; ++n) _Pragma("unroll") for (int k = 0; k < 2; ++k) dst[n][k] = *(const PG8_LAS bf16x8*)(lds + PG8_SB(b, h) + boff + n * 2048 + k * 1024); } while (0)
#define PG8_MMA(ai, bj, At, Bt) do { __builtin_amdgcn_s_setprio(1); _Pragma("unroll") for (int m = 0; m < 4; ++m) _Pragma("unroll") for (int n = 0; n < 2; ++n) _Pragma("unroll") for (int k = 0; k < 2; ++k) \
        acc[ai][bj][m][n] = __builtin_amdgcn_mfma_f32_16x16x32_bf16(Bt[n][k], At[m][k], acc[ai][bj][m][n], 0, 0, 0); __builtin_amdgcn_s_setprio(0); } while (0)
#define PG8_WAIT_V(n) asm volatile("s_waitcnt vmcnt(" #n ")" ::: "memory")
#define PG8_WAIT_L(n) asm volatile("s_waitcnt lgkmcnt(" #n ")" ::: "memory")
#define PG8_BAR __builtin_amdgcn_s_barrier()
#define PG8_SCHED __builtin_amdgcn_sched_barrier(0)
    Unit cur, nxt; int ui = 0;
    if (!S.next(0, cur)) return;
    f32x4 acc[2][2][4][2];
#pragma unroll
    for (int a = 0; a < 2; ++a)
#pragma unroll
        for (int b = 0; b < 2; ++b)
#pragma unroll
            for (int m = 0; m < 4; ++m)
#pragma unroll
                for (int n = 0; n < 2; ++n) acc[a][b][m][n] = (f32x4){0.f, 0.f, 0.f, 0.f};
    bf16x8 At[4][2], B0[2][2], B1[2][2];
    const char* cA = (const char*)g.A + (size_t)cur.pm * tstep + (size_t)cur.kt0 * kstep; const char* cB = (const char*)g.Bt + (size_t)cur.pn * tstep + (size_t)cur.kt0 * kstep;
    S.a_ready(cur);
    if constexpr (SP2) {
        PG8_STAGE(PG8_SB(0, 0), cB, voffB); PG8_STAGE(PG8_SB(0, 1), cB + hstep, voffB); PG8_STAGE(PG8_SA(0, 0), cA, voffA); PG8_STAGE(PG8_SA(0, 1), cA + hstep, voffA);
        if (wr == 1) PG8_BAR;
        PG8_WAIT_V(2); PG8_BAR;
        PG8_STAGE(PG8_SB(1, 0), cB + kstep, voffB); PG8_STAGE(PG8_SA(1, 0), cA + kstep, voffA); PG8_STAGE(PG8_SB(1, 1), cB + hstep + kstep, voffB);
        PG8_WAIT_V(6); PG8_BAR;
    } else {
        PG8_STAGE(PG8_SB(0, 0), cB, voffB); PG8_STAGE(PG8_SA(0, 0), cA, voffA); PG8_STAGE(PG8_SB(0, 1), cB + hstep, voffB); PG8_STAGE(PG8_SA(0, 1), cA + hstep, voffA);
        if (wr == 1) PG8_BAR;
        PG8_WAIT_V(4); PG8_BAR;
        PG8_STAGE(PG8_SB(1, 0), cB + kstep, voffB); PG8_STAGE(PG8_SA(1, 0), cA + kstep, voffA); PG8_STAGE(PG8_SB(1, 1), cB + hstep + kstep, voffB);
        PG8_WAIT_V(6); PG8_BAR;
    }
    for (;;) {
        const bool has_next = S.next(ui + 1, nxt);
        const char* nA = has_next ? (const char*)g.A + (size_t)nxt.pm * tstep + (size_t)nxt.kt0 * kstep : cA; const char* nB = has_next ? (const char*)g.Bt + (size_t)nxt.pn * tstep + (size_t)nxt.kt0 * kstep : cB;
        const int nt = cur.nt;
        for (int t = 0; t < nt; t += 2) {
            const bool last = (t == nt - 2);
            if constexpr (Epi::HAS_HOOK) { if (E.hook_at(cur, t)) E.hook(acc, cur, t, wr, wc, fr, fq); }
            const char* a1 = cA + (size_t)(t + 1) * kstep;
            const char* a2 = last ? nA : cA + (size_t)(t + 2) * kstep; const char* b2 = last ? nB : cB + (size_t)(t + 2) * kstep;
            const char* a3 = a2 + kstep; const char* b3 = b2 + kstep;
            if (last && has_next) S.a_ready(nxt);
            if constexpr (SP2) {
            PG8_LDB(B0, 0, 0); PG8_LDB(B1, 0, 1); PG8_SCHED; PG8_LDA(At, 0, 0); PG8_STAGE(PG8_SA(1, 1), a1 + hstep, voffA);
            PG8_WAIT_V(8); PG8_WAIT_L(0); PG8_BAR; PG8_MMA(0, 0, At, B0); PG8_MMA(0, 1, At, B1); PG8_BAR; PG8_SCHED;
            PG8_LDA(At, 0, 1); PG8_STAGE(PG8_SB(0, 0), b2, voffB); PG8_STAGE(PG8_SB(0, 1), b2 + hstep, voffB); PG8_STAGE(PG8_SA(0, 0), a2, voffA);
            PG8_WAIT_V(8); PG8_WAIT_L(0); PG8_BAR; PG8_MMA(1, 0, At, B0); PG8_MMA(1, 1, At, B1); PG8_BAR; PG8_SCHED;
            PG8_LDB(B0, 1, 0); PG8_LDB(B1, 1, 1); PG8_SCHED; PG8_LDA(At, 1, 0); PG8_STAGE(PG8_SA(0, 1), a2 + hstep, voffA);
            PG8_WAIT_V(8); PG8_WAIT_L(0); PG8_BAR; PG8_MMA(0, 0, At, B0); PG8_MMA(0, 1, At, B1); PG8_BAR; PG8_SCHED;
            PG8_LDA(At, 1, 1); PG8_STAGE(PG8_SB(1, 0), b3, voffB); PG8_STAGE(PG8_SB(1, 1), b3 + hstep, voffB); PG8_STAGE(PG8_SA(1, 0), a3, voffA);
            PG8_WAIT_V(8); PG8_WAIT_L(0); PG8_BAR; PG8_MMA(1, 0, At, B0); PG8_MMA(1, 1, At, B1); PG8_BAR; PG8_SCHED;
            } else {
            PG8_LDB(B0, 0, 0); PG8_SCHED; PG8_LDA(At, 0, 0); PG8_STAGE(PG8_SA(1, 1), a1 + hstep, voffA);
            PG8_WAIT_L(8); PG8_BAR; PG8_WAIT_L(0); PG8_MMA(0, 0, At, B0); PG8_BAR; PG8_SCHED;
            PG8_LDB(B1, 0, 1); PG8_STAGE(PG8_SB(0, 0), b2, voffB);
            PG8_BAR; PG8_WAIT_L(0); PG8_MMA(0, 1, At, B1); PG8_BAR;
            PG8_LDA(At, 0, 1); PG8_STAGE(PG8_SA(0, 0), a2, voffA);
            PG8_BAR; PG8_WAIT_L(0); PG8_MMA(1, 0, At, B0); PG8_BAR; PG8_SCHED;
            PG8_STAGE(PG8_SB(0, 1), b2 + hstep, voffB);
            PG8_WAIT_V(6); PG8_BAR; PG8_MMA(1, 1, At, B1); PG8_BAR;
            PG8_LDB(B0, 1, 0); PG8_SCHED; PG8_LDA(At, 1, 0); PG8_STAGE(PG8_SA(0, 1), a2 + hstep, voffA);
            PG8_WAIT_L(8); PG8_BAR; PG8_WAIT_L(0); PG8_MMA(0, 0, At, B0); PG8_BAR; PG8_SCHED;
            PG8_LDB(B1, 1, 1); PG8_STAGE(PG8_SB(1, 0), b3, voffB);
            PG8_BAR; PG8_WAIT_L(0); PG8_MMA(0, 1, At, B1); PG8_BAR;
            PG8_LDA(At, 1, 1); PG8_STAGE(PG8_SA(1, 0), a3, voffA);
            PG8_BAR; PG8_WAIT_L(0); PG8_MMA(1, 0, At, B0); PG8_BAR; PG8_SCHED;
            PG8_STAGE(PG8_SB(1, 1), b3 + hstep, voffB);
            PG8_WAIT_V(6); PG8_BAR; PG8_MMA(1, 1, At, B1); PG8_BAR;
            }
        }
        if constexpr (ALIGN_EPI) { if (wr == 0) PG8_BAR; }
        if constexpr (!Epi::AFTER_DRAIN) { E(acc, cur, wr, wc, fr, fq); S.done(cur); }
        if (!has_next) break;
#pragma unroll
        for (int a = 0; a < 2; ++a)
#pragma unroll
            for (int b = 0; b < 2; ++b)
#pragma unroll
                for (int m = 0; m < 4; ++m)
#pragma unroll
                    for (int n = 0; n < 2; ++n) acc[a][b][m][n] = (f32x4){0.f, 0.f, 0.f, 0.f};
        cur = nxt; cA = nA; cB = nB; ++ui;
        if constexpr (ALIGN_EPI) { if (wr == 1) PG8_BAR; }
    }
    PG8_WAIT_V(0);
    if constexpr (!ALIGN_EPI) { if (wr == 0) PG8_BAR; }
    PG8_BAR;
    if constexpr (Epi::AFTER_DRAIN) { E.fused(acc, cur, wr, wc, fr, fq, lds, wid, lane); S.done(cur); }
#undef PG8_SA
#undef PG8_SB
#undef PG8_STAGE
#undef PG8_LDA
#undef PG8_LDB
#undef PG8_MMA
#undef PG8_WAIT_V
#undef PG8_WAIT_L
#undef PG8_BAR
#undef PG8_SCHED
}
}
constexpr int NWAVES = 8, NT = NWAVES * 64;
constexpr int D = 2048, MP = 8192, MS = 128, MR = MP + MS, MT = 8448;
constexpr int SEQ = 4096;
constexpr int NZ = 15872;
constexpr int NZW = 16128;
constexpr int ZQA = 0, ZKA = 1024, ZVA = 2048, ZGA = 4096, ZUB = 6144, ZVB = 7168, ZQC = 8192, ZKC = 9216, ZVC = 9472, ZGT = 9728, ZLR = 15872;
constexpr int NIN = 15888, FF = 5632, NADA = 12288;
constexpr int MOD_SH1 = 0, MOD_SC1 = 2048, MOD_G1 = 4096, MOD_SH2 = 6144, MOD_SC2 = 8192, MOD_G2 = 10240;
constexpr float EPS = 1e-6f;
constexpr size_t O_YP = 0, O_YS = 16777216, O_SGP = 17039360, O_SGS = 19136512, O_CKP = 153354240, O_CVP = 153485312, O_CKS = 153616384, O_CVS = 153681920, O_GMV = 153747456, O_END = 154009600;
enum { I_XP = 0, I_XS, I_CP, I_CS, I_SGLA, I_CK, I_CV, I_WADA, I_BADA, I_N1W, I_N2W, I_WIN, I_WGK2, I_BGK, I_GLANW, I_GMNW, I_GMNB, I_GMWS, I_GMBS, I_SINK, I_WPA, I_WPB, I_WPC, I_WO, I_WFI, I_WFO, I_FNW, N_IN };

constexpr size_t MiB = 1u << 20;
constexpr size_t WS_CTL = 0, CTL_ZERO_BYTES = 1 * MiB;
constexpr size_t WS_WADA = 2 * MiB;
constexpr size_t WS_CA   = WS_WADA + 2 * 48 * MiB;
constexpr size_t WS_MOD  = WS_CA + 1 * MiB;
constexpr size_t WS_WIN  = WS_MOD + 24 * MiB;
constexpr size_t WS_WPRJ = WS_WIN + 2 * 63 * MiB;
constexpr size_t WS_WO   = WS_WPRJ + 32 * MiB;
constexpr size_t WS_WFI  = WS_WO + 16 * MiB;
constexpr size_t WS_WFO  = WS_WFI + 88 * MiB;
constexpr size_t WS_X    = WS_WFO + 44 * MiB;
constexpr size_t WS_H    = WS_X + 66 * MiB;
constexpr size_t WS_Z    = WS_H + 33 * MiB;
constexpr size_t WS_OABC = WS_Z + 260 * MiB;
constexpr size_t WS_M32  = WS_OABC + 66 * MiB;
constexpr size_t WS_MG   = WS_M32 + 66 * MiB;
constexpr size_t WS_ACT  = WS_MG + 33 * MiB;
constexpr size_t WS_GK   = WS_ACT + 91 * MiB;
constexpr size_t WS_OB   = WS_GK + 33 * MiB;
constexpr size_t WS_VN   = WS_OB + 65 * MiB;
constexpr size_t WS_QT   = WS_VN + 33 * MiB;
constexpr size_t WS_KH   = WS_QT + 16 * MiB;
constexpr size_t WS_AI   = WS_KH + 16 * MiB;
constexpr size_t WS_GAM  = WS_AI + 4 * MiB;
constexpr size_t WS_GST  = WS_GAM + 1 * MiB;
constexpr size_t WS_GAMS = WS_GST + 32 * MiB;
constexpr size_t WS_VNB  = WS_GAMS + 1 * MiB;
constexpr size_t WS_PART = WS_VNB + 16 * MiB;
constexpr size_t WS_END  = WS_PART + 32 * MiB;
static_assert((size_t)MT * NZ * 2 <= 260 * MiB && (size_t)MT * FF * 2 <= 91 * MiB && (size_t)NZW * D * 2 <= 63 * MiB, "ws map");
constexpr int CW_BAR = 4096;

constexpr int RING_BYTES = 131072;
constexpr int MISC_OFF = 150 * 1024;
constexpr int LDS_BYTES = 152 * 1024;

#define GAS __attribute__((address_space(1)))
#define LAS __attribute__((address_space(3)))
typedef unsigned short bf16;
typedef unsigned v4u __attribute__((ext_vector_type(4)));
typedef unsigned v2u __attribute__((ext_vector_type(2)));
typedef float f32x4 __attribute__((ext_vector_type(4)));
#define LDS_WAIT() asm volatile("s_waitcnt lgkmcnt(0)" ::: "memory")
#define VM_WAIT() asm volatile("s_waitcnt vmcnt(0)" ::: "memory")
typedef __bf16 bf16x2_t __attribute__((ext_vector_type(2)));
__device__ __forceinline__ unsigned pk2(float lo, float hi) { bf16x2_t v; v[0] = (__bf16)lo; v[1] = (__bf16)hi; return __builtin_bit_cast(unsigned, v); }
__device__ __forceinline__ unsigned f2bf(float f) { return pk2(f, 0.f) & 0xffffu; }
__device__ __forceinline__ float bf2f(bf16 b) { return __uint_as_float(((unsigned)b) << 16); }
__device__ __forceinline__ float wave_sum(float v) {
#pragma unroll
    for (int o = 1; o < 64; o <<= 1) v += __shfl_xor(v, o);
    return v;
}
__device__ __forceinline__ float sigmoidf_(float x) { return 1.0f / (1.0f + __expf(-x)); }
__device__ __forceinline__ float siluf_(float x) { return x * sigmoidf_(x); }
__device__ __forceinline__ float geluf_(float x) { return x * sigmoidf_(1.5957691216057308f * (x + 0.044715f * x * x * x)); }
__device__ __forceinline__ float logsigmoidf_(float x) { return fminf(x, 0.f) - log1pf(expf(-fabsf(x))); }
#define XB_TMO      128
#define XB_XCNT(j)  (256  + 64 * (j))
#define XB_XSUB(j)  (1280 + 64 * (j))
#define XB_XGEN(j)  (2304 + 64 * (j))
#define XB_TOP      3328
#define XB_TOPGEN   3392
#define XCD_BAR_WORDS 3456
#define XB_SPIN_CAP (1u << 18)

__device__ __forceinline__ unsigned xb_ld(unsigned* p)              { return __hip_atomic_load(p, __ATOMIC_RELAXED, __HIP_MEMORY_SCOPE_AGENT); }
__device__ __forceinline__ unsigned xb_add(unsigned* p, unsigned v) { return __hip_atomic_fetch_add(p, v, __ATOMIC_RELAXED, __HIP_MEMORY_SCOPE_AGENT); }
__device__ __forceinline__ unsigned xb_xcc_id() { return (unsigned)__builtin_amdgcn_s_getreg((3 << 11) | 20) & 0xFu; }
#define XB_SPIN(cond, bar) do { unsigned _sp = 0; while (cond) { __builtin_amdgcn_s_sleep(1); \
    if ((++_sp & 255u) == 0u) { if (xb_ld(&(bar)[XB_TMO])) break; if (_sp > XB_SPIN_CAP) { atomicAdd(&(bar)[XB_TMO], 1u); break; } } } } while (0)

struct XcdBarrier {
    unsigned* bar; unsigned x;
    volatile LAS unsigned* st;
};

__device__ __forceinline__ XcdBarrier xcd_barrier_post(unsigned* bar, volatile LAS unsigned* st) {
    XcdBarrier b; b.bar = bar; b.x = xb_xcc_id(); b.st = st;
    if (threadIdx.x == 0) (void)xb_add(&bar[XB_XCNT(b.x)], 1u);
    return b;
}
__device__ __forceinline__ void xcd_barrier_complete(unsigned* bar, unsigned x, unsigned& nloc, unsigned& nx) {
    const unsigned G = gridDim.x * gridDim.y * gridDim.z;
    unsigned sum, cnt, mine, sp = 0u;
    for (;;) {
        sum = 0u; cnt = 0u; mine = 0u;
#pragma unroll
        for (unsigned j = 0; j < 16; ++j) { const unsigned c = xb_ld(&bar[XB_XCNT(j)]); sum += c; cnt += (c > 0u) ? 1u : 0u; mine = (j == x) ? c : mine; }
        if (sum == G) break;
        __builtin_amdgcn_s_sleep(1);
        if ((++sp & 255u) == 0u) { if (xb_ld(&bar[XB_TMO])) break; if (sp > XB_SPIN_CAP) { atomicAdd(&bar[XB_TMO], 1u); break; } }
    }
    nloc = mine > 0u ? mine : 1u; nx = cnt > 0u ? cnt : 1u;
}

__device__ __forceinline__ void xcd_barrier(const XcdBarrier& b) {
    asm volatile("s_waitcnt vmcnt(0)" ::: "memory");
    __syncthreads();
    if (threadIdx.x == 0) {
        unsigned* bar = b.bar;
        __builtin_amdgcn_s_waitcnt(0);
        unsigned nloc = b.st[0], nx = b.st[1];
        if (nloc == 0u) { xcd_barrier_complete(bar, b.x, nloc, nx); b.st[0] = nloc; b.st[1] = nx; }
        const unsigned old = xb_add(&bar[XB_XSUB(b.x)], 1u);
        const unsigned gen = old / nloc;
        if (old + 1u == (gen + 1u) * nloc) {
            __builtin_amdgcn_fence(__ATOMIC_RELEASE, "agent");
            asm volatile("s_waitcnt vmcnt(0)" ::: "memory");
            const unsigned og = xb_add(&bar[XB_TOP], 1u);
            const unsigned tg = og / nx;
            if (og + 1u == (tg + 1u) * nx) xb_add(&bar[XB_TOPGEN], 1u);
            else XB_SPIN(xb_ld(&bar[XB_TOPGEN]) == tg, bar);
            __builtin_amdgcn_fence(__ATOMIC_ACQUIRE, "agent");
            xb_add(&bar[XB_XGEN(b.x)], 1u);
            asm volatile("s_waitcnt vmcnt(0)" ::: "memory");
        } else {
            XB_SPIN(xb_ld(&bar[XB_XGEN(b.x)]) == gen, bar);
            __builtin_amdgcn_fence(__ATOMIC_ACQUIRE, "agent");
            asm volatile("s_waitcnt vmcnt(0)" ::: "memory");
        }
    }
    __syncthreads();
}
struct Prm { const float* in[N_IN]; float* out; unsigned char* ws; int ph_lo, ph_hi, var, pad; };
static_assert(sizeof(Prm) == N_IN * 8 + 32, "Prm has no padding bytes");
struct Frame {
    LAS unsigned char* lds;
    int vcu, G;
};
struct Tix { int tid, lane, wave; };
__device__ __forceinline__ Tix tix() { int t = threadIdx.x; asm volatile("" : "+v"(t)); Tix r; r.tid = t; r.lane = t & 63; r.wave = __builtin_amdgcn_readfirstlane(t >> 6); return r; }

__device__ __forceinline__ int map_col(int mode, int n) {
    if (mode == 1) return n < 6144 ? n : (n < 6160 ? ZLR + (n - 6144) : n - 16);
    if (mode == 2) return n < FF ? ((n >> 7) * 256 + (n & 127)) : ((((n - FF) >> 7) * 256) + 128 + ((n - FF) & 127));
    return n;
}
__device__ __forceinline__ void conv_item(const float* W, int K, int N, bf16* WT, int ld, int koff, int mode, LAS float* scr, int item, int lane) {
    const int nkb = K / 64, nb = item / nkb, kb = item % nkb, k0 = 64 * kb, n0 = 64 * nb;
    const int q = lane & 15, kr = lane >> 4; const bool okc = (n0 + 4 * q) < N;
    f32x4 v[16];
#pragma unroll
    for (int i = 0; i < 16; ++i) v[i] = okc ? *(const f32x4*)(W + (size_t)(k0 + 4 * i + kr) * N + n0 + 4 * q) : (f32x4){0.f, 0.f, 0.f, 0.f};
#pragma unroll
    for (int i = 0; i < 16; ++i) { LAS float* s = scr + (4 * i + kr) * 65 + 4 * q; s[0] = v[i].x; s[1] = v[i].y; s[2] = v[i].z; s[3] = v[i].w; }
    LDS_WAIT(); asm volatile("" ::: "memory");
    const int c = lane & 7;
#pragma unroll
    for (int j = 0; j < 8; ++j) { const int n = (lane >> 3) + 8 * j; const LAS float* s = scr + (8 * c) * 65 + n;
        v4u o; o.x = pk2(s[0 * 65], s[1 * 65]); o.y = pk2(s[2 * 65], s[3 * 65]); o.z = pk2(s[4 * 65], s[5 * 65]); o.w = pk2(s[6 * 65], s[7 * 65]);
        if (n0 + n < N) *(GAS v4u*)(WT + (size_t)map_col(mode, n0 + n) * ld + koff + k0 + 8 * c) = o; }
    LDS_WAIT(); asm volatile("" ::: "memory");
}
struct ConvDesc { const float* W; bf16* WT; int K, N, ld, koff, mode, items; };

__device__ __forceinline__ void phase_convert(Frame& F) {
    const Tix T = tix();
    const __attribute__((address_space(4))) Prm* Pk = (const __attribute__((address_space(4))) Prm*)__builtin_amdgcn_kernarg_segment_ptr(); asm volatile("" : "+s"(Pk));
    LAS float* scr = (LAS float*)(F.lds + T.wave * 16640);
    const int gw = F.vcu * NWAVES + T.wave, NGW = F.G * NWAVES;
    unsigned char* ws = Pk->ws;
    for (int l = 0; l < 2; ++l) {
        for (int mi = 1; mi < 8; ++mi) {
            ConvDesc d;
            if (mi == 0)      { d.W = Pk->in[I_WADA] + (size_t)l * D * NADA; d.WT = (bf16*)(ws + WS_WADA) + (size_t)l * NADA * D; d.K = D; d.N = NADA; d.ld = D; d.koff = 0; d.mode = 0; }
            else if (mi == 1) { d.W = Pk->in[I_WIN] + (size_t)l * D * NIN;   d.WT = (bf16*)(ws + WS_WIN) + (size_t)l * NZW * D;    d.K = D; d.N = NIN;  d.ld = D; d.koff = 0; d.mode = 1; }
            else if (mi == 2) { d.W = Pk->in[I_WPA] + (size_t)l * 2048 * D;  d.WT = (bf16*)(ws + WS_WPRJ) + (size_t)l * D * 4096; d.K = 2048; d.N = D; d.ld = 4096; d.koff = 0; d.mode = 0; }
            else if (mi == 3) { d.W = Pk->in[I_WPB] + (size_t)l * 1024 * D;  d.WT = (bf16*)(ws + WS_WPRJ) + (size_t)l * D * 4096; d.K = 1024; d.N = D; d.ld = 4096; d.koff = 2048; d.mode = 0; }
            else if (mi == 4) { d.W = Pk->in[I_WPC] + (size_t)l * 1024 * D;  d.WT = (bf16*)(ws + WS_WPRJ) + (size_t)l * D * 4096; d.K = 1024; d.N = D; d.ld = 4096; d.koff = 3072; d.mode = 0; }
            else if (mi == 5) { d.W = Pk->in[I_WO] + (size_t)l * D * D;      d.WT = (bf16*)(ws + WS_WO) + (size_t)l * D * D;      d.K = D; d.N = D; d.ld = D; d.koff = 0; d.mode = 0; }
            else if (mi == 6) { d.W = Pk->in[I_WFI] + (size_t)l * D * 2 * FF; d.WT = (bf16*)(ws + WS_WFI) + (size_t)l * 2 * FF * D; d.K = D; d.N = 2 * FF; d.ld = D; d.koff = 0; d.mode = 2; }
            else              { d.W = Pk->in[I_WFO] + (size_t)l * FF * D;    d.WT = (bf16*)(ws + WS_WFO) + (size_t)l * D * FF;    d.K = FF; d.N = D; d.ld = FF; d.koff = 0; d.mode = 0; }
            d.items = (d.K / 64) * ((d.N + 63) / 64);
            for (int it = gw; it < d.items; it += NGW) conv_item(d.W, d.K, d.N, d.WT, d.ld, d.koff, d.mode, scr, it, T.lane);
        }
    }
    { bf16* CA = (bf16*)(ws + WS_CA);
      for (int i = blockIdx.x * NT + T.tid; i < 256 * D; i += F.G * NT) { const int r = i >> 11, c = i & 2047; float v = 0.f;
          if (r < 2) v = Pk->in[I_CP][r * D + c]; else if (r < 130) v = Pk->in[I_CS][(r - 2) * D + c];
          CA[i] = (bf16)f2bf(r < 130 ? siluf_(v) : 0.f); } }
    { f32x4* X4 = (f32x4*)(ws + WS_X); const f32x4* xp = (const f32x4*)Pk->in[I_XP]; const f32x4* xs = (const f32x4*)Pk->in[I_XS];
      for (int i = blockIdx.x * NT + T.tid; i < MT * D / 4; i += F.G * NT) { const int r = i >> 9;
          X4[i] = r < MP ? xp[i] : (r < MR ? xs[i - MP * D / 4] : (f32x4){0.f, 0.f, 0.f, 0.f}); } }
}

template <bool FINAL>
__device__ __forceinline__ void phase_norm_t(Frame& F, float* X, const float* nw, const float* mod, int sh_off, int sc_off, bf16* H, float* out, const float* part, int nsl) {
    const Tix T = tix();
    const int gw = F.vcu * NWAVES + T.wave, NGW = F.G * NWAVES;
    const int nit = FINAL ? MP : MP + (MT - MR);
    f32x4 vn[8];
    if (gw < nit) { const int row = gw < MP ? gw : gw + MS; const f32x4* xr = (const f32x4*)(X + (size_t)row * D) + T.lane;
#pragma unroll
        for (int j = 0; j < 8; ++j) vn[j] = xr[64 * j]; }
    for (int it = gw; it < nit; it += NGW) {
        const int row = it < MP ? it : it + MS;
        f32x4 v[8]; float s = 0.f;
#pragma unroll
        for (int j = 0; j < 8; ++j) v[j] = vn[j];
        if (it + NGW < nit) { const int it2 = it + NGW, row2 = it2 < MP ? it2 : it2 + MS; const f32x4* xr = (const f32x4*)(X + (size_t)row2 * D) + T.lane;
#pragma unroll
            for (int j = 0; j < 8; ++j) vn[j] = xr[64 * j]; }
#pragma unroll
        for (int j = 0; j < 8; ++j) s += (v[j].x * v[j].x + v[j].y * v[j].y) + (v[j].z * v[j].z + v[j].w * v[j].w);
        const float rstd = 1.0f / sqrtf(wave_sum(s) * (1.0f / D) + EPS);
        if (FINAL) { f32x4* o = (f32x4*)(out + (size_t)row * D) + T.lane;
#pragma unroll
            for (int j = 0; j < 8; ++j) { const f32x4 w = *(const f32x4*)(nw + 4 * (T.lane + 64 * j)); o[64 * j] = (v[j] * rstd) * w; } }
        else { const float* md = mod + (size_t)pg8::batch_of_row(row) * NADA; v2u* o = (v2u*)(H + (size_t)row * D) + T.lane;
#pragma unroll
            for (int j = 0; j < 8; ++j) { const int c = 4 * (T.lane + 64 * j);
                const f32x4 w = *(const f32x4*)(nw + c), sc = *(const f32x4*)(md + sc_off + c), sh = *(const f32x4*)(md + sh_off + c);
                const f32x4 y = (v[j] * rstd) * w * (sc + 1.0f) + sh;
                v2u q; q.x = pk2(y.x, y.y); q.y = pk2(y.z, y.w); o[64 * j] = q; } }
    }
    LAS float* red = (LAS float*)F.lds;
    for (int sr = (int)blockIdx.x; sr < MS; sr += F.G) {
        const int row = MP + sr, c = 4 * T.tid;
        f32x4 x = *(const f32x4*)(X + (size_t)row * D + c);
        { f32x4 pp[11];
#pragma unroll
          for (int s = 0; s < 11; ++s) pp[s] = s < nsl ? *(const f32x4*)(part + ((size_t)s * 128 + sr) * D + c) : (f32x4){0.f, 0.f, 0.f, 0.f};
#pragma unroll
          for (int s = 0; s < 11; ++s) x += pp[s]; }
        if (nsl > 0) *(f32x4*)(X + (size_t)row * D + c) = x;
        const float ss = wave_sum((x.x * x.x + x.y * x.y) + (x.z * x.z + x.w * x.w));
        __syncthreads();
        if (T.lane == 0) red[T.wave] = ss;
        __syncthreads();
        const float tot = ((red[0] + red[1]) + (red[2] + red[3])) + ((red[4] + red[5]) + (red[6] + red[7]));
        const float rstd = 1.0f / sqrtf(tot * (1.0f / D) + EPS);
        const f32x4 w = *(const f32x4*)(nw + c);
        if (FINAL) *(f32x4*)(out + (size_t)row * D + c) = (x * rstd) * w;
        else { const float* md = mod + (size_t)pg8::batch_of_row(row) * NADA; const f32x4 sc = *(const f32x4*)(md + sc_off + c), sh = *(const f32x4*)(md + sh_off + c);
            const f32x4 y = (x * rstd) * w * (sc + 1.0f) + sh; v2u q; q.x = pk2(y.x, y.y); q.y = pk2(y.z, y.w); *(v2u*)(H + (size_t)row * D + c) = q; }
    }
    __syncthreads();
}

__device__ __forceinline__ void gla_sample_unit(Frame& F, int unit, const bf16* Z, const bf16* H, const bf16* WlraT, const float* wgk2, const float* bgk, const float* Sin  , float* Sout, const float* gnw, bf16* OABC) {
    const Tix T = tix();
    const int b = unit >> 2, h = unit & 3; const size_t row = MP + b;
    LAS float* sq = (LAS float*)F.lds; LAS float* sk = sq + 256; LAS float* se = sk + 256; LAS float* red = se + 256;
    LAS float* lrs = red + 2048;
    __syncthreads();
    { const int rr = T.tid & 15, ksg = T.tid >> 4; float a = 0.f;
      const bf16* hp = H + row * D + 64 * ksg; const bf16* wp = WlraT + (size_t)rr * D + 64 * ksg;
#pragma unroll
      for (int i = 0; i < 8; ++i) { const v4u hv = *(const v4u*)(hp + 8 * i), wv = *(const v4u*)(wp + 8 * i);
          a += (__uint_as_float(hv.x << 16) * __uint_as_float(wv.x << 16) + __uint_as_float(hv.x & 0xffff0000u) * __uint_as_float(wv.x & 0xffff0000u)) + (__uint_as_float(hv.y << 16) * __uint_as_float(wv.y << 16) + __uint_as_float(hv.y & 0xffff0000u) * __uint_as_float(wv.y & 0xffff0000u))
             + (__uint_as_float(hv.z << 16) * __uint_as_float(wv.z << 16) + __uint_as_float(hv.z & 0xffff0000u) * __uint_as_float(wv.z & 0xffff0000u)) + (__uint_as_float(hv.w << 16) * __uint_as_float(wv.w << 16) + __uint_as_float(hv.w & 0xffff0000u) * __uint_as_float(wv.w & 0xffff0000u)); }
      lrs[ksg * 16 + rr] = a; }
    __syncthreads();
    if (T.tid < 16) { float a = 0.f;
#pragma unroll
        for (int s = 0; s < 32; ++s) a += lrs[s * 16 + T.tid];
        lrs[512 + T.tid] = a; }
    __syncthreads();
    if (T.tid < 256) { const int d = T.tid; sq[d] = bf2f(Z[row * NZ + ZQA + h * 256 + d]) * 0.0625f; sk[d] = bf2f(Z[row * NZ + ZKA + h * 256 + d]);
        float x = bgk[h * 256 + d];
#pragma unroll
        for (int rr = 0; rr < 16; ++rr) x += lrs[512 + rr] * wgk2[rr * 1024 + h * 256 + d];
        se[d] = __expf((fminf(x, 0.f) - __logf(1.0f + __expf(-fabsf(x)))) * (1.0f / 16.0f)); }
    __syncthreads();
    const int c4 = T.tid & 127, rg = T.tid >> 7;
    f32x4 v; { const bf16* vp = Z + row * NZ + ZVA + h * 512 + 4 * c4; v.x = bf2f(vp[0]); v.y = bf2f(vp[1]); v.z = bf2f(vp[2]); v.w = bf2f(vp[3]); }
    const size_t base = ((size_t)b * 4 + h) * 256 * 512;
    f32x4 o = (f32x4){0.f, 0.f, 0.f, 0.f};
    for (int it0 = 0; it0 < 64; it0 += 16) {
        f32x4 sv[16];
#pragma unroll
        for (int u = 0; u < 16; ++u) sv[u] = __builtin_nontemporal_load((const f32x4*)(Sin + base + (size_t)(rg + 4 * (it0 + u)) * 512 + 4 * c4));
#pragma unroll
        for (int u = 0; u < 16; ++u) { const int dk = rg + 4 * (it0 + u);
            const f32x4 sn = sv[u] * se[dk] + v * sk[dk];
            __builtin_nontemporal_store(sn, (f32x4*)(Sout + base + (size_t)dk * 512 + 4 * c4));
            o += sn * sq[dk]; } }
    *(LAS f32x4*)(red + rg * 512 + 4 * c4) = o;
    __syncthreads();
    { const int c = T.tid; const float t = (red[c] + red[512 + c]) + (red[1024 + c] + red[1536 + c]);
      const float ss = wave_sum(t * t);
      if (T.lane == 0) lrs[600 + T.wave] = ss;
      __syncthreads();
      const float tot = ((lrs[600] + lrs[601]) + (lrs[602] + lrs[603])) + ((lrs[604] + lrs[605]) + (lrs[606] + lrs[607]));
      const float rstd = 1.0f / sqrtf(tot * (1.0f / 512.0f) + EPS);
      OABC[row * 4096 + h * 512 + c] = (bf16)f2bf(t * rstd * gnw[c] * siluf_(bf2f(Z[row * NZ + ZGA + h * 512 + c]))); }
}

__device__ __forceinline__ void gm_ln_row(const Tix& T, int row, const v2u (&vw)[4], const bf16* Z, const float* nw, const float* nb, bf16* VNB, float* gmv_out  , const float* ws_, const float* bs, bf16* OABC) {
    float x[16]; float s = 0.f;
#pragma unroll
    for (int j = 0; j < 4; ++j) { const v2u w = vw[j];
        x[4 * j + 0] = geluf_(__uint_as_float(w.x << 16)); x[4 * j + 1] = geluf_(__uint_as_float(w.x & 0xffff0000u)); x[4 * j + 2] = geluf_(__uint_as_float(w.y << 16)); x[4 * j + 3] = geluf_(__uint_as_float(w.y & 0xffff0000u));
        s += (x[4 * j] + x[4 * j + 1]) + (x[4 * j + 2] + x[4 * j + 3]); }
    const float mu = wave_sum(s) * (1.0f / 1024.0f); float q = 0.f;
#pragma unroll
    for (int i = 0; i < 16; ++i) { x[i] -= mu; q += x[i] * x[i]; }
    const float rstd = 1.0f / sqrtf(wave_sum(q) * (1.0f / 1024.0f) + EPS);
#pragma unroll
    for (int j = 0; j < 4; ++j) { const int c = 4 * (T.lane + 64 * j); const f32x4 w = *(const f32x4*)(nw + c), bb = *(const f32x4*)(nb + c);
        f32x4 y; y.x = x[4 * j] * rstd * w.x + bb.x; y.y = x[4 * j + 1] * rstd * w.y + bb.y; y.z = x[4 * j + 2] * rstd * w.z + bb.z; y.w = x[4 * j + 3] * rstd * w.w + bb.w;
        if (row < MP) { v2u o; o.x = pk2(y.x, y.y); o.y = pk2(y.z, y.w); *(v2u*)(VNB + (size_t)row * 1024 + c) = o; }
        else { *(f32x4*)(gmv_out + (size_t)(row - MP) * 1024 + c) = y;
            const int g = c >> 8; const float w00 = ws_[(size_t)g * 128 * 128], b0 = bs[g * 128];
            const v2u uq = *(const v2u*)(Z + (size_t)row * NZ + ZUB + c);
            v2u o; o.x = pk2(geluf_(__uint_as_float(uq.x << 16)) * (w00 * y.x + b0), geluf_(__uint_as_float(uq.x & 0xffff0000u)) * (w00 * y.y + b0));
            o.y = pk2(geluf_(__uint_as_float(uq.y << 16)) * (w00 * y.z + b0), geluf_(__uint_as_float(uq.y & 0xffff0000u)) * (w00 * y.w + b0));
            *(v2u*)(OABC + (size_t)row * 4096 + 2048 + c) = o; } }
}
__device__ __forceinline__ void gm_ln_rows(Frame& F, int ow, int OW, const bf16* Z, const float* nw, const float* nb, bf16* VNB, float* gmv_out, const float* ws_, const float* bs, bf16* OABC) {
    const Tix T = tix();
    const int w0 = ow * NWAVES + T.wave, stride = OW * NWAVES;
    v2u nx[4];
    if (w0 < MR) {
#pragma unroll
        for (int j = 0; j < 4; ++j) nx[j] = *(const v2u*)(Z + (size_t)w0 * NZ + ZVB + 4 * (T.lane + 64 * j)); }
    for (int row = w0; row < MR; row += stride) {
        v2u cur[4];
#pragma unroll
        for (int j = 0; j < 4; ++j) cur[j] = nx[j];
        if (row + stride < MR) {
#pragma unroll
            for (int j = 0; j < 4; ++j) nx[j] = *(const v2u*)(Z + (size_t)(row + stride) * NZ + ZVB + 4 * (T.lane + 64 * j)); }
        gm_ln_row(T, row, cur, Z, nw, nb, VNB, gmv_out, ws_, bs, OABC);
    }
}

__device__ __forceinline__ void cache_outs(Frame& F, int wg, int nwg, int l, const bf16* Z, float* out) {
    const Tix T = tix();
    for (int idx = wg * NT + T.tid; idx < 2 * 128 * 512; idx += nwg * NT) {
        const int c = idx & 511, r = (idx >> 9) & 127, b = idx >> 16; const size_t row = (size_t)b * SEQ + (SEQ - 128) + r;
        const float v = bf2f(Z[row * NZ + ZKC + c]);
        if (c < 256) out[O_CKP + ((size_t)(l * 2 + b) * 128 + r) * 256 + c] = v; else out[O_CVP + ((size_t)(l * 2 + b) * 128 + r) * 256 + (c - 256)] = v;
    }
    for (int idx = wg * NT + T.tid; idx < 128 * 512; idx += nwg * NT) {
        const int c = idx & 511, b = idx >> 9; const float v = bf2f(Z[(size_t)(MP + b) * NZ + ZKC + c]);
        if (c < 256) out[O_CKS + (size_t)(l * 128 + b) * 256 + c] = v; else out[O_CVS + (size_t)(l * 128 + b) * 256 + (c - 256)] = v;
    }
}

__device__ __forceinline__ void gla_fin(Frame& F, const float* OBf, const bf16* Z, const float* gnw, bf16* OABC) {
    const Tix T = tix();
    const bf16* OB = (const bf16*)OBf;
    const int gw = F.vcu * NWAVES + T.wave, NGW = F.G * NWAVES;
    v2u on[8], gn[8];
#define FIN_LOAD(rw) do { const bf16* op_ = OB + (size_t)(rw) * 2048 + 4 * T.lane; const bf16* gp_ = Z + (size_t)(rw) * NZ + ZGA + 4 * T.lane; \
        _Pragma("unroll") for (int j = 0; j < 8; ++j) { on[j] = *(const v2u*)(op_ + 256 * j); gn[j] = *(const v2u*)(gp_ + 256 * j); } } while (0)
    if (gw < MP) FIN_LOAD(gw);
    for (int row = gw; row < MP; row += NGW) {
        f32x4 o[8]; v2u gq[8];
#pragma unroll
        for (int j = 0; j < 8; ++j) { o[j] = (f32x4){__uint_as_float(on[j].x << 16), __uint_as_float(on[j].x & 0xffff0000u), __uint_as_float(on[j].y << 16), __uint_as_float(on[j].y & 0xffff0000u)}; gq[j] = gn[j]; }
        if (row + NGW < MP) FIN_LOAD(row + NGW);
#pragma unroll
        for (int h = 0; h < 4; ++h) { const f32x4 a = o[2 * h], b = o[2 * h + 1];
            const float s = (a.x * a.x + a.y * a.y) + (a.z * a.z + a.w * a.w) + (b.x * b.x + b.y * b.y) + (b.z * b.z + b.w * b.w);
            const float rstd = 1.0f / sqrtf(wave_sum(s) * (1.0f / 512.0f) + EPS);
#pragma unroll
            for (int jj = 0; jj < 2; ++jj) { const int j = 2 * h + jj, c = 4 * T.lane + 256 * jj; const f32x4 ov = o[j]; const f32x4 w = *(const f32x4*)(gnw + c);
                const float g0 = siluf_(__uint_as_float(gq[j].x << 16)), g1 = siluf_(__uint_as_float(gq[j].x & 0xffff0000u)), g2 = siluf_(__uint_as_float(gq[j].y << 16)), g3 = siluf_(__uint_as_float(gq[j].y & 0xffff0000u));
                v2u r; r.x = pk2(ov.x * rstd * w.x * g0, ov.y * rstd * w.y * g1); r.y = pk2(ov.z * rstd * w.z * g2, ov.w * rstd * w.w * g3);
                *(v2u*)(OABC + (size_t)row * 4096 + h * 512 + c) = r; } }
    }
#undef FIN_LOAD
}
typedef short bf16x8 __attribute__((ext_vector_type(8)));
typedef unsigned short u16x4 __attribute__((ext_vector_type(4)));
__device__ __forceinline__ unsigned offb(unsigned row, unsigned ch) { return 256u * row + 16u * (ch ^ (((row & 3u) << 2) | ((row >> 2) & 3u))); }
__device__ __forceinline__ unsigned tr_addr16(unsigned lane, unsigned c, unsigned ks, unsigned t) {
    const unsigned g = lane >> 4, q = (lane & 15u) >> 2, p = lane & 3u; return offb(32u * ks + 8u * g + 4u * t + q, 2u * c + (p >> 1)) + 8u * (p & 1u); }
struct TrLane { unsigned L0, L1, X0, X1; };
__device__ __forceinline__ TrLane tr_lane(unsigned lane) {
    const unsigned g = lane >> 4, q = (lane & 15u) >> 2, p = lane & 3u; TrLane t;
    const unsigned m0 = (q << 2) | ((2u * g) & 3u), m1 = (q << 2) | ((2u * g + 1u) & 3u);
    t.L0 = 2048u * g + 256u * q + 8u * (p & 1u) + 16u * ((p >> 1) ^ (m0 & 1u)); t.L1 = 2048u * g + 1024u + 256u * q + 8u * (p & 1u) + 16u * ((p >> 1) ^ (m1 & 1u));
    t.X0 = (m0 >> 1) << 5; t.X1 = (m1 >> 1) << 5; return t;
}
__device__ __forceinline__ void tr_frag2(unsigned base, const TrLane& tl, unsigned c, bf16x8& f0, bf16x8& f1) {
    const unsigned a0 = base + tl.L0 + ((c << 5) ^ tl.X0), a1 = base + tl.L1 + ((c << 5) ^ tl.X1);
    u16x4 r0, r1, r2, r3;
    asm volatile("ds_read_b64_tr_b16 %0, %4\n\tds_read_b64_tr_b16 %1, %5\n\tds_read_b64_tr_b16 %2, %4 offset:8192\n\tds_read_b64_tr_b16 %3, %5 offset:8192\n\ts_waitcnt lgkmcnt(0)"
                 : "=&v"(r0), "=&v"(r1), "=&v"(r2), "=&v"(r3) : "v"(a0), "v"(a1) : "memory");
    f0 = (bf16x8){(short)r0[0], (short)r0[1], (short)r0[2], (short)r0[3], (short)r1[0], (short)r1[1], (short)r1[2], (short)r1[3]};
    f1 = (bf16x8){(short)r2[0], (short)r2[1], (short)r2[2], (short)r2[3], (short)r3[0], (short)r3[1], (short)r3[2], (short)r3[3]};
}
__device__ __forceinline__ void tr_frag4(unsigned base, const TrLane& tl, unsigned c, bf16x8& f0, bf16x8& f1, bf16x8& f2, bf16x8& f3) {
    const unsigned a0 = base + tl.L0 + ((c << 5) ^ tl.X0), a1 = base + tl.L1 + ((c << 5) ^ tl.X1), a2 = base + tl.L0 + (((c + 1u) << 5) ^ tl.X0), a3 = base + tl.L1 + (((c + 1u) << 5) ^ tl.X1);
    u16x4 r0, r1, r2, r3, r4, r5, r6, r7;
    asm volatile("ds_read_b64_tr_b16 %0, %8\n\tds_read_b64_tr_b16 %1, %9\n\tds_read_b64_tr_b16 %2, %8 offset:8192\n\tds_read_b64_tr_b16 %3, %9 offset:8192\n\t"
                 "ds_read_b64_tr_b16 %4, %10\n\tds_read_b64_tr_b16 %5, %11\n\tds_read_b64_tr_b16 %6, %10 offset:8192\n\tds_read_b64_tr_b16 %7, %11 offset:8192\n\ts_waitcnt lgkmcnt(0)"
                 : "=&v"(r0), "=&v"(r1), "=&v"(r2), "=&v"(r3), "=&v"(r4), "=&v"(r5), "=&v"(r6), "=&v"(r7) : "v"(a0), "v"(a1), "v"(a2), "v"(a3) : "memory");
    f0 = (bf16x8){(short)r0[0], (short)r0[1], (short)r0[2], (short)r0[3], (short)r1[0], (short)r1[1], (short)r1[2], (short)r1[3]};
    f1 = (bf16x8){(short)r2[0], (short)r2[1], (short)r2[2], (short)r2[3], (short)r3[0], (short)r3[1], (short)r3[2], (short)r3[3]};
    f2 = (bf16x8){(short)r4[0], (short)r4[1], (short)r4[2], (short)r4[3], (short)r5[0], (short)r5[1], (short)r5[2], (short)r5[3]};
    f3 = (bf16x8){(short)r6[0], (short)r6[1], (short)r6[2], (short)r6[3], (short)r7[0], (short)r7[1], (short)r7[2], (short)r7[3]};
}
__device__ __forceinline__ unsigned cvtpk(float lo, float hi) { return pk2(lo, hi); }
__device__ __forceinline__ unsigned cvtpk_pin(float lo, float hi) { unsigned r; asm volatile("v_cvt_pk_bf16_f32 %0, %1, %2\n\ts_nop 1" : "=v"(r) : "v"(lo), "v"(hi)); return r; }

constexpr int GLA_PREP_STRIDE = 264;

__device__ __forceinline__ void gla_prep_unit(Frame& F, int unit, const bf16* Z, const bf16* H, const bf16* WlraT, const float* wgk2, const float* bgk, bf16* QT, bf16* KH, bf16* AI, float* GAM) {
    const Tix T = tix();
    const int b = unit >> 8, h = (unit >> 6) & 3, c = unit & 63;
    const int d4 = 4 * T.lane, seg = T.wave;
    const int r = T.lane & 15, g = T.lane >> 4;
    LAS bf16* QA = (LAS bf16*)F.lds; LAS bf16* KA = QA + 64 * GLA_PREP_STRIDE; LAS float* tots = (LAS float*)(KA + 64 * GLA_PREP_STRIDE);
    LAS float* lrp = tots + 2048;
    const size_t rowc = (size_t)b * SEQ + c * 64;
    __syncthreads();
    {
      const int tl = T.wave & 3, kh = T.wave >> 2; f32x4 acc = (f32x4){0.f, 0.f, 0.f, 0.f};
      const bf16* hp = H + (rowc + 16 * tl + r) * D + kh * 1024 + 8 * g; const bf16* wp = WlraT + (size_t)r * D + kh * 1024 + 8 * g;
#pragma unroll 16
      for (int s = 0; s < 32; ++s) acc = __builtin_amdgcn_mfma_f32_16x16x32_bf16(*(const bf16x8*)(hp + 32 * s), *(const bf16x8*)(wp + 32 * s), acc, 0, 0, 0);
#pragma unroll
      for (int e = 0; e < 4; ++e) lrp[(kh * 64 + 16 * tl + 4 * g + e) * 16 + r] = acc[e]; }
    const size_t row0 = rowc + seg * 8;
    v2u qv[8], kv[8];
#pragma unroll
    for (int t = 0; t < 8; ++t) { qv[t] = *(const v2u*)(Z + (row0 + t) * NZ + ZQA + h * 256 + d4); kv[t] = *(const v2u*)(Z + (row0 + t) * NZ + ZKA + h * 256 + d4); }
    __syncthreads();
    f32x4 cum[8]; f32x4 run = (f32x4){0.f, 0.f, 0.f, 0.f};
    { f32x4 w[16];
#pragma unroll
      for (int rr = 0; rr < 16; ++rr) w[rr] = *(const f32x4*)(wgk2 + rr * 1024 + h * 256 + d4);
      const f32x4 bb = *(const f32x4*)(bgk + h * 256 + d4);
#pragma unroll
      for (int t = 0; t < 8; ++t) { const int tk = seg * 8 + t; f32x4 x = bb;
#pragma unroll
          for (int r4 = 0; r4 < 4; ++r4) { const f32x4 l0 = *(const LAS f32x4*)(lrp + tk * 16 + 4 * r4), l1 = *(const LAS f32x4*)(lrp + (64 + tk) * 16 + 4 * r4);
              x += (l0.x + l1.x) * w[4 * r4] + (l0.y + l1.y) * w[4 * r4 + 1] + (l0.z + l1.z) * w[4 * r4 + 2] + (l0.w + l1.w) * w[4 * r4 + 3]; }
#pragma unroll
          for (int j = 0; j < 4; ++j) run[j] += (fminf(x[j], 0.f) - __logf(1.0f + __expf(-fabsf(x[j])))) * (1.0f / 16.0f);
          cum[t] = run; } }
    *(LAS f32x4*)(tots + seg * 256 + d4) = run;
    __syncthreads();
    f32x4 add = (f32x4){0.f, 0.f, 0.f, 0.f}, bmid = add, bl = add;
#pragma unroll
    for (int s = 0; s < 8; ++s) { const f32x4 ts = *(const LAS f32x4*)(tots + s * 256 + d4); if (s < seg) add += ts; if (s < 4) bmid += ts; bl += ts; }
#pragma unroll
    for (int t = 0; t < 8; ++t) { const f32x4 bt = cum[t] + add; const size_t row = row0 + t; const int tk = seg * 8 + t;
        f32x4 q, k; q[0] = __uint_as_float(qv[t].x << 16); q[1] = __uint_as_float(qv[t].x & 0xffff0000u); q[2] = __uint_as_float(qv[t].y << 16); q[3] = __uint_as_float(qv[t].y & 0xffff0000u);
        k[0] = __uint_as_float(kv[t].x << 16); k[1] = __uint_as_float(kv[t].x & 0xffff0000u); k[2] = __uint_as_float(kv[t].y << 16); k[3] = __uint_as_float(kv[t].y & 0xffff0000u);
        q = q * 0.0625f;
        f32x4 o0, o1, o2, o3;
#pragma unroll
        for (int j = 0; j < 4; ++j) { o0[j] = q[j] * __expf(bt[j]); o1[j] = k[j] * __expf(bl[j] - bt[j]); o2[j] = q[j] * __expf(bt[j] - bmid[j]); o3[j] = k[j] * __expf(bmid[j] - bt[j]); }
        v2u w0, w1, w2, w3; w0.x = pk2(o0[0], o0[1]); w0.y = pk2(o0[2], o0[3]); w1.x = pk2(o1[0], o1[1]); w1.y = pk2(o1[2], o1[3]); w2.x = pk2(o2[0], o2[1]); w2.y = pk2(o2[2], o2[3]); w3.x = pk2(o3[0], o3[1]); w3.y = pk2(o3[2], o3[3]);
        *(v2u*)(QT + row * 1024 + h * 256 + d4) = w0; *(v2u*)(KH + row * 1024 + h * 256 + d4) = w1;
        *(LAS v2u*)(QA + tk * GLA_PREP_STRIDE + d4) = w2; *(LAS v2u*)(KA + tk * GLA_PREP_STRIDE + d4) = w3; }
    if (seg == 0) { f32x4 eg; eg[0] = __expf(bl[0]); eg[1] = __expf(bl[1]); eg[2] = __expf(bl[2]); eg[3] = __expf(bl[3]); *(f32x4*)(GAM + (size_t)unit * 256 + d4) = eg; }
    __syncthreads();
#pragma unroll
    for (int x = 0; x < 2; ++x) { const int tt = 2 * T.wave + x, j = tt >> 2, sb = tt & 3;
        f32x4 acc = (f32x4){0.f, 0.f, 0.f, 0.f};
        if (sb <= j) {
#pragma unroll
            for (int ks = 0; ks < 8; ++ks) { const bf16x8 a = *(const LAS bf16x8*)(QA + (16 * j + r) * GLA_PREP_STRIDE + 32 * ks + 8 * g), bb = *(const LAS bf16x8*)(KA + (16 * sb + r) * GLA_PREP_STRIDE + 32 * ks + 8 * g);
                acc = __builtin_amdgcn_mfma_f32_16x16x32_bf16(a, bb, acc, 0, 0, 0); } }
        bf16* ap = AI + (size_t)unit * 4096;
#pragma unroll
        for (int e = 0; e < 4; ++e) { const int t = 16 * j + 4 * g + e, s = 16 * sb + r; ap[t * 64 + s] = (bf16)f2bf(s <= t ? acc[e] : 0.f); } }
}

constexpr int GL_KH = 0, GL_QT = 32768, GL_V = 65536, GL_A = 81920, GL_GAM = 90112, GL_END = 91136;
template <bool OUT>
__device__ __forceinline__ void gla_pass(Frame& F, int worker, const bf16* Z, const bf16* QT, const bf16* KH, const bf16* AI, const float* GAM, float* GST, float* GAMS, float* OB, float* state_out) {
    const Tix T = tix();
    const int lane = T.lane, wave = T.wave, r = lane & 15, g = lane >> 4;
    const int grp = worker >> 2, qs = worker & 3, b = grp >> 5, h = (grp >> 3) & 3, sc = grp & 7;
    const unsigned lbase = (unsigned)(size_t)F.lds; const TrLane tl = tr_lane((unsigned)lane);
    f32x4 S[16];
#pragma unroll
    for (int i = 0; i < 16; ++i) S[i] = (f32x4){0.f, 0.f, 0.f, 0.f};
    if (OUT) {
        const f32x4* gp = (const f32x4*)(GST + ((((size_t)grp * 4 + qs) * 8 + wave) * 16) * 256) + lane;
#pragma unroll
        for (int i = 0; i < 16; ++i) S[i] = gp[64 * i];
    }
    const int srow = T.tid >> 4, sch = T.tid & 15;
    v4u pk[2][2], pq[2][2], pv[2], pa; f32x4 pg;
    const size_t seq0 = (size_t)b * SEQ + sc * 512;
    const unsigned tko = (unsigned)(srow * 1024 + 8 * sch) * 2u, tvo = (unsigned)(srow * NZ + 8 * sch) * 2u;
#define GLA_LOAD(cc) do { const size_t rw = seq0 + (cc) * 64; const size_t un = (size_t)((b * 4 + h) * 64 + sc * 8 + (cc)); \
        const char* kb = (const char*)(KH + rw * 1024 + h * 256); const char* qb = (const char*)(QT + rw * 1024 + h * 256); const char* vb = (const char*)(Z + rw * NZ + ZVA + h * 512 + qs * 128); \
        _Pragma("unroll") for (int hh = 0; hh < 2; ++hh) _Pragma("unroll") for (int u = 0; u < 2; ++u) { \
            pk[hh][u] = *(const v4u*)(kb + (hh * 256 + u * 65536) + tko); \
            if (OUT) pq[hh][u] = *(const v4u*)(qb + (hh * 256 + u * 65536) + tko); } \
        _Pragma("unroll") for (int u = 0; u < 2; ++u) pv[u] = *(const v4u*)(vb + (size_t)u * (32 * NZ * 2) + tvo); \
        if (OUT) pa = *(const v4u*)((const char*)(AI + un * 4096) + (unsigned)T.tid * 16u); \
        if (T.tid < 64) pg = *(const f32x4*)((const char*)(GAM + un * 256) + (unsigned)T.tid * 16u); } while (0)
    GLA_LOAD(0);
    for (int c = 0; c < 8; ++c) {
        __syncthreads();
#pragma unroll
        for (int hh = 0; hh < 2; ++hh)
#pragma unroll
            for (int u = 0; u < 2; ++u) { *(LAS v4u*)(F.lds + GL_KH + hh * 16384 + offb(srow + 32 * u, sch)) = pk[hh][u]; if (OUT) *(LAS v4u*)(F.lds + GL_QT + hh * 16384 + offb(srow + 32 * u, sch)) = pq[hh][u]; }
#pragma unroll
        for (int u = 0; u < 2; ++u) *(LAS v4u*)(F.lds + GL_V + offb(srow + 32 * u, sch)) = pv[u];
        if (OUT) { const int ar = T.tid >> 3, ach = T.tid & 7; *(LAS v4u*)(F.lds + GL_A + 128 * ar + 16 * (ach ^ (ar & 7))) = pa; }
        if (T.tid < 64) *(LAS f32x4*)(F.lds + GL_GAM + 16 * T.tid) = pg;
        __syncthreads();
        if (c + 1 < 8) GLA_LOAD(c + 1);
        bf16x8 V0, V1; tr_frag2(lbase + GL_V, tl, (unsigned)wave, V0, V1);
        if (OUT) {
            const size_t orow0 = seq0 + c * 64;
            const unsigned mr = ((unsigned)(r & 3) << 2) | ((unsigned)(r >> 2) & 3u);
            const unsigned ql0 = 256u * r + 8u * (g & 1) + 16u * (((unsigned)(g >> 1)) ^ (mr & 3u)), ql1 = 256u * r + 8u * (g & 1) + 16u * ((((unsigned)(g >> 1)) | 2u) ^ (mr & 3u)), qx = (mr >> 2) << 6;
            const unsigned al0 = 128u * r + 16u * (((unsigned)g) ^ (unsigned)(r & 7)), al1 = 128u * r + 16u * ((4u + (unsigned)g) ^ (unsigned)(r & 7));
#pragma unroll 1
            for (int j = 0; j < 4; ++j) {
                f32x4 acc = (f32x4){0.f, 0.f, 0.f, 0.f};
                { const bf16x8 a0 = *(const LAS bf16x8*)(F.lds + GL_A + 2048 * j + al0), a1 = *(const LAS bf16x8*)(F.lds + GL_A + 2048 * j + al1);
                  acc = __builtin_amdgcn_mfma_f32_16x16x32_bf16(V0, a0, acc, 0, 0, 0); acc = __builtin_amdgcn_mfma_f32_16x16x32_bf16(V1, a1, acc, 0, 0, 0); }
#pragma unroll
                for (int s = 0; s < 8; ++s) {
                    const unsigned qo = GL_QT + (unsigned)(s >> 2) * 16384u + 4096u * j + ((64u * (s & 3)) ^ qx);
                    const v2u lo = *(const LAS v2u*)(F.lds + qo + ql0), hi = *(const LAS v2u*)(F.lds + qo + ql1);
                    const v4u w = (v4u){lo.x, lo.y, hi.x, hi.y};
                    const v4u sw = (v4u){cvtpk_pin(S[2 * s][0], S[2 * s][1]), cvtpk_pin(S[2 * s][2], S[2 * s][3]), cvtpk_pin(S[2 * s + 1][0], S[2 * s + 1][1]), cvtpk_pin(S[2 * s + 1][2], S[2 * s + 1][3])};
                    acc = __builtin_amdgcn_mfma_f32_16x16x32_bf16(__builtin_bit_cast(bf16x8, sw), __builtin_bit_cast(bf16x8, w), acc, 0, 0, 0); }
                { v2u ow; ow.x = pk2(acc[0], acc[1]); ow.y = pk2(acc[2], acc[3]);     *(v2u*)((bf16*)OB + (orow0 + 16 * j + r) * 2048 + h * 512 + qs * 128 + 16 * wave + 4 * g) = ow; }
            }
        }
#pragma unroll
        for (int i = 0; i < 16; i += 2) {
            const f32x4 gm0 = *(const LAS f32x4*)(F.lds + GL_GAM + 4 * (16 * i + 4 * g)), gm1 = *(const LAS f32x4*)(F.lds + GL_GAM + 4 * (16 * (i + 1) + 4 * g));
            bf16x8 k0, k1, k2, k3; tr_frag4(lbase + GL_KH + (i >> 3) * 16384, tl, (unsigned)(i & 7), k0, k1, k2, k3);
            f32x4 s0 = S[i] * gm0, s1 = S[i + 1] * gm1;
            s0 = __builtin_amdgcn_mfma_f32_16x16x32_bf16(k0, V0, s0, 0, 0, 0); s1 = __builtin_amdgcn_mfma_f32_16x16x32_bf16(k2, V0, s1, 0, 0, 0);
            S[i] = __builtin_amdgcn_mfma_f32_16x16x32_bf16(k1, V1, s0, 0, 0, 0); S[i + 1] = __builtin_amdgcn_mfma_f32_16x16x32_bf16(k3, V1, s1, 0, 0, 0);
        }
    }
#undef GLA_LOAD
    if (!OUT) {
        f32x4* gp = (f32x4*)(GST + ((((size_t)grp * 4 + qs) * 8 + wave) * 16) * 256) + lane;
#pragma unroll
        for (int i = 0; i < 16; ++i) gp[64 * i] = S[i];
        if (qs == 0 && wave == 0) {
            f32x4 gt = (f32x4){1.f, 1.f, 1.f, 1.f};
            for (int c = 0; c < 8; ++c) gt = gt * *(const f32x4*)(GAM + ((size_t)((b * 4 + h) * 64 + sc * 8 + c)) * 256 + 4 * lane);
            *(f32x4*)(GAMS + (size_t)grp * 256 + 4 * lane) = gt; }
    } else if (sc == 7) {
#pragma unroll
        for (int i = 0; i < 16; ++i)
#pragma unroll
            for (int e = 0; e < 4; ++e) state_out[(((size_t)b * 4 + h) * 256 + 16 * i + 4 * g + e) * 512 + qs * 128 + 16 * wave + r] = S[i][e];
    }
    __syncthreads();
}

constexpr int GM_W = 0, GM_V = 32768, GM_END = 98304;
__device__ __forceinline__ void gm_mix_unit(Frame& F, int unit, const bf16* Z, const bf16* VNB, const float* ws_, const float* bs, bf16* OABC) {
    const Tix T = tix();
    const int lane = T.lane, wave = T.wave, r = lane & 15, g4 = lane >> 4;
    const int n = unit >> 2, grp = unit & 3; const size_t row0 = (size_t)n * 128;
    __syncthreads();
#pragma unroll
    for (int i = 0; i < 4; ++i) { const int ci = T.tid + 512 * i, row = ci >> 4, ch = ci & 15; const float* wp = ws_ + ((size_t)grp * 128 + row) * 128 + 8 * ch;
        const f32x4 a = *(const f32x4*)wp, b = *(const f32x4*)(wp + 4); const int s0 = 8 * ch;
        v4u o; o.x = pk2(s0 + 0 <= row ? a.x : 0.f, s0 + 1 <= row ? a.y : 0.f); o.y = pk2(s0 + 2 <= row ? a.z : 0.f, s0 + 3 <= row ? a.w : 0.f);
        o.z = pk2(s0 + 4 <= row ? b.x : 0.f, s0 + 5 <= row ? b.y : 0.f); o.w = pk2(s0 + 6 <= row ? b.z : 0.f, s0 + 7 <= row ? b.w : 0.f);
        *(LAS v4u*)(F.lds + GM_W + offb((unsigned)row, (unsigned)ch)) = o; }
#pragma unroll
    for (int i = 0; i < 8; ++i) { const int ci = T.tid + 512 * i, row = ci >> 5, c32 = ci & 31;
        const v4u v = *(const v4u*)(VNB + (row0 + row) * 1024 + grp * 256 + 8 * c32);
        *(LAS v4u*)(F.lds + GM_V + (c32 >> 4) * 32768 + offb((unsigned)row, (unsigned)(c32 & 15))) = v; }
    __syncthreads();
    const unsigned lbase = (unsigned)(size_t)F.lds; const TrLane tl = tr_lane((unsigned)lane);
    bf16x8 Bf[2][4];
#pragma unroll
    for (int x = 0; x < 2; ++x) { const unsigned ct = 2u * wave + x;
        const unsigned vb = lbase + GM_V + (ct >> 3) * 32768u;
        tr_frag2(vb, tl, ct & 7u, Bf[x][0], Bf[x][1]); tr_frag2(vb + 16384u, tl, ct & 7u, Bf[x][2], Bf[x][3]); }
    const unsigned mr = ((unsigned)(r & 3) << 2) | ((unsigned)(r >> 2) & 3u);
#pragma unroll
    for (int j = 0; j < 8; ++j) {
        f32x4 acc0 = (f32x4){0.f, 0.f, 0.f, 0.f}, acc1 = acc0;
#pragma unroll
        for (int ks = 0; ks <= (j >> 1); ++ks) {
            const bf16x8 a = *(const LAS bf16x8*)(F.lds + GM_W + 256u * (16 * j + r) + 16u * (((unsigned)(4 * ks + g4)) ^ mr));
            acc0 = __builtin_amdgcn_mfma_f32_16x16x32_bf16(Bf[0][ks], a, acc0, 0, 0, 0); acc1 = __builtin_amdgcn_mfma_f32_16x16x32_bf16(Bf[1][ks], a, acc1, 0, 0, 0); }
        const int t = 16 * j + r; const size_t row = row0 + t; const float bb = bs[grp * 128 + t];
#pragma unroll
        for (int x = 0; x < 2; ++x) { const int c = grp * 256 + 32 * wave + 16 * x + 4 * g4; const f32x4 av = x ? acc1 : acc0;
            const v2u uq = *(const v2u*)(Z + row * NZ + ZUB + c);
            v2u o; o.x = pk2(geluf_(__uint_as_float(uq.x << 16)) * (av[0] + bb), geluf_(__uint_as_float(uq.x & 0xffff0000u)) * (av[1] + bb));
            o.y = pk2(geluf_(__uint_as_float(uq.y << 16)) * (av[2] + bb), geluf_(__uint_as_float(uq.y & 0xffff0000u)) * (av[3] + bb));
            *(v2u*)(OABC + row * 4096 + 2048 + c) = o; }
    }
}

constexpr int SW_K = 0, SW_V = 32768, SW_END = 65536;
__device__ __forceinline__ void swa_unit(Frame& F, int unit, const bf16* Z, const float* sinks, bf16* OABC) {
    const Tix T = tix();
    const int lane = T.lane, wave = T.wave, r = lane & 15, g = lane >> 4;
    const int kv = unit & 3, n = (unit >> 2) & 31, b = unit >> 7;
    const size_t rowq0 = (size_t)b * SEQ + n * 128;
    __syncthreads();
#pragma unroll
    for (int i = 0; i < 4; ++i) { const int ci = T.tid + 512 * i, key = ci >> 3, ch = ci & 7;
        v4u kk = (v4u){0u, 0u, 0u, 0u}, vv = kk;
        if (n > 0 || key >= 128) { const bf16* zp = Z + (rowq0 - 128 + key) * NZ + kv * 64 + 8 * ch; kk = *(const v4u*)(zp + ZKC); vv = *(const v4u*)(zp + ZVC); }
        const unsigned o = 128u * key + 16u * ((unsigned)ch ^ (unsigned)(key & 7));
        *(LAS v4u*)(F.lds + SW_K + o) = kk; *(LAS v4u*)(F.lds + SW_V + o) = vv; }
    __syncthreads();
    const int head = kv * 4 + (wave >> 1), qh = wave & 1;
    const float slope = exp2f(-0.5f * (float)(head + 1)), sink = sinks[head];
    const unsigned lbase = (unsigned)(size_t)F.lds;
    bf16x8 qfa[4][2];
#pragma unroll
    for (int qt = 0; qt < 4; ++qt)
#pragma unroll
        for (int ks = 0; ks < 2; ++ks) qfa[qt][ks] = *(const bf16x8*)(Z + (rowq0 + 64 * qh + 16 * qt + r) * NZ + ZQC + head * 64 + 32 * ks + 8 * g);
#pragma unroll
    for (int qt = 0; qt < 4; ++qt) {
        const int i0 = 64 * qh + 16 * qt, a = i0 >> 4;
        const size_t qrow = rowq0 + i0 + r;
        bf16x8 qf[2]; qf[0] = qfa[qt][0]; qf[1] = qfa[qt][1];
        f32x4 st[10];
#pragma unroll
        for (int t = 0; t < 9; ++t) { const int krow = 16 * (a + t) + r; f32x4 acc = (f32x4){0.f, 0.f, 0.f, 0.f};
#pragma unroll
            for (int ks = 0; ks < 2; ++ks) { const bf16x8 kf = *(const LAS bf16x8*)(F.lds + SW_K + 128u * krow + 16u * (((unsigned)(4 * ks + g)) ^ (unsigned)(krow & 7)));
                acc = __builtin_amdgcn_mfma_f32_16x16x32_bf16(kf, qf[ks], acc, 0, 0, 0); }
            st[t] = acc; }
        st[9] = (f32x4){0.f, 0.f, 0.f, 0.f};
        const int iq = i0 + r; float mx = sink;
#pragma unroll
        for (int t = 0; t < 9; ++t)
#pragma unroll
            for (int e = 0; e < 4; ++e) { const int j = 16 * (a + t) + 4 * g + e, dist = 128 + iq - j; const bool ok = dist >= 0 && dist < 128 && (n > 0 || j >= 128);
                const float s = ok ? st[t][e] * 0.125f - slope * (float)dist : -1e30f; st[t][e] = s; mx = fmaxf(mx, s); }
        mx = fmaxf(mx, __shfl_xor(mx, 16)); mx = fmaxf(mx, __shfl_xor(mx, 32));
        float sum = 0.f;
#pragma unroll
        for (int t = 0; t < 9; ++t)
#pragma unroll
            for (int e = 0; e < 4; ++e) { const float p = __expf(st[t][e] - mx); st[t][e] = p; sum += p; }
        sum += __shfl_xor(sum, 16); sum += __shfl_xor(sum, 32);
        const float inv = 1.0f / (sum + __expf(sink - mx));
        f32x4 o[4];
#pragma unroll
        for (int dt = 0; dt < 4; ++dt) o[dt] = (f32x4){0.f, 0.f, 0.f, 0.f};
#pragma unroll
        for (int pr = 0; pr < 5; ++pr) {
            const v4u pw = (v4u){cvtpk(st[2 * pr][0], st[2 * pr][1]), cvtpk(st[2 * pr][2], st[2 * pr][3]), cvtpk(st[2 * pr + 1][0], st[2 * pr + 1][1]), cvtpk(st[2 * pr + 1][2], st[2 * pr + 1][3])};
            const bf16x8 pf = __builtin_bit_cast(bf16x8, pw);
            const int q4 = r >> 2, p4 = r & 3;
            const int k0 = 16 * (a + 2 * pr) + 4 * g + q4; int k1 = k0 + 16; if (k1 > 255) k1 = 255;
            const unsigned b0 = lbase + SW_V + 128u * k0 + 8u * (p4 & 1), b1 = lbase + SW_V + 128u * k1 + 8u * (p4 & 1);
            const unsigned x0 = (unsigned)(k0 & 7), x1 = (unsigned)(k1 & 7), ph = (unsigned)(p4 >> 1);
            u16x4 r0, r1, r2, r3, r4, r5, r6, r7;
            asm volatile("ds_read_b64_tr_b16 %0, %8\n\tds_read_b64_tr_b16 %1, %9\n\tds_read_b64_tr_b16 %2, %10\n\tds_read_b64_tr_b16 %3, %11\n\t"
                         "ds_read_b64_tr_b16 %4, %12\n\tds_read_b64_tr_b16 %5, %13\n\tds_read_b64_tr_b16 %6, %14\n\tds_read_b64_tr_b16 %7, %15\n\ts_waitcnt lgkmcnt(0)"
                         : "=&v"(r0), "=&v"(r1), "=&v"(r2), "=&v"(r3), "=&v"(r4), "=&v"(r5), "=&v"(r6), "=&v"(r7)
                         : "v"(b0 + 16u * ((0u + ph) ^ x0)), "v"(b1 + 16u * ((0u + ph) ^ x1)), "v"(b0 + 16u * ((2u + ph) ^ x0)), "v"(b1 + 16u * ((2u + ph) ^ x1)),
                           "v"(b0 + 16u * ((4u + ph) ^ x0)), "v"(b1 + 16u * ((4u + ph) ^ x1)), "v"(b0 + 16u * ((6u + ph) ^ x0)), "v"(b1 + 16u * ((6u + ph) ^ x1)) : "memory");
            const bf16x8 v0 = (bf16x8){(short)r0[0], (short)r0[1], (short)r0[2], (short)r0[3], (short)r1[0], (short)r1[1], (short)r1[2], (short)r1[3]};
            const bf16x8 v1 = (bf16x8){(short)r2[0], (short)r2[1], (short)r2[2], (short)r2[3], (short)r3[0], (short)r3[1], (short)r3[2], (short)r3[3]};
            const bf16x8 v2 = (bf16x8){(short)r4[0], (short)r4[1], (short)r4[2], (short)r4[3], (short)r5[0], (short)r5[1], (short)r5[2], (short)r5[3]};
            const bf16x8 v3 = (bf16x8){(short)r6[0], (short)r6[1], (short)r6[2], (short)r6[3], (short)r7[0], (short)r7[1], (short)r7[2], (short)r7[3]};
            o[0] = __builtin_amdgcn_mfma_f32_16x16x32_bf16(v0, pf, o[0], 0, 0, 0); o[1] = __builtin_amdgcn_mfma_f32_16x16x32_bf16(v1, pf, o[1], 0, 0, 0);
            o[2] = __builtin_amdgcn_mfma_f32_16x16x32_bf16(v2, pf, o[2], 0, 0, 0); o[3] = __builtin_amdgcn_mfma_f32_16x16x32_bf16(v3, pf, o[3], 0, 0, 0);
        }
        bf16* op = OABC + qrow * 4096 + 3072 + head * 64 + 4 * g;
#pragma unroll
        for (int dt = 0; dt < 4; ++dt) { v2u w; w.x = pk2(o[dt][0] * inv, o[dt][1] * inv); w.y = pk2(o[dt][2] * inv, o[dt][3] * inv); *(v2u*)(op + 16 * dt) = w; }
    }
}

__device__ __forceinline__ void swa_sample_wave(Frame& F, int item, const bf16* Z, const float* sinks, const float* ck, const float* cv, bf16* OABC) {
    const Tix T = tix();
    const int lane = T.lane, b = item >> 4, head = item & 15, kv = head >> 2; const size_t row = MP + b;
    LAS float* sq = (LAS float*)(F.lds + T.wave * 1024); LAS float* sp = sq + 64;
    const float slope = exp2f(-0.5f * (float)(head + 1)), sink = sinks[head];
    sq[lane] = bf2f(Z[row * NZ + ZQC + head * 64 + lane]);
    LDS_WAIT();
    float s2[2];
#pragma unroll
    for (int u = 0; u < 2; ++u) { const int j = 1 + lane + 64 * u;
        float s = 0.f;
        if (j < 128) { const float* kp = ck + ((size_t)(b * 128 + j) * 4 + kv) * 64;
#pragma unroll
            for (int d4 = 0; d4 < 16; ++d4) { const f32x4 kk = *(const f32x4*)(kp + 4 * d4); const f32x4 qq = *(const LAS f32x4*)(sq + 4 * d4); s += (qq.x * kk.x + qq.y * kk.y) + (qq.z * kk.z + qq.w * kk.w); } }
        else { const bf16* kp = Z + row * NZ + ZKC + kv * 64;
#pragma unroll
            for (int d = 0; d < 64; ++d) s += sq[d] * bf2f(kp[d]); }
        s2[u] = s * 0.125f - slope * (float)(128 - j); }
    float mx = fmaxf(fmaxf(s2[0], s2[1]), sink);
#pragma unroll
    for (int o = 1; o < 64; o <<= 1) mx = fmaxf(mx, __shfl_xor(mx, o));
    const float p0 = __expf(s2[0] - mx), p1 = __expf(s2[1] - mx);
    const float inv = 1.0f / (wave_sum(p0 + p1) + __expf(sink - mx));
    sp[lane] = p0; sp[64 + lane] = p1;
    LDS_WAIT();
    { const int jq = lane >> 4, d4 = 4 * (lane & 15); f32x4 acc = (f32x4){0.f, 0.f, 0.f, 0.f};
      f32x4 vv[32];
#pragma unroll
      for (int i = 0; i < 32; ++i) { const int jj = 4 * i + jq;
          if (jj < 127) vv[i] = *(const f32x4*)(cv + ((size_t)(b * 128 + jj + 1) * 4 + kv) * 64 + d4);
          else { const v2u w = *(const v2u*)(Z + row * NZ + ZVC + kv * 64 + d4); vv[i] = (f32x4){__uint_as_float(w.x << 16), __uint_as_float(w.x & 0xffff0000u), __uint_as_float(w.y << 16), __uint_as_float(w.y & 0xffff0000u)}; } }
#pragma unroll
      for (int i = 0; i < 32; ++i) acc += vv[i] * sp[4 * i + jq];
#pragma unroll
      for (int j = 0; j < 4; ++j) { acc[j] += __shfl_xor(acc[j], 16); acc[j] += __shfl_xor(acc[j], 32); }
      if (jq == 0) { v2u w; w.x = pk2(acc[0] * inv, acc[1] * inv); w.y = pk2(acc[2] * inv, acc[3] * inv); *(v2u*)(OABC + row * 4096 + 3072 + head * 64 + d4) = w; } }
    LDS_WAIT();
}

constexpr int MD_PITCH = 208;
__device__ __forceinline__ void mod_direct(Frame& F, const bf16* CA  , const float* wada  , const float* bada  , float* MOD  ) {
    const Tix T = tix();
    const int lane = T.lane, wave = T.wave, r = lane & 15, g = lane >> 4;
    for (int sl = (int)blockIdx.x; sl < 256; sl += F.G) {
        const int l = sl >> 7, n0 = (sl & 127) * 96;
        const float* W = wada + (size_t)l * D * NADA + n0;
        f32x4 acc[7];
#pragma unroll
        for (int i = 0; i < 7; ++i) acc[i] = (f32x4){0.f, 0.f, 0.f, 0.f};
        f32x4 pw[6];
        const unsigned sk0 = (unsigned)(T.tid / 24), sq0 = (unsigned)(T.tid % 24);
#define MD_LOAD(kb) do { unsigned kk = sk0, q = sq0; _Pragma("unroll") for (int i = 0; i < 6; ++i) { pw[i] = *(const f32x4*)(W + (size_t)((kb) * 128 + kk) * NADA + 4 * q); q += 8; kk += 21; if (q >= 24) { q -= 24; kk += 1; } } } while (0)
        MD_LOAD(0);
        const unsigned lbase = (unsigned)(size_t)F.lds;
        for (int kb = 0; kb < 16; ++kb) {
            __syncthreads();
            { unsigned kk = sk0, q = sq0;
#pragma unroll
              for (int i = 0; i < 6; ++i) { v2u w; w.x = pk2(pw[i].x, pw[i].y); w.y = pk2(pw[i].z, pw[i].w); *(LAS v2u*)(F.lds + kk * MD_PITCH + 8 * q) = w; q += 8; kk += 21; if (q >= 24) { q -= 24; kk += 1; } } }
            __syncthreads();
            if (kb + 1 < 16) MD_LOAD(kb + 1);
            bf16x8 af[4], ag[4];
#pragma unroll
            for (int k4 = 0; k4 < 4; ++k4) { af[k4] = *(const bf16x8*)(CA + (size_t)(16 * wave + r) * D + kb * 128 + 32 * k4 + 8 * g); ag[k4] = *(const bf16x8*)(CA + (size_t)(128 + r) * D + kb * 128 + 32 * k4 + 8 * g); }
#pragma unroll
            for (int ks = 0; ks < 4; ++ks) {
                const bf16x8 a0 = af[ks], a8 = ag[ks];
                const unsigned q4 = (unsigned)(r >> 2), p4 = (unsigned)(r & 3);
                const unsigned a_lo = lbase + (32u * ks + 8u * g + q4) * MD_PITCH + 8u * p4, a_hi = a_lo + 4u * MD_PITCH;
                u16x4 t0, t1, t2, t3, t4, t5, t6, t7, t8, t9, ta, tb;
                asm volatile("ds_read_b64_tr_b16 %0, %12\n\tds_read_b64_tr_b16 %1, %13\n\tds_read_b64_tr_b16 %2, %12 offset:32\n\tds_read_b64_tr_b16 %3, %13 offset:32\n\t"
                             "ds_read_b64_tr_b16 %4, %12 offset:64\n\tds_read_b64_tr_b16 %5, %13 offset:64\n\tds_read_b64_tr_b16 %6, %12 offset:96\n\tds_read_b64_tr_b16 %7, %13 offset:96\n\t"
                             "ds_read_b64_tr_b16 %8, %12 offset:128\n\tds_read_b64_tr_b16 %9, %13 offset:128\n\tds_read_b64_tr_b16 %10, %12 offset:160\n\tds_read_b64_tr_b16 %11, %13 offset:160\n\ts_waitcnt lgkmcnt(0)"
                             : "=&v"(t0), "=&v"(t1), "=&v"(t2), "=&v"(t3), "=&v"(t4), "=&v"(t5), "=&v"(t6), "=&v"(t7), "=&v"(t8), "=&v"(t9), "=&v"(ta), "=&v"(tb) : "v"(a_lo), "v"(a_hi) : "memory");
#define MD_FR(lo, hi) (bf16x8){(short)lo[0], (short)lo[1], (short)lo[2], (short)lo[3], (short)hi[0], (short)hi[1], (short)hi[2], (short)hi[3]}
                const bf16x8 bfr[6] = {MD_FR(t0, t1), MD_FR(t2, t3), MD_FR(t4, t5), MD_FR(t6, t7), MD_FR(t8, t9), MD_FR(ta, tb)};
#undef MD_FR
#pragma unroll
                for (int nt = 0; nt < 6; ++nt) {
                    acc[nt] = __builtin_amdgcn_mfma_f32_16x16x32_bf16(a0, bfr[nt], acc[nt], 0, 0, 0);
                    if (nt == wave) acc[6] = __builtin_amdgcn_mfma_f32_16x16x32_bf16(a8, bfr[nt], acc[6], 0, 0, 0);
                }
            }
        }
#undef MD_LOAD
        float* mo = MOD + (size_t)l * 256 * NADA; const float* bb = bada + (size_t)l * NADA;
#pragma unroll
        for (int nt = 0; nt < 6; ++nt) { const int col = n0 + 16 * nt + r; const float bv = bb[col];
#pragma unroll
            for (int e = 0; e < 4; ++e) mo[(size_t)(16 * wave + 4 * g + e) * NADA + col] = acc[nt][e] + bv; }
        if (wave < 6) { const int col = n0 + 16 * wave + r; const float bv = bb[col];
#pragma unroll
            for (int e = 0; e < 4; ++e) mo[(size_t)(128 + 4 * g + e) * NADA + col] = acc[6][e] + bv; }
        __syncthreads();
    }
}

__device__ __forceinline__ void gla_scan(Frame& F, float* GST, const float* GAMS) {
    const Tix T = tix();
    const int gw = F.vcu * NWAVES + T.wave, NGW = F.G * NWAVES, g = T.lane >> 4;
    for (int item = gw; item < 8 * 4 * 8 * 16; item += NGW) {
        const int i = item & 15, w = (item >> 4) & 7, qs = (item >> 7) & 3, bh = item >> 9;
        f32x4 G[8], Gm[8];
#pragma unroll
        for (int sc = 0; sc < 8; ++sc) { const int grp = bh * 8 + sc;
            G[sc] = *((const f32x4*)(GST + ((((size_t)grp * 4 + qs) * 8 + w) * 16 + i) * 256) + T.lane);
            Gm[sc] = *(const f32x4*)(GAMS + (size_t)grp * 256 + 16 * i + 4 * g); }
        f32x4 S = G[0] * 0.0f;
#pragma unroll
        for (int sc = 0; sc < 8; ++sc) { const int grp = bh * 8 + sc;
            *((f32x4*)(GST + ((((size_t)grp * 4 + qs) * 8 + w) * 16 + i) * 256) + T.lane) = S;
            S = Gm[sc] * S + G[sc]; }
    }
}
constexpr int NPH = 27;
#ifndef EN_CONV
#define EN_CONV 1
#endif
#ifndef EN_MOD
#define EN_MOD 1
#endif
#ifndef EN_NORM
#define EN_NORM 1
#endif
#ifndef EN_WIN
#define EN_WIN 1
#endif
#ifndef EN_GK
#define EN_GK 1
#endif
#ifndef EN_GLAN
#define EN_GLAN 1
#endif
#ifndef EN_MIXA
#define EN_MIXA 1
#endif
#ifndef EN_MIXB
#define EN_MIXB 1
#endif
#ifndef EN_PROJ
#define EN_PROJ 1
#endif
#ifndef EN_WO
#define EN_WO 1
#endif
#ifndef EN_FFI
#define EN_FFI 1
#endif
#ifndef EN_FFO
#define EN_FFO 1
#endif
#ifndef EN_FINAL
#define EN_FINAL 1
#endif
#ifndef MK_PROBE
#define MK_PROBE 0
#endif
#ifndef MK_REP_K
#define MK_REP_K 0
#endif
#ifndef MK_REP_N
#define MK_REP_N 0
#endif
#ifndef MK_REP_VAR
#define MK_REP_VAR 0
#endif
#ifndef MK_ONE_LAUNCH
#define MK_ONE_LAUNCH 1
#endif
typedef const __attribute__((address_space(4))) Prm* KPrm;
__device__ __forceinline__ KPrm kargs() { KPrm p = (KPrm)__builtin_amdgcn_kernarg_segment_ptr(); asm volatile("" : "+s"(p)); return p; }
#define PH_BEGIN KPrm K = kargs(); unsigned char* ws = K->ws; (void)ws;
__global__ void __launch_bounds__(NT, 2) mega_fwd(Prm P_unused) {
    extern __shared__ __attribute__((aligned(16))) unsigned char lds_raw[];
    Frame F;
    F.lds = (LAS unsigned char*)lds_raw;
    F.G = gridDim.x; { const int bx = blockIdx.x; F.vcu = (F.G % 8 == 0) ? (bx % 8) * (F.G / 8) + bx / 8 : bx; }
    volatile LAS unsigned* MISC = (volatile LAS unsigned*)(F.lds + MISC_OFF);
    if (threadIdx.x < 64) MISC[threadIdx.x] = 0u;
    __syncthreads();
    int lo, hi;
    XcdBarrier bar;
    { KPrm K = kargs(); lo = K->ph_lo; hi = K->ph_hi; unsigned* ctl = (unsigned*)(K->ws + WS_CTL);
      bar.bar = ctl + CW_BAR; bar.x = 0; bar.st = nullptr;
      if (hi - lo > 1) bar = xcd_barrier_post(ctl + CW_BAR, MISC + 8); }
#define IN(k) (lo <= (k) && (k) < hi)
#define SEAM(k) do { if (IN(k) && IN((k) + 1)) xcd_barrier(bar); } while (0)
#define WSP(T, off) ((T*)(ws + (off)))

    if (EN_CONV && IN(0)) { phase_convert(F); }
    SEAM(0);
    if (EN_MOD && IN(1)) { PH_BEGIN mod_direct(F, WSP(const bf16, WS_CA), K->in[I_WADA], K->in[I_BADA], WSP(float, WS_MOD)); }
    SEAM(1);
#if 0
    SEAM(0);
    if (EN_MOD && IN(1)) {
        PH_BEGIN
        const int c = (int)blockIdx.x, l = c / 48;
        if (l < 2) {
            pg8::Gemm g{WSP(const bf16, WS_CA), WSP(const bf16, WS_WADA) + (size_t)l * NADA * D, 256, NADA, D, D};
            pg8::StaticOrder S; S.init(256, NADA, 1 << 20, c - 48 * l, D);
            pg8::EpiF32 E{WSP(float, WS_MOD) + (size_t)l * 256 * NADA, NADA, K->in[I_BADA] + (size_t)l * NADA};
            pg8::gemm_phase<pg8::EpiF32, pg8::StaticOrder, true, true>(F.lds, g, S, E);
        }
    }
    SEAM(1);
#endif

    for (int l = 0; l < 2; ++l) {
        const int pb = 2 + 12 * l;
        if (EN_NORM && IN(pb + 0)) { PH_BEGIN phase_norm_t<false>(F, WSP(float, WS_X), K->in[I_N1W] + (size_t)l * D, WSP(const float, WS_MOD) + (size_t)l * 256 * NADA, MOD_SH1, MOD_SC1, WSP(bf16, WS_H), nullptr, WSP(const float, WS_PART + 16 * MiB), l == 0 ? 0 : 11); }
        SEAM(pb + 0);
        if (EN_WIN && IN(pb + 1)) {
            PH_BEGIN
            pg8::Gemm g{WSP(const bf16, WS_H), WSP(const bf16, WS_WIN) + (size_t)l * NZW * D, MT, NZ, D, D};
            pg8::StaticOrder S; S.init(MT, NZ, F.G, (int)blockIdx.x, D);
            pg8::EpiZ E{WSP(bf16, WS_Z), NZ, ZGT / 256, K->var};
            pg8::gemm_phase<pg8::EpiZ, pg8::StaticOrder, true, true>(F.lds, g, S, E);
        }
        SEAM(pb + 1);
        if (IN(pb + 2)) {
            PH_BEGIN
            const bf16* Zb = WSP(const bf16, WS_Z); const bf16* Hb = WSP(const bf16, WS_H); const bf16* Wl = WSP(const bf16, WS_WIN) + (size_t)l * NZW * D + (size_t)ZLR * D;
            const float* wgk2 = K->in[I_WGK2] + (size_t)l * 16 * 1024; const float* bgk = K->in[I_BGK] + (size_t)l * 1024;
            const int ow = (int)blockIdx.x, OW = F.G;
            for (int half = 0; half < 2; ++half) {
                if ((half == 0) == ((ow & 1) == 1)) {
                    if (EN_MIXA && !(K->var & 8)) for (int u = ow; u < 512; u += OW) gla_sample_unit(F, u, Zb, Hb, Wl, wgk2, bgk, K->in[I_SGLA] + (size_t)l * 128 * 4 * 256 * 512, K->out + O_SGS + (size_t)l * 128 * 4 * 256 * 512, K->in[I_GLANW] + (size_t)l * 512, WSP(bf16, WS_OABC));
                } else {
                    if (EN_GLAN && !(K->var & 16)) for (int u = ow; u < 512; u += OW) gla_prep_unit(F, u, Zb, Hb, Wl, wgk2, bgk, WSP(bf16, WS_QT), WSP(bf16, WS_KH), WSP(bf16, WS_AI), WSP(float, WS_GAM));
                    if (EN_MIXA && !(K->var & 32)) {
                        __syncthreads();
                        if (!(K->var & 64)) gm_ln_rows(F, ow, OW, Zb, K->in[I_GMNW] + (size_t)l * 1024, K->in[I_GMNB] + (size_t)l * 1024, WSP(bf16, WS_VNB), K->out + O_GMV + (size_t)l * 128 * 1024, K->in[I_GMWS] + (size_t)l * 4 * 128 * 128, K->in[I_GMBS] + (size_t)l * 4 * 128, WSP(bf16, WS_OABC));
                        if (!(K->var & 128)) for (int u = ow; u < 256; u += OW) swa_unit(F, u, Zb, K->in[I_SINK] + (size_t)l * 16, WSP(bf16, WS_OABC));
                        __syncthreads();
                        if (!(K->var & 256)) for (int it = ow * NWAVES + tix().wave; it < MS * 16; it += OW * NWAVES) swa_sample_wave(F, it, Zb, K->in[I_SINK] + (size_t)l * 16, K->in[I_CK] + (size_t)l * 128 * 128 * 256, K->in[I_CV] + (size_t)l * 128 * 128 * 256, WSP(bf16, WS_OABC));
                        __syncthreads();
                        cache_outs(F, ow, OW, l, Zb, K->out);
                    }
                }
            }
        }
        SEAM(pb + 2);
        if (IN(pb + 3)) {
            PH_BEGIN
            if (EN_GLAN) for (int w = (int)blockIdx.x; w < 256; w += F.G) gla_pass<false>(F, w, WSP(const bf16, WS_Z), WSP(const bf16, WS_QT), WSP(const bf16, WS_KH), WSP(const bf16, WS_AI), WSP(const float, WS_GAM), WSP(float, WS_GST), WSP(float, WS_GAMS), nullptr, nullptr);
            if (EN_MIXB) for (int u = (int)blockIdx.x; u < 256; u += F.G) gm_mix_unit(F, u, WSP(const bf16, WS_Z), WSP(const bf16, WS_VNB), K->in[I_GMWS] + (size_t)l * 4 * 128 * 128, K->in[I_GMBS] + (size_t)l * 4 * 128, WSP(bf16, WS_OABC));
        }
        SEAM(pb + 3);
        if (EN_GLAN && IN(pb + 4)) { PH_BEGIN gla_scan(F, WSP(float, WS_GST), WSP(const float, WS_GAMS)); }
        SEAM(pb + 4);
        if (IN(pb + 5)) {
            PH_BEGIN
            if (EN_GLAN) for (int w = (int)blockIdx.x; w < 256; w += F.G) gla_pass<true>(F, w, WSP(const bf16, WS_Z), WSP(const bf16, WS_QT), WSP(const bf16, WS_KH), WSP(const bf16, WS_AI), WSP(const float, WS_GAM), WSP(float, WS_GST), WSP(float, WS_GAMS), WSP(float, WS_OB), K->out + O_SGP + (size_t)l * 2 * 4 * 256 * 512);
        }
        SEAM(pb + 5);
        if (EN_MIXB && IN(pb + 6)) { PH_BEGIN gla_fin(F, WSP(const float, WS_OB), WSP(const bf16, WS_Z), K->in[I_GLANW] + (size_t)l * 512, WSP(bf16, WS_OABC)); }
        SEAM(pb + 6);
        if (EN_PROJ && IN(pb + 7)) {
            PH_BEGIN
            pg8::Gemm g{WSP(const bf16, WS_OABC), WSP(const bf16, WS_WPRJ) + (size_t)l * D * 4096, MT, D, 4096, 4096};
            pg8::MiniOrder S; S.init(F.G, (int)blockIdx.x, 4096, 8, K->var);
            pg8::EpiProjR E{WSP(const bf16, WS_Z), NZ, ZGT, WSP(float, WS_PART), WSP(bf16, WS_MG), MP, K->var};
            pg8::gemm_phase<pg8::EpiProjR, pg8::MiniOrder, true, true>(F.lds, g, S, E);
        }
        SEAM(pb + 7);
        if (EN_WO && IN(pb + 8)) {
            PH_BEGIN
            pg8::Gemm g{WSP(const bf16, WS_MG), WSP(const bf16, WS_WO) + (size_t)l * D * D, MT, D, D, D};
            pg8::MiniOrder S; S.init(F.G, (int)blockIdx.x, D, 4, K->var);
            {
              const Tix T = tix(); pg8::Unit u;
              for (int i = 0; S.next(i, u); ++i) if (u.pm >= 32) { const int k0 = 64 * u.kt0, kw = 16 * u.nt;
                  for (int idx0 = T.tid; idx0 < 128 * kw; idx0 += 4 * NT) {
                      f32x4 pv[4][8];
#pragma unroll
                      for (int q = 0; q < 4; ++q) { const int idx = idx0 + q * NT, r = idx / kw, c = k0 + 4 * (idx % kw);
#pragma unroll
                          for (int s = 0; s < 8; ++s) pv[q][s] = *(const f32x4*)(WSP(const float, WS_PART) + ((size_t)s * 128 + r) * D + c); }
#pragma unroll
                      for (int q = 0; q < 4; ++q) { const int idx = idx0 + q * NT, r = idx / kw, c = k0 + 4 * (idx % kw);
                          const f32x4 v = ((pv[q][0] + pv[q][1]) + (pv[q][2] + pv[q][3])) + ((pv[q][4] + pv[q][5]) + (pv[q][6] + pv[q][7]));
                          v2u w; w.x = pk2(v.x, v.y); w.y = pk2(v.z, v.w); *(v2u*)(WSP(bf16, WS_MG) + (size_t)(MP + r) * D + c) = w; } }
                  for (int idx = T.tid; idx < 128 * kw; idx += NT) { const int r = 128 + idx / kw, c = k0 + 4 * (idx % kw); *(v2u*)(WSP(bf16, WS_MG) + (size_t)(MP + r) * D + c) = (v2u){0u, 0u}; } }
              VM_WAIT(); __syncthreads(); }
            pg8::EpiResid E{WSP(float, WS_X), WSP(const float, WS_MOD) + (size_t)l * 256 * NADA + MOD_G1, NADA, WSP(float, WS_PART + 8 * MiB), MP, K->var};
            pg8::gemm_phase<pg8::EpiResid, pg8::MiniOrder, true, true>(F.lds, g, S, E);
        }
        SEAM(pb + 8);
        if (EN_NORM && IN(pb + 9)) { PH_BEGIN phase_norm_t<false>(F, WSP(float, WS_X), K->in[I_N2W] + (size_t)l * D, WSP(const float, WS_MOD) + (size_t)l * 256 * NADA, MOD_SH2, MOD_SC2, WSP(bf16, WS_H), nullptr, WSP(const float, WS_PART + 8 * MiB), 8); }
        SEAM(pb + 9);
        if (EN_FFI && IN(pb + 10)) {
            PH_BEGIN
            pg8::Gemm g{WSP(const bf16, WS_H), WSP(const bf16, WS_WFI) + (size_t)l * 2 * FF * D, MT, 2 * FF, D, D};
            pg8::StaticOrder S; S.init(MT, 2 * FF, F.G, (int)blockIdx.x, D);
            pg8::EpiSwiGLU E{WSP(bf16, WS_ACT), FF};
            pg8::gemm_phase<pg8::EpiSwiGLU, pg8::StaticOrder, true, true>(F.lds, g, S, E);
        }
        SEAM(pb + 10);
        if (EN_FFO && IN(pb + 11)) {
            PH_BEGIN
            pg8::Gemm g{WSP(const bf16, WS_ACT), WSP(const bf16, WS_WFO) + (size_t)l * D * FF, MT, D, FF, FF};
            pg8::MiniOrder S; S.init(F.G, (int)blockIdx.x, FF, 8, K->var);
            pg8::EpiResid E{WSP(float, WS_X), WSP(const float, WS_MOD) + (size_t)l * 256 * NADA + MOD_G2, NADA, WSP(float, WS_PART + 16 * MiB), MP, K->var};
            pg8::gemm_phase<pg8::EpiResid, pg8::MiniOrder, true, true>(F.lds, g, S, E);
        }
        SEAM(pb + 11);
    }
    if (EN_FINAL && IN(26)) { PH_BEGIN phase_norm_t<true>(F, WSP(float, WS_X), K->in[I_FNW], nullptr, 0, 0, nullptr, K->out, WSP(const float, WS_PART + 16 * MiB), 11); }
#undef IN
#undef SEAM
}

extern "C" void kernel_launch(void* const* d_in, const int* in_sizes, int n_in, void* d_out, int out_size, void* d_ws, size_t ws_size, hipStream_t stream) {
    static int grid = 0;
    if (grid == 0) {
        if (n_in != N_IN || (size_t)out_size != O_END || ws_size < WS_END) { fprintf(stderr, "kernel_launch: unexpected problem (n_in %d, out %d, ws %zu); nothing launched\n", n_in, out_size, ws_size); grid = -1; return; }
        int dev = 0, cus = 0, per_cu = 0;
        if (hipGetDevice(&dev) != hipSuccess || hipDeviceGetAttribute(&cus, hipDeviceAttributeMultiprocessorCount, dev) != hipSuccess) { grid = -1; return; }
        if (hipFuncSetAttribute((const void*)mega_fwd, hipFuncAttributeMaxDynamicSharedMemorySize, LDS_BYTES) != hipSuccess) { fprintf(stderr, "kernel_launch: hipFuncSetAttribute failed\n"); grid = -1; return; }
        if (hipOccupancyMaxActiveBlocksPerMultiprocessor(&per_cu, (const void*)mega_fwd, NT, LDS_BYTES) != hipSuccess || per_cu < 1) { fprintf(stderr, "kernel_launch: occupancy query says %d\n", per_cu); }
        (void)hipGetLastError();
        grid = cus;
        if (grid < 128) { fprintf(stderr, "kernel_launch: this build needs >= 128 CUs (mini-unit deal)\n"); grid = -1; return; }
    }
    if (grid < 0) return;
    (void)hipMemsetAsync((char*)d_ws + WS_CTL, 0, CTL_ZERO_BYTES, stream);
    Prm p{};
    for (int i = 0; i < N_IN; ++i) p.in[i] = (const float*)d_in[i];
    p.out = (float*)d_out; p.ws = (unsigned char*)d_ws;
#if MK_ONE_LAUNCH
    p.ph_lo = 0; p.ph_hi = NPH;
    hipLaunchKernelGGL(mega_fwd, dim3(grid), dim3(NT), LDS_BYTES, stream, p);
#if MK_PROBE
    for (int i = 0; i < MK_REP_N; ++i) { p.ph_lo = MK_REP_K; p.ph_hi = MK_REP_K + 1; p.var = MK_REP_VAR; hipLaunchKernelGGL(mega_fwd, dim3(grid), dim3(NT), LDS_BYTES, stream, p); }
#endif
#else
    for (int k = 0; k < NPH; ++k) { p.ph_lo = k; p.ph_hi = k + 1; hipLaunchKernelGGL(mega_fwd, dim3(grid), dim3(NT), LDS_BYTES, stream, p); }
#endif
}
```

```cpp
#include <hip/hip_runtime.h>
#include <cstdio>
#include <cstdint>
namespace pg8 {
#define PG8_LAS __attribute__((address_space(3)))
typedef unsigned short bf16_t;
typedef short bf16x8 __attribute__((ext_vector_type(8)));
typedef float f32x4 __attribute__((ext_vector_type(4)));
typedef unsigned u32x4 __attribute__((ext_vector_type(4)));
constexpr int BM = 256, BK = 64, HALF = 128, HTB = HALF * BK * 2  , STAGE_BYTES = 8 * HTB, NXCD = 8, WGM = 8;

__host__ __device__ __forceinline__ int lds_byte(int r, int c) { const int st = (r >> 4) * 2 + (c >> 5), rr = r & 15, cc = c & 31, ob = rr * 64 + cc * 2; return st * 1024 + (ob ^ (((ob >> 9) & 1) << 5)); }
__host__ __device__ __forceinline__ void stage_rc(int b, int& R, int& C) { const int st = b / 1024, sb = b % 1024, swz = sb ^ (((sb >> 9) & 1) << 5); R = (st >> 1) * 16 + swz / 64; C = (st & 1) * 32 + (swz % 64) / 2; }
__host__ __device__ __forceinline__ int perm32(int rho) { const int n = rho >> 4, i = rho & 15; return 8 * (i >> 2) + 4 * n + (i & 3); }

struct Unit { int pm, pn, kt0, nt; };
struct Gemm { const bf16_t* A; const bf16_t* Bt; int M, N, K, ld; };

struct StaticOrder {
    int nM, nN, nwg, G, c, ntf;
    __host__ __device__ __forceinline__ void init(int M, int N, int G_, int c_, int K) { nM = M / BM; nN = N / BM; nwg = nM * nN; G = G_; c = c_; ntf = K / BK; }
    __host__ __device__ __forceinline__ bool next(int i, Unit& u) const {
        const long L = (long)i * G + c; if (L >= nwg) return false;
        int wgid = (int)L; { const int q = nwg / NXCD, r = nwg % NXCD, xcd = wgid % NXCD, off = wgid / NXCD; wgid = (xcd < r ? xcd * (q + 1) : r * (q + 1) + (xcd - r) * q) + off; }
        const int nig = WGM * nN, gid = wgid / nig, fm = gid * WGM, gsz = (nM - fm) < WGM ? (nM - fm) : WGM;
        u.pm = fm + ((wgid % nig) % gsz); u.pn = (wgid % nig) / gsz; u.kt0 = 0; u.nt = ntf; return true;
    }
    __device__ __forceinline__ void a_ready(const Unit&) const {}
    __device__ __forceinline__ void done(const Unit&) const {}
};
struct MiniOrder {
    StaticOrder main; int nmini, ntm;
    __host__ __device__ __forceinline__ void init(int G_, int c_, int K, int ntm_, int var = 0) { main.init(32 * BM, 2048, G_, c_, K); ntm = ntm_; nmini = (var & 4) ? 0 : 8 * ((K / BK) / ntm_); }
    __host__ __device__ __forceinline__ bool next(int i, Unit& u) const {
        const bool has_mini = main.c < nmini;
        if (has_mini && i == 0) { const int m = main.c; u.pm = 32; u.pn = m & 7; u.kt0 = ntm * (m >> 3); u.nt = ntm; return true; }
        return main.next(has_mini ? i - 1 : i, u);
    }
    __device__ __forceinline__ void a_ready(const Unit&) const {}
    __device__ __forceinline__ void done(const Unit&) const {}
};


typedef __bf16 bf16x2_t __attribute__((ext_vector_type(2)));
__device__ __forceinline__ unsigned cvt_pk_bf16(float lo, float hi) { bf16x2_t v; v[0] = (__bf16)lo; v[1] = (__bf16)hi; return __builtin_bit_cast(unsigned, v); }
typedef float f32x2 __attribute__((ext_vector_type(2)));
__device__ __forceinline__ f32x2 gelu_pk(f32x2 v) {
    const f32x2 av = __builtin_elementwise_abs(v), d = av * 0.2316418882f + 1.0f;
    f32x2 t; t.x = __builtin_amdgcn_rcpf(d.x); t.y = __builtin_amdgcn_rcpf(d.y);
    f32x2 q = t * 0.5307027145f + (-0.7265760135f); q = q * t + 0.7107068705f; q = q * t + (-0.142248368f); q = q * t + 0.127414796f; q = q * t;
    const f32x2 s = (v * v) * (-0.72134752044f);
    f32x2 e; e.x = __builtin_amdgcn_exp2f(s.x); e.y = __builtin_amdgcn_exp2f(s.y);
    const f32x2 m = v * (q * e), r = v - m;
    f32x2 o; o.x = v.x < 0.f ? m.x : r.x; o.y = v.y < 0.f ? m.y : r.y; return o;
}

template <int ACT  > struct EpiBf16 {
    static constexpr bool PERM = true, AFTER_DRAIN = false, HAS_HOOK = false; static_assert(ACT == 0 || ACT == 1, "EpiBf16: ACT is 0 (none) or 1 (gelu_pk)");
    bf16_t* O; int ldc; const float* bias; int split_cols; size_t split_stride; float scale0;
    __device__ __forceinline__ void operator()(const f32x4 (&acc)[2][2][4][2], const Unit& u, int wr, int wc, int fr, int fq) const {
        const int row0 = u.pm * BM + wr * 64 + fr; int colt = u.pn * BM; bf16_t* base = O;
        float sc = 1.f; if (split_cols) { const int t = colt / split_cols; base += (size_t)t * split_stride; colt -= t * split_cols; if (t == 0) sc = scale0; }
        const int col0 = colt + wc * 32 + 8 * fq, bcol0 = u.pn * BM + wc * 32 + 8 * fq;
        f32x4 bv[2][2];
#pragma unroll
        for (int bj = 0; bj < 2; ++bj)
#pragma unroll
            for (int n = 0; n < 2; ++n) bv[bj][n] = bias ? *(const f32x4*)(bias + bcol0 + bj * HALF + 4 * n) : (f32x4){0.f, 0.f, 0.f, 0.f};
#pragma unroll
        for (int ai = 0; ai < 2; ++ai)
#pragma unroll
            for (int m = 0; m < 4; ++m) { bf16_t* rowp = base + (size_t)(row0 + ai * HALF + m * 16) * ldc + col0;
#pragma unroll
                for (int bj = 0; bj < 2; ++bj) { f32x4 v0 = acc[ai][bj][m][0] + bv[bj][0], v1 = acc[ai][bj][m][1] + bv[bj][1];
                    if (ACT == 1) { f32x2 a = gelu_pk((f32x2){v0[0], v0[1]}), b = gelu_pk((f32x2){v0[2], v0[3]}), c = gelu_pk((f32x2){v1[0], v1[1]}), d = gelu_pk((f32x2){v1[2], v1[3]});
                        v0 = (f32x4){a.x, a.y, b.x, b.y}; v1 = (f32x4){c.x, c.y, d.x, d.y}; }
                    v0 = v0 * sc; v1 = v1 * sc; u32x4 w; w.x = cvt_pk_bf16(v0[0], v0[1]); w.y = cvt_pk_bf16(v0[2], v0[3]); w.z = cvt_pk_bf16(v1[0], v1[1]); w.w = cvt_pk_bf16(v1[2], v1[3]);
                    *(u32x4*)(rowp + bj * HALF) = w; } }
    }
};
struct EpiF32 {
    static constexpr bool PERM = false, AFTER_DRAIN = false, HAS_HOOK = false;
    float* C; int ldc; const float* bias;
    __device__ __forceinline__ void operator()(const f32x4 (&acc)[2][2][4][2], const Unit& u, int wr, int wc, int fr, int fq) const {
        const int row0 = u.pm * BM + wr * 64 + fr, col0 = u.pn * BM + wc * 32 + 4 * fq;
        f32x4 bv[2][2];
#pragma unroll
        for (int bj = 0; bj < 2; ++bj)
#pragma unroll
            for (int n = 0; n < 2; ++n) bv[bj][n] = bias ? *(const f32x4*)(bias + col0 + bj * HALF + n * 16) : (f32x4){0.f, 0.f, 0.f, 0.f};
#pragma unroll
        for (int ai = 0; ai < 2; ++ai)
#pragma unroll
            for (int m = 0; m < 4; ++m) { float* rowp = C + (size_t)(row0 + ai * HALF + m * 16) * ldc + col0;
#pragma unroll
                for (int bj = 0; bj < 2; ++bj)
#pragma unroll
                    for (int n = 0; n < 2; ++n) *(f32x4*)(rowp + bj * HALF + n * 16) = acc[ai][bj][m][n] + bv[bj][n]; }
    }
};
__device__ __forceinline__ float bf_lo(unsigned w) { return __uint_as_float(w << 16); }
__device__ __forceinline__ float bf_hi(unsigned w) { return __uint_as_float(w & 0xffff0000u); }
__device__ __forceinline__ float fsigmoid(float x) { return __builtin_amdgcn_rcpf(1.0f + __expf(-x)); }
__device__ __forceinline__ float fsilu(float x) { return x * fsigmoid(x); }
__device__ __forceinline__ int batch_of_row(int row) { return row < 4096 ? 0 : (row < 8192 ? 1 : (row - 8192 < 128 ? row - 8190 : 129)); }
typedef unsigned u32x2 __attribute__((ext_vector_type(2)));

struct EpiZ {
    static constexpr bool PERM = true, AFTER_DRAIN = false, HAS_HOOK = false;
    bf16_t* O; int ldc; int gate_pn0; int var;
    __device__ __forceinline__ void operator()(const f32x4 (&acc)[2][2][4][2], const Unit& u, int wr, int wc, int fr, int fq) const {
        if (var & 1) return;
        const int row0 = u.pm * BM + wr * 64 + fr, col0 = u.pn * BM + wc * 32 + 8 * fq; const bool gt = (u.pn >= gate_pn0) && !(var & 2);
#pragma unroll
        for (int ai = 0; ai < 2; ++ai)
#pragma unroll
            for (int m = 0; m < 4; ++m) { bf16_t* rowp = O + (size_t)(row0 + ai * HALF + m * 16) * ldc + col0;
#pragma unroll
                for (int bj = 0; bj < 2; ++bj) { f32x4 v0 = acc[ai][bj][m][0], v1 = acc[ai][bj][m][1];
                    if (gt) {
#pragma unroll
                        for (int j = 0; j < 4; ++j) { v0[j] = 1.0f + __expf(-fminf(fmaxf(v0[j], -40.f), 40.f)); v1[j] = 1.0f + __expf(-fminf(fmaxf(v1[j], -40.f), 40.f)); } }
                    u32x4 w; w.x = cvt_pk_bf16(v0[0], v0[1]); w.y = cvt_pk_bf16(v0[2], v0[3]); w.z = cvt_pk_bf16(v1[0], v1[1]); w.w = cvt_pk_bf16(v1[2], v1[3]);
                    *(u32x4*)(rowp + bj * HALF) = w; } }
    }
};
struct EpiProjR {
    static constexpr bool PERM = true, AFTER_DRAIN = false, HAS_HOOK = true;
    const bf16_t* Z; int ldz; int gcol0; float* PART; bf16_t* MG; int mp0; int var;
    __device__ __forceinline__ bool hook_at(const Unit& u, int t) const { return u.nt == 64 && (t == 32 || t == 48) && !(var & 2); }
    __device__ __forceinline__ void hook(f32x4 (&acc)[2][2][4][2], const Unit& u, int t, int wr, int wc, int fr, int fq) const {
        int row0 = u.pm * BM + wr * 64 + fr, col0 = u.pn * BM + wc * 32 + 8 * fq; asm volatile("" : "+v"(row0), "+v"(col0));
        const int gp = gcol0 + (t == 32 ? 0 : 2048);
#pragma unroll
        for (int ai = 0; ai < 2; ++ai) {
            u32x4 gprev[4][2], gnext[4][2];
#pragma unroll
            for (int m = 0; m < 4; ++m) { const bf16_t* zp = Z + (size_t)(row0 + ai * HALF + m * 16) * ldz + gp + col0;
#pragma unroll
                for (int bj = 0; bj < 2; ++bj) { gprev[m][bj] = *(const u32x4*)(zp + bj * HALF); gnext[m][bj] = *(const u32x4*)(zp + 2048 + bj * HALF); } }
#pragma unroll
            for (int m = 0; m < 4; ++m)
#pragma unroll
                for (int bj = 0; bj < 2; ++bj) { const u32x4 gpv = gprev[m][bj], gnx = gnext[m][bj];
                    f32x4 r0, r1; r0[0] = bf_lo(gnx.x) * __builtin_amdgcn_rcpf(bf_lo(gpv.x)); r0[1] = bf_hi(gnx.x) * __builtin_amdgcn_rcpf(bf_hi(gpv.x));
                    r0[2] = bf_lo(gnx.y) * __builtin_amdgcn_rcpf(bf_lo(gpv.y)); r0[3] = bf_hi(gnx.y) * __builtin_amdgcn_rcpf(bf_hi(gpv.y));
                    r1[0] = bf_lo(gnx.z) * __builtin_amdgcn_rcpf(bf_lo(gpv.z)); r1[1] = bf_hi(gnx.z) * __builtin_amdgcn_rcpf(bf_hi(gpv.z));
                    r1[2] = bf_lo(gnx.w) * __builtin_amdgcn_rcpf(bf_lo(gpv.w)); r1[3] = bf_hi(gnx.w) * __builtin_amdgcn_rcpf(bf_hi(gpv.w));
                    acc[ai][bj][m][0] = acc[ai][bj][m][0] * r0; acc[ai][bj][m][1] = acc[ai][bj][m][1] * r1; }
            asm volatile("" ::: "memory"); }
        asm volatile("s_waitcnt vmcnt(0)" ::: "memory");
    }
    __device__ __forceinline__ void operator()(const f32x4 (&acc)[2][2][4][2], const Unit& u, int wr, int wc, int fr, int fq) const {
        if (var & 1) return;
        int row0 = u.pm * BM + wr * 64 + fr, col0 = u.pn * BM + wc * 32 + 8 * fq; asm volatile("" : "+v"(row0), "+v"(col0));
        const bool mini = u.nt != 64; const int br = mini ? (u.kt0 < 32 ? 0 : (u.kt0 < 48 ? 1 : 2)) : 2;
#pragma unroll
        for (int ai = 0; ai < 2; ++ai) {
            u32x4 gw[4][2];
#pragma unroll
            for (int m = 0; m < 4; ++m) { const bf16_t* zp = Z + (size_t)(row0 + ai * HALF + m * 16) * ldz + gcol0 + br * 2048 + col0;
#pragma unroll
                for (int bj = 0; bj < 2; ++bj) gw[m][bj] = *(const u32x4*)(zp + bj * HALF); }
#pragma unroll
            for (int m = 0; m < 4; ++m) { const int row = row0 + ai * HALF + m * 16;
#pragma unroll
                for (int bj = 0; bj < 2; ++bj) { const int col = col0 + bj * HALF; const u32x4 gq = gw[m][bj];
                    f32x4 g0, g1; g0[0] = __builtin_amdgcn_rcpf(bf_lo(gq.x)); g0[1] = __builtin_amdgcn_rcpf(bf_hi(gq.x)); g0[2] = __builtin_amdgcn_rcpf(bf_lo(gq.y)); g0[3] = __builtin_amdgcn_rcpf(bf_hi(gq.y));
                    g1[0] = __builtin_amdgcn_rcpf(bf_lo(gq.z)); g1[1] = __builtin_amdgcn_rcpf(bf_hi(gq.z)); g1[2] = __builtin_amdgcn_rcpf(bf_lo(gq.w)); g1[3] = __builtin_amdgcn_rcpf(bf_hi(gq.w));
                    const f32x4 v0 = acc[ai][bj][m][0] * g0, v1 = acc[ai][bj][m][1] * g1;
                    if (!mini) { u32x4 w; w.x = cvt_pk_bf16(v0[0], v0[1]); w.y = cvt_pk_bf16(v0[2], v0[3]); w.z = cvt_pk_bf16(v1[0], v1[1]); w.w = cvt_pk_bf16(v1[2], v1[3]); *(u32x4*)(MG + (size_t)row * 2048 + col) = w; }
                    else if (ai == 0) { float* pp = PART + ((size_t)(u.kt0 / u.nt) * 128 + (row - mp0)) * 2048 + col; *(f32x4*)pp = v0; *(f32x4*)(pp + 4) = v1; } } }
            asm volatile("" ::: "memory"); }
    }
};
struct EpiResid {
    static constexpr bool PERM = false, AFTER_DRAIN = false, HAS_HOOK = false;
    float* X; const float* Xin; const float* gate; int ldg; float* PART; int mp0; int var;
    __device__ __forceinline__ void operator()(const f32x4 (&acc)[2][2][4][2], const Unit& u, int wr, int wc, int fr, int fq) const {
        if (var & 1) return;
        int row0 = u.pm * BM + wr * 64 + fr, col0 = u.pn * BM + wc * 32 + 4 * fq; asm volatile("" : "+v"(row0), "+v"(col0)); const bool mini = u.pm >= 32;
#pragma unroll
        for (int ai = 0; ai < 2; ++ai)
#pragma unroll
            for (int mp = 0; mp < 2; ++mp) {
                f32x4 gg[2][4], xx[2][4];
#pragma unroll
                for (int mm = 0; mm < 2; ++mm) { const int row = row0 + ai * HALF + (2 * mp + mm) * 16; const float* gp = gate + (size_t)batch_of_row(row) * ldg + col0; const float* xp = Xin + (size_t)row * 2048 + col0;
#pragma unroll
                    for (int q = 0; q < 4; ++q) { gg[mm][q] = *(const f32x4*)(gp + (q >> 1) * HALF + (q & 1) * 16); if (!mini) xx[mm][q] = *(const f32x4*)(xp + (q >> 1) * HALF + (q & 1) * 16); } }
#pragma unroll
                for (int mm = 0; mm < 2; ++mm) { const int m = 2 * mp + mm, row = row0 + ai * HALF + m * 16; float* xp = X + (size_t)row * 2048 + col0;
#pragma unroll
                    for (int q = 0; q < 4; ++q) { float* xq = xp + (q >> 1) * HALF + (q & 1) * 16; const f32x4 v = gg[mm][q] * acc[ai][q >> 1][m][q & 1];
                        if (!mini) *(f32x4*)xq = xx[mm][q] + v;
                        else if (ai == 0) *(f32x4*)(PART + ((size_t)(u.kt0 / u.nt) * 128 + (row - mp0)) * 2048 + col0 + (q >> 1) * HALF + (q & 1) * 16) = v; } }
                asm volatile("" ::: "memory"); }
    }
};
struct EpiSwiGLU {
    static constexpr bool PERM = true, AFTER_DRAIN = false, HAS_HOOK = false;
    bf16_t* ACT; int ldc;
    __device__ __forceinline__ void operator()(const f32x4 (&acc)[2][2][4][2], const Unit& u, int wr, int wc, int fr, int fq) const {
        const int row0 = u.pm * BM + wr * 64 + fr, col0 = u.pn * HALF + wc * 32 + 8 * fq;
#pragma unroll
        for (int ai = 0; ai < 2; ++ai)
#pragma unroll
            for (int m = 0; m < 4; ++m) { bf16_t* rowp = ACT + (size_t)(row0 + ai * HALF + m * 16) * ldc + col0;
                const f32x4 a0 = acc[ai][0][m][0], a1 = acc[ai][0][m][1], b0 = acc[ai][1][m][0], b1 = acc[ai][1][m][1];
                u32x4 w; w.x = cvt_pk_bf16(fsilu(a0[0]) * b0[0], fsilu(a0[1]) * b0[1]); w.y = cvt_pk_bf16(fsilu(a0[2]) * b0[2], fsilu(a0[3]) * b0[3]);
                w.z = cvt_pk_bf16(fsilu(a1[0]) * b1[0], fsilu(a1[1]) * b1[1]); w.w = cvt_pk_bf16(fsilu(a1[2]) * b1[2], fsilu(a1[3]) * b1[3]);
                *(u32x4*)rowp = w; }
    }
};
template <class Epi, class Sched, bool ALIGN_EPI = false, bool SP2 = false>
__device__ __forceinline__ void gemm_phase(PG8_LAS unsigned char* lds, const Gemm g, const Sched& S, const Epi& E) {
    int tid_ = threadIdx.x; asm volatile("" : "+v"(tid_));
    const int tid = tid_, wid = __builtin_amdgcn_readfirstlane(tid >> 6), lane = tid & 63, wr = wid >> 2, wc = wid & 3, fr = lane & 15, fq = lane >> 4;
    const int LD = g.ld;
    unsigned voffA[2], voffB[2];
#pragma unroll
    for (int i = 0; i < 2; ++i) { int R, C; stage_rc(tid * 16 + i * 8192, R, C); const int Rb = Epi::PERM ? ((R & ~31) + perm32(R & 31)) : R;
        voffA[i] = (unsigned)(R * LD + C) * 2u; voffB[i] = (unsigned)(Rb * LD + C) * 2u; }
    const size_t kstep = (size_t)(BK * 2);
    const size_t hstep = (size_t)HALF * LD * 2;
    const size_t tstep = 2 * hstep;
    const unsigned ldsw = (unsigned)wid * 1024u;
    const int aoff = lds_byte(wr * 64 + fr, fq * 8), boff = lds_byte(wc * 32 + fr, fq * 8);
#define PG8_SA(b, h) (((b) * 2 + (h)) * HTB)
#define PG8_SB(b, h) ((4 + (b) * 2 + (h)) * HTB)
#define PG8_STAGE(bufoff, gbase, voff) do { _Pragma("unroll") for (int _i = 0; _i < 2; ++_i) \
        __builtin_amdgcn_global_load_lds((const unsigned*)((const char*)(gbase) + (voff)[_i]), (PG8_LAS unsigned*)(lds + (bufoff) + ldsw + _i * 8192), 16, 0, 0); } while (0)
#define PG8_LDA(dst, b, h) do { _Pragma("unroll") for (int m = 0; m < 4; ++m) _Pragma("unroll") for (int k = 0; k < 2; ++k) dst[m][k] = *(const PG8_LAS bf16x8*)(lds + PG8_SA(b, h) + aoff + m * 2048 + k * 1024); } while (0)
#define PG8_LDB(dst, b, h) do { _Pragma("unroll") for (int n = 0; n < 2; ++n) _Pragma("unroll") for (int k = 0; k < 2; ++k) dst[n][k] = *(const PG8_LAS bf16x8*)(lds + PG8_SB(b, h) + boff + n * 2048 + k * 1024); } while (0)
#define PG8_MMA(ai, bj, At, Bt) do { __builtin_amdgcn_s_setprio(1); _Pragma("unroll") for (int m = 0; m < 4; ++m) _Pragma("unroll") for (int n = 0; n < 2; ++n) _Pragma("unroll") for (int k = 0; k < 2; ++k) \
        acc[ai][bj][m][n] = __builtin_amdgcn_mfma_f32_16x16x32_bf16(Bt[n][k], At[m][k], acc[ai][bj][m][n], 0, 0, 0); __builtin_amdgcn_s_setprio(0); } while (0)
#define PG8_WAIT_V(n) asm volatile("s_waitcnt vmcnt(" #n ")" ::: "memory")
#define PG8_WAIT_L(n) asm volatile("s_waitcnt lgkmcnt(" #n ")" ::: "memory")
#define PG8_BAR __builtin_amdgcn_s_barrier()
#define PG8_SCHED __builtin_amdgcn_sched_barrier(0)
    Unit cur, nxt; int ui = 0;
    if (!S.next(0, cur)) return;
    f32x4 acc[2][2][4][2];
#pragma unroll
    for (int a = 0; a < 2; ++a)
#pragma unroll
        for (int b = 0; b < 2; ++b)
#pragma unroll
            for (int m = 0; m < 4; ++m)
#pragma unroll
                for (int n = 0; n < 2; ++n) acc[a][b][m][n] = (f32x4){0.f, 0.f, 0.f, 0.f};
    bf16x8 At[4][2], B0[2][2], B1[2][2];
    const char* cA = (const char*)g.A + (size_t)cur.pm * tstep + (size_t)cur.kt0 * kstep; const char* cB = (const char*)g.Bt + (size_t)cur.pn * tstep + (size_t)cur.kt0 * kstep;
    S.a_ready(cur);
    if constexpr (SP2) {
        PG8_STAGE(PG8_SB(0, 0), cB, voffB); PG8_STAGE(PG8_SB(0, 1), cB + hstep, voffB); PG8_STAGE(PG8_SA(0, 0), cA, voffA); PG8_STAGE(PG8_SA(0, 1), cA + hstep, voffA);
        if (wr == 1) PG8_BAR;
        PG8_WAIT_V(2); PG8_BAR;
        PG8_STAGE(PG8_SB(1, 0), cB + kstep, voffB); PG8_STAGE(PG8_SA(1, 0), cA + kstep, voffA); PG8_STAGE(PG8_SB(1, 1), cB + hstep + kstep, voffB);
        PG8_WAIT_V(6); PG8_BAR;
    } else {
        PG8_STAGE(PG8_SB(0, 0), cB, voffB); PG8_STAGE(PG8_SA(0, 0), cA, voffA); PG8_STAGE(PG8_SB(0, 1), cB + hstep, voffB); PG8_STAGE(PG8_SA(0, 1), cA + hstep, voffA);
        if (wr == 1) PG8_BAR;
        PG8_WAIT_V(4); PG8_BAR;
        PG8_STAGE(PG8_SB(1, 0), cB + kstep, voffB); PG8_STAGE(PG8_SA(1, 0), cA + kstep, voffA); PG8_STAGE(PG8_SB(1, 1), cB + hstep + kstep, voffB);
        PG8_WAIT_V(6); PG8_BAR;
    }
    for (;;) {
        const bool has_next = S.next(ui + 1, nxt);
        const char* nA = has_next ? (const char*)g.A + (size_t)nxt.pm * tstep + (size_t)nxt.kt0 * kstep : cA; const char* nB = has_next ? (const char*)g.Bt + (size_t)nxt.pn * tstep + (size_t)nxt.kt0 * kstep : cB;
        const int nt = cur.nt;
        for (int t = 0; t < nt; t += 2) {
            const bool last = (t == nt - 2);
            if constexpr (Epi::HAS_HOOK) { if (E.hook_at(cur, t)) E.hook(acc, cur, t, wr, wc, fr, fq); }
            const char* a1 = cA + (size_t)(t + 1) * kstep;
            const char* a2 = last ? nA : cA + (size_t)(t + 2) * kstep; const char* b2 = last ? nB : cB + (size_t)(t + 2) * kstep;
            const char* a3 = a2 + kstep; const char* b3 = b2 + kstep;
            if (last && has_next) S.a_ready(nxt);
            if constexpr (SP2) {
            PG8_LDB(B0, 0, 0); PG8_LDB(B1, 0, 1); PG8_SCHED; PG8_LDA(At, 0, 0); PG8_STAGE(PG8_SA(1, 1), a1 + hstep, voffA);
            PG8_WAIT_V(8); PG8_WAIT_L(0); PG8_BAR; PG8_MMA(0, 0, At, B0); PG8_MMA(0, 1, At, B1); PG8_BAR; PG8_SCHED;
            PG8_LDA(At, 0, 1); PG8_STAGE(PG8_SB(0, 0), b2, voffB); PG8_STAGE(PG8_SB(0, 1), b2 + hstep, voffB); PG8_STAGE(PG8_SA(0, 0), a2, voffA);
            PG8_WAIT_V(8); PG8_WAIT_L(0); PG8_BAR; PG8_MMA(1, 0, At, B0); PG8_MMA(1, 1, At, B1); PG8_BAR; PG8_SCHED;
            PG8_LDB(B0, 1, 0); PG8_LDB(B1, 1, 1); PG8_SCHED; PG8_LDA(At, 1, 0); PG8_STAGE(PG8_SA(0, 1), a2 + hstep, voffA);
            PG8_WAIT_V(8); PG8_WAIT_L(0); PG8_BAR; PG8_MMA(0, 0, At, B0); PG8_MMA(0, 1, At, B1); PG8_BAR; PG8_SCHED;
            PG8_LDA(At, 1, 1); PG8_STAGE(PG8_SB(1, 0), b3, voffB); PG8_STAGE(PG8_SB(1, 1), b3 + hstep, voffB); PG8_STAGE(PG8_SA(1, 0), a3, voffA);
            PG8_WAIT_V(8); PG8_WAIT_L(0); PG8_BAR; PG8_MMA(1, 0, At, B0); PG8_MMA(1, 1, At, B1); PG8_BAR; PG8_SCHED;
            } else {
            PG8_LDB(B0, 0, 0); PG8_SCHED; PG8_LDA(At, 0, 0); PG8_STAGE(PG8_SA(1, 1), a1 + hstep, voffA);
            PG8_WAIT_L(8); PG8_BAR; PG8_WAIT_L(0); PG8_MMA(0, 0, At, B0); PG8_BAR; PG8_SCHED;
            PG8_LDB(B1, 0, 1); PG8_STAGE(PG8_SB(0, 0), b2, voffB);
            PG8_BAR; PG8_WAIT_L(0); PG8_MMA(0, 1, At, B1); PG8_BAR;
            PG8_LDA(At, 0, 1); PG8_STAGE(PG8_SA(0, 0), a2, voffA);
            PG8_BAR; PG8_WAIT_L(0); PG8_MMA(1, 0, At, B0); PG8_BAR; PG8_SCHED;
            PG8_STAGE(PG8_SB(0, 1), b2 + hstep, voffB);
            PG8_WAIT_V(6); PG8_BAR; PG8_MMA(1, 1, At, B1); PG8_BAR;
            PG8_LDB(B0, 1, 0); PG8_SCHED; PG8_LDA(At, 1, 0); PG8_STAGE(PG8_SA(0, 1), a2 + hstep, voffA);
            PG8_WAIT_L(8); PG8_BAR; PG8_WAIT_L(0); PG8_MMA(0, 0, At, B0); PG8_BAR; PG8_SCHED;
            PG8_LDB(B1, 1, 1); PG8_STAGE(PG8_SB(1, 0), b3, voffB);
            PG8_BAR; PG8_WAIT_L(0); PG8_MMA(0, 1, At, B1); PG8_BAR;
            PG8_LDA(At, 1, 1); PG8_STAGE(PG8_SA(1, 0), a3, voffA);
            PG8_BAR; PG8_WAIT_L(0); PG8_MMA(1, 0, At, B0); PG8_BAR; PG8_SCHED;
            PG8_STAGE(PG8_SB(1, 1), b3 + hstep, voffB);
            PG8_WAIT_V(6); PG8_BAR; PG8_MMA(1, 1, At, B1); PG8_BAR;
            }
        }
        if constexpr (ALIGN_EPI) { if (wr == 0) PG8_BAR; }
        if constexpr (!Epi::AFTER_DRAIN) { E(acc, cur, wr, wc, fr, fq); S.done(cur); }
        if (!has_next) break;
#pragma unroll
        for (int a = 0; a < 2; ++a)
#pragma unroll
            for (int b = 0; b < 2; ++b)
#pragma unroll
                for (int m = 0; m < 4; ++m)
#pragma unroll
                    for (int n = 0; n < 2; ++n) acc[a][b][m][n] = (f32x4){0.f, 0.f, 0.f, 0.f};
        cur = nxt; cA = nA; cB = nB; ++ui;
        if constexpr (ALIGN_EPI) { if (wr == 1) PG8_BAR; }
    }
    PG8_WAIT_V(0);
    if constexpr (!ALIGN_EPI) { if (wr == 0) PG8_BAR; }
    PG8_BAR;
    if constexpr (Epi::AFTER_DRAIN) { E.fused(acc, cur, wr, wc, fr, fq, lds, wid, lane); S.done(cur); }
#undef PG8_SA
#undef PG8_SB
#undef PG8_STAGE
#undef PG8_LDA
#undef PG8_LDB
#undef PG8_MMA
#undef PG8_WAIT_V
#undef PG8_WAIT_L
#undef PG8_BAR
#undef PG8_SCHED
}
}
constexpr int NWAVES = 8, NT = NWAVES * 64;
constexpr int D = 2048, MP = 8192, MS = 128, MR = MP + MS, MT = 8448;
constexpr int SEQ = 4096;
constexpr int NZ = 15872;
constexpr int NZW = 16128;
constexpr int ZQA = 0, ZKA = 1024, ZVA = 2048, ZGA = 4096, ZUB = 6144, ZVB = 7168, ZQC = 8192, ZKC = 9216, ZVC = 9472, ZGT = 9728, ZLR = 15872;
constexpr int NIN = 15888, FF = 5632, NADA = 12288;
constexpr int MOD_SH1 = 0, MOD_SC1 = 2048, MOD_G1 = 4096, MOD_SH2 = 6144, MOD_SC2 = 8192, MOD_G2 = 10240;
constexpr float EPS = 1e-6f;
constexpr size_t O_YP = 0, O_YS = 16777216, O_SGP = 17039360, O_SGS = 19136512, O_CKP = 153354240, O_CVP = 153485312, O_CKS = 153616384, O_CVS = 153681920, O_GMV = 153747456, O_END = 154009600;
enum { I_XP = 0, I_XS, I_CP, I_CS, I_SGLA, I_CK, I_CV, I_WADA, I_BADA, I_N1W, I_N2W, I_WIN, I_WGK2, I_BGK, I_GLANW, I_GMNW, I_GMNB, I_GMWS, I_GMBS, I_SINK, I_WPA, I_WPB, I_WPC, I_WO, I_WFI, I_WFO, I_FNW, N_IN };

constexpr size_t MiB = 1u << 20;
constexpr size_t WS_CTL = 0, CTL_ZERO_BYTES = 1 * MiB;
constexpr size_t WS_WADA = 2 * MiB;
constexpr size_t WS_CA   = WS_WADA + 2 * 48 * MiB;
constexpr size_t WS_MOD  = WS_CA + 1 * MiB;
constexpr size_t WS_WIN  = WS_MOD + 24 * MiB;
constexpr size_t WS_WPRJ = WS_WIN + 2 * 63 * MiB;
constexpr size_t WS_WO   = WS_WPRJ + 32 * MiB;
constexpr size_t WS_WFI  = WS_WO + 16 * MiB;
constexpr size_t WS_WFO  = WS_WFI + 88 * MiB;
constexpr size_t WS_X    = WS_WFO + 44 * MiB;
constexpr size_t WS_H    = WS_X + 66 * MiB;
constexpr size_t WS_Z    = WS_H + 33 * MiB;
constexpr size_t WS_OABC = WS_Z + 260 * MiB;
constexpr size_t WS_M32  = WS_OABC + 66 * MiB;
constexpr size_t WS_MG   = WS_M32 + 66 * MiB;
constexpr size_t WS_ACT  = WS_MG + 33 * MiB;
constexpr size_t WS_GK   = WS_ACT + 91 * MiB;
constexpr size_t WS_OB   = WS_GK + 33 * MiB;
constexpr size_t WS_VN   = WS_OB + 65 * MiB;
constexpr size_t WS_QT   = WS_VN + 33 * MiB;
constexpr size_t WS_KH   = WS_QT + 16 * MiB;
constexpr size_t WS_AI   = WS_KH + 16 * MiB;
constexpr size_t WS_GAM  = WS_AI + 4 * MiB;
constexpr size_t WS_GST  = WS_GAM + 1 * MiB;
constexpr size_t WS_GAMS = WS_GST + 32 * MiB;
constexpr size_t WS_VNB  = WS_GAMS + 1 * MiB;
constexpr size_t WS_PART = WS_VNB + 16 * MiB;
constexpr size_t WS_END  = WS_PART + 32 * MiB;
static_assert((size_t)MT * NZ * 2 <= 260 * MiB && (size_t)MT * FF * 2 <= 91 * MiB && (size_t)NZW * D * 2 <= 63 * MiB, "ws map");
constexpr int CW_BAR = 4096;

constexpr int RING_BYTES = 131072;
constexpr int MISC_OFF = 150 * 1024;
constexpr int LDS_BYTES = 152 * 1024;

#define GAS __attribute__((address_space(1)))
#define LAS __attribute__((address_space(3)))
typedef unsigned short bf16;
typedef unsigned v4u __attribute__((ext_vector_type(4)));
typedef unsigned v2u __attribute__((ext_vector_type(2)));
typedef float f32x4 __attribute__((ext_vector_type(4)));
#define LDS_WAIT() asm volatile("s_waitcnt lgkmcnt(0)" ::: "memory")
#define VM_WAIT() asm volatile("s_waitcnt vmcnt(0)" ::: "memory")
typedef __bf16 bf16x2_t __attribute__((ext_vector_type(2)));
__device__ __forceinline__ unsigned pk2(float lo, float hi) { bf16x2_t v; v[0] = (__bf16)lo; v[1] = (__bf16)hi; return __builtin_bit_cast(unsigned, v); }
__device__ __forceinline__ unsigned f2bf(float f) { return pk2(f, 0.f) & 0xffffu; }
__device__ __forceinline__ float bf2f(bf16 b) { return __uint_as_float(((unsigned)b) << 16); }
__device__ __forceinline__ float wave_sum(float v) {
#pragma unroll
    for (int o = 1; o < 64; o <<= 1) v += __shfl_xor(v, o);
    return v;
}
__device__ __forceinline__ float sigmoidf_(float x) { return 1.0f / (1.0f + __expf(-x)); }
__device__ __forceinline__ float siluf_(float x) { return x * sigmoidf_(x); }
__device__ __forceinline__ float geluf_(float x) { return x * sigmoidf_(1.5957691216057308f * (x + 0.044715f * x * x * x)); }
__device__ __forceinline__ float logsigmoidf_(float x) { return fminf(x, 0.f) - log1pf(expf(-fabsf(x))); }
#define XB_TMO      128
#define XB_XCNT(j)  (256  + 64 * (j))
#define XB_XSUB(j)  (1280 + 64 * (j))
#define XB_XGEN(j)  (2304 + 64 * (j))
#define XB_TOP      3328
#define XB_TOPGEN   3392
#define XCD_BAR_WORDS 3456
#define XB_SPIN_CAP (1u << 18)

__device__ __forceinline__ unsigned xb_ld(unsigned* p)              { return __hip_atomic_load(p, __ATOMIC_RELAXED, __HIP_MEMORY_SCOPE_AGENT); }
__device__ __forceinline__ unsigned xb_add(unsigned* p, unsigned v) { return __hip_atomic_fetch_add(p, v, __ATOMIC_RELAXED, __HIP_MEMORY_SCOPE_AGENT); }
__device__ __forceinline__ unsigned xb_xcc_id() { return (unsigned)__builtin_amdgcn_s_getreg((3 << 11) | 20) & 0xFu; }
#define XB_SPIN(cond, bar) do { unsigned _sp = 0; while (cond) { __builtin_amdgcn_s_sleep(1); \
    if ((++_sp & 255u) == 0u) { if (xb_ld(&(bar)[XB_TMO])) break; if (_sp > XB_SPIN_CAP) { atomicAdd(&(bar)[XB_TMO], 1u); break; } } } } while (0)

struct XcdBarrier {
    unsigned* bar; unsigned x;
    volatile LAS unsigned* st;
};

__device__ __forceinline__ XcdBarrier xcd_barrier_post(unsigned* bar, volatile LAS unsigned* st) {
    XcdBarrier b; b.bar = bar; b.x = xb_xcc_id(); b.st = st;
    if (threadIdx.x == 0) (void)xb_add(&bar[XB_XCNT(b.x)], 1u);
    return b;
}
__device__ __forceinline__ void xcd_barrier_complete(unsigned* bar, unsigned x, unsigned& nloc, unsigned& nx) {
    const unsigned G = gridDim.x * gridDim.y * gridDim.z;
    unsigned sum, cnt, mine, sp = 0u;
    for (;;) {
        sum = 0u; cnt = 0u; mine = 0u;
#pragma unroll
        for (unsigned j = 0; j < 16; ++j) { const unsigned c = xb_ld(&bar[XB_XCNT(j)]); sum += c; cnt += (c > 0u) ? 1u : 0u; mine = (j == x) ? c : mine; }
        if (sum == G) break;
        __builtin_amdgcn_s_sleep(1);
        if ((++sp & 255u) == 0u) { if (xb_ld(&bar[XB_TMO])) break; if (sp > XB_SPIN_CAP) { atomicAdd(&bar[XB_TMO], 1u); break; } }
    }
    nloc = mine > 0u ? mine : 1u; nx = cnt > 0u ? cnt : 1u;
}

__device__ __forceinline__ void xcd_barrier(const XcdBarrier& b) {
    asm volatile("s_waitcnt vmcnt(0)" ::: "memory");
    __syncthreads();
    if (threadIdx.x == 0) {
        unsigned* bar = b.bar;
        __builtin_amdgcn_s_waitcnt(0);
        unsigned nloc = b.st[0], nx = b.st[1];
        if (nloc == 0u) { xcd_barrier_complete(bar, b.x, nloc, nx); b.st[0] = nloc; b.st[1] = nx; }
        const unsigned old = xb_add(&bar[XB_XSUB(b.x)], 1u);
        const unsigned gen = old / nloc;
        if (old + 1u == (gen + 1u) * nloc) {
            __builtin_amdgcn_fence(__ATOMIC_RELEASE, "agent");
            asm volatile("s_waitcnt vmcnt(0)" ::: "memory");
            const unsigned og = xb_add(&bar[XB_TOP], 1u);
            const unsigned tg = og / nx;
            if (og + 1u == (tg + 1u) * nx) xb_add(&bar[XB_TOPGEN], 1u);
            else XB_SPIN(xb_ld(&bar[XB_TOPGEN]) == tg, bar);
            __builtin_amdgcn_fence(__ATOMIC_ACQUIRE, "agent");
            xb_add(&bar[XB_XGEN(b.x)], 1u);
            asm volatile("s_waitcnt vmcnt(0)" ::: "memory");
        } else {
            XB_SPIN(xb_ld(&bar[XB_XGEN(b.x)]) == gen, bar);
            __builtin_amdgcn_fence(__ATOMIC_ACQUIRE, "agent");
            asm volatile("s_waitcnt vmcnt(0)" ::: "memory");
        }
    }
    __syncthreads();
}
struct Prm { const float* in[N_IN]; float* out; unsigned char* ws; int ph_lo, ph_hi, var, pad; };
static_assert(sizeof(Prm) == N_IN * 8 + 32, "Prm has no padding bytes");
struct Frame {
    LAS unsigned char* lds;
    int vcu, G;
};
struct Tix { int tid, lane, wave; };
__device__ __forceinline__ Tix tix() { int t = threadIdx.x; asm volatile("" : "+v"(t)); Tix r; r.tid = t; r.lane = t & 63; r.wave = __builtin_amdgcn_readfirstlane(t >> 6); return r; }

__device__ __forceinline__ int map_col(int mode, int n) {
    if (mode == 1) return n < 6144 ? n : (n < 6160 ? ZLR + (n - 6144) : n - 16);
    if (mode == 2) return n < FF ? ((n >> 7) * 256 + (n & 127)) : ((((n - FF) >> 7) * 256) + 128 + ((n - FF) & 127));
    return n;
}
__device__ __forceinline__ void conv_item(const float* W, int K, int N, bf16* WT, int ld, int koff, int mode, LAS float* scr, int item, int lane) {
    const int nkb = K / 64, nb = item / nkb, kb = item % nkb, k0 = 64 * kb, n0 = 64 * nb;
    const int q = lane & 15, kr = lane >> 4; const bool okc = (n0 + 4 * q) < N;
    f32x4 v[16];
#pragma unroll
    for (int i = 0; i < 16; ++i) v[i] = okc ? *(const f32x4*)(W + (size_t)(k0 + 4 * i + kr) * N + n0 + 4 * q) : (f32x4){0.f, 0.f, 0.f, 0.f};
#pragma unroll
    for (int i = 0; i < 16; ++i) { LAS float* s = scr + (4 * i + kr) * 65 + 4 * q; s[0] = v[i].x; s[1] = v[i].y; s[2] = v[i].z; s[3] = v[i].w; }
    LDS_WAIT(); asm volatile("" ::: "memory");
    const int c = lane & 7;
#pragma unroll
    for (int j = 0; j < 8; ++j) { const int n = (lane >> 3) + 8 * j; const LAS float* s = scr + (8 * c) * 65 + n;
        v4u o; o.x = pk2(s[0 * 65], s[1 * 65]); o.y = pk2(s[2 * 65], s[3 * 65]); o.z = pk2(s[4 * 65], s[5 * 65]); o.w = pk2(s[6 * 65], s[7 * 65]);
        if (n0 + n < N) *(GAS v4u*)(WT + (size_t)map_col(mode, n0 + n) * ld + koff + k0 + 8 * c) = o; }
    LDS_WAIT(); asm volatile("" ::: "memory");
}
struct ConvDesc { const float* W; bf16* WT; int K, N, ld, koff, mode, items; };

__device__ __forceinline__ void phase_convert(Frame& F) {
    const Tix T = tix();
    const __attribute__((address_space(4))) Prm* Pk = (const __attribute__((address_space(4))) Prm*)__builtin_amdgcn_kernarg_segment_ptr(); asm volatile("" : "+s"(Pk));
    LAS float* scr = (LAS float*)(F.lds + T.wave * 16640);
    const int gw = F.vcu * NWAVES + T.wave, NGW = F.G * NWAVES;
    unsigned char* ws = Pk->ws;
    for (int l = 0; l < 2; ++l) {
        for (int mi = 1; mi < 8; ++mi) {
            ConvDesc d;
            if (mi == 0)      { d.W = Pk->in[I_WADA] + (size_t)l * D * NADA; d.WT = (bf16*)(ws + WS_WADA) + (size_t)l * NADA * D; d.K = D; d.N = NADA; d.ld = D; d.koff = 0; d.mode = 0; }
            else if (mi == 1) { d.W = Pk->in[I_WIN] + (size_t)l * D * NIN;   d.WT = (bf16*)(ws + WS_WIN) + (size_t)l * NZW * D;    d.K = D; d.N = NIN;  d.ld = D; d.koff = 0; d.mode = 1; }
            else if (mi == 2) { d.W = Pk->in[I_WPA] + (size_t)l * 2048 * D;  d.WT = (bf16*)(ws + WS_WPRJ) + (size_t)l * D * 4096; d.K = 2048; d.N = D; d.ld = 4096; d.koff = 0; d.mode = 0; }
            else if (mi == 3) { d.W = Pk->in[I_WPB] + (size_t)l * 1024 * D;  d.WT = (bf16*)(ws + WS_WPRJ) + (size_t)l * D * 4096; d.K = 1024; d.N = D; d.ld = 4096; d.koff = 2048; d.mode = 0; }
            else if (mi == 4) { d.W = Pk->in[I_WPC] + (size_t)l * 1024 * D;  d.WT = (bf16*)(ws + WS_WPRJ) + (size_t)l * D * 4096; d.K = 1024; d.N = D; d.ld = 4096; d.koff = 3072; d.mode = 0; }
            else if (mi == 5) { d.W = Pk->in[I_WO] + (size_t)l * D * D;      d.WT = (bf16*)(ws + WS_WO) + (size_t)l * D * D;      d.K = D; d.N = D; d.ld = D; d.koff = 0; d.mode = 0; }
            else if (mi == 6) { d.W = Pk->in[I_WFI] + (size_t)l * D * 2 * FF; d.WT = (bf16*)(ws + WS_WFI) + (size_t)l * 2 * FF * D; d.K = D; d.N = 2 * FF; d.ld = D; d.koff = 0; d.mode = 2; }
            else              { d.W = Pk->in[I_WFO] + (size_t)l * FF * D;    d.WT = (bf16*)(ws + WS_WFO) + (size_t)l * D * FF;    d.K = FF; d.N = D; d.ld = FF; d.koff = 0; d.mode = 0; }
            d.items = (d.K / 64) * ((d.N + 63) / 64);
            for (int it = gw; it < d.items; it += NGW) conv_item(d.W, d.K, d.N, d.WT, d.ld, d.koff, d.mode, scr, it, T.lane);
        }
    }
    { bf16* CA = (bf16*)(ws + WS_CA);
      for (int i = blockIdx.x * NT + T.tid; i < 256 * D; i += F.G * NT) { const int r = i >> 11, c = i & 2047; float v = 0.f;
          if (r < 2) v = Pk->in[I_CP][r * D + c]; else if (r < 130) v = Pk->in[I_CS][(r - 2) * D + c];
          CA[i] = (bf16)f2bf(r < 130 ? siluf_(v) : 0.f); } }
    { f32x4* X4 = (f32x4*)(ws + WS_X); const f32x4* xp = (const f32x4*)Pk->in[I_XP]; const f32x4* xs = (const f32x4*)Pk->in[I_XS];
      (void)xp;
      for (int i = MP * D / 4 + blockIdx.x * NT + T.tid; i < MT * D / 4; i += F.G * NT) { const int r = i >> 9;
          X4[i] = r < MR ? xs[i - MP * D / 4] : (f32x4){0.f, 0.f, 0.f, 0.f}; } }
}

template <bool FINAL>
__device__ __forceinline__ void phase_norm_t(Frame& F, float* X, const float* nw, const float* mod, int sh_off, int sc_off, bf16* H, float* out, const float* part, int nsl, const float* Xp = nullptr  ) {
    const Tix T = tix();
    const int gw = F.vcu * NWAVES + T.wave, NGW = F.G * NWAVES;
    const int nit = FINAL ? MP : MP + (MT - MR);
    f32x4 vn[8];
    const float* Xs = Xp ? Xp : X;
    if (gw < nit) { const int row = gw < MP ? gw : gw + MS; const f32x4* xr = (const f32x4*)((row < MP ? Xs : X) + (size_t)row * D) + T.lane;
#pragma unroll
        for (int j = 0; j < 8; ++j) vn[j] = xr[64 * j]; }
    for (int it = gw; it < nit; it += NGW) {
        const int row = it < MP ? it : it + MS;
        f32x4 v[8]; float s = 0.f;
#pragma unroll
        for (int j = 0; j < 8; ++j) v[j] = vn[j];
        if (it + NGW < nit) { const int it2 = it + NGW, row2 = it2 < MP ? it2 : it2 + MS; const f32x4* xr = (const f32x4*)((row2 < MP ? Xs : X) + (size_t)row2 * D) + T.lane;
#pragma unroll
            for (int j = 0; j < 8; ++j) vn[j] = xr[64 * j]; }
#pragma unroll
        for (int j = 0; j < 8; ++j) s += (v[j].x * v[j].x + v[j].y * v[j].y) + (v[j].z * v[j].z + v[j].w * v[j].w);
        const float rstd = 1.0f / sqrtf(wave_sum(s) * (1.0f / D) + EPS);
        if (FINAL) { f32x4* o = (f32x4*)(out + (size_t)row * D) + T.lane;
#pragma unroll
            for (int j = 0; j < 8; ++j) { const f32x4 w = *(const f32x4*)(nw + 4 * (T.lane + 64 * j)); o[64 * j] = (v[j] * rstd) * w; } }
        else { const float* md = mod + (size_t)pg8::batch_of_row(row) * NADA; v2u* o = (v2u*)(H + (size_t)row * D) + T.lane;
#pragma unroll
            for (int j = 0; j < 8; ++j) { const int c = 4 * (T.lane + 64 * j);
                const f32x4 w = *(const f32x4*)(nw + c), sc = *(const f32x4*)(md + sc_off + c), sh = *(const f32x4*)(md + sh_off + c);
                const f32x4 y = (v[j] * rstd) * w * (sc + 1.0f) + sh;
                v2u q; q.x = pk2(y.x, y.y); q.y = pk2(y.z, y.w); o[64 * j] = q; } }
    }
    LAS float* red = (LAS float*)F.lds;
    for (int sr = (int)blockIdx.x; sr < MS; sr += F.G) {
        const int row = MP + sr, c = 4 * T.tid;
        f32x4 x = *(const f32x4*)(X + (size_t)row * D + c);
        { f32x4 pp[11];
#pragma unroll
          for (int s = 0; s < 11; ++s) pp[s] = s < nsl ? *(const f32x4*)(part + ((size_t)s * 128 + sr) * D + c) : (f32x4){0.f, 0.f, 0.f, 0.f};
#pragma unroll
          for (int s = 0; s < 11; ++s) x += pp[s]; }
        if (nsl > 0) *(f32x4*)(X + (size_t)row * D + c) = x;
        const float ss = wave_sum((x.x * x.x + x.y * x.y) + (x.z * x.z + x.w * x.w));
        __syncthreads();
        if (T.lane == 0) red[T.wave] = ss;
        __syncthreads();
        const float tot = ((red[0] + red[1]) + (red[2] + red[3])) + ((red[4] + red[5]) + (red[6] + red[7]));
        const float rstd = 1.0f / sqrtf(tot * (1.0f / D) + EPS);
        const f32x4 w = *(const f32x4*)(nw + c);
        if (FINAL) *(f32x4*)(out + (size_t)row * D + c) = (x * rstd) * w;
        else { const float* md = mod + (size_t)pg8::batch_of_row(row) * NADA; const f32x4 sc = *(const f32x4*)(md + sc_off + c), sh = *(const f32x4*)(md + sh_off + c);
            const f32x4 y = (x * rstd) * w * (sc + 1.0f) + sh; v2u q; q.x = pk2(y.x, y.y); q.y = pk2(y.z, y.w); *(v2u*)(H + (size_t)row * D + c) = q; }
    }
    __syncthreads();
}

__device__ __forceinline__ void gla_sample_unit(Frame& F, int unit, const bf16* Z, const bf16* H, const bf16* WlraT, const float* wgk2, const float* bgk, const float* Sin  , float* Sout, const float* gnw, bf16* OABC) {
    const Tix T = tix();
    const int b = unit >> 2, h = unit & 3; const size_t row = MP + b;
    LAS float* sq = (LAS float*)F.lds; LAS float* sk = sq + 256; LAS float* se = sk + 256; LAS float* red = se + 256;
    LAS float* lrs = red + 2048;
    __syncthreads();
    { const int rr = T.tid & 15, ksg = T.tid >> 4; float a = 0.f;
      const bf16* hp = H + row * D + 64 * ksg; const bf16* wp = WlraT + (size_t)rr * D + 64 * ksg;
#pragma unroll
      for (int i = 0; i < 8; ++i) { const v4u hv = *(const v4u*)(hp + 8 * i), wv = *(const v4u*)(wp + 8 * i);
          a += (__uint_as_float(hv.x << 16) * __uint_as_float(wv.x << 16) + __uint_as_float(hv.x & 0xffff0000u) * __uint_as_float(wv.x & 0xffff0000u)) + (__uint_as_float(hv.y << 16) * __uint_as_float(wv.y << 16) + __uint_as_float(hv.y & 0xffff0000u) * __uint_as_float(wv.y & 0xffff0000u))
             + (__uint_as_float(hv.z << 16) * __uint_as_float(wv.z << 16) + __uint_as_float(hv.z & 0xffff0000u) * __uint_as_float(wv.z & 0xffff0000u)) + (__uint_as_float(hv.w << 16) * __uint_as_float(wv.w << 16) + __uint_as_float(hv.w & 0xffff0000u) * __uint_as_float(wv.w & 0xffff0000u)); }
      lrs[ksg * 16 + rr] = a; }
    __syncthreads();
    if (T.tid < 16) { float a = 0.f;
#pragma unroll
        for (int s = 0; s < 32; ++s) a += lrs[s * 16 + T.tid];
        lrs[512 + T.tid] = a; }
    __syncthreads();
    if (T.tid < 256) { const int d = T.tid; sq[d] = bf2f(Z[row * NZ + ZQA + h * 256 + d]) * 0.0625f; sk[d] = bf2f(Z[row * NZ + ZKA + h * 256 + d]);
        float x = bgk[h * 256 + d];
#pragma unroll
        for (int rr = 0; rr < 16; ++rr) x += lrs[512 + rr] * wgk2[rr * 1024 + h * 256 + d];
        se[d] = __expf((fminf(x, 0.f) - __logf(1.0f + __expf(-fabsf(x)))) * (1.0f / 16.0f)); }
    __syncthreads();
    const int c4 = T.tid & 127, rg = T.tid >> 7;
    f32x4 v; { const bf16* vp = Z + row * NZ + ZVA + h * 512 + 4 * c4; v.x = bf2f(vp[0]); v.y = bf2f(vp[1]); v.z = bf2f(vp[2]); v.w = bf2f(vp[3]); }
    const size_t base = ((size_t)b * 4 + h) * 256 * 512;
    f32x4 o = (f32x4){0.f, 0.f, 0.f, 0.f};
    for (int it0 = 0; it0 < 64; it0 += 32) {
        f32x4 sv[32];
#pragma unroll
        for (int u = 0; u < 32; ++u) sv[u] = __builtin_nontemporal_load((const f32x4*)(Sin + base + (size_t)(rg + 4 * (it0 + u)) * 512 + 4 * c4));
#pragma unroll
        for (int u = 0; u < 32; ++u) { const int dk = rg + 4 * (it0 + u);
            const f32x4 sn = sv[u] * se[dk] + v * sk[dk];
            __builtin_nontemporal_store(sn, (f32x4*)(Sout + base + (size_t)dk * 512 + 4 * c4));
            o += sn * sq[dk]; } }
    *(LAS f32x4*)(red + rg * 512 + 4 * c4) = o;
    __syncthreads();
    { const int c = T.tid; const float t = (red[c] + red[512 + c]) + (red[1024 + c] + red[1536 + c]);
      const float ss = wave_sum(t * t);
      if (T.lane == 0) lrs[600 + T.wave] = ss;
      __syncthreads();
      const float tot = ((lrs[600] + lrs[601]) + (lrs[602] + lrs[603])) + ((lrs[604] + lrs[605]) + (lrs[606] + lrs[607]));
      const float rstd = 1.0f / sqrtf(tot * (1.0f / 512.0f) + EPS);
      OABC[row * 4096 + h * 512 + c] = (bf16)f2bf(t * rstd * gnw[c] * siluf_(bf2f(Z[row * NZ + ZGA + h * 512 + c]))); }
}

__device__ __forceinline__ void gm_ln_row(const Tix& T, int row, const v2u (&vw)[4], const bf16* Z, const float* nw, const float* nb, bf16* VNB, float* gmv_out  , const float* ws_, const float* bs, bf16* OABC) {
    float x[16]; float s = 0.f;
#pragma unroll
    for (int j = 0; j < 4; ++j) { const v2u w = vw[j];
        x[4 * j + 0] = geluf_(__uint_as_float(w.x << 16)); x[4 * j + 1] = geluf_(__uint_as_float(w.x & 0xffff0000u)); x[4 * j + 2] = geluf_(__uint_as_float(w.y << 16)); x[4 * j + 3] = geluf_(__uint_as_float(w.y & 0xffff0000u));
        s += (x[4 * j] + x[4 * j + 1]) + (x[4 * j + 2] + x[4 * j + 3]); }
    const float mu = wave_sum(s) * (1.0f / 1024.0f); float q = 0.f;
#pragma unroll
    for (int i = 0; i < 16; ++i) { x[i] -= mu; q += x[i] * x[i]; }
    const float rstd = 1.0f / sqrtf(wave_sum(q) * (1.0f / 1024.0f) + EPS);
#pragma unroll
    for (int j = 0; j < 4; ++j) { const int c = 4 * (T.lane + 64 * j); const f32x4 w = *(const f32x4*)(nw + c), bb = *(const f32x4*)(nb + c);
        f32x4 y; y.x = x[4 * j] * rstd * w.x + bb.x; y.y = x[4 * j + 1] * rstd * w.y + bb.y; y.z = x[4 * j + 2] * rstd * w.z + bb.z; y.w = x[4 * j + 3] * rstd * w.w + bb.w;
        if (row < MP) { v2u o; o.x = pk2(y.x, y.y); o.y = pk2(y.z, y.w); *(v2u*)(VNB + (size_t)row * 1024 + c) = o; }
        else { *(f32x4*)(gmv_out + (size_t)(row - MP) * 1024 + c) = y;
            const int g = c >> 8; const float w00 = ws_[(size_t)g * 128 * 128], b0 = bs[g * 128];
            const v2u uq = *(const v2u*)(Z + (size_t)row * NZ + ZUB + c);
            v2u o; o.x = pk2(geluf_(__uint_as_float(uq.x << 16)) * (w00 * y.x + b0), geluf_(__uint_as_float(uq.x & 0xffff0000u)) * (w00 * y.y + b0));
            o.y = pk2(geluf_(__uint_as_float(uq.y << 16)) * (w00 * y.z + b0), geluf_(__uint_as_float(uq.y & 0xffff0000u)) * (w00 * y.w + b0));
            *(v2u*)(OABC + (size_t)row * 4096 + 2048 + c) = o; } }
}
__device__ __forceinline__ void gm_ln_rows(Frame& F, int ow, int OW, const bf16* Z, const float* nw, const float* nb, bf16* VNB, float* gmv_out, const float* ws_, const float* bs, bf16* OABC) {
    const Tix T = tix();
    const int w0 = ow * NWAVES + T.wave, stride = OW * NWAVES;
    v2u nx[4];
    if (w0 < MR) {
#pragma unroll
        for (int j = 0; j < 4; ++j) nx[j] = *(const v2u*)(Z + (size_t)w0 * NZ + ZVB + 4 * (T.lane + 64 * j)); }
    for (int row = w0; row < MR; row += stride) {
        v2u cur[4];
#pragma unroll
        for (int j = 0; j < 4; ++j) cur[j] = nx[j];
        if (row + stride < MR) {
#pragma unroll
            for (int j = 0; j < 4; ++j) nx[j] = *(const v2u*)(Z + (size_t)(row + stride) * NZ + ZVB + 4 * (T.lane + 64 * j)); }
        gm_ln_row(T, row, cur, Z, nw, nb, VNB, gmv_out, ws_, bs, OABC);
    }
}

__device__ __forceinline__ void cache_outs(Frame& F, int wg, int nwg, int l, const bf16* Z, float* out) {
    const Tix T = tix();
    for (int idx = wg * NT + T.tid; idx < 2 * 128 * 512; idx += nwg * NT) {
        const int c = idx & 511, r = (idx >> 9) & 127, b = idx >> 16; const size_t row = (size_t)b * SEQ + (SEQ - 128) + r;
        const float v = bf2f(Z[row * NZ + ZKC + c]);
        if (c < 256) out[O_CKP + ((size_t)(l * 2 + b) * 128 + r) * 256 + c] = v; else out[O_CVP + ((size_t)(l * 2 + b) * 128 + r) * 256 + (c - 256)] = v;
    }
    for (int idx = wg * NT + T.tid; idx < 128 * 512; idx += nwg * NT) {
        const int c = idx & 511, b = idx >> 9; const float v = bf2f(Z[(size_t)(MP + b) * NZ + ZKC + c]);
        if (c < 256) out[O_CKS + (size_t)(l * 128 + b) * 256 + c] = v; else out[O_CVS + (size_t)(l * 128 + b) * 256 + (c - 256)] = v;
    }
}

__device__ __forceinline__ void gla_fin(Frame& F, const float* OBf, const bf16* Z, const float* gnw, bf16* OABC) {
    const Tix T = tix();
    const bf16* OB = (const bf16*)OBf;
    const int gw = F.vcu * NWAVES + T.wave, NGW = F.G * NWAVES;
    v2u on[8], gn[8];
#define FIN_LOAD(rw) do { const bf16* op_ = OB + (size_t)(rw) * 2048 + 4 * T.lane; const bf16* gp_ = Z + (size_t)(rw) * NZ + ZGA + 4 * T.lane; \
        _Pragma("unroll") for (int j = 0; j < 8; ++j) { on[j] = *(const v2u*)(op_ + 256 * j); gn[j] = *(const v2u*)(gp_ + 256 * j); } } while (0)
    if (gw < MP) FIN_LOAD(gw);
    for (int row = gw; row < MP; row += NGW) {
        f32x4 o[8]; v2u gq[8];
#pragma unroll
        for (int j = 0; j < 8; ++j) { o[j] = (f32x4){__uint_as_float(on[j].x << 16), __uint_as_float(on[j].x & 0xffff0000u), __uint_as_float(on[j].y << 16), __uint_as_float(on[j].y & 0xffff0000u)}; gq[j] = gn[j]; }
        if (row + NGW < MP) FIN_LOAD(row + NGW);
#pragma unroll
        for (int h = 0; h < 4; ++h) { const f32x4 a = o[2 * h], b = o[2 * h + 1];
            const float s = (a.x * a.x + a.y * a.y) + (a.z * a.z + a.w * a.w) + (b.x * b.x + b.y * b.y) + (b.z * b.z + b.w * b.w);
            const float rstd = 1.0f / sqrtf(wave_sum(s) * (1.0f / 512.0f) + EPS);
#pragma unroll
            for (int jj = 0; jj < 2; ++jj) { const int j = 2 * h + jj, c = 4 * T.lane + 256 * jj; const f32x4 ov = o[j]; const f32x4 w = *(const f32x4*)(gnw + c);
                const float g0 = siluf_(__uint_as_float(gq[j].x << 16)), g1 = siluf_(__uint_as_float(gq[j].x & 0xffff0000u)), g2 = siluf_(__uint_as_float(gq[j].y << 16)), g3 = siluf_(__uint_as_float(gq[j].y & 0xffff0000u));
                v2u r; r.x = pk2(ov.x * rstd * w.x * g0, ov.y * rstd * w.y * g1); r.y = pk2(ov.z * rstd * w.z * g2, ov.w * rstd * w.w * g3);
                *(v2u*)(OABC + (size_t)row * 4096 + h * 512 + c) = r; } }
    }
#undef FIN_LOAD
}
typedef short bf16x8 __attribute__((ext_vector_type(8)));
typedef unsigned short u16x4 __attribute__((ext_vector_type(4)));
__device__ __forceinline__ unsigned offb(unsigned row, unsigned ch) { return 256u * row + 16u * (ch ^ (((row & 3u) << 2) | ((row >> 2) & 3u))); }
__device__ __forceinline__ unsigned tr_addr16(unsigned lane, unsigned c, unsigned ks, unsigned t) {
    const unsigned g = lane >> 4, q = (lane & 15u) >> 2, p = lane & 3u; return offb(32u * ks + 8u * g + 4u * t + q, 2u * c + (p >> 1)) + 8u * (p & 1u); }
struct TrLane { unsigned L0, L1, X0, X1; };
__device__ __forceinline__ TrLane tr_lane(unsigned lane) {
    const unsigned g = lane >> 4, q = (lane & 15u) >> 2, p = lane & 3u; TrLane t;
    const unsigned m0 = (q << 2) | ((2u * g) & 3u), m1 = (q << 2) | ((2u * g + 1u) & 3u);
    t.L0 = 2048u * g + 256u * q + 8u * (p & 1u) + 16u * ((p >> 1) ^ (m0 & 1u)); t.L1 = 2048u * g + 1024u + 256u * q + 8u * (p & 1u) + 16u * ((p >> 1) ^ (m1 & 1u));
    t.X0 = (m0 >> 1) << 5; t.X1 = (m1 >> 1) << 5; return t;
}
__device__ __forceinline__ void tr_frag2(unsigned base, const TrLane& tl, unsigned c, bf16x8& f0, bf16x8& f1) {
    const unsigned a0 = base + tl.L0 + ((c << 5) ^ tl.X0), a1 = base + tl.L1 + ((c << 5) ^ tl.X1);
    u16x4 r0, r1, r2, r3;
    asm volatile("ds_read_b64_tr_b16 %0, %4\n\tds_read_b64_tr_b16 %1, %5\n\tds_read_b64_tr_b16 %2, %4 offset:8192\n\tds_read_b64_tr_b16 %3, %5 offset:8192\n\ts_waitcnt lgkmcnt(0)"
                 : "=&v"(r0), "=&v"(r1), "=&v"(r2), "=&v"(r3) : "v"(a0), "v"(a1) : "memory");
    f0 = (bf16x8){(short)r0[0], (short)r0[1], (short)r0[2], (short)r0[3], (short)r1[0], (short)r1[1], (short)r1[2], (short)r1[3]};
    f1 = (bf16x8){(short)r2[0], (short)r2[1], (short)r2[2], (short)r2[3], (short)r3[0], (short)r3[1], (short)r3[2], (short)r3[3]};
}
__device__ __forceinline__ void tr_frag4(unsigned base, const TrLane& tl, unsigned c, bf16x8& f0, bf16x8& f1, bf16x8& f2, bf16x8& f3) {
    const unsigned a0 = base + tl.L0 + ((c << 5) ^ tl.X0), a1 = base + tl.L1 + ((c << 5) ^ tl.X1), a2 = base + tl.L0 + (((c + 1u) << 5) ^ tl.X0), a3 = base + tl.L1 + (((c + 1u) << 5) ^ tl.X1);
    u16x4 r0, r1, r2, r3, r4, r5, r6, r7;
    asm volatile("ds_read_b64_tr_b16 %0, %8\n\tds_read_b64_tr_b16 %1, %9\n\tds_read_b64_tr_b16 %2, %8 offset:8192\n\tds_read_b64_tr_b16 %3, %9 offset:8192\n\t"
                 "ds_read_b64_tr_b16 %4, %10\n\tds_read_b64_tr_b16 %5, %11\n\tds_read_b64_tr_b16 %6, %10 offset:8192\n\tds_read_b64_tr_b16 %7, %11 offset:8192\n\ts_waitcnt lgkmcnt(0)"
                 : "=&v"(r0), "=&v"(r1), "=&v"(r2), "=&v"(r3), "=&v"(r4), "=&v"(r5), "=&v"(r6), "=&v"(r7) : "v"(a0), "v"(a1), "v"(a2), "v"(a3) : "memory");
    f0 = (bf16x8){(short)r0[0], (short)r0[1], (short)r0[2], (short)r0[3], (short)r1[0], (short)r1[1], (short)r1[2], (short)r1[3]};
    f1 = (bf16x8){(short)r2[0], (short)r2[1], (short)r2[2], (short)r2[3], (short)r3[0], (short)r3[1], (short)r3[2], (short)r3[3]};
    f2 = (bf16x8){(short)r4[0], (short)r4[1], (short)r4[2], (short)r4[3], (short)r5[0], (short)r5[1], (short)r5[2], (short)r5[3]};
    f3 = (bf16x8){(short)r6[0], (short)r6[1], (short)r6[2], (short)r6[3], (short)r7[0], (short)r7[1], (short)r7[2], (short)r7[3]};
}
__device__ __forceinline__ unsigned cvtpk(float lo, float hi) { return pk2(lo, hi); }
__device__ __forceinline__ unsigned cvtpk_pin(float lo, float hi) { unsigned r; asm volatile("v_cvt_pk_bf16_f32 %0, %1, %2\n\ts_nop 1" : "=v"(r) : "v"(lo), "v"(hi)); return r; }

constexpr int GLA_PREP_STRIDE = 264;

__device__ __forceinline__ void gla_prep_unit(Frame& F, int unit, const bf16* Z, const bf16* H, const bf16* WlraT, const float* wgk2, const float* bgk, bf16* QT, bf16* KH, bf16* AI, float* GAM) {
    const Tix T = tix();
    const int b = unit >> 8, h = (unit >> 6) & 3, c = unit & 63;
    const int d4 = 4 * T.lane, seg = T.wave;
    const int r = T.lane & 15, g = T.lane >> 4;
    LAS bf16* QA = (LAS bf16*)F.lds; LAS bf16* KA = QA + 64 * GLA_PREP_STRIDE; LAS float* tots = (LAS float*)(KA + 64 * GLA_PREP_STRIDE);
    LAS float* lrp = tots + 2048;
    const size_t rowc = (size_t)b * SEQ + c * 64;
    __syncthreads();
    {
      const int tl = T.wave & 3, kh = T.wave >> 2; f32x4 acc = (f32x4){0.f, 0.f, 0.f, 0.f};
      const bf16* hp = H + (rowc + 16 * tl + r) * D + kh * 1024 + 8 * g; const bf16* wp = WlraT + (size_t)r * D + kh * 1024 + 8 * g;
#pragma unroll 16
      for (int s = 0; s < 32; ++s) acc = __builtin_amdgcn_mfma_f32_16x16x32_bf16(*(const bf16x8*)(hp + 32 * s), *(const bf16x8*)(wp + 32 * s), acc, 0, 0, 0);
#pragma unroll
      for (int e = 0; e < 4; ++e) lrp[(kh * 64 + 16 * tl + 4 * g + e) * 16 + r] = acc[e]; }
    const size_t row0 = rowc + seg * 8;
    v2u qv[8], kv[8];
#pragma unroll
    for (int t = 0; t < 8; ++t) { qv[t] = *(const v2u*)(Z + (row0 + t) * NZ + ZQA + h * 256 + d4); kv[t] = *(const v2u*)(Z + (row0 + t) * NZ + ZKA + h * 256 + d4); }
    __syncthreads();
    f32x4 cum[8]; f32x4 run = (f32x4){0.f, 0.f, 0.f, 0.f};
    { f32x4 w[16];
#pragma unroll
      for (int rr = 0; rr < 16; ++rr) w[rr] = *(const f32x4*)(wgk2 + rr * 1024 + h * 256 + d4);
      const f32x4 bb = *(const f32x4*)(bgk + h * 256 + d4);
#pragma unroll
      for (int t = 0; t < 8; ++t) { const int tk = seg * 8 + t; f32x4 x = bb;
#pragma unroll
          for (int r4 = 0; r4 < 4; ++r4) { const f32x4 l0 = *(const LAS f32x4*)(lrp + tk * 16 + 4 * r4), l1 = *(const LAS f32x4*)(lrp + (64 + tk) * 16 + 4 * r4);
              x += (l0.x + l1.x) * w[4 * r4] + (l0.y + l1.y) * w[4 * r4 + 1] + (l0.z + l1.z) * w[4 * r4 + 2] + (l0.w + l1.w) * w[4 * r4 + 3]; }
#pragma unroll
          for (int j = 0; j < 4; ++j) run[j] += (fminf(x[j], 0.f) - __logf(1.0f + __expf(-fabsf(x[j])))) * (1.0f / 16.0f);
          cum[t] = run; } }
    *(LAS f32x4*)(tots + seg * 256 + d4) = run;
    __syncthreads();
    f32x4 add = (f32x4){0.f, 0.f, 0.f, 0.f}, bmid = add, bl = add;
#pragma unroll
    for (int s = 0; s < 8; ++s) { const f32x4 ts = *(const LAS f32x4*)(tots + s * 256 + d4); if (s < seg) add += ts; if (s < 4) bmid += ts; bl += ts; }
#pragma unroll
    for (int t = 0; t < 8; ++t) { const f32x4 bt = cum[t] + add; const size_t row = row0 + t; const int tk = seg * 8 + t;
        f32x4 q, k; q[0] = __uint_as_float(qv[t].x << 16); q[1] = __uint_as_float(qv[t].x & 0xffff0000u); q[2] = __uint_as_float(qv[t].y << 16); q[3] = __uint_as_float(qv[t].y & 0xffff0000u);
        k[0] = __uint_as_float(kv[t].x << 16); k[1] = __uint_as_float(kv[t].x & 0xffff0000u); k[2] = __uint_as_float(kv[t].y << 16); k[3] = __uint_as_float(kv[t].y & 0xffff0000u);
        q = q * 0.0625f;
        f32x4 o0, o1, o2, o3;
#pragma unroll
        for (int j = 0; j < 4; ++j) { o0[j] = q[j] * __expf(bt[j]); o1[j] = k[j] * __expf(bl[j] - bt[j]); o2[j] = q[j] * __expf(bt[j] - bmid[j]); o3[j] = k[j] * __expf(bmid[j] - bt[j]); }
        v2u w0, w1, w2, w3; w0.x = pk2(o0[0], o0[1]); w0.y = pk2(o0[2], o0[3]); w1.x = pk2(o1[0], o1[1]); w1.y = pk2(o1[2], o1[3]); w2.x = pk2(o2[0], o2[1]); w2.y = pk2(o2[2], o2[3]); w3.x = pk2(o3[0], o3[1]); w3.y = pk2(o3[2], o3[3]);
        *(v2u*)(QT + row * 1024 + h * 256 + d4) = w0; *(v2u*)(KH + row * 1024 + h * 256 + d4) = w1;
        *(LAS v2u*)(QA + tk * GLA_PREP_STRIDE + d4) = w2; *(LAS v2u*)(KA + tk * GLA_PREP_STRIDE + d4) = w3; }
    if (seg == 0) { f32x4 eg; eg[0] = __expf(bl[0]); eg[1] = __expf(bl[1]); eg[2] = __expf(bl[2]); eg[3] = __expf(bl[3]); *(f32x4*)(GAM + (size_t)unit * 256 + d4) = eg; }
    __syncthreads();
#pragma unroll
    for (int x = 0; x < 2; ++x) { const int tt = 2 * T.wave + x, j = tt >> 2, sb = tt & 3;
        f32x4 acc = (f32x4){0.f, 0.f, 0.f, 0.f};
        if (sb <= j) {
#pragma unroll
            for (int ks = 0; ks < 8; ++ks) { const bf16x8 a = *(const LAS bf16x8*)(QA + (16 * j + r) * GLA_PREP_STRIDE + 32 * ks + 8 * g), bb = *(const LAS bf16x8*)(KA + (16 * sb + r) * GLA_PREP_STRIDE + 32 * ks + 8 * g);
                acc = __builtin_amdgcn_mfma_f32_16x16x32_bf16(a, bb, acc, 0, 0, 0); } }
        bf16* ap = AI + (size_t)unit * 4096;
#pragma unroll
        for (int e = 0; e < 4; ++e) { const int t = 16 * j + 4 * g + e, s = 16 * sb + r; ap[t * 64 + s] = (bf16)f2bf(s <= t ? acc[e] : 0.f); } }
}

constexpr int GL_KH = 0, GL_QT = 32768, GL_V = 65536, GL_A = 81920, GL_GAM = 90112, GL_END = 91136;
template <bool OUT>
__device__ __forceinline__ void gla_pass(Frame& F, int worker, const bf16* Z, const bf16* QT, const bf16* KH, const bf16* AI, const float* GAM, float* GST, float* GAMS, float* OB, float* state_out) {
    const Tix T = tix();
    const int lane = T.lane, wave = T.wave, r = lane & 15, g = lane >> 4;
    const int grp = worker >> 2, qs = worker & 3, b = grp >> 5, h = (grp >> 3) & 3, sc = grp & 7;
    const unsigned lbase = (unsigned)(size_t)F.lds; const TrLane tl = tr_lane((unsigned)lane);
    f32x4 S[16];
#pragma unroll
    for (int i = 0; i < 16; ++i) S[i] = (f32x4){0.f, 0.f, 0.f, 0.f};
    if (OUT) {
        const f32x4* gp = (const f32x4*)(GST + ((((size_t)grp * 4 + qs) * 8 + wave) * 16) * 256) + lane;
#pragma unroll
        for (int i = 0; i < 16; ++i) S[i] = gp[64 * i];
    }
    const int srow = T.tid >> 4, sch = T.tid & 15;
    v4u pk[2][2], pq[2][2], pv[2], pa; f32x4 pg;
    const size_t seq0 = (size_t)b * SEQ + sc * 512;
    const unsigned tko = (unsigned)(srow * 1024 + 8 * sch) * 2u, tvo = (unsigned)(srow * NZ + 8 * sch) * 2u;
#define GLA_LOAD(cc) do { const size_t rw = seq0 + (cc) * 64; const size_t un = (size_t)((b * 4 + h) * 64 + sc * 8 + (cc)); \
        const char* kb = (const char*)(KH + rw * 1024 + h * 256); const char* qb = (const char*)(QT + rw * 1024 + h * 256); const char* vb = (const char*)(Z + rw * NZ + ZVA + h * 512 + qs * 128); \
        _Pragma("unroll") for (int hh = 0; hh < 2; ++hh) _Pragma("unroll") for (int u = 0; u < 2; ++u) { \
            pk[hh][u] = *(const v4u*)(kb + (hh * 256 + u * 65536) + tko); \
            if (OUT) pq[hh][u] = *(const v4u*)(qb + (hh * 256 + u * 65536) + tko); } \
        _Pragma("unroll") for (int u = 0; u < 2; ++u) pv[u] = *(const v4u*)(vb + (size_t)u * (32 * NZ * 2) + tvo); \
        if (OUT) pa = *(const v4u*)((const char*)(AI + un * 4096) + (unsigned)T.tid * 16u); \
        if (T.tid < 64) pg = *(const f32x4*)((const char*)(GAM + un * 256) + (unsigned)T.tid * 16u); } while (0)
    GLA_LOAD(0);
    for (int c = 0; c < 8; ++c) {
        __syncthreads();
#pragma unroll
        for (int hh = 0; hh < 2; ++hh)
#pragma unroll
            for (int u = 0; u < 2; ++u) { *(LAS v4u*)(F.lds + GL_KH + hh * 16384 + offb(srow + 32 * u, sch)) = pk[hh][u]; if (OUT) *(LAS v4u*)(F.lds + GL_QT + hh * 16384 + offb(srow + 32 * u, sch)) = pq[hh][u]; }
#pragma unroll
        for (int u = 0; u < 2; ++u) *(LAS v4u*)(F.lds + GL_V + offb(srow + 32 * u, sch)) = pv[u];
        if (OUT) { const int ar = T.tid >> 3, ach = T.tid & 7; *(LAS v4u*)(F.lds + GL_A + 128 * ar + 16 * (ach ^ (ar & 7))) = pa; }
        if (T.tid < 64) *(LAS f32x4*)(F.lds + GL_GAM + 16 * T.tid) = pg;
        __syncthreads();
        if (c + 1 < 8) GLA_LOAD(c + 1);
        bf16x8 V0, V1; tr_frag2(lbase + GL_V, tl, (unsigned)wave, V0, V1);
        if (OUT) {
            const size_t orow0 = seq0 + c * 64;
            const unsigned mr = ((unsigned)(r & 3) << 2) | ((unsigned)(r >> 2) & 3u);
            const unsigned ql0 = 256u * r + 8u * (g & 1) + 16u * (((unsigned)(g >> 1)) ^ (mr & 3u)), ql1 = 256u * r + 8u * (g & 1) + 16u * ((((unsigned)(g >> 1)) | 2u) ^ (mr & 3u)), qx = (mr >> 2) << 6;
            const unsigned al0 = 128u * r + 16u * (((unsigned)g) ^ (unsigned)(r & 7)), al1 = 128u * r + 16u * ((4u + (unsigned)g) ^ (unsigned)(r & 7));
#pragma unroll 1
            for (int j = 0; j < 4; ++j) {
                f32x4 acc = (f32x4){0.f, 0.f, 0.f, 0.f};
                { const bf16x8 a0 = *(const LAS bf16x8*)(F.lds + GL_A + 2048 * j + al0), a1 = *(const LAS bf16x8*)(F.lds + GL_A + 2048 * j + al1);
                  acc = __builtin_amdgcn_mfma_f32_16x16x32_bf16(V0, a0, acc, 0, 0, 0); acc = __builtin_amdgcn_mfma_f32_16x16x32_bf16(V1, a1, acc, 0, 0, 0); }
#pragma unroll
                for (int s = 0; s < 8; ++s) {
                    const unsigned qo = GL_QT + (unsigned)(s >> 2) * 16384u + 4096u * j + ((64u * (s & 3)) ^ qx);
                    const v2u lo = *(const LAS v2u*)(F.lds + qo + ql0), hi = *(const LAS v2u*)(F.lds + qo + ql1);
                    const v4u w = (v4u){lo.x, lo.y, hi.x, hi.y};
                    const v4u sw = (v4u){cvtpk_pin(S[2 * s][0], S[2 * s][1]), cvtpk_pin(S[2 * s][2], S[2 * s][3]), cvtpk_pin(S[2 * s + 1][0], S[2 * s + 1][1]), cvtpk_pin(S[2 * s + 1][2], S[2 * s + 1][3])};
                    acc = __builtin_amdgcn_mfma_f32_16x16x32_bf16(__builtin_bit_cast(bf16x8, sw), __builtin_bit_cast(bf16x8, w), acc, 0, 0, 0); }
                { v2u ow; ow.x = pk2(acc[0], acc[1]); ow.y = pk2(acc[2], acc[3]);     *(v2u*)((bf16*)OB + (orow0 + 16 * j + r) * 2048 + h * 512 + qs * 128 + 16 * wave + 4 * g) = ow; }
            }
        }
#pragma unroll
        for (int i = 0; i < 16; i += 2) {
            const f32x4 gm0 = *(const LAS f32x4*)(F.lds + GL_GAM + 4 * (16 * i + 4 * g)), gm1 = *(const LAS f32x4*)(F.lds + GL_GAM + 4 * (16 * (i + 1) + 4 * g));
            bf16x8 k0, k1, k2, k3; tr_frag4(lbase + GL_KH + (i >> 3) * 16384, tl, (unsigned)(i & 7), k0, k1, k2, k3);
            f32x4 s0 = S[i] * gm0, s1 = S[i + 1] * gm1;
            s0 = __builtin_amdgcn_mfma_f32_16x16x32_bf16(k0, V0, s0, 0, 0, 0); s1 = __builtin_amdgcn_mfma_f32_16x16x32_bf16(k2, V0, s1, 0, 0, 0);
            S[i] = __builtin_amdgcn_mfma_f32_16x16x32_bf16(k1, V1, s0, 0, 0, 0); S[i + 1] = __builtin_amdgcn_mfma_f32_16x16x32_bf16(k3, V1, s1, 0, 0, 0);
        }
    }
#undef GLA_LOAD
    if (!OUT) {
        f32x4* gp = (f32x4*)(GST + ((((size_t)grp * 4 + qs) * 8 + wave) * 16) * 256) + lane;
#pragma unroll
        for (int i = 0; i < 16; ++i) gp[64 * i] = S[i];
        if (qs == 0 && wave == 0) {
            f32x4 gt = (f32x4){1.f, 1.f, 1.f, 1.f};
            for (int c = 0; c < 8; ++c) gt = gt * *(const f32x4*)(GAM + ((size_t)((b * 4 + h) * 64 + sc * 8 + c)) * 256 + 4 * lane);
            *(f32x4*)(GAMS + (size_t)grp * 256 + 4 * lane) = gt; }
    } else if (sc == 7) {
#pragma unroll
        for (int i = 0; i < 16; ++i)
#pragma unroll
            for (int e = 0; e < 4; ++e) state_out[(((size_t)b * 4 + h) * 256 + 16 * i + 4 * g + e) * 512 + qs * 128 + 16 * wave + r] = S[i][e];
    }
    __syncthreads();
}

constexpr int GM_W = 0, GM_V = 32768, GM_END = 98304;
__device__ __forceinline__ void gm_mix_unit(Frame& F, int unit, const bf16* Z, const bf16* VNB, const float* ws_, const float* bs, bf16* OABC) {
    const Tix T = tix();
    const int lane = T.lane, wave = T.wave, r = lane & 15, g4 = lane >> 4;
    const int n = unit >> 2, grp = unit & 3; const size_t row0 = (size_t)n * 128;
    __syncthreads();
#pragma unroll
    for (int i = 0; i < 4; ++i) { const int ci = T.tid + 512 * i, row = ci >> 4, ch = ci & 15; const float* wp = ws_ + ((size_t)grp * 128 + row) * 128 + 8 * ch;
        const f32x4 a = *(const f32x4*)wp, b = *(const f32x4*)(wp + 4); const int s0 = 8 * ch;
        v4u o; o.x = pk2(s0 + 0 <= row ? a.x : 0.f, s0 + 1 <= row ? a.y : 0.f); o.y = pk2(s0 + 2 <= row ? a.z : 0.f, s0 + 3 <= row ? a.w : 0.f);
        o.z = pk2(s0 + 4 <= row ? b.x : 0.f, s0 + 5 <= row ? b.y : 0.f); o.w = pk2(s0 + 6 <= row ? b.z : 0.f, s0 + 7 <= row ? b.w : 0.f);
        *(LAS v4u*)(F.lds + GM_W + offb((unsigned)row, (unsigned)ch)) = o; }
#pragma unroll
    for (int i = 0; i < 8; ++i) { const int ci = T.tid + 512 * i, row = ci >> 5, c32 = ci & 31;
        const v4u v = *(const v4u*)(VNB + (row0 + row) * 1024 + grp * 256 + 8 * c32);
        *(LAS v4u*)(F.lds + GM_V + (c32 >> 4) * 32768 + offb((unsigned)row, (unsigned)(c32 & 15))) = v; }
    __syncthreads();
    const unsigned lbase = (unsigned)(size_t)F.lds; const TrLane tl = tr_lane((unsigned)lane);
    bf16x8 Bf[2][4];
#pragma unroll
    for (int x = 0; x < 2; ++x) { const unsigned ct = 2u * wave + x;
        const unsigned vb = lbase + GM_V + (ct >> 3) * 32768u;
        tr_frag2(vb, tl, ct & 7u, Bf[x][0], Bf[x][1]); tr_frag2(vb + 16384u, tl, ct & 7u, Bf[x][2], Bf[x][3]); }
    const unsigned mr = ((unsigned)(r & 3) << 2) | ((unsigned)(r >> 2) & 3u);
#pragma unroll
    for (int j = 0; j < 8; ++j) {
        f32x4 acc0 = (f32x4){0.f, 0.f, 0.f, 0.f}, acc1 = acc0;
#pragma unroll
        for (int ks = 0; ks <= (j >> 1); ++ks) {
            const bf16x8 a = *(const LAS bf16x8*)(F.lds + GM_W + 256u * (16 * j + r) + 16u * (((unsigned)(4 * ks + g4)) ^ mr));
            acc0 = __builtin_amdgcn_mfma_f32_16x16x32_bf16(Bf[0][ks], a, acc0, 0, 0, 0); acc1 = __builtin_amdgcn_mfma_f32_16x16x32_bf16(Bf[1][ks], a, acc1, 0, 0, 0); }
        const int t = 16 * j + r; const size_t row = row0 + t; const float bb = bs[grp * 128 + t];
#pragma unroll
        for (int x = 0; x < 2; ++x) { const int c = grp * 256 + 32 * wave + 16 * x + 4 * g4; const f32x4 av = x ? acc1 : acc0;
            const v2u uq = *(const v2u*)(Z + row * NZ + ZUB + c);
            v2u o; o.x = pk2(geluf_(__uint_as_float(uq.x << 16)) * (av[0] + bb), geluf_(__uint_as_float(uq.x & 0xffff0000u)) * (av[1] + bb));
            o.y = pk2(geluf_(__uint_as_float(uq.y << 16)) * (av[2] + bb), geluf_(__uint_as_float(uq.y & 0xffff0000u)) * (av[3] + bb));
            *(v2u*)(OABC + row * 4096 + 2048 + c) = o; }
    }
}

constexpr int SW_K = 0, SW_V = 32768, SW_END = 65536;
__device__ __forceinline__ void swa_unit(Frame& F, int unit, const bf16* Z, const float* sinks, bf16* OABC) {
    const Tix T = tix();
    const int lane = T.lane, wave = T.wave, r = lane & 15, g = lane >> 4;
    const int kv = unit & 3, n = (unit >> 2) & 31, b = unit >> 7;
    const size_t rowq0 = (size_t)b * SEQ + n * 128;
    __syncthreads();
#pragma unroll
    for (int i = 0; i < 4; ++i) { const int ci = T.tid + 512 * i, key = ci >> 3, ch = ci & 7;
        v4u kk = (v4u){0u, 0u, 0u, 0u}, vv = kk;
        if (n > 0 || key >= 128) { const bf16* zp = Z + (rowq0 - 128 + key) * NZ + kv * 64 + 8 * ch; kk = *(const v4u*)(zp + ZKC); vv = *(const v4u*)(zp + ZVC); }
        const unsigned o = 128u * key + 16u * ((unsigned)ch ^ (unsigned)(key & 7));
        *(LAS v4u*)(F.lds + SW_K + o) = kk; *(LAS v4u*)(F.lds + SW_V + o) = vv; }
    __syncthreads();
    const int head = kv * 4 + (wave >> 1), qh = wave & 1;
    const float slope = exp2f(-0.5f * (float)(head + 1)), sink = sinks[head];
    const unsigned lbase = (unsigned)(size_t)F.lds;
    bf16x8 qfa[4][2];
#pragma unroll
    for (int qt = 0; qt < 4; ++qt)
#pragma unroll
        for (int ks = 0; ks < 2; ++ks) qfa[qt][ks] = *(const bf16x8*)(Z + (rowq0 + 64 * qh + 16 * qt + r) * NZ + ZQC + head * 64 + 32 * ks + 8 * g);
#pragma unroll
    for (int qt = 0; qt < 4; ++qt) {
        const int i0 = 64 * qh + 16 * qt, a = i0 >> 4;
        const size_t qrow = rowq0 + i0 + r;
        bf16x8 qf[2]; qf[0] = qfa[qt][0]; qf[1] = qfa[qt][1];
        f32x4 st[10];
#pragma unroll
        for (int t = 0; t < 9; ++t) { const int krow = 16 * (a + t) + r; f32x4 acc = (f32x4){0.f, 0.f, 0.f, 0.f};
#pragma unroll
            for (int ks = 0; ks < 2; ++ks) { const bf16x8 kf = *(const LAS bf16x8*)(F.lds + SW_K + 128u * krow + 16u * (((unsigned)(4 * ks + g)) ^ (unsigned)(krow & 7)));
                acc = __builtin_amdgcn_mfma_f32_16x16x32_bf16(kf, qf[ks], acc, 0, 0, 0); }
            st[t] = acc; }
        st[9] = (f32x4){0.f, 0.f, 0.f, 0.f};
        const int iq = i0 + r; float mx = sink;
#pragma unroll
        for (int t = 0; t < 9; ++t)
#pragma unroll
            for (int e = 0; e < 4; ++e) { const int j = 16 * (a + t) + 4 * g + e, dist = 128 + iq - j; const bool ok = dist >= 0 && dist < 128 && (n > 0 || j >= 128);
                const float s = ok ? st[t][e] * 0.125f - slope * (float)dist : -1e30f; st[t][e] = s; mx = fmaxf(mx, s); }
        mx = fmaxf(mx, __shfl_xor(mx, 16)); mx = fmaxf(mx, __shfl_xor(mx, 32));
        float sum = 0.f;
#pragma unroll
        for (int t = 0; t < 9; ++t)
#pragma unroll
            for (int e = 0; e < 4; ++e) { const float p = __expf(st[t][e] - mx); st[t][e] = p; sum += p; }
        sum += __shfl_xor(sum, 16); sum += __shfl_xor(sum, 32);
        const float inv = 1.0f / (sum + __expf(sink - mx));
        f32x4 o[4];
#pragma unroll
        for (int dt = 0; dt < 4; ++dt) o[dt] = (f32x4){0.f, 0.f, 0.f, 0.f};
#pragma unroll
        for (int pr = 0; pr < 5; ++pr) {
            const v4u pw = (v4u){cvtpk(st[2 * pr][0], st[2 * pr][1]), cvtpk(st[2 * pr][2], st[2 * pr][3]), cvtpk(st[2 * pr + 1][0], st[2 * pr + 1][1]), cvtpk(st[2 * pr + 1][2], st[2 * pr + 1][3])};
            const bf16x8 pf = __builtin_bit_cast(bf16x8, pw);
            const int q4 = r >> 2, p4 = r & 3;
            const int k0 = 16 * (a + 2 * pr) + 4 * g + q4; int k1 = k0 + 16; if (k1 > 255) k1 = 255;
            const unsigned b0 = lbase + SW_V + 128u * k0 + 8u * (p4 & 1), b1 = lbase + SW_V + 128u * k1 + 8u * (p4 & 1);
            const unsigned x0 = (unsigned)(k0 & 7), x1 = (unsigned)(k1 & 7), ph = (unsigned)(p4 >> 1);
            u16x4 r0, r1, r2, r3, r4, r5, r6, r7;
            asm volatile("ds_read_b64_tr_b16 %0, %8\n\tds_read_b64_tr_b16 %1, %9\n\tds_read_b64_tr_b16 %2, %10\n\tds_read_b64_tr_b16 %3, %11\n\t"
                         "ds_read_b64_tr_b16 %4, %12\n\tds_read_b64_tr_b16 %5, %13\n\tds_read_b64_tr_b16 %6, %14\n\tds_read_b64_tr_b16 %7, %15\n\ts_waitcnt lgkmcnt(0)"
                         : "=&v"(r0), "=&v"(r1), "=&v"(r2), "=&v"(r3), "=&v"(r4), "=&v"(r5), "=&v"(r6), "=&v"(r7)
                         : "v"(b0 + 16u * ((0u + ph) ^ x0)), "v"(b1 + 16u * ((0u + ph) ^ x1)), "v"(b0 + 16u * ((2u + ph) ^ x0)), "v"(b1 + 16u * ((2u + ph) ^ x1)),
                           "v"(b0 + 16u * ((4u + ph) ^ x0)), "v"(b1 + 16u * ((4u + ph) ^ x1)), "v"(b0 + 16u * ((6u + ph) ^ x0)), "v"(b1 + 16u * ((6u + ph) ^ x1)) : "memory");
            const bf16x8 v0 = (bf16x8){(short)r0[0], (short)r0[1], (short)r0[2], (short)r0[3], (short)r1[0], (short)r1[1], (short)r1[2], (short)r1[3]};
            const bf16x8 v1 = (bf16x8){(short)r2[0], (short)r2[1], (short)r2[2], (short)r2[3], (short)r3[0], (short)r3[1], (short)r3[2], (short)r3[3]};
            const bf16x8 v2 = (bf16x8){(short)r4[0], (short)r4[1], (short)r4[2], (short)r4[3], (short)r5[0], (short)r5[1], (short)r5[2], (short)r5[3]};
            const bf16x8 v3 = (bf16x8){(short)r6[0], (short)r6[1], (short)r6[2], (short)r6[3], (short)r7[0], (short)r7[1], (short)r7[2], (short)r7[3]};
            o[0] = __builtin_amdgcn_mfma_f32_16x16x32_bf16(v0, pf, o[0], 0, 0, 0); o[1] = __builtin_amdgcn_mfma_f32_16x16x32_bf16(v1, pf, o[1], 0, 0, 0);
            o[2] = __builtin_amdgcn_mfma_f32_16x16x32_bf16(v2, pf, o[2], 0, 0, 0); o[3] = __builtin_amdgcn_mfma_f32_16x16x32_bf16(v3, pf, o[3], 0, 0, 0);
        }
        bf16* op = OABC + qrow * 4096 + 3072 + head * 64 + 4 * g;
#pragma unroll
        for (int dt = 0; dt < 4; ++dt) { v2u w; w.x = pk2(o[dt][0] * inv, o[dt][1] * inv); w.y = pk2(o[dt][2] * inv, o[dt][3] * inv); *(v2u*)(op + 16 * dt) = w; }
    }
}

__device__ __forceinline__ void swa_sample_wave(Frame& F, int item, const bf16* Z, const float* sinks, const float* ck, const float* cv, bf16* OABC) {
    const Tix T = tix();
    const int lane = T.lane, b = item >> 4, head = item & 15, kv = head >> 2; const size_t row = MP + b;
    LAS float* sq = (LAS float*)(F.lds + T.wave * 1024); LAS float* sp = sq + 64;
    const float slope = exp2f(-0.5f * (float)(head + 1)), sink = sinks[head];
    sq[lane] = bf2f(Z[row * NZ + ZQC + head * 64 + lane]);
    LDS_WAIT();
    float s2[2];
#pragma unroll
    for (int u = 0; u < 2; ++u) { const int j = 1 + lane + 64 * u;
        float s = 0.f;
        if (j < 128) { const float* kp = ck + ((size_t)(b * 128 + j) * 4 + kv) * 64;
#pragma unroll
            for (int d4 = 0; d4 < 16; ++d4) { const f32x4 kk = *(const f32x4*)(kp + 4 * d4); const f32x4 qq = *(const LAS f32x4*)(sq + 4 * d4); s += (qq.x * kk.x + qq.y * kk.y) + (qq.z * kk.z + qq.w * kk.w); } }
        else { const bf16* kp = Z + row * NZ + ZKC + kv * 64;
#pragma unroll
            for (int d = 0; d < 64; ++d) s += sq[d] * bf2f(kp[d]); }
        s2[u] = s * 0.125f - slope * (float)(128 - j); }
    float mx = fmaxf(fmaxf(s2[0], s2[1]), sink);
#pragma unroll
    for (int o = 1; o < 64; o <<= 1) mx = fmaxf(mx, __shfl_xor(mx, o));
    const float p0 = __expf(s2[0] - mx), p1 = __expf(s2[1] - mx);
    const float inv = 1.0f / (wave_sum(p0 + p1) + __expf(sink - mx));
    sp[lane] = p0; sp[64 + lane] = p1;
    LDS_WAIT();
    { const int jq = lane >> 4, d4 = 4 * (lane & 15); f32x4 acc = (f32x4){0.f, 0.f, 0.f, 0.f};
      f32x4 vv[32];
#pragma unroll
      for (int i = 0; i < 32; ++i) { const int jj = 4 * i + jq;
          if (jj < 127) vv[i] = *(const f32x4*)(cv + ((size_t)(b * 128 + jj + 1) * 4 + kv) * 64 + d4);
          else { const v2u w = *(const v2u*)(Z + row * NZ + ZVC + kv * 64 + d4); vv[i] = (f32x4){__uint_as_float(w.x << 16), __uint_as_float(w.x & 0xffff0000u), __uint_as_float(w.y << 16), __uint_as_float(w.y & 0xffff0000u)}; } }
#pragma unroll
      for (int i = 0; i < 32; ++i) acc += vv[i] * sp[4 * i + jq];
#pragma unroll
      for (int j = 0; j < 4; ++j) { acc[j] += __shfl_xor(acc[j], 16); acc[j] += __shfl_xor(acc[j], 32); }
      if (jq == 0) { v2u w; w.x = pk2(acc[0] * inv, acc[1] * inv); w.y = pk2(acc[2] * inv, acc[3] * inv); *(v2u*)(OABC + row * 4096 + 3072 + head * 64 + d4) = w; } }
    LDS_WAIT();
}

constexpr int MD_PITCH = 208;
__device__ __forceinline__ void mod_direct(Frame& F, const bf16* CA  , const float* wada  , const float* bada  , float* MOD  ) {
    const Tix T = tix();
    const int lane = T.lane, wave = T.wave, r = lane & 15, g = lane >> 4;
    for (int sl = (int)blockIdx.x; sl < 256; sl += F.G) {
        const int l = sl >> 7, n0 = (sl & 127) * 96;
        const float* W = wada + (size_t)l * D * NADA + n0;
        f32x4 acc[7];
#pragma unroll
        for (int i = 0; i < 7; ++i) acc[i] = (f32x4){0.f, 0.f, 0.f, 0.f};
        f32x4 pw[6];
        const unsigned sk0 = (unsigned)(T.tid / 24), sq0 = (unsigned)(T.tid % 24);
#define MD_LOAD(kb) do { unsigned kk = sk0, q = sq0; _Pragma("unroll") for (int i = 0; i < 6; ++i) { pw[i] = *(const f32x4*)(W + (size_t)((kb) * 128 + kk) * NADA + 4 * q); q += 8; kk += 21; if (q >= 24) { q -= 24; kk += 1; } } } while (0)
        MD_LOAD(0);
        const unsigned lbase = (unsigned)(size_t)F.lds;
        for (int kb = 0; kb < 16; ++kb) {
            __syncthreads();
            { unsigned kk = sk0, q = sq0;
#pragma unroll
              for (int i = 0; i < 6; ++i) { v2u w; w.x = pk2(pw[i].x, pw[i].y); w.y = pk2(pw[i].z, pw[i].w); *(LAS v2u*)(F.lds + kk * MD_PITCH + 8 * q) = w; q += 8; kk += 21; if (q >= 24) { q -= 24; kk += 1; } } }
            __syncthreads();
            if (kb + 1 < 16) MD_LOAD(kb + 1);
            bf16x8 af[4], ag[4];
#pragma unroll
            for (int k4 = 0; k4 < 4; ++k4) { af[k4] = *(const bf16x8*)(CA + (size_t)(16 * wave + r) * D + kb * 128 + 32 * k4 + 8 * g); ag[k4] = *(const bf16x8*)(CA + (size_t)(128 + r) * D + kb * 128 + 32 * k4 + 8 * g); }
#pragma unroll
            for (int ks = 0; ks < 4; ++ks) {
                const bf16x8 a0 = af[ks], a8 = ag[ks];
                const unsigned q4 = (unsigned)(r >> 2), p4 = (unsigned)(r & 3);
                const unsigned a_lo = lbase + (32u * ks + 8u * g + q4) * MD_PITCH + 8u * p4, a_hi = a_lo + 4u * MD_PITCH;
                u16x4 t0, t1, t2, t3, t4, t5, t6, t7, t8, t9, ta, tb;
                asm volatile("ds_read_b64_tr_b16 %0, %12\n\tds_read_b64_tr_b16 %1, %13\n\tds_read_b64_tr_b16 %2, %12 offset:32\n\tds_read_b64_tr_b16 %3, %13 offset:32\n\t"
                             "ds_read_b64_tr_b16 %4, %12 offset:64\n\tds_read_b64_tr_b16 %5, %13 offset:64\n\tds_read_b64_tr_b16 %6, %12 offset:96\n\tds_read_b64_tr_b16 %7, %13 offset:96\n\t"
                             "ds_read_b64_tr_b16 %8, %12 offset:128\n\tds_read_b64_tr_b16 %9, %13 offset:128\n\tds_read_b64_tr_b16 %10, %12 offset:160\n\tds_read_b64_tr_b16 %11, %13 offset:160\n\ts_waitcnt lgkmcnt(0)"
                             : "=&v"(t0), "=&v"(t1), "=&v"(t2), "=&v"(t3), "=&v"(t4), "=&v"(t5), "=&v"(t6), "=&v"(t7), "=&v"(t8), "=&v"(t9), "=&v"(ta), "=&v"(tb) : "v"(a_lo), "v"(a_hi) : "memory");
#define MD_FR(lo, hi) (bf16x8){(short)lo[0], (short)lo[1], (short)lo[2], (short)lo[3], (short)hi[0], (short)hi[1], (short)hi[2], (short)hi[3]}
                const bf16x8 bfr[6] = {MD_FR(t0, t1), MD_FR(t2, t3), MD_FR(t4, t5), MD_FR(t6, t7), MD_FR(t8, t9), MD_FR(ta, tb)};
#undef MD_FR
#pragma unroll
                for (int nt = 0; nt < 6; ++nt) {
                    acc[nt] = __builtin_amdgcn_mfma_f32_16x16x32_bf16(a0, bfr[nt], acc[nt], 0, 0, 0);
                    if (nt == wave) acc[6] = __builtin_amdgcn_mfma_f32_16x16x32_bf16(a8, bfr[nt], acc[6], 0, 0, 0);
                }
            }
        }
#undef MD_LOAD
        float* mo = MOD + (size_t)l * 256 * NADA; const float* bb = bada + (size_t)l * NADA;
#pragma unroll
        for (int nt = 0; nt < 6; ++nt) { const int col = n0 + 16 * nt + r; const float bv = bb[col];
#pragma unroll
            for (int e = 0; e < 4; ++e) mo[(size_t)(16 * wave + 4 * g + e) * NADA + col] = acc[nt][e] + bv; }
        if (wave < 6) { const int col = n0 + 16 * wave + r; const float bv = bb[col];
#pragma unroll
            for (int e = 0; e < 4; ++e) mo[(size_t)(128 + 4 * g + e) * NADA + col] = acc[6][e] + bv; }
        __syncthreads();
    }
}

__device__ __forceinline__ void gla_scan(Frame& F, float* GST, const float* GAMS) {
    const Tix T = tix();
    const int gw = F.vcu * NWAVES + T.wave, NGW = F.G * NWAVES, g = T.lane >> 4;
    for (int item = gw; item < 8 * 4 * 8 * 16; item += NGW) {
        const int i = item & 15, w = (item >> 4) & 7, qs = (item >> 7) & 3, bh = item >> 9;
        f32x4 G[8], Gm[8];
#pragma unroll
        for (int sc = 0; sc < 8; ++sc) { const int grp = bh * 8 + sc;
            G[sc] = *((const f32x4*)(GST + ((((size_t)grp * 4 + qs) * 8 + w) * 16 + i) * 256) + T.lane);
            Gm[sc] = *(const f32x4*)(GAMS + (size_t)grp * 256 + 16 * i + 4 * g); }
        f32x4 S = G[0] * 0.0f;
#pragma unroll
        for (int sc = 0; sc < 8; ++sc) { const int grp = bh * 8 + sc;
            *((f32x4*)(GST + ((((size_t)grp * 4 + qs) * 8 + w) * 16 + i) * 256) + T.lane) = S;
            S = Gm[sc] * S + G[sc]; }
    }
}
constexpr int NPH = 27;
#ifndef EN_CONV
#define EN_CONV 1
#endif
#ifndef EN_MOD
#define EN_MOD 1
#endif
#ifndef EN_NORM
#define EN_NORM 1
#endif
#ifndef EN_WIN
#define EN_WIN 1
#endif
#ifndef EN_GK
#define EN_GK 1
#endif
#ifndef EN_GLAN
#define EN_GLAN 1
#endif
#ifndef EN_MIXA
#define EN_MIXA 1
#endif
#ifndef EN_MIXB
#define EN_MIXB 1
#endif
#ifndef EN_PROJ
#define EN_PROJ 1
#endif
#ifndef EN_WO
#define EN_WO 1
#endif
#ifndef EN_FFI
#define EN_FFI 1
#endif
#ifndef EN_FFO
#define EN_FFO 1
#endif
#ifndef EN_FINAL
#define EN_FINAL 1
#endif
#ifndef MK_PROBE
#define MK_PROBE 0
#endif
#ifndef MK_REP_K
#define MK_REP_K 0
#endif
#ifndef MK_REP_N
#define MK_REP_N 0
#endif
#ifndef MK_REP_VAR
#define MK_REP_VAR 0
#endif
#ifndef MK_ONE_LAUNCH
#define MK_ONE_LAUNCH 1
#endif
typedef const __attribute__((address_space(4))) Prm* KPrm;
__device__ __forceinline__ KPrm kargs() { KPrm p = (KPrm)__builtin_amdgcn_kernarg_segment_ptr(); asm volatile("" : "+s"(p)); return p; }
#define PH_BEGIN KPrm K = kargs(); unsigned char* ws = K->ws; (void)ws;
__global__ void __launch_bounds__(NT, 2) mega_fwd(Prm P_unused) {
    extern __shared__ __attribute__((aligned(16))) unsigned char lds_raw[];
    Frame F;
    F.lds = (LAS unsigned char*)lds_raw;
    F.G = gridDim.x; { const int bx = blockIdx.x; F.vcu = (F.G % 8 == 0) ? (bx % 8) * (F.G / 8) + bx / 8 : bx; }
    volatile LAS unsigned* MISC = (volatile LAS unsigned*)(F.lds + MISC_OFF);
    if (threadIdx.x < 64) MISC[threadIdx.x] = 0u;
    __syncthreads();
    int lo, hi;
    XcdBarrier bar;
    { KPrm K = kargs(); lo = K->ph_lo; hi = K->ph_hi; unsigned* ctl = (unsigned*)(K->ws + WS_CTL);
      bar.bar = ctl + CW_BAR; bar.x = 0; bar.st = nullptr;
      if (hi - lo > 1) bar = xcd_barrier_post(ctl + CW_BAR, MISC + 8); }
#define IN(k) (lo <= (k) && (k) < hi)
#define SEAM(k) do { if (IN(k) && IN((k) + 1)) xcd_barrier(bar); } while (0)
#define WSP(T, off) ((T*)(ws + (off)))

    if (EN_CONV && IN(0)) { phase_convert(F); }
    SEAM(0);
    if (EN_MOD && IN(1)) { PH_BEGIN mod_direct(F, WSP(const bf16, WS_CA), K->in[I_WADA], K->in[I_BADA], WSP(float, WS_MOD)); }
    SEAM(1);
#if 0
    SEAM(0);
    if (EN_MOD && IN(1)) {
        PH_BEGIN
        const int c = (int)blockIdx.x, l = c / 48;
        if (l < 2) {
            pg8::Gemm g{WSP(const bf16, WS_CA), WSP(const bf16, WS_WADA) + (size_t)l * NADA * D, 256, NADA, D, D};
            pg8::StaticOrder S; S.init(256, NADA, 1 << 20, c - 48 * l, D);
            pg8::EpiF32 E{WSP(float, WS_MOD) + (size_t)l * 256 * NADA, NADA, K->in[I_BADA] + (size_t)l * NADA};
            pg8::gemm_phase<pg8::EpiF32, pg8::StaticOrder, true, true>(F.lds, g, S, E);
        }
    }
    SEAM(1);
#endif

    for (int l = 0; l < 2; ++l) {
        const int pb = 2 + 12 * l;
        if (EN_NORM && IN(pb + 0)) { PH_BEGIN phase_norm_t<false>(F, WSP(float, WS_X), K->in[I_N1W] + (size_t)l * D, WSP(const float, WS_MOD) + (size_t)l * 256 * NADA, MOD_SH1, MOD_SC1, WSP(bf16, WS_H), nullptr, WSP(const float, WS_PART + 16 * MiB), l == 0 ? 0 : 11, l == 0 ? K->in[I_XP] : nullptr); }
        SEAM(pb + 0);
        if (EN_WIN && IN(pb + 1)) {
            PH_BEGIN
            pg8::Gemm g{WSP(const bf16, WS_H), WSP(const bf16, WS_WIN) + (size_t)l * NZW * D, MT, NZ, D, D};
            pg8::StaticOrder S; S.init(MT, NZ, F.G, (int)blockIdx.x, D);
            pg8::EpiZ E{WSP(bf16, WS_Z), NZ, ZGT / 256, K->var};
            pg8::gemm_phase<pg8::EpiZ, pg8::StaticOrder, true, true>(F.lds, g, S, E);
        }
        SEAM(pb + 1);
        if (IN(pb + 2)) {
            PH_BEGIN
            const bf16* Zb = WSP(const bf16, WS_Z); const bf16* Hb = WSP(const bf16, WS_H); const bf16* Wl = WSP(const bf16, WS_WIN) + (size_t)l * NZW * D + (size_t)ZLR * D;
            const float* wgk2 = K->in[I_WGK2] + (size_t)l * 16 * 1024; const float* bgk = K->in[I_BGK] + (size_t)l * 1024;
            const int ow = (int)blockIdx.x, OW = F.G;
            for (int half = 0; half < 2; ++half) {
                if ((half == 0) == ((ow & 1) == 1)) {
                    if (EN_MIXA && !(K->var & 8)) for (int u = ow; u < 512; u += OW) gla_sample_unit(F, u, Zb, Hb, Wl, wgk2, bgk, K->in[I_SGLA] + (size_t)l * 128 * 4 * 256 * 512, K->out + O_SGS + (size_t)l * 128 * 4 * 256 * 512, K->in[I_GLANW] + (size_t)l * 512, WSP(bf16, WS_OABC));
                } else {
                    if (EN_GLAN && !(K->var & 16)) for (int u = ow; u < 512; u += OW) gla_prep_unit(F, u, Zb, Hb, Wl, wgk2, bgk, WSP(bf16, WS_QT), WSP(bf16, WS_KH), WSP(bf16, WS_AI), WSP(float, WS_GAM));
                    if (EN_MIXA && !(K->var & 32)) {
                        __syncthreads();
                        if (!(K->var & 64)) gm_ln_rows(F, ow, OW, Zb, K->in[I_GMNW] + (size_t)l * 1024, K->in[I_GMNB] + (size_t)l * 1024, WSP(bf16, WS_VNB), K->out + O_GMV + (size_t)l * 128 * 1024, K->in[I_GMWS] + (size_t)l * 4 * 128 * 128, K->in[I_GMBS] + (size_t)l * 4 * 128, WSP(bf16, WS_OABC));
                        if (!(K->var & 128)) for (int u = ow; u < 256; u += OW) swa_unit(F, u, Zb, K->in[I_SINK] + (size_t)l * 16, WSP(bf16, WS_OABC));
                        __syncthreads();
                        if (!(K->var & 256)) for (int it = ow * NWAVES + tix().wave; it < MS * 16; it += OW * NWAVES) swa_sample_wave(F, it, Zb, K->in[I_SINK] + (size_t)l * 16, K->in[I_CK] + (size_t)l * 128 * 128 * 256, K->in[I_CV] + (size_t)l * 128 * 128 * 256, WSP(bf16, WS_OABC));
                        __syncthreads();
                        cache_outs(F, ow, OW, l, Zb, K->out);
                    }
                }
            }
        }
        SEAM(pb + 2);
        if (IN(pb + 3)) {
            PH_BEGIN
            if (EN_GLAN) for (int w = (int)blockIdx.x; w < 256; w += F.G) gla_pass<false>(F, w, WSP(const bf16, WS_Z), WSP(const bf16, WS_QT), WSP(const bf16, WS_KH), WSP(const bf16, WS_AI), WSP(const float, WS_GAM), WSP(float, WS_GST), WSP(float, WS_GAMS), nullptr, nullptr);
            if (EN_MIXB) for (int u = (int)blockIdx.x; u < 256; u += F.G) gm_mix_unit(F, u, WSP(const bf16, WS_Z), WSP(const bf16, WS_VNB), K->in[I_GMWS] + (size_t)l * 4 * 128 * 128, K->in[I_GMBS] + (size_t)l * 4 * 128, WSP(bf16, WS_OABC));
        }
        SEAM(pb + 3);
        if (EN_GLAN && IN(pb + 4)) { PH_BEGIN gla_scan(F, WSP(float, WS_GST), WSP(const float, WS_GAMS)); }
        SEAM(pb + 4);
        if (IN(pb + 5)) {
            PH_BEGIN
            if (EN_GLAN) for (int w = (int)blockIdx.x; w < 256; w += F.G) gla_pass<true>(F, w, WSP(const bf16, WS_Z), WSP(const bf16, WS_QT), WSP(const bf16, WS_KH), WSP(const bf16, WS_AI), WSP(const float, WS_GAM), WSP(float, WS_GST), WSP(float, WS_GAMS), WSP(float, WS_OB), K->out + O_SGP + (size_t)l * 2 * 4 * 256 * 512);
        }
        SEAM(pb + 5);
        if (EN_MIXB && IN(pb + 6)) { PH_BEGIN gla_fin(F, WSP(const float, WS_OB), WSP(const bf16, WS_Z), K->in[I_GLANW] + (size_t)l * 512, WSP(bf16, WS_OABC)); }
        SEAM(pb + 6);
        if (EN_PROJ && IN(pb + 7)) {
            PH_BEGIN
            pg8::Gemm g{WSP(const bf16, WS_OABC), WSP(const bf16, WS_WPRJ) + (size_t)l * D * 4096, MT, D, 4096, 4096};
            pg8::MiniOrder S; S.init(F.G, (int)blockIdx.x, 4096, 8, K->var);
            pg8::EpiProjR E{WSP(const bf16, WS_Z), NZ, ZGT, WSP(float, WS_PART), WSP(bf16, WS_MG), MP, K->var};
            pg8::gemm_phase<pg8::EpiProjR, pg8::MiniOrder, true, true>(F.lds, g, S, E);
        }
        SEAM(pb + 7);
        if (EN_WO && IN(pb + 8)) {
            PH_BEGIN
            pg8::Gemm g{WSP(const bf16, WS_MG), WSP(const bf16, WS_WO) + (size_t)l * D * D, MT, D, D, D};
            pg8::MiniOrder S; S.init(F.G, (int)blockIdx.x, D, 4, K->var);
            {
              const Tix T = tix(); pg8::Unit u;
              for (int i = 0; S.next(i, u); ++i) if (u.pm >= 32) { const int k0 = 64 * u.kt0, kw = 16 * u.nt;
                  for (int idx0 = T.tid; idx0 < 128 * kw; idx0 += 4 * NT) {
                      f32x4 pv[4][8];
#pragma unroll
                      for (int q = 0; q < 4; ++q) { const int idx = idx0 + q * NT, r = idx / kw, c = k0 + 4 * (idx % kw);
#pragma unroll
                          for (int s = 0; s < 8; ++s) pv[q][s] = *(const f32x4*)(WSP(const float, WS_PART) + ((size_t)s * 128 + r) * D + c); }
#pragma unroll
                      for (int q = 0; q < 4; ++q) { const int idx = idx0 + q * NT, r = idx / kw, c = k0 + 4 * (idx % kw);
                          const f32x4 v = ((pv[q][0] + pv[q][1]) + (pv[q][2] + pv[q][3])) + ((pv[q][4] + pv[q][5]) + (pv[q][6] + pv[q][7]));
                          v2u w; w.x = pk2(v.x, v.y); w.y = pk2(v.z, v.w); *(v2u*)(WSP(bf16, WS_MG) + (size_t)(MP + r) * D + c) = w; } }
                  for (int idx = T.tid; idx < 128 * kw; idx += NT) { const int r = 128 + idx / kw, c = k0 + 4 * (idx % kw); *(v2u*)(WSP(bf16, WS_MG) + (size_t)(MP + r) * D + c) = (v2u){0u, 0u}; } }
              VM_WAIT(); __syncthreads(); }
            pg8::EpiResid E{WSP(float, WS_X), l == 0 ? K->in[I_XP] : WSP(const float, WS_X), WSP(const float, WS_MOD) + (size_t)l * 256 * NADA + MOD_G1, NADA, WSP(float, WS_PART + 8 * MiB), MP, K->var};
            pg8::gemm_phase<pg8::EpiResid, pg8::MiniOrder, true, true>(F.lds, g, S, E);
        }
        SEAM(pb + 8);
        if (EN_NORM && IN(pb + 9)) { PH_BEGIN phase_norm_t<false>(F, WSP(float, WS_X), K->in[I_N2W] + (size_t)l * D, WSP(const float, WS_MOD) + (size_t)l * 256 * NADA, MOD_SH2, MOD_SC2, WSP(bf16, WS_H), nullptr, WSP(const float, WS_PART + 8 * MiB), 8); }
        SEAM(pb + 9);
        if (EN_FFI && IN(pb + 10)) {
            PH_BEGIN
            pg8::Gemm g{WSP(const bf16, WS_H), WSP(const bf16, WS_WFI) + (size_t)l * 2 * FF * D, MT, 2 * FF, D, D};
            pg8::StaticOrder S; S.init(MT, 2 * FF, F.G, (int)blockIdx.x, D);
            pg8::EpiSwiGLU E{WSP(bf16, WS_ACT), FF};
            pg8::gemm_phase<pg8::EpiSwiGLU, pg8::StaticOrder, true, true>(F.lds, g, S, E);
        }
        SEAM(pb + 10);
        if (EN_FFO && IN(pb + 11)) {
            PH_BEGIN
            pg8::Gemm g{WSP(const bf16, WS_ACT), WSP(const bf16, WS_WFO) + (size_t)l * D * FF, MT, D, FF, FF};
            pg8::MiniOrder S; S.init(F.G, (int)blockIdx.x, FF, 8, K->var);
            pg8::EpiResid E{WSP(float, WS_X), WSP(const float, WS_X), WSP(const float, WS_MOD) + (size_t)l * 256 * NADA + MOD_G2, NADA, WSP(float, WS_PART + 16 * MiB), MP, K->var};
            pg8::gemm_phase<pg8::EpiResid, pg8::MiniOrder, true, true>(F.lds, g, S, E);
        }
        SEAM(pb + 11);
    }
    if (EN_FINAL && IN(26)) { PH_BEGIN phase_norm_t<true>(F, WSP(float, WS_X), K->in[I_FNW], nullptr, 0, 0, nullptr, K->out, WSP(const float, WS_PART + 16 * MiB), 11); }
#undef IN
#undef SEAM
}

extern "C" void kernel_launch(void* const* d_in, const int* in_sizes, int n_in, void* d_out, int out_size, void* d_ws, size_t ws_size, hipStream_t stream) {
    static int grid = 0;
    if (grid == 0) {
        if (n_in != N_IN || (size_t)out_size != O_END || ws_size < WS_END) { fprintf(stderr, "kernel_launch: unexpected problem (n_in %d, out %d, ws %zu); nothing launched\n", n_in, out_size, ws_size); grid = -1; return; }
        int dev = 0, cus = 0, per_cu = 0;
        if (hipGetDevice(&dev) != hipSuccess || hipDeviceGetAttribute(&cus, hipDeviceAttributeMultiprocessorCount, dev) != hipSuccess) { grid = -1; return; }
        if (hipFuncSetAttribute((const void*)mega_fwd, hipFuncAttributeMaxDynamicSharedMemorySize, LDS_BYTES) != hipSuccess) { fprintf(stderr, "kernel_launch: hipFuncSetAttribute failed\n"); grid = -1; return; }
        if (hipOccupancyMaxActiveBlocksPerMultiprocessor(&per_cu, (const void*)mega_fwd, NT, LDS_BYTES) != hipSuccess || per_cu < 1) { fprintf(stderr, "kernel_launch: occupancy query says %d\n", per_cu); }
        (void)hipGetLastError();
        grid = cus;
        if (grid < 128) { fprintf(stderr, "kernel_launch: this build needs >= 128 CUs (mini-unit deal)\n"); grid = -1; return; }
    }
    if (grid < 0) return;
    (void)hipMemsetAsync((char*)d_ws + WS_CTL, 0, CTL_ZERO_BYTES, stream);
    Prm p{};
    for (int i = 0; i < N_IN; ++i) p.in[i] = (const float*)d_in[i];
    p.out = (float*)d_out; p.ws = (unsigned char*)d_ws;
#if MK_ONE_LAUNCH
    p.ph_lo = 0; p.ph_hi = NPH;
    hipLaunchKernelGGL(mega_fwd, dim3(grid), dim3(NT), LDS_BYTES, stream, p);
#if MK_PROBE
    for (int i = 0; i < MK_REP_N; ++i) { p.ph_lo = MK_REP_K; p.ph_hi = MK_REP_K + 1; p.var = MK_REP_VAR; hipLaunchKernelGGL(mega_fwd, dim3(grid), dim3(NT), LDS_BYTES, stream, p); }
#endif
#else
    for (int k = 0; k < NPH; ++k) { p.ph_lo = k; p.ph_hi = k + 1; hipLaunchKernelGGL(mega_fwd, dim3(grid), dim3(NT), LDS_BYTES, stream, p); }
#endif
}
```

```cpp
#include <hip/hip_runtime.h>
#include <cstdio>
#include <cstdint>
namespace pg8 {
#define PG8_LAS __attribute__((address_space(3)))
typedef unsigned short bf16_t;
typedef short bf16x8 __attribute__((ext_vector_type(8)));
typedef float f32x4 __attribute__((ext_vector_type(4)));
typedef unsigned u32x4 __attribute__((ext_vector_type(4)));
constexpr int BM = 256, BK = 64, HALF = 128, HTB = HALF * BK * 2  , STAGE_BYTES = 8 * HTB, NXCD = 8, WGM = 8;

__host__ __device__ __forceinline__ int lds_byte(int r, int c) { const int st = (r >> 4) * 2 + (c >> 5), rr = r & 15, cc = c & 31, ob = rr * 64 + cc * 2; return st * 1024 + (ob ^ (((ob >> 9) & 1) << 5)); }
__host__ __device__ __forceinline__ void stage_rc(int b, int& R, int& C) { const int st = b / 1024, sb = b % 1024, swz = sb ^ (((sb >> 9) & 1) << 5); R = (st >> 1) * 16 + swz / 64; C = (st & 1) * 32 + (swz % 64) / 2; }
__host__ __device__ __forceinline__ int perm32(int rho) { const int n = rho >> 4, i = rho & 15; return 8 * (i >> 2) + 4 * n + (i & 3); }

struct Unit { int pm, pn, kt0, nt; };
struct Gemm { const bf16_t* A; const bf16_t* Bt; int M, N, K, ld; };

struct StaticOrder {
    int nM, nN, nwg, G, c, ntf;
    __host__ __device__ __forceinline__ void init(int M, int N, int G_, int c_, int K) { nM = M / BM; nN = N / BM; nwg = nM * nN; G = G_; c = c_; ntf = K / BK; }
    __host__ __device__ __forceinline__ bool next(int i, Unit& u) const {
        const long L = (long)i * G + c; if (L >= nwg) return false;
        int wgid = (int)L; { const int q = nwg / NXCD, r = nwg % NXCD, xcd = wgid % NXCD, off = wgid / NXCD; wgid = (xcd < r ? xcd * (q + 1) : r * (q + 1) + (xcd - r) * q) + off; }
        const int nig = WGM * nN, gid = wgid / nig, fm = gid * WGM, gsz = (nM - fm) < WGM ? (nM - fm) : WGM;
        u.pm = fm + ((wgid % nig) % gsz); u.pn = (wgid % nig) / gsz; u.kt0 = 0; u.nt = ntf; return true;
    }
    __device__ __forceinline__ void a_ready(const Unit&) const {}
    __device__ __forceinline__ void done(const Unit&) const {}
};
struct MiniOrder {
    StaticOrder main; int nmini, ntm;
    __host__ __device__ __forceinline__ void init(int G_, int c_, int K, int ntm_, int var = 0) { main.init(32 * BM, 2048, G_, c_, K); ntm = ntm_; nmini = (var & 4) ? 0 : 8 * ((K / BK) / ntm_); }
    __host__ __device__ __forceinline__ bool next(int i, Unit& u) const {
        const bool has_mini = main.c < nmini;
        if (has_mini && i == 0) { const int m = main.c; u.pm = 32; u.pn = m & 7; u.kt0 = ntm * (m >> 3); u.nt = ntm; return true; }
        return main.next(has_mini ? i - 1 : i, u);
    }
    __device__ __forceinline__ void a_ready(const Unit&) const {}
    __device__ __forceinline__ void done(const Unit&) const {}
};


typedef __bf16 bf16x2_t __attribute__((ext_vector_type(2)));
__device__ __forceinline__ unsigned cvt_pk_bf16(float lo, float hi) { bf16x2_t v; v[0] = (__bf16)lo; v[1] = (__bf16)hi; return __builtin_bit_cast(unsigned, v); }
typedef float f32x2 __attribute__((ext_vector_type(2)));
__device__ __forceinline__ f32x2 gelu_pk(f32x2 v) {
    const f32x2 av = __builtin_elementwise_abs(v), d = av * 0.2316418882f + 1.0f;
    f32x2 t; t.x = __builtin_amdgcn_rcpf(d.x); t.y = __builtin_amdgcn_rcpf(d.y);
    f32x2 q = t * 0.5307027145f + (-0.7265760135f); q = q * t + 0.7107068705f; q = q * t + (-0.142248368f); q = q * t + 0.127414796f; q = q * t;
    const f32x2 s = (v * v) * (-0.72134752044f);
    f32x2 e; e.x = __builtin_amdgcn_exp2f(s.x); e.y = __builtin_amdgcn_exp2f(s.y);
    const f32x2 m = v * (q * e), r = v - m;
    f32x2 o; o.x = v.x < 0.f ? m.x : r.x; o.y = v.y < 0.f ? m.y : r.y; return o;
}

template <int ACT  > struct EpiBf16 {
    static constexpr bool PERM = true, AFTER_DRAIN = false, HAS_HOOK = false; static_assert(ACT == 0 || ACT == 1, "EpiBf16: ACT is 0 (none) or 1 (gelu_pk)");
    bf16_t* O; int ldc; const float* bias; int split_cols; size_t split_stride; float scale0;
    __device__ __forceinline__ void operator()(const f32x4 (&acc)[2][2][4][2], const Unit& u, int wr, int wc, int fr, int fq) const {
        const int row0 = u.pm * BM + wr * 64 + fr; int colt = u.pn * BM; bf16_t* base = O;
        float sc = 1.f; if (split_cols) { const int t = colt / split_cols; base += (size_t)t * split_stride; colt -= t * split_cols; if (t == 0) sc = scale0; }
        const int col0 = colt + wc * 32 + 8 * fq, bcol0 = u.pn * BM + wc * 32 + 8 * fq;
        f32x4 bv[2][2];
#pragma unroll
        for (int bj = 0; bj < 2; ++bj)
#pragma unroll
            for (int n = 0; n < 2; ++n) bv[bj][n] = bias ? *(const f32x4*)(bias + bcol0 + bj * HALF + 4 * n) : (f32x4){0.f, 0.f, 0.f, 0.f};
#pragma unroll
        for (int ai = 0; ai < 2; ++ai)
#pragma unroll
            for (int m = 0; m < 4; ++m) { bf16_t* rowp = base + (size_t)(row0 + ai * HALF + m * 16) * ldc + col0;
#pragma unroll
                for (int bj = 0; bj < 2; ++bj) { f32x4 v0 = acc[ai][bj][m][0] + bv[bj][0], v1 = acc[ai][bj][m][1] + bv[bj][1];
                    if (ACT == 1) { f32x2 a = gelu_pk((f32x2){v0[0], v0[1]}), b = gelu_pk((f32x2){v0[2], v0[3]}), c = gelu_pk((f32x2){v1[0], v1[1]}), d = gelu_pk((f32x2){v1[2], v1[3]});
                        v0 = (f32x4){a.x, a.y, b.x, b.y}; v1 = (f32x4){c.x, c.y, d.x, d.y}; }
                    v0 = v0 * sc; v1 = v1 * sc; u32x4 w; w.x = cvt_pk_bf16(v0[0], v0[1]); w.y = cvt_pk_bf16(v0[2], v0[3]); w.z = cvt_pk_bf16(v1[0], v1[1]); w.w = cvt_pk_bf16(v1[2], v1[3]);
                    *(u32x4*)(rowp + bj * HALF) = w; } }
    }
};
struct EpiF32 {
    static constexpr bool PERM = false, AFTER_DRAIN = false, HAS_HOOK = false;
    float* C; int ldc; const float* bias;
    __device__ __forceinline__ void operator()(const f32x4 (&acc)[2][2][4][2], const Unit& u, int wr, int wc, int fr, int fq) const {
        const int row0 = u.pm * BM + wr * 64 + fr, col0 = u.pn * BM + wc * 32 + 4 * fq;
        f32x4 bv[2][2];
#pragma unroll
        for (int bj = 0; bj < 2; ++bj)
#pragma unroll
            for (int n = 0; n < 2; ++n) bv[bj][n] = bias ? *(const f32x4*)(bias + col0 + bj * HALF + n * 16) : (f32x4){0.f, 0.f, 0.f, 0.f};
#pragma unroll
        for (int ai = 0; ai < 2; ++ai)
#pragma unroll
            for (int m = 0; m < 4; ++m) { float* rowp = C + (size_t)(row0 + ai * HALF + m * 16) * ldc + col0;
#pragma unroll
                for (int bj = 0; bj < 2; ++bj)
#pragma unroll
                    for (int n = 0; n < 2; ++n) *(f32x4*)(rowp + bj * HALF + n * 16) = acc[ai][bj][m][n] + bv[bj][n]; }
    }
};
__device__ __forceinline__ float bf_lo(unsigned w) { return __uint_as_float(w << 16); }
__device__ __forceinline__ float bf_hi(unsigned w) { return __uint_as_float(w & 0xffff0000u); }
__device__ __forceinline__ float fsigmoid(float x) { return __builtin_amdgcn_rcpf(1.0f + __expf(-x)); }
__device__ __forceinline__ float fsilu(float x) { return x * fsigmoid(x); }
__device__ __forceinline__ int batch_of_row(int row) { return row < 4096 ? 0 : (row < 8192 ? 1 : (row - 8192 < 128 ? row - 8190 : 129)); }
typedef unsigned u32x2 __attribute__((ext_vector_type(2)));

struct EpiZ {
    static constexpr bool PERM = true, AFTER_DRAIN = false, HAS_HOOK = false;
    bf16_t* O; int ldc; int gate_pn0; int var;
    __device__ __forceinline__ void operator()(const f32x4 (&acc)[2][2][4][2], const Unit& u, int wr, int wc, int fr, int fq) const {
        if (var & 1) return;
        const int row0 = u.pm * BM + wr * 64 + fr, col0 = u.pn * BM + wc * 32 + 8 * fq; const bool gt = (u.pn >= gate_pn0) && !(var & 2);
#pragma unroll
        for (int ai = 0; ai < 2; ++ai)
#pragma unroll
            for (int m = 0; m < 4; ++m) { bf16_t* rowp = O + (size_t)(row0 + ai * HALF + m * 16) * ldc + col0;
#pragma unroll
                for (int bj = 0; bj < 2; ++bj) { f32x4 v0 = acc[ai][bj][m][0], v1 = acc[ai][bj][m][1];
                    if (gt) {
#pragma unroll
                        for (int j = 0; j < 4; ++j) { v0[j] = 1.0f + __expf(-fminf(fmaxf(v0[j], -40.f), 40.f)); v1[j] = 1.0f + __expf(-fminf(fmaxf(v1[j], -40.f), 40.f)); } }
                    u32x4 w; w.x = cvt_pk_bf16(v0[0], v0[1]); w.y = cvt_pk_bf16(v0[2], v0[3]); w.z = cvt_pk_bf16(v1[0], v1[1]); w.w = cvt_pk_bf16(v1[2], v1[3]);
                    *(u32x4*)(rowp + bj * HALF) = w; } }
    }
};
struct EpiProjR {
    static constexpr bool PERM = true, AFTER_DRAIN = false, HAS_HOOK = true;
    const bf16_t* Z; int ldz; int gcol0; float* PART; bf16_t* MG; int mp0; int var;
    __device__ __forceinline__ bool hook_at(const Unit& u, int t) const { return u.nt == 64 && (t == 32 || t == 48) && !(var & 2); }
    __device__ __forceinline__ void hook(f32x4 (&acc)[2][2][4][2], const Unit& u, int t, int wr, int wc, int fr, int fq) const {
        int row0 = u.pm * BM + wr * 64 + fr, col0 = u.pn * BM + wc * 32 + 8 * fq; asm volatile("" : "+v"(row0), "+v"(col0));
        const int gp = gcol0 + (t == 32 ? 0 : 2048);
#pragma unroll
        for (int ai = 0; ai < 2; ++ai) {
            u32x4 gprev[4][2], gnext[4][2];
#pragma unroll
            for (int m = 0; m < 4; ++m) { const bf16_t* zp = Z + (size_t)(row0 + ai * HALF + m * 16) * ldz + gp + col0;
#pragma unroll
                for (int bj = 0; bj < 2; ++bj) { gprev[m][bj] = *(const u32x4*)(zp + bj * HALF); gnext[m][bj] = *(const u32x4*)(zp + 2048 + bj * HALF); } }
#pragma unroll
            for (int m = 0; m < 4; ++m)
#pragma unroll
                for (int bj = 0; bj < 2; ++bj) { const u32x4 gpv = gprev[m][bj], gnx = gnext[m][bj];
                    f32x4 r0, r1; r0[0] = bf_lo(gnx.x) * __builtin_amdgcn_rcpf(bf_lo(gpv.x)); r0[1] = bf_hi(gnx.x) * __builtin_amdgcn_rcpf(bf_hi(gpv.x));
                    r0[2] = bf_lo(gnx.y) * __builtin_amdgcn_rcpf(bf_lo(gpv.y)); r0[3] = bf_hi(gnx.y) * __builtin_amdgcn_rcpf(bf_hi(gpv.y));
                    r1[0] = bf_lo(gnx.z) * __builtin_amdgcn_rcpf(bf_lo(gpv.z)); r1[1] = bf_hi(gnx.z) * __builtin_amdgcn_rcpf(bf_hi(gpv.z));
                    r1[2] = bf_lo(gnx.w) * __builtin_amdgcn_rcpf(bf_lo(gpv.w)); r1[3] = bf_hi(gnx.w) * __builtin_amdgcn_rcpf(bf_hi(gpv.w));
                    acc[ai][bj][m][0] = acc[ai][bj][m][0] * r0; acc[ai][bj][m][1] = acc[ai][bj][m][1] * r1; }
            asm volatile("" ::: "memory"); }
        asm volatile("s_waitcnt vmcnt(0)" ::: "memory");
    }
    __device__ __forceinline__ void operator()(const f32x4 (&acc)[2][2][4][2], const Unit& u, int wr, int wc, int fr, int fq) const {
        if (var & 1) return;
        int row0 = u.pm * BM + wr * 64 + fr, col0 = u.pn * BM + wc * 32 + 8 * fq; asm volatile("" : "+v"(row0), "+v"(col0));
        const bool mini = u.nt != 64; const int br = mini ? (u.kt0 < 32 ? 0 : (u.kt0 < 48 ? 1 : 2)) : 2;
#pragma unroll
        for (int ai = 0; ai < 2; ++ai) {
            u32x4 gw[4][2];
#pragma unroll
            for (int m = 0; m < 4; ++m) { const bf16_t* zp = Z + (size_t)(row0 + ai * HALF + m * 16) * ldz + gcol0 + br * 2048 + col0;
#pragma unroll
                for (int bj = 0; bj < 2; ++bj) gw[m][bj] = *(const u32x4*)(zp + bj * HALF); }
#pragma unroll
            for (int m = 0; m < 4; ++m) { const int row = row0 + ai * HALF + m * 16;
#pragma unroll
                for (int bj = 0; bj < 2; ++bj) { const int col = col0 + bj * HALF; const u32x4 gq = gw[m][bj];
                    f32x4 g0, g1; g0[0] = __builtin_amdgcn_rcpf(bf_lo(gq.x)); g0[1] = __builtin_amdgcn_rcpf(bf_hi(gq.x)); g0[2] = __builtin_amdgcn_rcpf(bf_lo(gq.y)); g0[3] = __builtin_amdgcn_rcpf(bf_hi(gq.y));
                    g1[0] = __builtin_amdgcn_rcpf(bf_lo(gq.z)); g1[1] = __builtin_amdgcn_rcpf(bf_hi(gq.z)); g1[2] = __builtin_amdgcn_rcpf(bf_lo(gq.w)); g1[3] = __builtin_amdgcn_rcpf(bf_hi(gq.w));
                    const f32x4 v0 = acc[ai][bj][m][0] * g0, v1 = acc[ai][bj][m][1] * g1;
                    if (!mini) { u32x4 w; w.x = cvt_pk_bf16(v0[0], v0[1]); w.y = cvt_pk_bf16(v0[2], v0[3]); w.z = cvt_pk_bf16(v1[0], v1[1]); w.w = cvt_pk_bf16(v1[2], v1[3]); *(u32x4*)(MG + (size_t)row * 2048 + col) = w; }
                    else if (ai == 0) { float* pp = PART + ((size_t)(u.kt0 / u.nt) * 128 + (row - mp0)) * 2048 + col; *(f32x4*)pp = v0; *(f32x4*)(pp + 4) = v1; } } }
            asm volatile("" ::: "memory"); }
    }
};
struct EpiResid {
    static constexpr bool PERM = false, AFTER_DRAIN = false, HAS_HOOK = false;
    float* X; const float* Xin; const float* gate; int ldg; float* PART; int mp0; int var;
    __device__ __forceinline__ void operator()(const f32x4 (&acc)[2][2][4][2], const Unit& u, int wr, int wc, int fr, int fq) const {
        if (var & 1) return;
        int row0 = u.pm * BM + wr * 64 + fr, col0 = u.pn * BM + wc * 32 + 4 * fq; asm volatile("" : "+v"(row0), "+v"(col0)); const bool mini = u.pm >= 32;
#pragma unroll
        for (int ai = 0; ai < 2; ++ai)
#pragma unroll
            for (int mp = 0; mp < 2; ++mp) {
                f32x4 gg[2][4], xx[2][4];
#pragma unroll
                for (int mm = 0; mm < 2; ++mm) { const int row = row0 + ai * HALF + (2 * mp + mm) * 16; const float* gp = gate + (size_t)batch_of_row(row) * ldg + col0; const float* xp = Xin + (size_t)row * 2048 + col0;
#pragma unroll
                    for (int q = 0; q < 4; ++q) { gg[mm][q] = *(const f32x4*)(gp + (q >> 1) * HALF + (q & 1) * 16); if (!mini) xx[mm][q] = *(const f32x4*)(xp + (q >> 1) * HALF + (q & 1) * 16); } }
#pragma unroll
                for (int mm = 0; mm < 2; ++mm) { const int m = 2 * mp + mm, row = row0 + ai * HALF + m * 16; float* xp = X + (size_t)row * 2048 + col0;
#pragma unroll
                    for (int q = 0; q < 4; ++q) { float* xq = xp + (q >> 1) * HALF + (q & 1) * 16; const f32x4 v = gg[mm][q] * acc[ai][q >> 1][m][q & 1];
                        if (!mini) *(f32x4*)xq = xx[mm][q] + v;
                        else if (ai == 0) *(f32x4*)(PART + ((size_t)(u.kt0 / u.nt) * 128 + (row - mp0)) * 2048 + col0 + (q >> 1) * HALF + (q & 1) * 16) = v; } }
                asm volatile("" ::: "memory"); }
    }
};
struct EpiSwiGLU {
    static constexpr bool PERM = true, AFTER_DRAIN = false, HAS_HOOK = false;
    bf16_t* ACT; int ldc;
    __device__ __forceinline__ void operator()(const f32x4 (&acc)[2][2][4][2], const Unit& u, int wr, int wc, int fr, int fq) const {
        const int row0 = u.pm * BM + wr * 64 + fr, col0 = u.pn * HALF + wc * 32 + 8 * fq;
#pragma unroll
        for (int ai = 0; ai < 2; ++ai)
#pragma unroll
            for (int m = 0; m < 4; ++m) { bf16_t* rowp = ACT + (size_t)(row0 + ai * HALF + m * 16) * ldc + col0;
                const f32x4 a0 = acc[ai][0][m][0], a1 = acc[ai][0][m][1], b0 = acc[ai][1][m][0], b1 = acc[ai][1][m][1];
                u32x4 w; w.x = cvt_pk_bf16(fsilu(a0[0]) * b0[0], fsilu(a0[1]) * b0[1]); w.y = cvt_pk_bf16(fsilu(a0[2]) * b0[2], fsilu(a0[3]) * b0[3]);
                w.z = cvt_pk_bf16(fsilu(a1[0]) * b1[0], fsilu(a1[1]) * b1[1]); w.w = cvt_pk_bf16(fsilu(a1[2]) * b1[2], fsilu(a1[3]) * b1[3]);
                *(u32x4*)rowp = w; }
    }
};
template <class Epi, class Sched, bool ALIGN_EPI = false, bool SP2 = false>
__device__ __forceinline__ void gemm_phase(PG8_LAS unsigned char* lds, const Gemm g, const Sched& S, const Epi& E) {
    int tid_ = threadIdx.x; asm volatile("" : "+v"(tid_));
    const int tid = tid_, wid = __builtin_amdgcn_readfirstlane(tid >> 6), lane = tid & 63, wr = wid >> 2, wc = wid & 3, fr = lane & 15, fq = lane >> 4;
    const int LD = g.ld;
    unsigned voffA[2], voffB[2];
#pragma unroll
    for (int i = 0; i < 2; ++i) { int R, C; stage_rc(tid * 16 + i * 8192, R, C); const int Rb = Epi::PERM ? ((R & ~31) + perm32(R & 31)) : R;
        voffA[i] = (unsigned)(R * LD + C) * 2u; voffB[i] = (unsigned)(Rb * LD + C) * 2u; }
    const size_t kstep = (size_t)(BK * 2);
    const size_t hstep = (size_t)HALF * LD * 2;
    const size_t tstep = 2 * hstep;
    const unsigned ldsw = (unsigned)wid * 1024u;
    const int aoff = lds_byte(wr * 64 + fr, fq * 8), boff = lds_byte(wc * 32 + fr, fq * 8);
#define PG8_SA(b, h) (((b) * 2 + (h)) * HTB)
#define PG8_SB(b, h) ((4 + (b) * 2 + (h)) * HTB)
#define PG8_STAGE(bufoff, gbase, voff) do { _Pragma("unroll") for (int _i = 0; _i < 2; ++_i) \
        __builtin_amdgcn_global_load_lds((const unsigned*)((const char*)(gbase) + (voff)[_i]), (PG8_LAS unsigned*)(lds + (bufoff) + ldsw + _i * 8192), 16, 0, 0); } while (0)
#define PG8_LDA(dst, b, h) do { _Pragma("unroll") for (int m = 0; m < 4; ++m) _Pragma("unroll") for (int k = 0; k < 2; ++k) dst[m][k] = *(const PG8_LAS bf16x8*)(lds + PG8_SA(b, h) + aoff + m * 2048 + k * 1024); } while (0)
#define PG8_LDB(dst, b, h) do { _Pragma("unroll") for (int n = 0; n < 2; ++n) _Pragma("unroll") for (int k = 0; k < 2; ++k) dst[n][k] = *(const PG8_LAS bf16x8*)(lds + PG8_SB(b, h) + boff + n * 2048 + k * 1024); } while (0)
#define PG8_MMA(ai, bj, At, Bt) do { __builtin_amdgcn_s_setprio(1); _Pragma("unroll") for (int m = 0; m < 4; ++m) _Pragma("unroll") for (int n = 0; n < 2; ++n) _Pragma("unroll") for (int k = 0; k < 2; ++k) \
        acc[ai][bj][m][n] = __builtin_amdgcn_mfma_f32_16x16x32_bf16(Bt[n][k], At[m][k], acc[ai][bj][m][n], 0, 0, 0); __builtin_amdgcn_s_setprio(0); } while (0)
#define PG8_WAIT_V(n) asm volatile("s_waitcnt vmcnt(" #n ")" ::: "memory")
#define PG8_WAIT_L(n) asm volatile("s_waitcnt lgkmcnt(" #n ")" ::: "memory")
#define PG8_BAR __builtin_amdgcn_s_barrier()
#define PG8_SCHED __builtin_amdgcn_sched_barrier(0)
    Unit cur, nxt; int ui = 0;
    if (!S.next(0, cur)) return;
    f32x4 acc[2][2][4][2];
#pragma unroll
    for (int a = 0; a < 2; ++a)
#pragma unroll
        for (int b = 0; b < 2; ++b)
#pragma unroll
            for (int m = 0; m < 4; ++m)
#pragma unroll
                for (int n = 0; n < 2; ++n) acc[a][b][m][n] = (f32x4){0.f, 0.f, 0.f, 0.f};
    bf16x8 At[4][2], B0[2][2], B1[2][2];
    const char* cA = (const char*)g.A + (size_t)cur.pm * tstep + (size_t)cur.kt0 * kstep; const char* cB = (const char*)g.Bt + (size_t)cur.pn * tstep + (size_t)cur.kt0 * kstep;
    S.a_ready(cur);
    if constexpr (SP2) {
        PG8_STAGE(PG8_SB(0, 0), cB, voffB); PG8_STAGE(PG8_SB(0, 1), cB + hstep, voffB); PG8_STAGE(PG8_SA(0, 0), cA, voffA); PG8_STAGE(PG8_SA(0, 1), cA + hstep, voffA);
        if (wr == 1) PG8_BAR;
        PG8_WAIT_V(2); PG8_BAR;
        PG8_STAGE(PG8_SB(1, 0), cB + kstep, voffB); PG8_STAGE(PG8_SA(1, 0), cA + kstep, voffA); PG8_STAGE(PG8_SB(1, 1), cB + hstep + kstep, voffB);
        PG8_WAIT_V(6); PG8_BAR;
    } else {
        PG8_STAGE(PG8_SB(0, 0), cB, voffB); PG8_STAGE(PG8_SA(0, 0), cA, voffA); PG8_STAGE(PG8_SB(0, 1), cB + hstep, voffB); PG8_STAGE(PG8_SA(0, 1), cA + hstep, voffA);
        if (wr == 1) PG8_BAR;
        PG8_WAIT_V(4); PG8_BAR;
        PG8_STAGE(PG8_SB(1, 0), cB + kstep, voffB); PG8_STAGE(PG8_SA(1, 0), cA + kstep, voffA); PG8_STAGE(PG8_SB(1, 1), cB + hstep + kstep, voffB);
        PG8_WAIT_V(6); PG8_BAR;
    }
    for (;;) {
        const bool has_next = S.next(ui + 1, nxt);
        const char* nA = has_next ? (const char*)g.A + (size_t)nxt.pm * tstep + (size_t)nxt.kt0 * kstep : cA; const char* nB = has_next ? (const char*)g.Bt + (size_t)nxt.pn * tstep + (size_t)nxt.kt0 * kstep : cB;
        const int nt = cur.nt;
        for (int t = 0; t < nt; t += 2) {
            const bool last = (t == nt - 2);
            if constexpr (Epi::HAS_HOOK) { if (E.hook_at(cur, t)) E.hook(acc, cur, t, wr, wc, fr, fq); }
            const char* a1 = cA + (size_t)(t + 1) * kstep;
            const char* a2 = last ? nA : cA + (size_t)(t + 2) * kstep; const char* b2 = last ? nB : cB + (size_t)(t + 2) * kstep;
            const char* a3 = a2 + kstep; const char* b3 = b2 + kstep;
            if (last && has_next) S.a_ready(nxt);
            if constexpr (SP2) {
            PG8_LDB(B0, 0, 0); PG8_LDB(B1, 0, 1); PG8_SCHED; PG8_LDA(At, 0, 0); PG8_STAGE(PG8_SA(1, 1), a1 + hstep, voffA);
            PG8_WAIT_V(8); PG8_WAIT_L(0); PG8_BAR; PG8_MMA(0, 0, At, B0); PG8_MMA(0, 1, At, B1); PG8_BAR; PG8_SCHED;
            PG8_LDA(At, 0, 1); PG8_STAGE(PG8_SB(0, 0), b2, voffB); PG8_STAGE(PG8_SB(0, 1), b2 + hstep, voffB); PG8_STAGE(PG8_SA(0, 0), a2, voffA);
            PG8_WAIT_V(8); PG8_WAIT_L(0); PG8_BAR; PG8_MMA(1, 0, At, B0); PG8_MMA(1, 1, At, B1); PG8_BAR; PG8_SCHED;
            PG8_LDB(B0, 1, 0); PG8_LDB(B1, 1, 1); PG8_SCHED; PG8_LDA(At, 1, 0); PG8_STAGE(PG8_SA(0, 1), a2 + hstep, voffA);
            PG8_WAIT_V(8); PG8_WAIT_L(0); PG8_BAR; PG8_MMA(0, 0, At, B0); PG8_MMA(0, 1, At, B1); PG8_BAR; PG8_SCHED;
            PG8_LDA(At, 1, 1); PG8_STAGE(PG8_SB(1, 0), b3, voffB); PG8_STAGE(PG8_SB(1, 1), b3 + hstep, voffB); PG8_STAGE(PG8_SA(1, 0), a3, voffA);
            PG8_WAIT_V(8); PG8_WAIT_L(0); PG8_BAR; PG8_MMA(1, 0, At, B0); PG8_MMA(1, 1, At, B1); PG8_BAR; PG8_SCHED;
            } else {
            PG8_LDB(B0, 0, 0); PG8_SCHED; PG8_LDA(At, 0, 0); PG8_STAGE(PG8_SA(1, 1), a1 + hstep, voffA);
            PG8_WAIT_L(8); PG8_BAR; PG8_WAIT_L(0); PG8_MMA(0, 0, At, B0); PG8_BAR; PG8_SCHED;
            PG8_LDB(B1, 0, 1); PG8_STAGE(PG8_SB(0, 0), b2, voffB);
            PG8_BAR; PG8_WAIT_L(0); PG8_MMA(0, 1, At, B1); PG8_BAR;
            PG8_LDA(At, 0, 1); PG8_STAGE(PG8_SA(0, 0), a2, voffA);
            PG8_BAR; PG8_WAIT_L(0); PG8_MMA(1, 0, At, B0); PG8_BAR; PG8_SCHED;
            PG8_STAGE(PG8_SB(0, 1), b2 + hstep, voffB);
            PG8_WAIT_V(6); PG8_BAR; PG8_MMA(1, 1, At, B1); PG8_BAR;
            PG8_LDB(B0, 1, 0); PG8_SCHED; PG8_LDA(At, 1, 0); PG8_STAGE(PG8_SA(0, 1), a2 + hstep, voffA);
            PG8_WAIT_L(8); PG8_BAR; PG8_WAIT_L(0); PG8_MMA(0, 0, At, B0); PG8_BAR; PG8_SCHED;
            PG8_LDB(B1, 1, 1); PG8_STAGE(PG8_SB(1, 0), b3, voffB);
            PG8_BAR; PG8_WAIT_L(0); PG8_MMA(0, 1, At, B1); PG8_BAR;
            PG8_LDA(At, 1, 1); PG8_STAGE(PG8_SA(1, 0), a3, voffA);
            PG8_BAR; PG8_WAIT_L(0); PG8_MMA(1, 0, At, B0); PG8_BAR; PG8_SCHED;
            PG8_STAGE(PG8_SB(1, 1), b3 + hstep, voffB);
            PG8_WAIT_V(6); PG8_BAR; PG8_MMA(1, 1, At, B1); PG8_BAR;
            }
        }
        if constexpr (ALIGN_EPI) { if (wr == 0) PG8_BAR; }
        if constexpr (!Epi::AFTER_DRAIN) { E(acc, cur, wr, wc, fr, fq); S.done(cur); }
        if (!has_next) break;
#pragma unroll
        for (int a = 0; a < 2; ++a)
#pragma unroll
            for (int b = 0; b < 2; ++b)
#pragma unroll
                for (int m = 0; m < 4; ++m)
#pragma unroll
                    for (int n = 0; n < 2; ++n) acc[a][b][m][n] = (f32x4){0.f, 0.f, 0.f, 0.f};
        cur = nxt; cA = nA; cB = nB; ++ui;
        if constexpr (ALIGN_EPI) { if (wr == 1) PG8_BAR; }
    }
    PG8_WAIT_V(0);
    if constexpr (!ALIGN_EPI) { if (wr == 0) PG8_BAR; }
    PG8_BAR;
    if constexpr (Epi::AFTER_DRAIN) { E.fused(acc, cur, wr, wc, fr, fq, lds, wid, lane); S.done(cur); }
#undef PG8_SA
#undef PG8_SB
#undef PG8_STAGE
#undef PG8_LDA
#undef PG8_LDB
#undef PG8_MMA
#undef PG8_WAIT_V
#undef PG8_WAIT_L
#undef PG8_BAR
#undef PG8_SCHED
}
}
constexpr int NWAVES = 8, NT = NWAVES * 64;
constexpr int D = 2048, MP = 8192, MS = 128, MR = MP + MS, MT = 8448;
constexpr int SEQ = 4096;
constexpr int NZ = 15872;
constexpr int NZW = 16128;
constexpr int ZQA = 0, ZKA = 1024, ZVA = 2048, ZGA = 4096, ZUB = 6144, ZVB = 7168, ZQC = 8192, ZKC = 9216, ZVC = 9472, ZGT = 9728, ZLR = 15872;
constexpr int NIN = 15888, FF = 5632, NADA = 12288;
constexpr int MOD_SH1 = 0, MOD_SC1 = 2048, MOD_G1 = 4096, MOD_SH2 = 6144, MOD_SC2 = 8192, MOD_G2 = 10240;
constexpr float EPS = 1e-6f;
constexpr size_t O_YP = 0, O_YS = 16777216, O_SGP = 17039360, O_SGS = 19136512, O_CKP = 153354240, O_CVP = 153485312, O_CKS = 153616384, O_CVS = 153681920, O_GMV = 153747456, O_END = 154009600;
enum { I_XP = 0, I_XS, I_CP, I_CS, I_SGLA, I_CK, I_CV, I_WADA, I_BADA, I_N1W, I_N2W, I_WIN, I_WGK2, I_BGK, I_GLANW, I_GMNW, I_GMNB, I_GMWS, I_GMBS, I_SINK, I_WPA, I_WPB, I_WPC, I_WO, I_WFI, I_WFO, I_FNW, N_IN };

constexpr size_t MiB = 1u << 20;
constexpr size_t WS_CTL = 0, CTL_ZERO_BYTES = 1 * MiB;
constexpr size_t WS_WADA = 2 * MiB;
constexpr size_t WS_CA   = WS_WADA + 2 * 48 * MiB;
constexpr size_t WS_MOD  = WS_CA + 1 * MiB;
constexpr size_t WS_WIN  = WS_MOD + 24 * MiB;
constexpr size_t WS_WPRJ = WS_WIN + 2 * 63 * MiB;
constexpr size_t WS_WO   = WS_WPRJ + 32 * MiB;
constexpr size_t WS_WFI  = WS_WO + 16 * MiB;
constexpr size_t WS_WFO  = WS_WFI + 88 * MiB;
constexpr size_t WS_X    = WS_WFO + 44 * MiB;
constexpr size_t WS_H    = WS_X + 66 * MiB;
constexpr size_t WS_Z    = WS_H + 33 * MiB;
constexpr size_t WS_OABC = WS_Z + 260 * MiB;
constexpr size_t WS_M32  = WS_OABC + 66 * MiB;
constexpr size_t WS_MG   = WS_M32 + 66 * MiB;
constexpr size_t WS_ACT  = WS_MG + 33 * MiB;
constexpr size_t WS_GK   = WS_ACT + 91 * MiB;
constexpr size_t WS_OB   = WS_GK + 33 * MiB;
constexpr size_t WS_VN   = WS_OB + 65 * MiB;
constexpr size_t WS_QT   = WS_VN + 33 * MiB;
constexpr size_t WS_KH   = WS_QT + 16 * MiB;
constexpr size_t WS_AI   = WS_KH + 16 * MiB;
constexpr size_t WS_GAM  = WS_AI + 4 * MiB;
constexpr size_t WS_GST  = WS_GAM + 1 * MiB;
constexpr size_t WS_GAMS = WS_GST + 32 * MiB;
constexpr size_t WS_VNB  = WS_GAMS + 1 * MiB;
constexpr size_t WS_PART = WS_VNB + 16 * MiB;
constexpr size_t WS_END  = WS_PART + 32 * MiB;
static_assert((size_t)MT * NZ * 2 <= 260 * MiB && (size_t)MT * FF * 2 <= 91 * MiB && (size_t)NZW * D * 2 <= 63 * MiB, "ws map");
constexpr int CW_BAR = 4096;

constexpr int RING_BYTES = 131072;
constexpr int MISC_OFF = 150 * 1024;
constexpr int LDS_BYTES = 152 * 1024;

#define GAS __attribute__((address_space(1)))
#define LAS __attribute__((address_space(3)))
typedef unsigned short bf16;
typedef unsigned v4u __attribute__((ext_vector_type(4)));
typedef unsigned v2u __attribute__((ext_vector_type(2)));
typedef float f32x4 __attribute__((ext_vector_type(4)));
#define LDS_WAIT() asm volatile("s_waitcnt lgkmcnt(0)" ::: "memory")
#define VM_WAIT() asm volatile("s_waitcnt vmcnt(0)" ::: "memory")
typedef __bf16 bf16x2_t __attribute__((ext_vector_type(2)));
__device__ __forceinline__ unsigned pk2(float lo, float hi) { bf16x2_t v; v[0] = (__bf16)lo; v[1] = (__bf16)hi; return __builtin_bit_cast(unsigned, v); }
__device__ __forceinline__ unsigned f2bf(float f) { return pk2(f, 0.f) & 0xffffu; }
__device__ __forceinline__ float bf2f(bf16 b) { return __uint_as_float(((unsigned)b) << 16); }
__device__ __forceinline__ float wave_sum(float v) {
#pragma unroll
    for (int o = 1; o < 64; o <<= 1) v += __shfl_xor(v, o);
    return v;
}
__device__ __forceinline__ float sigmoidf_(float x) { return __builtin_amdgcn_rcpf(1.0f + __expf(-x)); }
__device__ __forceinline__ float siluf_(float x) { return x * sigmoidf_(x); }
__device__ __forceinline__ float geluf_(float x) { return x * sigmoidf_(1.5957691216057308f * (x + 0.044715f * x * x * x)); }
__device__ __forceinline__ float logsigmoidf_(float x) { return fminf(x, 0.f) - log1pf(expf(-fabsf(x))); }
#define XB_TMO      128
#define XB_XCNT(j)  (256  + 64 * (j))
#define XB_XSUB(j)  (1280 + 64 * (j))
#define XB_XGEN(j)  (2304 + 64 * (j))
#define XB_TOP      3328
#define XB_TOPGEN   3392
#define XCD_BAR_WORDS 3456
#define XB_SPIN_CAP (1u << 18)

__device__ __forceinline__ unsigned xb_ld(unsigned* p)              { return __hip_atomic_load(p, __ATOMIC_RELAXED, __HIP_MEMORY_SCOPE_AGENT); }
__device__ __forceinline__ unsigned xb_add(unsigned* p, unsigned v) { return __hip_atomic_fetch_add(p, v, __ATOMIC_RELAXED, __HIP_MEMORY_SCOPE_AGENT); }
__device__ __forceinline__ unsigned xb_xcc_id() { return (unsigned)__builtin_amdgcn_s_getreg((3 << 11) | 20) & 0xFu; }
#define XB_SPIN(cond, bar) do { unsigned _sp = 0; while (cond) { __builtin_amdgcn_s_sleep(1); \
    if ((++_sp & 255u) == 0u) { if (xb_ld(&(bar)[XB_TMO])) break; if (_sp > XB_SPIN_CAP) { atomicAdd(&(bar)[XB_TMO], 1u); break; } } } } while (0)

struct XcdBarrier {
    unsigned* bar; unsigned x;
    volatile LAS unsigned* st;
};

__device__ __forceinline__ XcdBarrier xcd_barrier_post(unsigned* bar, volatile LAS unsigned* st) {
    XcdBarrier b; b.bar = bar; b.x = xb_xcc_id(); b.st = st;
    if (threadIdx.x == 0) (void)xb_add(&bar[XB_XCNT(b.x)], 1u);
    return b;
}
__device__ __forceinline__ void xcd_barrier_complete(unsigned* bar, unsigned x, unsigned& nloc, unsigned& nx) {
    const unsigned G = gridDim.x * gridDim.y * gridDim.z;
    unsigned sum, cnt, mine, sp = 0u;
    for (;;) {
        sum = 0u; cnt = 0u; mine = 0u;
#pragma unroll
        for (unsigned j = 0; j < 16; ++j) { const unsigned c = xb_ld(&bar[XB_XCNT(j)]); sum += c; cnt += (c > 0u) ? 1u : 0u; mine = (j == x) ? c : mine; }
        if (sum == G) break;
        __builtin_amdgcn_s_sleep(1);
        if ((++sp & 255u) == 0u) { if (xb_ld(&bar[XB_TMO])) break; if (sp > XB_SPIN_CAP) { atomicAdd(&bar[XB_TMO], 1u); break; } }
    }
    nloc = mine > 0u ? mine : 1u; nx = cnt > 0u ? cnt : 1u;
}

__device__ __forceinline__ void xcd_barrier(const XcdBarrier& b) {
    asm volatile("s_waitcnt vmcnt(0)" ::: "memory");
    __syncthreads();
    if (threadIdx.x == 0) {
        unsigned* bar = b.bar;
        __builtin_amdgcn_s_waitcnt(0);
        unsigned nloc = b.st[0], nx = b.st[1];
        if (nloc == 0u) { xcd_barrier_complete(bar, b.x, nloc, nx); b.st[0] = nloc; b.st[1] = nx; }
        const unsigned old = xb_add(&bar[XB_XSUB(b.x)], 1u);
        const unsigned gen = old / nloc;
        if (old + 1u == (gen + 1u) * nloc) {
            __builtin_amdgcn_fence(__ATOMIC_RELEASE, "agent");
            asm volatile("s_waitcnt vmcnt(0)" ::: "memory");
            const unsigned og = xb_add(&bar[XB_TOP], 1u);
            const unsigned tg = og / nx;
            if (og + 1u == (tg + 1u) * nx) xb_add(&bar[XB_TOPGEN], 1u);
            else XB_SPIN(xb_ld(&bar[XB_TOPGEN]) == tg, bar);
            __builtin_amdgcn_fence(__ATOMIC_ACQUIRE, "agent");
            xb_add(&bar[XB_XGEN(b.x)], 1u);
            asm volatile("s_waitcnt vmcnt(0)" ::: "memory");
        } else {
            XB_SPIN(xb_ld(&bar[XB_XGEN(b.x)]) == gen, bar);
            __builtin_amdgcn_fence(__ATOMIC_ACQUIRE, "agent");
            asm volatile("s_waitcnt vmcnt(0)" ::: "memory");
        }
    }
    __syncthreads();
}
struct Prm { const float* in[N_IN]; float* out; unsigned char* ws; int ph_lo, ph_hi, var, pad; };
static_assert(sizeof(Prm) == N_IN * 8 + 32, "Prm has no padding bytes");
struct Frame {
    LAS unsigned char* lds;
    int vcu, G;
};
struct Tix { int tid, lane, wave; };
__device__ __forceinline__ Tix tix() { int t = threadIdx.x; asm volatile("" : "+v"(t)); Tix r; r.tid = t; r.lane = t & 63; r.wave = __builtin_amdgcn_readfirstlane(t >> 6); return r; }

__device__ __forceinline__ int map_col(int mode, int n) {
    if (mode == 1) return n < 6144 ? n : (n < 6160 ? ZLR + (n - 6144) : n - 16);
    if (mode == 2) return n < FF ? ((n >> 7) * 256 + (n & 127)) : ((((n - FF) >> 7) * 256) + 128 + ((n - FF) & 127));
    return n;
}
__device__ __forceinline__ void conv_item(const float* W, int K, int N, bf16* WT, int ld, int koff, int mode, LAS float* scr, int item, int lane) {
    const int nkb = K / 64, nb = item / nkb, kb = item % nkb, k0 = 64 * kb, n0 = 64 * nb;
    const int q = lane & 15, kr = lane >> 4; const bool okc = (n0 + 4 * q) < N;
    f32x4 v[16];
#pragma unroll
    for (int i = 0; i < 16; ++i) v[i] = okc ? *(const f32x4*)(W + (size_t)(k0 + 4 * i + kr) * N + n0 + 4 * q) : (f32x4){0.f, 0.f, 0.f, 0.f};
#pragma unroll
    for (int i = 0; i < 16; ++i) { LAS float* s = scr + (4 * i + kr) * 65 + 4 * q; s[0] = v[i].x; s[1] = v[i].y; s[2] = v[i].z; s[3] = v[i].w; }
    LDS_WAIT(); asm volatile("" ::: "memory");
    const int c = lane & 7;
#pragma unroll
    for (int j = 0; j < 8; ++j) { const int n = (lane >> 3) + 8 * j; const LAS float* s = scr + (8 * c) * 65 + n;
        v4u o; o.x = pk2(s[0 * 65], s[1 * 65]); o.y = pk2(s[2 * 65], s[3 * 65]); o.z = pk2(s[4 * 65], s[5 * 65]); o.w = pk2(s[6 * 65], s[7 * 65]);
        if (n0 + n < N) *(GAS v4u*)(WT + (size_t)map_col(mode, n0 + n) * ld + koff + k0 + 8 * c) = o; }
    LDS_WAIT(); asm volatile("" ::: "memory");
}
struct ConvDesc { const float* W; bf16* WT; int K, N, ld, koff, mode, items; };

__device__ __forceinline__ void phase_convert(Frame& F) {
    const Tix T = tix();
    const __attribute__((address_space(4))) Prm* Pk = (const __attribute__((address_space(4))) Prm*)__builtin_amdgcn_kernarg_segment_ptr(); asm volatile("" : "+s"(Pk));
    LAS float* scr = (LAS float*)(F.lds + T.wave * 16640);
    const int gw = F.vcu * NWAVES + T.wave, NGW = F.G * NWAVES;
    unsigned char* ws = Pk->ws;
    for (int l = 0; l < 2; ++l) {
        for (int mi = 1; mi < 8; ++mi) {
            ConvDesc d;
            if (mi == 0)      { d.W = Pk->in[I_WADA] + (size_t)l * D * NADA; d.WT = (bf16*)(ws + WS_WADA) + (size_t)l * NADA * D; d.K = D; d.N = NADA; d.ld = D; d.koff = 0; d.mode = 0; }
            else if (mi == 1) { d.W = Pk->in[I_WIN] + (size_t)l * D * NIN;   d.WT = (bf16*)(ws + WS_WIN) + (size_t)l * NZW * D;    d.K = D; d.N = NIN;  d.ld = D; d.koff = 0; d.mode = 1; }
            else if (mi == 2) { d.W = Pk->in[I_WPA] + (size_t)l * 2048 * D;  d.WT = (bf16*)(ws + WS_WPRJ) + (size_t)l * D * 4096; d.K = 2048; d.N = D; d.ld = 4096; d.koff = 0; d.mode = 0; }
            else if (mi == 3) { d.W = Pk->in[I_WPB] + (size_t)l * 1024 * D;  d.WT = (bf16*)(ws + WS_WPRJ) + (size_t)l * D * 4096; d.K = 1024; d.N = D; d.ld = 4096; d.koff = 2048; d.mode = 0; }
            else if (mi == 4) { d.W = Pk->in[I_WPC] + (size_t)l * 1024 * D;  d.WT = (bf16*)(ws + WS_WPRJ) + (size_t)l * D * 4096; d.K = 1024; d.N = D; d.ld = 4096; d.koff = 3072; d.mode = 0; }
            else if (mi == 5) { d.W = Pk->in[I_WO] + (size_t)l * D * D;      d.WT = (bf16*)(ws + WS_WO) + (size_t)l * D * D;      d.K = D; d.N = D; d.ld = D; d.koff = 0; d.mode = 0; }
            else if (mi == 6) { d.W = Pk->in[I_WFI] + (size_t)l * D * 2 * FF; d.WT = (bf16*)(ws + WS_WFI) + (size_t)l * 2 * FF * D; d.K = D; d.N = 2 * FF; d.ld = D; d.koff = 0; d.mode = 2; }
            else              { d.W = Pk->in[I_WFO] + (size_t)l * FF * D;    d.WT = (bf16*)(ws + WS_WFO) + (size_t)l * D * FF;    d.K = FF; d.N = D; d.ld = FF; d.koff = 0; d.mode = 0; }
            d.items = (d.K / 64) * ((d.N + 63) / 64);
            for (int it = gw; it < d.items; it += NGW) conv_item(d.W, d.K, d.N, d.WT, d.ld, d.koff, d.mode, scr, it, T.lane);
        }
    }
    { f32x4* X4 = (f32x4*)(ws + WS_X); const f32x4* xp = (const f32x4*)Pk->in[I_XP]; const f32x4* xs = (const f32x4*)Pk->in[I_XS];
      (void)xp;
      for (int i = MP * D / 4 + blockIdx.x * NT + T.tid; i < MR * D / 4; i += F.G * NT) X4[i] = xs[i - MP * D / 4]; }
}

template <bool FINAL>
__device__ __forceinline__ void phase_norm_t(Frame& F, float* X, const float* nw, const float* mod, int sh_off, int sc_off, bf16* H, float* out, const float* part, int nsl, const float* Xp = nullptr  ) {
    const Tix T = tix();
    const int gw = F.vcu * NWAVES + T.wave, NGW = F.G * NWAVES;
    const int nit = MP;
    f32x4 vn[8];
    const int sr0 = (int)blockIdx.x; f32x4 dx = (f32x4){0.f, 0.f, 0.f, 0.f}, dpp[11];
#pragma unroll
    for (int s = 0; s < 11; ++s) dpp[s] = (f32x4){0.f, 0.f, 0.f, 0.f};
    if (sr0 < MS) { dx = *(const f32x4*)(X + (size_t)(MP + sr0) * D + 4 * T.tid);
#pragma unroll
        for (int s = 0; s < 11; ++s) if (s < nsl) dpp[s] = *(const f32x4*)(part + ((size_t)s * 128 + sr0) * D + 4 * T.tid); }
    const float* Xs = Xp ? Xp : X;
    if (gw < nit) { const int row = gw < MP ? gw : gw + MS; const f32x4* xr = (const f32x4*)((row < MP ? Xs : X) + (size_t)row * D) + T.lane;
#pragma unroll
        for (int j = 0; j < 8; ++j) vn[j] = xr[64 * j]; }
    for (int it = gw; it < nit; it += NGW) {
        const int row = it < MP ? it : it + MS;
        f32x4 v[8]; float s = 0.f;
#pragma unroll
        for (int j = 0; j < 8; ++j) v[j] = vn[j];
        if (it + NGW < nit) { const int it2 = it + NGW, row2 = it2 < MP ? it2 : it2 + MS; const f32x4* xr = (const f32x4*)((row2 < MP ? Xs : X) + (size_t)row2 * D) + T.lane;
#pragma unroll
            for (int j = 0; j < 8; ++j) vn[j] = xr[64 * j]; }
#pragma unroll
        for (int j = 0; j < 8; ++j) s += (v[j].x * v[j].x + v[j].y * v[j].y) + (v[j].z * v[j].z + v[j].w * v[j].w);
        const float rstd = __builtin_amdgcn_rsqf(wave_sum(s) * (1.0f / D) + EPS);
        if (FINAL) { f32x4* o = (f32x4*)(out + (size_t)row * D) + T.lane;
#pragma unroll
            for (int j = 0; j < 8; ++j) { const f32x4 w = *(const f32x4*)(nw + 4 * (T.lane + 64 * j)); o[64 * j] = (v[j] * rstd) * w; } }
        else { const float* md = mod + (size_t)pg8::batch_of_row(row) * NADA; v2u* o = (v2u*)(H + (size_t)row * D) + T.lane;
#pragma unroll
            for (int j = 0; j < 8; ++j) { const int c = 4 * (T.lane + 64 * j);
                const f32x4 w = *(const f32x4*)(nw + c), sc = *(const f32x4*)(md + sc_off + c), sh = *(const f32x4*)(md + sh_off + c);
                const f32x4 y = (v[j] * rstd) * w * (sc + 1.0f) + sh;
                v2u q; q.x = pk2(y.x, y.y); q.y = pk2(y.z, y.w); o[64 * j] = q; } }
    }
    if (!FINAL) for (int i = F.G - 1 - (int)blockIdx.x; i < MT - MR; i += F.G) *(v2u*)(H + (size_t)(MR + i) * D + 4 * T.tid) = (v2u){0u, 0u};
    LAS float* red = (LAS float*)F.lds;
    for (int sr = (int)blockIdx.x; sr < MS; sr += F.G) {
        const int row = MP + sr, c = 4 * T.tid;
        f32x4 x = dx;
        if (sr != sr0) { x = *(const f32x4*)(X + (size_t)row * D + c);
#pragma unroll
          for (int s = 0; s < 11; ++s) dpp[s] = s < nsl ? *(const f32x4*)(part + ((size_t)s * 128 + sr) * D + c) : (f32x4){0.f, 0.f, 0.f, 0.f}; }
#pragma unroll
        for (int s = 0; s < 11; ++s) x += dpp[s];
        if (nsl > 0) *(f32x4*)(X + (size_t)row * D + c) = x;
        const float ss = wave_sum((x.x * x.x + x.y * x.y) + (x.z * x.z + x.w * x.w));
        __syncthreads();
        if (T.lane == 0) red[T.wave] = ss;
        __syncthreads();
        const float tot = ((red[0] + red[1]) + (red[2] + red[3])) + ((red[4] + red[5]) + (red[6] + red[7]));
        const float rstd = __builtin_amdgcn_rsqf(tot * (1.0f / D) + EPS);
        const f32x4 w = *(const f32x4*)(nw + c);
        if (FINAL) *(f32x4*)(out + (size_t)row * D + c) = (x * rstd) * w;
        else { const float* md = mod + (size_t)pg8::batch_of_row(row) * NADA; const f32x4 sc = *(const f32x4*)(md + sc_off + c), sh = *(const f32x4*)(md + sh_off + c);
            const f32x4 y = (x * rstd) * w * (sc + 1.0f) + sh; v2u q; q.x = pk2(y.x, y.y); q.y = pk2(y.z, y.w); *(v2u*)(H + (size_t)row * D + c) = q; }
    }
    __syncthreads();
}

__device__ __forceinline__ void gla_sample_unit(Frame& F, int unit, const bf16* Z, const bf16* H, const bf16* WlraT, const float* wgk2, const float* bgk, const float* Sin  , float* Sout, const float* gnw, bf16* OABC) {
    const Tix T = tix();
    const int b = unit >> 2, h = unit & 3; const size_t row = MP + b;
    LAS float* sq = (LAS float*)F.lds; LAS float* sk = sq + 256; LAS float* se = sk + 256; LAS float* red = se + 256;
    LAS float* lrs = red + 2048;
    __syncthreads();
    { const int rr = T.tid & 15, ksg = T.tid >> 4; float a = 0.f;
      const bf16* hp = H + row * D + 64 * ksg; const bf16* wp = WlraT + (size_t)rr * D + 64 * ksg;
#pragma unroll
      for (int i = 0; i < 8; ++i) { const v4u hv = *(const v4u*)(hp + 8 * i), wv = *(const v4u*)(wp + 8 * i);
          a += (__uint_as_float(hv.x << 16) * __uint_as_float(wv.x << 16) + __uint_as_float(hv.x & 0xffff0000u) * __uint_as_float(wv.x & 0xffff0000u)) + (__uint_as_float(hv.y << 16) * __uint_as_float(wv.y << 16) + __uint_as_float(hv.y & 0xffff0000u) * __uint_as_float(wv.y & 0xffff0000u))
             + (__uint_as_float(hv.z << 16) * __uint_as_float(wv.z << 16) + __uint_as_float(hv.z & 0xffff0000u) * __uint_as_float(wv.z & 0xffff0000u)) + (__uint_as_float(hv.w << 16) * __uint_as_float(wv.w << 16) + __uint_as_float(hv.w & 0xffff0000u) * __uint_as_float(wv.w & 0xffff0000u)); }
      lrs[ksg * 16 + rr] = a; }
    __syncthreads();
    if (T.tid < 16) { float a = 0.f;
#pragma unroll
        for (int s = 0; s < 32; ++s) a += lrs[s * 16 + T.tid];
        lrs[512 + T.tid] = a; }
    __syncthreads();
    if (T.tid < 256) { const int d = T.tid; sq[d] = bf2f(Z[row * NZ + ZQA + h * 256 + d]) * 0.0625f; sk[d] = bf2f(Z[row * NZ + ZKA + h * 256 + d]);
        float x = bgk[h * 256 + d];
#pragma unroll
        for (int rr = 0; rr < 16; ++rr) x += lrs[512 + rr] * wgk2[rr * 1024 + h * 256 + d];
        se[d] = __expf((fminf(x, 0.f) - __logf(1.0f + __expf(-fabsf(x)))) * (1.0f / 16.0f)); }
    __syncthreads();
    const int c4 = T.tid & 127, rg = T.tid >> 7;
    f32x4 v; { const bf16* vp = Z + row * NZ + ZVA + h * 512 + 4 * c4; v.x = bf2f(vp[0]); v.y = bf2f(vp[1]); v.z = bf2f(vp[2]); v.w = bf2f(vp[3]); }
    const size_t base = ((size_t)b * 4 + h) * 256 * 512;
    f32x4 o = (f32x4){0.f, 0.f, 0.f, 0.f};
    for (int it0 = 0; it0 < 64; it0 += 32) {
        f32x4 sv[32];
#pragma unroll
        for (int u = 0; u < 32; ++u) sv[u] = __builtin_nontemporal_load((const f32x4*)(Sin + base + (size_t)(rg + 4 * (it0 + u)) * 512 + 4 * c4));
#pragma unroll
        for (int u = 0; u < 32; ++u) { const int dk = rg + 4 * (it0 + u);
            const f32x4 sn = sv[u] * se[dk] + v * sk[dk];
            __builtin_nontemporal_store(sn, (f32x4*)(Sout + base + (size_t)dk * 512 + 4 * c4));
            o += sn * sq[dk]; } }
    *(LAS f32x4*)(red + rg * 512 + 4 * c4) = o;
    __syncthreads();
    { const int c = T.tid; const float t = (red[c] + red[512 + c]) + (red[1024 + c] + red[1536 + c]);
      const float ss = wave_sum(t * t);
      if (T.lane == 0) lrs[600 + T.wave] = ss;
      __syncthreads();
      const float tot = ((lrs[600] + lrs[601]) + (lrs[602] + lrs[603])) + ((lrs[604] + lrs[605]) + (lrs[606] + lrs[607]));
      const float rstd = __builtin_amdgcn_rsqf(tot * (1.0f / 512.0f) + EPS);
      OABC[row * 4096 + h * 512 + c] = (bf16)f2bf(t * rstd * gnw[c] * siluf_(bf2f(Z[row * NZ + ZGA + h * 512 + c]))); }
}

__device__ __forceinline__ void gm_ln_row(const Tix& T, int row, const v2u (&vw)[4], const bf16* Z, const float* nw, const float* nb, bf16* VNB, float* gmv_out  , const float* ws_, const float* bs, bf16* OABC) {
    float x[16]; float s = 0.f;
#pragma unroll
    for (int j = 0; j < 4; ++j) { const v2u w = vw[j];
        x[4 * j + 0] = geluf_(__uint_as_float(w.x << 16)); x[4 * j + 1] = geluf_(__uint_as_float(w.x & 0xffff0000u)); x[4 * j + 2] = geluf_(__uint_as_float(w.y << 16)); x[4 * j + 3] = geluf_(__uint_as_float(w.y & 0xffff0000u));
        s += (x[4 * j] + x[4 * j + 1]) + (x[4 * j + 2] + x[4 * j + 3]); }
    const float mu = wave_sum(s) * (1.0f / 1024.0f); float q = 0.f;
#pragma unroll
    for (int i = 0; i < 16; ++i) { x[i] -= mu; q += x[i] * x[i]; }
    const float rstd = __builtin_amdgcn_rsqf(wave_sum(q) * (1.0f / 1024.0f) + EPS);
#pragma unroll
    for (int j = 0; j < 4; ++j) { const int c = 4 * (T.lane + 64 * j); const f32x4 w = *(const f32x4*)(nw + c), bb = *(const f32x4*)(nb + c);
        f32x4 y; y.x = x[4 * j] * rstd * w.x + bb.x; y.y = x[4 * j + 1] * rstd * w.y + bb.y; y.z = x[4 * j + 2] * rstd * w.z + bb.z; y.w = x[4 * j + 3] * rstd * w.w + bb.w;
        if (row < MP) { v2u o; o.x = pk2(y.x, y.y); o.y = pk2(y.z, y.w); *(v2u*)(VNB + (size_t)row * 1024 + c) = o; }
        else { *(f32x4*)(gmv_out + (size_t)(row - MP) * 1024 + c) = y;
            const int g = c >> 8; const float w00 = ws_[(size_t)g * 128 * 128], b0 = bs[g * 128];
            const v2u uq = *(const v2u*)(Z + (size_t)row * NZ + ZUB + c);
            v2u o; o.x = pk2(geluf_(__uint_as_float(uq.x << 16)) * (w00 * y.x + b0), geluf_(__uint_as_float(uq.x & 0xffff0000u)) * (w00 * y.y + b0));
            o.y = pk2(geluf_(__uint_as_float(uq.y << 16)) * (w00 * y.z + b0), geluf_(__uint_as_float(uq.y & 0xffff0000u)) * (w00 * y.w + b0));
            *(v2u*)(OABC + (size_t)row * 4096 + 2048 + c) = o; } }
}
__device__ __forceinline__ void gm_ln_rows(Frame& F, int ow, int OW, const bf16* Z, const float* nw, const float* nb, bf16* VNB, float* gmv_out, const float* ws_, const float* bs, bf16* OABC) {
    const Tix T = tix();
    const int w0 = ow * NWAVES + T.wave, stride = OW * NWAVES;
    v2u nx[4];
    if (w0 < MR) {
#pragma unroll
        for (int j = 0; j < 4; ++j) nx[j] = *(const v2u*)(Z + (size_t)w0 * NZ + ZVB + 4 * (T.lane + 64 * j)); }
    for (int row = w0; row < MR; row += stride) {
        v2u cur[4];
#pragma unroll
        for (int j = 0; j < 4; ++j) cur[j] = nx[j];
        if (row + stride < MR) {
#pragma unroll
            for (int j = 0; j < 4; ++j) nx[j] = *(const v2u*)(Z + (size_t)(row + stride) * NZ + ZVB + 4 * (T.lane + 64 * j)); }
        gm_ln_row(T, row, cur, Z, nw, nb, VNB, gmv_out, ws_, bs, OABC);
    }
}

__device__ __forceinline__ void cache_outs(Frame& F, int wg, int nwg, int l, const bf16* Z, float* out) {
    const Tix T = tix();
    for (int idx = wg * NT + T.tid; idx < 2 * 128 * 512; idx += nwg * NT) {
        const int c = idx & 511, r = (idx >> 9) & 127, b = idx >> 16; const size_t row = (size_t)b * SEQ + (SEQ - 128) + r;
        const float v = bf2f(Z[row * NZ + ZKC + c]);
        if (c < 256) out[O_CKP + ((size_t)(l * 2 + b) * 128 + r) * 256 + c] = v; else out[O_CVP + ((size_t)(l * 2 + b) * 128 + r) * 256 + (c - 256)] = v;
    }
    for (int idx = wg * NT + T.tid; idx < 128 * 512; idx += nwg * NT) {
        const int c = idx & 511, b = idx >> 9; const float v = bf2f(Z[(size_t)(MP + b) * NZ + ZKC + c]);
        if (c < 256) out[O_CKS + (size_t)(l * 128 + b) * 256 + c] = v; else out[O_CVS + (size_t)(l * 128 + b) * 256 + (c - 256)] = v;
    }
}

__device__ __forceinline__ void gla_fin(Frame& F, const float* OBf, const bf16* Z, const float* gnw, bf16* OABC) {
    const Tix T = tix();
    const bf16* OB = (const bf16*)OBf;
    const int gw = F.vcu * NWAVES + T.wave, NGW = F.G * NWAVES;
    v2u on[8], gn[8];
#define FIN_LOAD(rw) do { const bf16* op_ = OB + (size_t)(rw) * 2048 + 4 * T.lane; const bf16* gp_ = Z + (size_t)(rw) * NZ + ZGA + 4 * T.lane; \
        _Pragma("unroll") for (int j = 0; j < 8; ++j) { on[j] = *(const v2u*)(op_ + 256 * j); gn[j] = *(const v2u*)(gp_ + 256 * j); } } while (0)
    if (gw < MP) FIN_LOAD(gw);
    for (int row = gw; row < MP; row += NGW) {
        f32x4 o[8]; v2u gq[8];
#pragma unroll
        for (int j = 0; j < 8; ++j) { o[j] = (f32x4){__uint_as_float(on[j].x << 16), __uint_as_float(on[j].x & 0xffff0000u), __uint_as_float(on[j].y << 16), __uint_as_float(on[j].y & 0xffff0000u)}; gq[j] = gn[j]; }
        if (row + NGW < MP) FIN_LOAD(row + NGW);
#pragma unroll
        for (int h = 0; h < 4; ++h) { const f32x4 a = o[2 * h], b = o[2 * h + 1];
            const float s = (a.x * a.x + a.y * a.y) + (a.z * a.z + a.w * a.w) + (b.x * b.x + b.y * b.y) + (b.z * b.z + b.w * b.w);
            const float rstd = __builtin_amdgcn_rsqf(wave_sum(s) * (1.0f / 512.0f) + EPS);
#pragma unroll
            for (int jj = 0; jj < 2; ++jj) { const int j = 2 * h + jj, c = 4 * T.lane + 256 * jj; const f32x4 ov = o[j]; const f32x4 w = *(const f32x4*)(gnw + c);
                const float g0 = siluf_(__uint_as_float(gq[j].x << 16)), g1 = siluf_(__uint_as_float(gq[j].x & 0xffff0000u)), g2 = siluf_(__uint_as_float(gq[j].y << 16)), g3 = siluf_(__uint_as_float(gq[j].y & 0xffff0000u));
                v2u r; r.x = pk2(ov.x * rstd * w.x * g0, ov.y * rstd * w.y * g1); r.y = pk2(ov.z * rstd * w.z * g2, ov.w * rstd * w.w * g3);
                *(v2u*)(OABC + (size_t)row * 4096 + h * 512 + c) = r; } }
    }
#undef FIN_LOAD
}
typedef short bf16x8 __attribute__((ext_vector_type(8)));
typedef unsigned short u16x4 __attribute__((ext_vector_type(4)));
__device__ __forceinline__ unsigned offb(unsigned row, unsigned ch) { return 256u * row + 16u * (ch ^ (((row & 3u) << 2) | ((row >> 2) & 3u))); }
__device__ __forceinline__ unsigned tr_addr16(unsigned lane, unsigned c, unsigned ks, unsigned t) {
    const unsigned g = lane >> 4, q = (lane & 15u) >> 2, p = lane & 3u; return offb(32u * ks + 8u * g + 4u * t + q, 2u * c + (p >> 1)) + 8u * (p & 1u); }
struct TrLane { unsigned L0, L1, X0, X1; };
__device__ __forceinline__ TrLane tr_lane(unsigned lane) {
    const unsigned g = lane >> 4, q = (lane & 15u) >> 2, p = lane & 3u; TrLane t;
    const unsigned m0 = (q << 2) | ((2u * g) & 3u), m1 = (q << 2) | ((2u * g + 1u) & 3u);
    t.L0 = 2048u * g + 256u * q + 8u * (p & 1u) + 16u * ((p >> 1) ^ (m0 & 1u)); t.L1 = 2048u * g + 1024u + 256u * q + 8u * (p & 1u) + 16u * ((p >> 1) ^ (m1 & 1u));
    t.X0 = (m0 >> 1) << 5; t.X1 = (m1 >> 1) << 5; return t;
}
__device__ __forceinline__ void tr_frag2(unsigned base, const TrLane& tl, unsigned c, bf16x8& f0, bf16x8& f1) {
    const unsigned a0 = base + tl.L0 + ((c << 5) ^ tl.X0), a1 = base + tl.L1 + ((c << 5) ^ tl.X1);
    u16x4 r0, r1, r2, r3;
    asm volatile("ds_read_b64_tr_b16 %0, %4\n\tds_read_b64_tr_b16 %1, %5\n\tds_read_b64_tr_b16 %2, %4 offset:8192\n\tds_read_b64_tr_b16 %3, %5 offset:8192\n\ts_waitcnt lgkmcnt(0)"
                 : "=&v"(r0), "=&v"(r1), "=&v"(r2), "=&v"(r3) : "v"(a0), "v"(a1) : "memory");
    f0 = (bf16x8){(short)r0[0], (short)r0[1], (short)r0[2], (short)r0[3], (short)r1[0], (short)r1[1], (short)r1[2], (short)r1[3]};
    f1 = (bf16x8){(short)r2[0], (short)r2[1], (short)r2[2], (short)r2[3], (short)r3[0], (short)r3[1], (short)r3[2], (short)r3[3]};
}
__device__ __forceinline__ void tr_frag4(unsigned base, const TrLane& tl, unsigned c, bf16x8& f0, bf16x8& f1, bf16x8& f2, bf16x8& f3) {
    const unsigned a0 = base + tl.L0 + ((c << 5) ^ tl.X0), a1 = base + tl.L1 + ((c << 5) ^ tl.X1), a2 = base + tl.L0 + (((c + 1u) << 5) ^ tl.X0), a3 = base + tl.L1 + (((c + 1u) << 5) ^ tl.X1);
    u16x4 r0, r1, r2, r3, r4, r5, r6, r7;
    asm volatile("ds_read_b64_tr_b16 %0, %8\n\tds_read_b64_tr_b16 %1, %9\n\tds_read_b64_tr_b16 %2, %8 offset:8192\n\tds_read_b64_tr_b16 %3, %9 offset:8192\n\t"
                 "ds_read_b64_tr_b16 %4, %10\n\tds_read_b64_tr_b16 %5, %11\n\tds_read_b64_tr_b16 %6, %10 offset:8192\n\tds_read_b64_tr_b16 %7, %11 offset:8192\n\ts_waitcnt lgkmcnt(0)"
                 : "=&v"(r0), "=&v"(r1), "=&v"(r2), "=&v"(r3), "=&v"(r4), "=&v"(r5), "=&v"(r6), "=&v"(r7) : "v"(a0), "v"(a1), "v"(a2), "v"(a3) : "memory");
    f0 = (bf16x8){(short)r0[0], (short)r0[1], (short)r0[2], (short)r0[3], (short)r1[0], (short)r1[1], (short)r1[2], (short)r1[3]};
    f1 = (bf16x8){(short)r2[0], (short)r2[1], (short)r2[2], (short)r2[3], (short)r3[0], (short)r3[1], (short)r3[2], (short)r3[3]};
    f2 = (bf16x8){(short)r4[0], (short)r4[1], (short)r4[2], (short)r4[3], (short)r5[0], (short)r5[1], (short)r5[2], (short)r5[3]};
    f3 = (bf16x8){(short)r6[0], (short)r6[1], (short)r6[2], (short)r6[3], (short)r7[0], (short)r7[1], (short)r7[2], (short)r7[3]};
}
__device__ __forceinline__ unsigned cvtpk(float lo, float hi) { return pk2(lo, hi); }
__device__ __forceinline__ unsigned cvtpk_pin(float lo, float hi) { unsigned r; asm volatile("v_cvt_pk_bf16_f32 %0, %1, %2\n\ts_nop 1" : "=v"(r) : "v"(lo), "v"(hi)); return r; }

constexpr int GLA_PREP_STRIDE = 264;

__device__ __forceinline__ void gla_prep_unit(Frame& F, int unit, const bf16* Z, const bf16* H, const bf16* WlraT, const float* wgk2, const float* bgk, bf16* QT, bf16* KH, bf16* AI, float* GAM, const bool keep_lra) {
    const Tix T = tix();
    const int b = unit >> 8, h = (unit >> 6) & 3, c = unit & 63;
    const int d4 = 4 * T.lane, seg = T.wave;
    const int r = T.lane & 15, g = T.lane >> 4;
    LAS bf16* QA = (LAS bf16*)F.lds; LAS bf16* KA = QA + 64 * GLA_PREP_STRIDE; LAS float* tots = (LAS float*)(KA + 64 * GLA_PREP_STRIDE);
    LAS float* lrp = tots + 2048;
    const size_t rowc = (size_t)b * SEQ + c * 64;
    __syncthreads();
    if (!keep_lra) {
      const int tl = T.wave & 3, kh = T.wave >> 2; f32x4 acc = (f32x4){0.f, 0.f, 0.f, 0.f};
      const bf16* hp = H + (rowc + 16 * tl + r) * D + kh * 1024 + 8 * g; const bf16* wp = WlraT + (size_t)r * D + kh * 1024 + 8 * g;
#pragma unroll 16
      for (int s = 0; s < 32; ++s) acc = __builtin_amdgcn_mfma_f32_16x16x32_bf16(*(const bf16x8*)(hp + 32 * s), *(const bf16x8*)(wp + 32 * s), acc, 0, 0, 0);
#pragma unroll
      for (int e = 0; e < 4; ++e) lrp[(kh * 64 + 16 * tl + 4 * g + e) * 16 + r] = acc[e]; }
    const size_t row0 = rowc + seg * 8;
    v2u qv[8], kv[8];
#pragma unroll
    for (int t = 0; t < 8; ++t) { qv[t] = *(const v2u*)(Z + (row0 + t) * NZ + ZQA + h * 256 + d4); kv[t] = *(const v2u*)(Z + (row0 + t) * NZ + ZKA + h * 256 + d4); }
    __syncthreads();
    f32x4 cum[8]; f32x4 run = (f32x4){0.f, 0.f, 0.f, 0.f};
    { f32x4 w[16];
#pragma unroll
      for (int rr = 0; rr < 16; ++rr) w[rr] = *(const f32x4*)(wgk2 + rr * 1024 + h * 256 + d4);
      const f32x4 bb = *(const f32x4*)(bgk + h * 256 + d4);
#pragma unroll
      for (int t = 0; t < 8; ++t) { const int tk = seg * 8 + t; f32x4 x = bb;
#pragma unroll
          for (int r4 = 0; r4 < 4; ++r4) { const f32x4 l0 = *(const LAS f32x4*)(lrp + tk * 16 + 4 * r4), l1 = *(const LAS f32x4*)(lrp + (64 + tk) * 16 + 4 * r4);
              x += (l0.x + l1.x) * w[4 * r4] + (l0.y + l1.y) * w[4 * r4 + 1] + (l0.z + l1.z) * w[4 * r4 + 2] + (l0.w + l1.w) * w[4 * r4 + 3]; }
#pragma unroll
          for (int j = 0; j < 4; ++j) run[j] += (fminf(x[j], 0.f) - __logf(1.0f + __expf(-fabsf(x[j])))) * (1.0f / 16.0f);
          cum[t] = run; } }
    *(LAS f32x4*)(tots + seg * 256 + d4) = run;
    __syncthreads();
    f32x4 add = (f32x4){0.f, 0.f, 0.f, 0.f}, bmid = add, bl = add;
#pragma unroll
    for (int s = 0; s < 8; ++s) { const f32x4 ts = *(const LAS f32x4*)(tots + s * 256 + d4); if (s < seg) add += ts; if (s < 4) bmid += ts; bl += ts; }
#pragma unroll
    for (int t = 0; t < 8; ++t) { const f32x4 bt = cum[t] + add; const size_t row = row0 + t; const int tk = seg * 8 + t;
        f32x4 q, k; q[0] = __uint_as_float(qv[t].x << 16); q[1] = __uint_as_float(qv[t].x & 0xffff0000u); q[2] = __uint_as_float(qv[t].y << 16); q[3] = __uint_as_float(qv[t].y & 0xffff0000u);
        k[0] = __uint_as_float(kv[t].x << 16); k[1] = __uint_as_float(kv[t].x & 0xffff0000u); k[2] = __uint_as_float(kv[t].y << 16); k[3] = __uint_as_float(kv[t].y & 0xffff0000u);
        q = q * 0.0625f;
        f32x4 o0, o1, o2, o3;
#pragma unroll
        for (int j = 0; j < 4; ++j) { o0[j] = q[j] * __expf(bt[j]); o1[j] = k[j] * __expf(bl[j] - bt[j]); o2[j] = q[j] * __expf(bt[j] - bmid[j]); o3[j] = k[j] * __expf(bmid[j] - bt[j]); }
        v2u w0, w1, w2, w3; w0.x = pk2(o0[0], o0[1]); w0.y = pk2(o0[2], o0[3]); w1.x = pk2(o1[0], o1[1]); w1.y = pk2(o1[2], o1[3]); w2.x = pk2(o2[0], o2[1]); w2.y = pk2(o2[2], o2[3]); w3.x = pk2(o3[0], o3[1]); w3.y = pk2(o3[2], o3[3]);
        *(v2u*)(QT + row * 1024 + h * 256 + d4) = w0; *(v2u*)(KH + row * 1024 + h * 256 + d4) = w1;
        *(LAS v2u*)(QA + tk * GLA_PREP_STRIDE + d4) = w2; *(LAS v2u*)(KA + tk * GLA_PREP_STRIDE + d4) = w3; }
    if (seg == 0) { f32x4 eg; eg[0] = __expf(bl[0]); eg[1] = __expf(bl[1]); eg[2] = __expf(bl[2]); eg[3] = __expf(bl[3]); *(f32x4*)(GAM + (size_t)unit * 256 + d4) = eg; }
    __syncthreads();
#pragma unroll
    for (int x = 0; x < 2; ++x) { const int tt = 2 * T.wave + x, j = tt >> 2, sb = tt & 3;
        f32x4 acc = (f32x4){0.f, 0.f, 0.f, 0.f};
        if (sb <= j) {
#pragma unroll
            for (int ks = 0; ks < 8; ++ks) { const bf16x8 a = *(const LAS bf16x8*)(QA + (16 * j + r) * GLA_PREP_STRIDE + 32 * ks + 8 * g), bb = *(const LAS bf16x8*)(KA + (16 * sb + r) * GLA_PREP_STRIDE + 32 * ks + 8 * g);
                acc = __builtin_amdgcn_mfma_f32_16x16x32_bf16(a, bb, acc, 0, 0, 0); } }
        bf16* ap = AI + (size_t)unit * 4096;
#pragma unroll
        for (int e = 0; e < 4; ++e) { const int t = 16 * j + 4 * g + e, s = 16 * sb + r; ap[t * 64 + s] = (bf16)f2bf(s <= t ? acc[e] : 0.f); } }
}

constexpr int GL_KH = 0, GL_QT = 32768, GL_V = 65536, GL_A = 81920, GL_GAM = 90112, GL_END = 91136;
template <bool OUT>
__device__ __forceinline__ void gla_pass(Frame& F, int worker, const bf16* Z, const bf16* QT, const bf16* KH, const bf16* AI, const float* GAM, float* GST, float* GAMS, float* OB, float* state_out) {
    const Tix T = tix();
    const int lane = T.lane, wave = T.wave, r = lane & 15, g = lane >> 4;
    const int grp = worker >> 2, qs = worker & 3, b = grp >> 5, h = (grp >> 3) & 3, sc = grp & 7;
    const unsigned lbase = (unsigned)(size_t)F.lds; const TrLane tl = tr_lane((unsigned)lane);
    f32x4 S[16];
#pragma unroll
    for (int i = 0; i < 16; ++i) S[i] = (f32x4){0.f, 0.f, 0.f, 0.f};
    if (OUT) {
        const f32x4* gp = (const f32x4*)(GST + ((((size_t)grp * 4 + qs) * 8 + wave) * 16) * 256) + lane;
#pragma unroll
        for (int i = 0; i < 16; ++i) S[i] = gp[64 * i];
    }
    const int srow = T.tid >> 4, sch = T.tid & 15;
    v4u pk[2][2], pq[2][2], pv[2], pa; f32x4 pg;
    const size_t seq0 = (size_t)b * SEQ + sc * 512;
    const unsigned tko = (unsigned)(srow * 1024 + 8 * sch) * 2u, tvo = (unsigned)(srow * NZ + 8 * sch) * 2u;
#define GLA_LOAD(cc) do { const size_t rw = seq0 + (cc) * 64; const size_t un = (size_t)((b * 4 + h) * 64 + sc * 8 + (cc)); \
        const char* kb = (const char*)(KH + rw * 1024 + h * 256); const char* qb = (const char*)(QT + rw * 1024 + h * 256); const char* vb = (const char*)(Z + rw * NZ + ZVA + h * 512 + qs * 128); \
        _Pragma("unroll") for (int hh = 0; hh < 2; ++hh) _Pragma("unroll") for (int u = 0; u < 2; ++u) { \
            pk[hh][u] = *(const v4u*)(kb + (hh * 256 + u * 65536) + tko); \
            if (OUT) pq[hh][u] = *(const v4u*)(qb + (hh * 256 + u * 65536) + tko); } \
        _Pragma("unroll") for (int u = 0; u < 2; ++u) pv[u] = *(const v4u*)(vb + (size_t)u * (32 * NZ * 2) + tvo); \
        if (OUT) pa = *(const v4u*)((const char*)(AI + un * 4096) + (unsigned)T.tid * 16u); \
        if (T.tid < 64) pg = *(const f32x4*)((const char*)(GAM + un * 256) + (unsigned)T.tid * 16u); } while (0)
    GLA_LOAD(0);
    for (int c = 0; c < 8; ++c) {
        __syncthreads();
#pragma unroll
        for (int hh = 0; hh < 2; ++hh)
#pragma unroll
            for (int u = 0; u < 2; ++u) { *(LAS v4u*)(F.lds + GL_KH + hh * 16384 + offb(srow + 32 * u, sch)) = pk[hh][u]; if (OUT) *(LAS v4u*)(F.lds + GL_QT + hh * 16384 + offb(srow + 32 * u, sch)) = pq[hh][u]; }
#pragma unroll
        for (int u = 0; u < 2; ++u) *(LAS v4u*)(F.lds + GL_V + offb(srow + 32 * u, sch)) = pv[u];
        if (OUT) { const int ar = T.tid >> 3, ach = T.tid & 7; *(LAS v4u*)(F.lds + GL_A + 128 * ar + 16 * (ach ^ (ar & 7))) = pa; }
        if (T.tid < 64) *(LAS f32x4*)(F.lds + GL_GAM + 16 * T.tid) = pg;
        __syncthreads();
        if (c + 1 < 8) GLA_LOAD(c + 1);
        bf16x8 V0, V1; tr_frag2(lbase + GL_V, tl, (unsigned)wave, V0, V1);
        if (OUT) {
            const size_t orow0 = seq0 + c * 64;
            const unsigned mr = ((unsigned)(r & 3) << 2) | ((unsigned)(r >> 2) & 3u);
            const unsigned ql0 = 256u * r + 8u * (g & 1) + 16u * (((unsigned)(g >> 1)) ^ (mr & 3u)), ql1 = 256u * r + 8u * (g & 1) + 16u * ((((unsigned)(g >> 1)) | 2u) ^ (mr & 3u)), qx = (mr >> 2) << 6;
            const unsigned al0 = 128u * r + 16u * (((unsigned)g) ^ (unsigned)(r & 7)), al1 = 128u * r + 16u * ((4u + (unsigned)g) ^ (unsigned)(r & 7));
#pragma unroll 1
            for (int j = 0; j < 4; ++j) {
                f32x4 acc = (f32x4){0.f, 0.f, 0.f, 0.f};
                { const bf16x8 a0 = *(const LAS bf16x8*)(F.lds + GL_A + 2048 * j + al0), a1 = *(const LAS bf16x8*)(F.lds + GL_A + 2048 * j + al1);
                  acc = __builtin_amdgcn_mfma_f32_16x16x32_bf16(V0, a0, acc, 0, 0, 0); acc = __builtin_amdgcn_mfma_f32_16x16x32_bf16(V1, a1, acc, 0, 0, 0); }
#pragma unroll
                for (int s = 0; s < 8; ++s) {
                    const unsigned qo = GL_QT + (unsigned)(s >> 2) * 16384u + 4096u * j + ((64u * (s & 3)) ^ qx);
                    const v2u lo = *(const LAS v2u*)(F.lds + qo + ql0), hi = *(const LAS v2u*)(F.lds + qo + ql1);
                    const v4u w = (v4u){lo.x, lo.y, hi.x, hi.y};
                    const v4u sw = (v4u){cvtpk_pin(S[2 * s][0], S[2 * s][1]), cvtpk_pin(S[2 * s][2], S[2 * s][3]), cvtpk_pin(S[2 * s + 1][0], S[2 * s + 1][1]), cvtpk_pin(S[2 * s + 1][2], S[2 * s + 1][3])};
                    acc = __builtin_amdgcn_mfma_f32_16x16x32_bf16(__builtin_bit_cast(bf16x8, sw), __builtin_bit_cast(bf16x8, w), acc, 0, 0, 0); }
                { v2u ow; ow.x = pk2(acc[0], acc[1]); ow.y = pk2(acc[2], acc[3]);     *(v2u*)((bf16*)OB + (orow0 + 16 * j + r) * 2048 + h * 512 + qs * 128 + 16 * wave + 4 * g) = ow; }
            }
        }
#pragma unroll
        for (int i = 0; i < 16; i += 2) {
            const f32x4 gm0 = *(const LAS f32x4*)(F.lds + GL_GAM + 4 * (16 * i + 4 * g)), gm1 = *(const LAS f32x4*)(F.lds + GL_GAM + 4 * (16 * (i + 1) + 4 * g));
            bf16x8 k0, k1, k2, k3; tr_frag4(lbase + GL_KH + (i >> 3) * 16384, tl, (unsigned)(i & 7), k0, k1, k2, k3);
            f32x4 s0 = S[i] * gm0, s1 = S[i + 1] * gm1;
            s0 = __builtin_amdgcn_mfma_f32_16x16x32_bf16(k0, V0, s0, 0, 0, 0); s1 = __builtin_amdgcn_mfma_f32_16x16x32_bf16(k2, V0, s1, 0, 0, 0);
            S[i] = __builtin_amdgcn_mfma_f32_16x16x32_bf16(k1, V1, s0, 0, 0, 0); S[i + 1] = __builtin_amdgcn_mfma_f32_16x16x32_bf16(k3, V1, s1, 0, 0, 0);
        }
    }
#undef GLA_LOAD
    if (!OUT) {
        f32x4* gp = (f32x4*)(GST + ((((size_t)grp * 4 + qs) * 8 + wave) * 16) * 256) + lane;
#pragma unroll
        for (int i = 0; i < 16; ++i) gp[64 * i] = S[i];
        if (qs == 0 && wave == 0) {
            f32x4 gt = (f32x4){1.f, 1.f, 1.f, 1.f};
            for (int c = 0; c < 8; ++c) gt = gt * *(const f32x4*)(GAM + ((size_t)((b * 4 + h) * 64 + sc * 8 + c)) * 256 + 4 * lane);
            *(f32x4*)(GAMS + (size_t)grp * 256 + 4 * lane) = gt; }
    } else if (sc == 7) {
#pragma unroll
        for (int i = 0; i < 16; ++i)
#pragma unroll
            for (int e = 0; e < 4; ++e) state_out[(((size_t)b * 4 + h) * 256 + 16 * i + 4 * g + e) * 512 + qs * 128 + 16 * wave + r] = S[i][e];
    }
    __syncthreads();
}

constexpr int GM_W = 0, GM_V = 32768, GM_END = 98304;
__device__ __forceinline__ void gm_mix_unit(Frame& F, int unit, const bf16* Z, const bf16* VNB, const float* ws_, const float* bs, bf16* OABC) {
    const Tix T = tix();
    const int lane = T.lane, wave = T.wave, r = lane & 15, g4 = lane >> 4;
    const int n = unit >> 2, grp = unit & 3; const size_t row0 = (size_t)n * 128;
    __syncthreads();
#pragma unroll
    for (int i = 0; i < 4; ++i) { const int ci = T.tid + 512 * i, row = ci >> 4, ch = ci & 15; const float* wp = ws_ + ((size_t)grp * 128 + row) * 128 + 8 * ch;
        const f32x4 a = *(const f32x4*)wp, b = *(const f32x4*)(wp + 4); const int s0 = 8 * ch;
        v4u o; o.x = pk2(s0 + 0 <= row ? a.x : 0.f, s0 + 1 <= row ? a.y : 0.f); o.y = pk2(s0 + 2 <= row ? a.z : 0.f, s0 + 3 <= row ? a.w : 0.f);
        o.z = pk2(s0 + 4 <= row ? b.x : 0.f, s0 + 5 <= row ? b.y : 0.f); o.w = pk2(s0 + 6 <= row ? b.z : 0.f, s0 + 7 <= row ? b.w : 0.f);
        *(LAS v4u*)(F.lds + GM_W + offb((unsigned)row, (unsigned)ch)) = o; }
#pragma unroll
    for (int i = 0; i < 8; ++i) { const int ci = T.tid + 512 * i, row = ci >> 5, c32 = ci & 31;
        const v4u v = *(const v4u*)(VNB + (row0 + row) * 1024 + grp * 256 + 8 * c32);
        *(LAS v4u*)(F.lds + GM_V + (c32 >> 4) * 32768 + offb((unsigned)row, (unsigned)(c32 & 15))) = v; }
    __syncthreads();
    const unsigned lbase = (unsigned)(size_t)F.lds; const TrLane tl = tr_lane((unsigned)lane);
    bf16x8 Bf[2][4];
#pragma unroll
    for (int x = 0; x < 2; ++x) { const unsigned ct = 2u * wave + x;
        const unsigned vb = lbase + GM_V + (ct >> 3) * 32768u;
        tr_frag2(vb, tl, ct & 7u, Bf[x][0], Bf[x][1]); tr_frag2(vb + 16384u, tl, ct & 7u, Bf[x][2], Bf[x][3]); }
    const unsigned mr = ((unsigned)(r & 3) << 2) | ((unsigned)(r >> 2) & 3u);
#pragma unroll
    for (int j = 0; j < 8; ++j) {
        f32x4 acc0 = (f32x4){0.f, 0.f, 0.f, 0.f}, acc1 = acc0;
#pragma unroll
        for (int ks = 0; ks <= (j >> 1); ++ks) {
            const bf16x8 a = *(const LAS bf16x8*)(F.lds + GM_W + 256u * (16 * j + r) + 16u * (((unsigned)(4 * ks + g4)) ^ mr));
            acc0 = __builtin_amdgcn_mfma_f32_16x16x32_bf16(Bf[0][ks], a, acc0, 0, 0, 0); acc1 = __builtin_amdgcn_mfma_f32_16x16x32_bf16(Bf[1][ks], a, acc1, 0, 0, 0); }
        const int t = 16 * j + r; const size_t row = row0 + t; const float bb = bs[grp * 128 + t];
#pragma unroll
        for (int x = 0; x < 2; ++x) { const int c = grp * 256 + 32 * wave + 16 * x + 4 * g4; const f32x4 av = x ? acc1 : acc0;
            const v2u uq = *(const v2u*)(Z + row * NZ + ZUB + c);
            v2u o; o.x = pk2(geluf_(__uint_as_float(uq.x << 16)) * (av[0] + bb), geluf_(__uint_as_float(uq.x & 0xffff0000u)) * (av[1] + bb));
            o.y = pk2(geluf_(__uint_as_float(uq.y << 16)) * (av[2] + bb), geluf_(__uint_as_float(uq.y & 0xffff0000u)) * (av[3] + bb));
            *(v2u*)(OABC + row * 4096 + 2048 + c) = o; }
    }
}

constexpr int SW_K = 0, SW_V = 32768, SW_END = 65536;
__device__ __forceinline__ void swa_unit(Frame& F, int unit, const bf16* Z, const float* sinks, bf16* OABC) {
    const Tix T = tix();
    const int lane = T.lane, wave = T.wave, r = lane & 15, g = lane >> 4;
    const int kv = unit & 3, n = (unit >> 2) & 31, b = unit >> 7;
    const size_t rowq0 = (size_t)b * SEQ + n * 128;
    __syncthreads();
#pragma unroll
    for (int i = 0; i < 4; ++i) { const int ci = T.tid + 512 * i, key = ci >> 3, ch = ci & 7;
        v4u kk = (v4u){0u, 0u, 0u, 0u}, vv = kk;
        if (n > 0 || key >= 128) { const bf16* zp = Z + (rowq0 - 128 + key) * NZ + kv * 64 + 8 * ch; kk = *(const v4u*)(zp + ZKC); vv = *(const v4u*)(zp + ZVC); }
        const unsigned o = 128u * key + 16u * ((unsigned)ch ^ (unsigned)(key & 7));
        *(LAS v4u*)(F.lds + SW_K + o) = kk; *(LAS v4u*)(F.lds + SW_V + o) = vv; }
    __syncthreads();
    const int head = kv * 4 + (wave >> 1), qh = wave & 1;
    const float slope = exp2f(-0.5f * (float)(head + 1)), sink = sinks[head];
    const unsigned lbase = (unsigned)(size_t)F.lds;
    bf16x8 qfa[4][2];
#pragma unroll
    for (int qt = 0; qt < 4; ++qt)
#pragma unroll
        for (int ks = 0; ks < 2; ++ks) qfa[qt][ks] = *(const bf16x8*)(Z + (rowq0 + 64 * qh + 16 * qt + r) * NZ + ZQC + head * 64 + 32 * ks + 8 * g);
#pragma unroll
    for (int qt = 0; qt < 4; ++qt) {
        const int i0 = 64 * qh + 16 * qt, a = i0 >> 4;
        const size_t qrow = rowq0 + i0 + r;
        bf16x8 qf[2]; qf[0] = qfa[qt][0]; qf[1] = qfa[qt][1];
        f32x4 st[10];
#pragma unroll
        for (int t = 0; t < 9; ++t) { const int krow = 16 * (a + t) + r; f32x4 acc = (f32x4){0.f, 0.f, 0.f, 0.f};
#pragma unroll
            for (int ks = 0; ks < 2; ++ks) { const bf16x8 kf = *(const LAS bf16x8*)(F.lds + SW_K + 128u * krow + 16u * (((unsigned)(4 * ks + g)) ^ (unsigned)(krow & 7)));
                acc = __builtin_amdgcn_mfma_f32_16x16x32_bf16(kf, qf[ks], acc, 0, 0, 0); }
            st[t] = acc; }
        st[9] = (f32x4){0.f, 0.f, 0.f, 0.f};
        const int iq = i0 + r; float mx = sink;
#pragma unroll
        for (int t = 0; t < 9; ++t)
#pragma unroll
            for (int e = 0; e < 4; ++e) { const int j = 16 * (a + t) + 4 * g + e, dist = 128 + iq - j; const bool ok = dist >= 0 && dist < 128 && (n > 0 || j >= 128);
                const float s = ok ? st[t][e] * 0.125f - slope * (float)dist : -1e30f; st[t][e] = s; mx = fmaxf(mx, s); }
        mx = fmaxf(mx, __shfl_xor(mx, 16)); mx = fmaxf(mx, __shfl_xor(mx, 32));
        float sum = 0.f;
#pragma unroll
        for (int t = 0; t < 9; ++t)
#pragma unroll
            for (int e = 0; e < 4; ++e) { const float p = __expf(st[t][e] - mx); st[t][e] = p; sum += p; }
        sum += __shfl_xor(sum, 16); sum += __shfl_xor(sum, 32);
        const float inv = __builtin_amdgcn_rcpf(sum + __expf(sink - mx));
        f32x4 o[4];
#pragma unroll
        for (int dt = 0; dt < 4; ++dt) o[dt] = (f32x4){0.f, 0.f, 0.f, 0.f};
#pragma unroll
        for (int pr = 0; pr < 5; ++pr) {
            const v4u pw = (v4u){cvtpk(st[2 * pr][0], st[2 * pr][1]), cvtpk(st[2 * pr][2], st[2 * pr][3]), cvtpk(st[2 * pr + 1][0], st[2 * pr + 1][1]), cvtpk(st[2 * pr + 1][2], st[2 * pr + 1][3])};
            const bf16x8 pf = __builtin_bit_cast(bf16x8, pw);
            const int q4 = r >> 2, p4 = r & 3;
            const int k0 = 16 * (a + 2 * pr) + 4 * g + q4; int k1 = k0 + 16; if (k1 > 255) k1 = 255;
            const unsigned b0 = lbase + SW_V + 128u * k0 + 8u * (p4 & 1), b1 = lbase + SW_V + 128u * k1 + 8u * (p4 & 1);
            const unsigned x0 = (unsigned)(k0 & 7), x1 = (unsigned)(k1 & 7), ph = (unsigned)(p4 >> 1);
            u16x4 r0, r1, r2, r3, r4, r5, r6, r7;
            asm volatile("ds_read_b64_tr_b16 %0, %8\n\tds_read_b64_tr_b16 %1, %9\n\tds_read_b64_tr_b16 %2, %10\n\tds_read_b64_tr_b16 %3, %11\n\t"
                         "ds_read_b64_tr_b16 %4, %12\n\tds_read_b64_tr_b16 %5, %13\n\tds_read_b64_tr_b16 %6, %14\n\tds_read_b64_tr_b16 %7, %15\n\ts_waitcnt lgkmcnt(0)"
                         : "=&v"(r0), "=&v"(r1), "=&v"(r2), "=&v"(r3), "=&v"(r4), "=&v"(r5), "=&v"(r6), "=&v"(r7)
                         : "v"(b0 + 16u * ((0u + ph) ^ x0)), "v"(b1 + 16u * ((0u + ph) ^ x1)), "v"(b0 + 16u * ((2u + ph) ^ x0)), "v"(b1 + 16u * ((2u + ph) ^ x1)),
                           "v"(b0 + 16u * ((4u + ph) ^ x0)), "v"(b1 + 16u * ((4u + ph) ^ x1)), "v"(b0 + 16u * ((6u + ph) ^ x0)), "v"(b1 + 16u * ((6u + ph) ^ x1)) : "memory");
            const bf16x8 v0 = (bf16x8){(short)r0[0], (short)r0[1], (short)r0[2], (short)r0[3], (short)r1[0], (short)r1[1], (short)r1[2], (short)r1[3]};
            const bf16x8 v1 = (bf16x8){(short)r2[0], (short)r2[1], (short)r2[2], (short)r2[3], (short)r3[0], (short)r3[1], (short)r3[2], (short)r3[3]};
            const bf16x8 v2 = (bf16x8){(short)r4[0], (short)r4[1], (short)r4[2], (short)r4[3], (short)r5[0], (short)r5[1], (short)r5[2], (short)r5[3]};
            const bf16x8 v3 = (bf16x8){(short)r6[0], (short)r6[1], (short)r6[2], (short)r6[3], (short)r7[0], (short)r7[1], (short)r7[2], (short)r7[3]};
            o[0] = __builtin_amdgcn_mfma_f32_16x16x32_bf16(v0, pf, o[0], 0, 0, 0); o[1] = __builtin_amdgcn_mfma_f32_16x16x32_bf16(v1, pf, o[1], 0, 0, 0);
            o[2] = __builtin_amdgcn_mfma_f32_16x16x32_bf16(v2, pf, o[2], 0, 0, 0); o[3] = __builtin_amdgcn_mfma_f32_16x16x32_bf16(v3, pf, o[3], 0, 0, 0);
        }
        bf16* op = OABC + qrow * 4096 + 3072 + head * 64 + 4 * g;
#pragma unroll
        for (int dt = 0; dt < 4; ++dt) { v2u w; w.x = pk2(o[dt][0] * inv, o[dt][1] * inv); w.y = pk2(o[dt][2] * inv, o[dt][3] * inv); *(v2u*)(op + 16 * dt) = w; }
    }
}

__device__ __forceinline__ void swa_sample_wave(Frame& F, int item, const bf16* Z, const float* sinks, const float* ck, const float* cv, bf16* OABC) {
    const Tix T = tix();
    const int lane = T.lane, b = item >> 4, head = item & 15, kv = head >> 2; const size_t row = MP + b;
    LAS float* sq = (LAS float*)(F.lds + T.wave * 1024); LAS float* sp = sq + 64;
    const float slope = exp2f(-0.5f * (float)(head + 1)), sink = sinks[head];
    sq[lane] = bf2f(Z[row * NZ + ZQC + head * 64 + lane]);
    LDS_WAIT();
    float s2[2];
#pragma unroll
    for (int u = 0; u < 2; ++u) { const int j = 1 + lane + 64 * u;
        float s = 0.f;
        if (j < 128) { const float* kp = ck + ((size_t)(b * 128 + j) * 4 + kv) * 64;
#pragma unroll
            for (int d4 = 0; d4 < 16; ++d4) { const f32x4 kk = *(const f32x4*)(kp + 4 * d4); const f32x4 qq = *(const LAS f32x4*)(sq + 4 * d4); s += (qq.x * kk.x + qq.y * kk.y) + (qq.z * kk.z + qq.w * kk.w); } }
        else { const bf16* kp = Z + row * NZ + ZKC + kv * 64;
#pragma unroll
            for (int d = 0; d < 64; ++d) s += sq[d] * bf2f(kp[d]); }
        s2[u] = s * 0.125f - slope * (float)(128 - j); }
    float mx = fmaxf(fmaxf(s2[0], s2[1]), sink);
#pragma unroll
    for (int o = 1; o < 64; o <<= 1) mx = fmaxf(mx, __shfl_xor(mx, o));
    const float p0 = __expf(s2[0] - mx), p1 = __expf(s2[1] - mx);
    const float inv = __builtin_amdgcn_rcpf(wave_sum(p0 + p1) + __expf(sink - mx));
    sp[lane] = p0; sp[64 + lane] = p1;
    LDS_WAIT();
    { const int jq = lane >> 4, d4 = 4 * (lane & 15); f32x4 acc = (f32x4){0.f, 0.f, 0.f, 0.f};
      f32x4 vv[32];
#pragma unroll
      for (int i = 0; i < 32; ++i) { const int jj = 4 * i + jq;
          if (jj < 127) vv[i] = *(const f32x4*)(cv + ((size_t)(b * 128 + jj + 1) * 4 + kv) * 64 + d4);
          else { const v2u w = *(const v2u*)(Z + row * NZ + ZVC + kv * 64 + d4); vv[i] = (f32x4){__uint_as_float(w.x << 16), __uint_as_float(w.x & 0xffff0000u), __uint_as_float(w.y << 16), __uint_as_float(w.y & 0xffff0000u)}; } }
#pragma unroll
      for (int i = 0; i < 32; ++i) acc += vv[i] * sp[4 * i + jq];
#pragma unroll
      for (int j = 0; j < 4; ++j) { acc[j] += __shfl_xor(acc[j], 16); acc[j] += __shfl_xor(acc[j], 32); }
      if (jq == 0) { v2u w; w.x = pk2(acc[0] * inv, acc[1] * inv); w.y = pk2(acc[2] * inv, acc[3] * inv); *(v2u*)(OABC + row * 4096 + 3072 + head * 64 + d4) = w; } }
    LDS_WAIT();
}

constexpr int MD_PITCH = 208;
__device__ __forceinline__ void mod_direct(Frame& F, const float* cprm  , const float* csmp  , const float* wada  , const float* bada  , float* MOD  ) {
    const Tix T = tix();
    const int lane = T.lane, wave = T.wave, r = lane & 15, g = lane >> 4;
    constexpr int MD_CA = 128 * MD_PITCH, CA_PITCH = 272;
    for (int sl = (int)blockIdx.x; sl < 256; sl += F.G) {
        const int l = sl >> 7, n0 = (sl & 127) * 96;
        const float* W = wada + (size_t)l * D * NADA + n0;
        f32x4 acc[7];
#pragma unroll
        for (int i = 0; i < 7; ++i) acc[i] = (f32x4){0.f, 0.f, 0.f, 0.f};
        f32x4 pw[6];
        const unsigned sk0 = (unsigned)(T.tid / 24), sq0 = (unsigned)(T.tid % 24);
#define MD_LOAD(kb) do { unsigned kk = sk0, q = sq0; _Pragma("unroll") for (int i = 0; i < 6; ++i) { pw[i] = *(const f32x4*)(W + (size_t)((kb) * 128 + kk) * NADA + 4 * q); q += 8; kk += 21; if (q >= 24) { q -= 24; kk += 1; } } } while (0)
        f32x4 pc[9];
#define MD_CLOAD(kb) do { _Pragma("unroll") for (int i = 0; i < 9; ++i) { const int e = T.tid + 512 * i, m = e >> 5, q = e & 31; \
            pc[i] = m < 2 ? *(const f32x4*)(cprm + (size_t)m * D + (kb) * 128 + 4 * q) : (m < 130 ? *(const f32x4*)(csmp + (size_t)(m - 2) * D + (kb) * 128 + 4 * q) : (f32x4){0.f, 0.f, 0.f, 0.f}); } } while (0)
        MD_LOAD(0);
        const unsigned lbase = (unsigned)(size_t)F.lds;
        for (int kb = 0; kb < 16; ++kb) {
            MD_CLOAD(kb);
            __syncthreads();
            { unsigned kk = sk0, q = sq0;
#pragma unroll
              for (int i = 0; i < 6; ++i) { v2u w; w.x = pk2(pw[i].x, pw[i].y); w.y = pk2(pw[i].z, pw[i].w); *(LAS v2u*)(F.lds + kk * MD_PITCH + 8 * q) = w; q += 8; kk += 21; if (q >= 24) { q -= 24; kk += 1; } } }
#pragma unroll
            for (int i = 0; i < 9; ++i) { const int e = T.tid + 512 * i, m = e >> 5, q = e & 31; const f32x4 c4 = pc[i];
                v2u w; w.x = pk2(siluf_(c4.x), siluf_(c4.y)); w.y = pk2(siluf_(c4.z), siluf_(c4.w)); *(LAS v2u*)(F.lds + MD_CA + m * CA_PITCH + 8 * q) = w; }
            __syncthreads();
            if (kb + 1 < 16) MD_LOAD(kb + 1);
#pragma unroll
            for (int ks = 0; ks < 4; ++ks) {
                const bf16x8 a0 = *(const LAS bf16x8*)(F.lds + MD_CA + (16 * wave + r) * CA_PITCH + 64 * ks + 16 * g), a8 = *(const LAS bf16x8*)(F.lds + MD_CA + (128 + r) * CA_PITCH + 64 * ks + 16 * g);
                const unsigned q4 = (unsigned)(r >> 2), p4 = (unsigned)(r & 3);
                const unsigned a_lo = lbase + (32u * ks + 8u * g + q4) * MD_PITCH + 8u * p4, a_hi = a_lo + 4u * MD_PITCH;
                u16x4 t0, t1, t2, t3, t4, t5, t6, t7, t8, t9, ta, tb;
                asm volatile("ds_read_b64_tr_b16 %0, %12\n\tds_read_b64_tr_b16 %1, %13\n\tds_read_b64_tr_b16 %2, %12 offset:32\n\tds_read_b64_tr_b16 %3, %13 offset:32\n\t"
                             "ds_read_b64_tr_b16 %4, %12 offset:64\n\tds_read_b64_tr_b16 %5, %13 offset:64\n\tds_read_b64_tr_b16 %6, %12 offset:96\n\tds_read_b64_tr_b16 %7, %13 offset:96\n\t"
                             "ds_read_b64_tr_b16 %8, %12 offset:128\n\tds_read_b64_tr_b16 %9, %13 offset:128\n\tds_read_b64_tr_b16 %10, %12 offset:160\n\tds_read_b64_tr_b16 %11, %13 offset:160\n\ts_waitcnt lgkmcnt(0)"
                             : "=&v"(t0), "=&v"(t1), "=&v"(t2), "=&v"(t3), "=&v"(t4), "=&v"(t5), "=&v"(t6), "=&v"(t7), "=&v"(t8), "=&v"(t9), "=&v"(ta), "=&v"(tb) : "v"(a_lo), "v"(a_hi) : "memory");
#define MD_FR(lo, hi) (bf16x8){(short)lo[0], (short)lo[1], (short)lo[2], (short)lo[3], (short)hi[0], (short)hi[1], (short)hi[2], (short)hi[3]}
                const bf16x8 bfr[6] = {MD_FR(t0, t1), MD_FR(t2, t3), MD_FR(t4, t5), MD_FR(t6, t7), MD_FR(t8, t9), MD_FR(ta, tb)};
#undef MD_FR
#pragma unroll
                for (int nt = 0; nt < 6; ++nt) {
                    acc[nt] = __builtin_amdgcn_mfma_f32_16x16x32_bf16(a0, bfr[nt], acc[nt], 0, 0, 0);
                    if (nt == wave) acc[6] = __builtin_amdgcn_mfma_f32_16x16x32_bf16(a8, bfr[nt], acc[6], 0, 0, 0);
                }
            }
        }
#undef MD_CLOAD
#undef MD_LOAD
        float* mo = MOD + (size_t)l * 256 * NADA; const float* bb = bada + (size_t)l * NADA;
#pragma unroll
        for (int nt = 0; nt < 6; ++nt) { const int col = n0 + 16 * nt + r; const float bv = bb[col];
#pragma unroll
            for (int e = 0; e < 4; ++e) mo[(size_t)(16 * wave + 4 * g + e) * NADA + col] = acc[nt][e] + bv; }
        if (wave < 6) { const int col = n0 + 16 * wave + r; const float bv = bb[col];
#pragma unroll
            for (int e = 0; e < 4; ++e) mo[(size_t)(128 + 4 * g + e) * NADA + col] = acc[6][e] + bv; }
        __syncthreads();
    }
}

__device__ __forceinline__ void gla_scan(Frame& F, float* GST, const float* GAMS) {
    const Tix T = tix();
    const int gw = F.vcu * NWAVES + T.wave, NGW = F.G * NWAVES, g = T.lane >> 4;
    for (int item = gw; item < 8 * 4 * 8 * 16; item += NGW) {
        const int i = item & 15, w = (item >> 4) & 7, qs = (item >> 7) & 3, bh = item >> 9;
        f32x4 G[8], Gm[8];
#pragma unroll
        for (int sc = 0; sc < 8; ++sc) { const int grp = bh * 8 + sc;
            G[sc] = *((const f32x4*)(GST + ((((size_t)grp * 4 + qs) * 8 + w) * 16 + i) * 256) + T.lane);
            Gm[sc] = *(const f32x4*)(GAMS + (size_t)grp * 256 + 16 * i + 4 * g); }
        f32x4 S = G[0] * 0.0f;
#pragma unroll
        for (int sc = 0; sc < 8; ++sc) { const int grp = bh * 8 + sc;
            *((f32x4*)(GST + ((((size_t)grp * 4 + qs) * 8 + w) * 16 + i) * 256) + T.lane) = S;
            S = Gm[sc] * S + G[sc]; }
    }
}
constexpr int NPH = 27;
#ifndef EN_CONV
#define EN_CONV 1
#endif
#ifndef EN_MOD
#define EN_MOD 1
#endif
#ifndef EN_NORM
#define EN_NORM 1
#endif
#ifndef EN_WIN
#define EN_WIN 1
#endif
#ifndef EN_GK
#define EN_GK 1
#endif
#ifndef EN_GLAN
#define EN_GLAN 1
#endif
#ifndef EN_MIXA
#define EN_MIXA 1
#endif
#ifndef EN_MIXB
#define EN_MIXB 1
#endif
#ifndef EN_PROJ
#define EN_PROJ 1
#endif
#ifndef EN_WO
#define EN_WO 1
#endif
#ifndef EN_FFI
#define EN_FFI 1
#endif
#ifndef EN_FFO
#define EN_FFO 1
#endif
#ifndef EN_FINAL
#define EN_FINAL 1
#endif
#ifndef MK_PROBE
#define MK_PROBE 0
#endif
#ifndef MK_REP_K
#define MK_REP_K 0
#endif
#ifndef MK_REP_N
#define MK_REP_N 0
#endif
#ifndef MK_REP_VAR
#define MK_REP_VAR 0
#endif
#ifndef MK_ONE_LAUNCH
#define MK_ONE_LAUNCH 1
#endif
typedef const __attribute__((address_space(4))) Prm* KPrm;
__device__ __forceinline__ KPrm kargs() { KPrm p = (KPrm)__builtin_amdgcn_kernarg_segment_ptr(); asm volatile("" : "+s"(p)); return p; }
#define PH_BEGIN KPrm K = kargs(); unsigned char* ws = K->ws; (void)ws;
__global__ void __launch_bounds__(NT, 2) mega_fwd(Prm P_unused) {
    extern __shared__ __attribute__((aligned(16))) unsigned char lds_raw[];
    Frame F;
    F.lds = (LAS unsigned char*)lds_raw;
    F.G = gridDim.x; { const int bx = blockIdx.x; F.vcu = (F.G % 8 == 0) ? (bx % 8) * (F.G / 8) + bx / 8 : bx; }
    volatile LAS unsigned* MISC = (volatile LAS unsigned*)(F.lds + MISC_OFF);
    if (threadIdx.x < 64) MISC[threadIdx.x] = 0u;
    __syncthreads();
    int lo, hi;
    XcdBarrier bar;
    { KPrm K = kargs(); lo = K->ph_lo; hi = K->ph_hi; unsigned* ctl = (unsigned*)(K->ws + WS_CTL);
      bar.bar = ctl + CW_BAR; bar.x = 0; bar.st = nullptr;
      if (hi - lo > 1) bar = xcd_barrier_post(ctl + CW_BAR, MISC + 8); }
#define IN(k) (lo <= (k) && (k) < hi)
#define SEAM(k) do { if (IN(k) && IN((k) + 1)) xcd_barrier(bar); } while (0)
#define WSP(T, off) ((T*)(ws + (off)))

    if (IN(0)) {
        for (int half = 0; half < 2; ++half) {
            if ((half == 0) == ((((int)blockIdx.x >> 3) & 1) == 1)) { if (EN_MOD) { PH_BEGIN mod_direct(F, K->in[I_CP], K->in[I_CS], K->in[I_WADA], K->in[I_BADA], WSP(float, WS_MOD)); } }
            else { if (EN_CONV) phase_convert(F); }
        }
    }
    SEAM(1);
#if 0
    SEAM(0);
    if (EN_MOD && IN(1)) {
        PH_BEGIN
        const int c = (int)blockIdx.x, l = c / 48;
        if (l < 2) {
            pg8::Gemm g{WSP(const bf16, WS_CA), WSP(const bf16, WS_WADA) + (size_t)l * NADA * D, 256, NADA, D, D};
            pg8::StaticOrder S; S.init(256, NADA, 1 << 20, c - 48 * l, D);
            pg8::EpiF32 E{WSP(float, WS_MOD) + (size_t)l * 256 * NADA, NADA, K->in[I_BADA] + (size_t)l * NADA};
            pg8::gemm_phase<pg8::EpiF32, pg8::StaticOrder, true, true>(F.lds, g, S, E);
        }
    }
    SEAM(1);
#endif

    for (int l = 0; l < 2; ++l) {
        const int pb = 2 + 12 * l;
        if (EN_NORM && IN(pb + 0)) { PH_BEGIN phase_norm_t<false>(F, WSP(float, WS_X), K->in[I_N1W] + (size_t)l * D, WSP(const float, WS_MOD) + (size_t)l * 256 * NADA, MOD_SH1, MOD_SC1, WSP(bf16, WS_H), nullptr, WSP(const float, WS_PART + 16 * MiB), l == 0 ? 0 : 11, l == 0 ? K->in[I_XP] : nullptr); }
        SEAM(pb + 0);
        if (EN_WIN && IN(pb + 1)) {
            PH_BEGIN
            pg8::Gemm g{WSP(const bf16, WS_H), WSP(const bf16, WS_WIN) + (size_t)l * NZW * D, MT, NZ, D, D};
            pg8::StaticOrder S; S.init(MT, NZ, F.G, (int)blockIdx.x, D);
            pg8::EpiZ E{WSP(bf16, WS_Z), NZ, ZGT / 256, K->var};
            pg8::gemm_phase<pg8::EpiZ, pg8::StaticOrder, true, true>(F.lds, g, S, E);
        }
        SEAM(pb + 1);
        if (IN(pb + 2)) {
            PH_BEGIN
            const bf16* Zb = WSP(const bf16, WS_Z); const bf16* Hb = WSP(const bf16, WS_H); const bf16* Wl = WSP(const bf16, WS_WIN) + (size_t)l * NZW * D + (size_t)ZLR * D;
            const float* wgk2 = K->in[I_WGK2] + (size_t)l * 16 * 1024; const float* bgk = K->in[I_BGK] + (size_t)l * 1024;
            const int ow = (int)blockIdx.x, OW = F.G;
            for (int step = 0; step < 3; ++step) {
                const int which = (step + ow) % 3;
                if (which == 0) {
                    if (EN_MIXA && !(K->var & 8)) for (int u = ow; u < 512; u += OW) gla_sample_unit(F, u, Zb, Hb, Wl, wgk2, bgk, K->in[I_SGLA] + (size_t)l * 128 * 4 * 256 * 512, K->out + O_SGS + (size_t)l * 128 * 4 * 256 * 512, K->in[I_GLANW] + (size_t)l * 512, WSP(bf16, WS_OABC));
                } else if (which == 1) {
                    if (EN_GLAN && !(K->var & 16)) for (int p = ow; p < 256; p += OW) {
                        const int pb_ = p >> 7, php = (p >> 6) & 1, pc = p & 63;
#pragma unroll 1
                        for (int i = 0; i < 2; ++i) gla_prep_unit(F, ((pb_ * 4 + 2 * php + i) << 6) + pc, Zb, Hb, Wl, wgk2, bgk, WSP(bf16, WS_QT), WSP(bf16, WS_KH), WSP(bf16, WS_AI), WSP(float, WS_GAM), i == 1); }
                } else {
                    if (EN_MIXA && !(K->var & 32)) {
                        __syncthreads();
                        if (!(K->var & 64)) gm_ln_rows(F, ow, OW, Zb, K->in[I_GMNW] + (size_t)l * 1024, K->in[I_GMNB] + (size_t)l * 1024, WSP(bf16, WS_VNB), K->out + O_GMV + (size_t)l * 128 * 1024, K->in[I_GMWS] + (size_t)l * 4 * 128 * 128, K->in[I_GMBS] + (size_t)l * 4 * 128, WSP(bf16, WS_OABC));
                        if (!(K->var & 128)) for (int u = ow; u < 256; u += OW) swa_unit(F, u, Zb, K->in[I_SINK] + (size_t)l * 16, WSP(bf16, WS_OABC));
                        __syncthreads();
                        if (!(K->var & 256)) for (int it = ow * NWAVES + tix().wave; it < MS * 16; it += OW * NWAVES) swa_sample_wave(F, it, Zb, K->in[I_SINK] + (size_t)l * 16, K->in[I_CK] + (size_t)l * 128 * 128 * 256, K->in[I_CV] + (size_t)l * 128 * 128 * 256, WSP(bf16, WS_OABC));
                        __syncthreads();
                        cache_outs(F, ow, OW, l, Zb, K->out);
                    }
                }
            }
        }
        SEAM(pb + 2);
        if (IN(pb + 3)) {
            PH_BEGIN
            if (EN_GLAN) for (int w = (int)blockIdx.x; w < 256; w += F.G) gla_pass<false>(F, w, WSP(const bf16, WS_Z), WSP(const bf16, WS_QT), WSP(const bf16, WS_KH), WSP(const bf16, WS_AI), WSP(const float, WS_GAM), WSP(float, WS_GST), WSP(float, WS_GAMS), nullptr, nullptr);
            if (EN_MIXB) for (int u = (int)blockIdx.x; u < 256; u += F.G) gm_mix_unit(F, u, WSP(const bf16, WS_Z), WSP(const bf16, WS_VNB), K->in[I_GMWS] + (size_t)l * 4 * 128 * 128, K->in[I_GMBS] + (size_t)l * 4 * 128, WSP(bf16, WS_OABC));
        }
        SEAM(pb + 3);
        if (EN_GLAN && IN(pb + 4)) { PH_BEGIN gla_scan(F, WSP(float, WS_GST), WSP(const float, WS_GAMS)); }
        SEAM(pb + 4);
        if (IN(pb + 5)) {
            PH_BEGIN
            if (EN_GLAN) for (int w = (int)blockIdx.x; w < 256; w += F.G) gla_pass<true>(F, w, WSP(const bf16, WS_Z), WSP(const bf16, WS_QT), WSP(const bf16, WS_KH), WSP(const bf16, WS_AI), WSP(const float, WS_GAM), WSP(float, WS_GST), WSP(float, WS_GAMS), WSP(float, WS_OB), K->out + O_SGP + (size_t)l * 2 * 4 * 256 * 512);
        }
        SEAM(pb + 5);
        if (EN_MIXB && IN(pb + 6)) { PH_BEGIN gla_fin(F, WSP(const float, WS_OB), WSP(const bf16, WS_Z), K->in[I_GLANW] + (size_t)l * 512, WSP(bf16, WS_OABC)); }
        SEAM(pb + 6);
        if (EN_PROJ && IN(pb + 7)) {
            PH_BEGIN
            pg8::Gemm g{WSP(const bf16, WS_OABC), WSP(const bf16, WS_WPRJ) + (size_t)l * D * 4096, MT, D, 4096, 4096};
            pg8::MiniOrder S; S.init(F.G, (int)blockIdx.x, 4096, 8, K->var);
            pg8::EpiProjR E{WSP(const bf16, WS_Z), NZ, ZGT, WSP(float, WS_PART), WSP(bf16, WS_MG), MP, K->var};
            pg8::gemm_phase<pg8::EpiProjR, pg8::MiniOrder, true, true>(F.lds, g, S, E);
        }
        SEAM(pb + 7);
        if (EN_WO && IN(pb + 8)) {
            PH_BEGIN
            pg8::Gemm g{WSP(const bf16, WS_MG), WSP(const bf16, WS_WO) + (size_t)l * D * D, MT, D, D, D};
            pg8::MiniOrder S; S.init(F.G, (int)blockIdx.x, D, 4, K->var);
            {
              const Tix T = tix(); pg8::Unit u;
              for (int i = 0; S.next(i, u); ++i) if (u.pm >= 32) { const int k0 = 64 * u.kt0, kw = 16 * u.nt;
                  for (int idx0 = T.tid; idx0 < 128 * kw; idx0 += 4 * NT) {
                      f32x4 pv[4][8];
#pragma unroll
                      for (int q = 0; q < 4; ++q) { const int idx = idx0 + q * NT, r = idx / kw, c = k0 + 4 * (idx % kw);
#pragma unroll
                          for (int s = 0; s < 8; ++s) pv[q][s] = *(const f32x4*)(WSP(const float, WS_PART) + ((size_t)s * 128 + r) * D + c); }
#pragma unroll
                      for (int q = 0; q < 4; ++q) { const int idx = idx0 + q * NT, r = idx / kw, c = k0 + 4 * (idx % kw);
                          const f32x4 v = ((pv[q][0] + pv[q][1]) + (pv[q][2] + pv[q][3])) + ((pv[q][4] + pv[q][5]) + (pv[q][6] + pv[q][7]));
                          v2u w; w.x = pk2(v.x, v.y); w.y = pk2(v.z, v.w); *(v2u*)(WSP(bf16, WS_MG) + (size_t)(MP + r) * D + c) = w; } }
                  for (int idx = T.tid; idx < 128 * kw; idx += NT) { const int r = 128 + idx / kw, c = k0 + 4 * (idx % kw); *(v2u*)(WSP(bf16, WS_MG) + (size_t)(MP + r) * D + c) = (v2u){0u, 0u}; } }
              VM_WAIT(); __syncthreads(); }
            pg8::EpiResid E{WSP(float, WS_X), l == 0 ? K->in[I_XP] : WSP(const float, WS_X), WSP(const float, WS_MOD) + (size_t)l * 256 * NADA + MOD_G1, NADA, WSP(float, WS_PART + 8 * MiB), MP, K->var};
            pg8::gemm_phase<pg8::EpiResid, pg8::MiniOrder, true, true>(F.lds, g, S, E);
        }
        SEAM(pb + 8);
        if (EN_NORM && IN(pb + 9)) { PH_BEGIN phase_norm_t<false>(F, WSP(float, WS_X), K->in[I_N2W] + (size_t)l * D, WSP(const float, WS_MOD) + (size_t)l * 256 * NADA, MOD_SH2, MOD_SC2, WSP(bf16, WS_H), nullptr, WSP(const float, WS_PART + 8 * MiB), 8); }
        SEAM(pb + 9);
        if (EN_FFI && IN(pb + 10)) {
            PH_BEGIN
            pg8::Gemm g{WSP(const bf16, WS_H), WSP(const bf16, WS_WFI) + (size_t)l * 2 * FF * D, MT, 2 * FF, D, D};
            pg8::StaticOrder S; S.init(MT, 2 * FF, F.G, (int)blockIdx.x, D);
            pg8::EpiSwiGLU E{WSP(bf16, WS_ACT), FF};
            pg8::gemm_phase<pg8::EpiSwiGLU, pg8::StaticOrder, true, true>(F.lds, g, S, E);
        }
        SEAM(pb + 10);
        if (EN_FFO && IN(pb + 11)) {
            PH_BEGIN
            pg8::Gemm g{WSP(const bf16, WS_ACT), WSP(const bf16, WS_WFO) + (size_t)l * D * FF, MT, D, FF, FF};
            pg8::MiniOrder S; S.init(F.G, (int)blockIdx.x, FF, 8, K->var);
            pg8::EpiResid E{WSP(float, WS_X), WSP(const float, WS_X), WSP(const float, WS_MOD) + (size_t)l * 256 * NADA + MOD_G2, NADA, WSP(float, WS_PART + 16 * MiB), MP, K->var};
            pg8::gemm_phase<pg8::EpiResid, pg8::MiniOrder, true, true>(F.lds, g, S, E);
        }
        SEAM(pb + 11);
    }
    if (EN_FINAL && IN(26)) { PH_BEGIN phase_norm_t<true>(F, WSP(float, WS_X), K->in[I_FNW], nullptr, 0, 0, nullptr, K->out, WSP(const float, WS_PART + 16 * MiB), 11); }
#undef IN
#undef SEAM
}

extern "C" void kernel_launch(void* const* d_in, const int* in_sizes, int n_in, void* d_out, int out_size, void* d_ws, size_t ws_size, hipStream_t stream) {
    static int grid = 0;
    if (grid == 0) {
        if (n_in != N_IN || (size_t)out_size != O_END || ws_size < WS_END) { fprintf(stderr, "kernel_launch: unexpected problem (n_in %d, out %d, ws %zu); nothing launched\n", n_in, out_size, ws_size); grid = -1; return; }
        int dev = 0, cus = 0, per_cu = 0;
        if (hipGetDevice(&dev) != hipSuccess || hipDeviceGetAttribute(&cus, hipDeviceAttributeMultiprocessorCount, dev) != hipSuccess) { grid = -1; return; }
        if (hipFuncSetAttribute((const void*)mega_fwd, hipFuncAttributeMaxDynamicSharedMemorySize, LDS_BYTES) != hipSuccess) { fprintf(stderr, "kernel_launch: hipFuncSetAttribute failed\n"); grid = -1; return; }
        if (hipOccupancyMaxActiveBlocksPerMultiprocessor(&per_cu, (const void*)mega_fwd, NT, LDS_BYTES) != hipSuccess || per_cu < 1) { fprintf(stderr, "kernel_launch: occupancy query says %d\n", per_cu); }
        (void)hipGetLastError();
        grid = cus;
        if (grid < 128) { fprintf(stderr, "kernel_launch: this build needs >= 128 CUs (mini-unit deal)\n"); grid = -1; return; }
    }
    if (grid < 0) return;
    (void)hipMemsetAsync((char*)d_ws + WS_CTL, 0, CTL_ZERO_BYTES, stream);
    Prm p{};
    for (int i = 0; i < N_IN; ++i) p.in[i] = (const float*)d_in[i];
    p.out = (float*)d_out; p.ws = (unsigned char*)d_ws;
#if MK_ONE_LAUNCH
    p.ph_lo = 0; p.ph_hi = NPH;
    hipLaunchKernelGGL(mega_fwd, dim3(grid), dim3(NT), LDS_BYTES, stream, p);
#if MK_PROBE
    for (int i = 0; i < MK_REP_N; ++i) { p.ph_lo = MK_REP_K; p.ph_hi = MK_REP_K + 1; p.var = MK_REP_VAR; hipLaunchKernelGGL(mega_fwd, dim3(grid), dim3(NT), LDS_BYTES, stream, p); }
#endif
#else
    for (int k = 0; k < NPH; ++k) { p.ph_lo = k; p.ph_hi = k + 1; hipLaunchKernelGGL(mega_fwd, dim3(grid), dim3(NT), LDS_BYTES, stream, p); }
#endif
}
```
